# Optimizing an MI355X kernel written in HIP

```python
import jax, jax.numpy as jnp
from jax import lax
import numpy as np

D_MODEL = 1024
BATCH = 2
SEQ = 8192
DEPTH = 1
DEC_BATCH = 128
DEC_SEQ = 8
PAST_LEN = 16384
PAGE_SIZE = 128

D_LRU = D_MODEL // 2
LRU_BLOCKS = 8
LRU_BLOCK = D_LRU // LRU_BLOCKS
CONV_W = 4
LRU_C = 8.0
MLA_HEADS = 8
QK_NOPE = 64
QK_ROPE = 32
V_DIM = 64
Q_LORA = D_MODEL // 4
KV_LORA = D_MODEL // 8
D_MLA = MLA_HEADS * V_DIM
D_MIX = D_LRU + D_MLA
D_IN = 2 * D_LRU + Q_LORA + KV_LORA + QK_ROPE
D_FF = 2816
ROPE_BASE = 10000.0
Q_BLOCK = 128
EPS = 1e-6

kernel_name = 'hymba_rglru_mla_macaron_step'


def rmsnorm(x, g):
    xf = x.astype(jnp.float32)
    y = xf * lax.rsqrt(jnp.mean(xf * xf, axis=-1, keepdims=True) + EPS)
    return (y * g.astype(jnp.float32)).astype(x.dtype)


def swiglu(x, w_gate, w_up, w_down):
    return (jax.nn.silu(x @ w_gate) * (x @ w_up)) @ w_down


def rope(x, pos):
    half = x.shape[-1] // 2
    freqs = ROPE_BASE ** (-jnp.arange(half, dtype=jnp.float32) / half)
    ang = pos.astype(jnp.float32)[:, None] * freqs[None, :]
    cos = jnp.cos(ang)[None, :, None, :]
    sin = jnp.sin(ang)[None, :, None, :]
    xf = x.astype(jnp.float32)
    x1, x2 = xf[..., :half], xf[..., half:]
    return jnp.concatenate([x1 * cos - x2 * sin, x2 * cos + x1 * sin], axis=-1).astype(x.dtype)


def causal_conv(x, buf, w, b):
    S = x.shape[1]
    xp = jnp.concatenate([buf.astype(x.dtype), x], axis=1)
    y = b + w[0] * xp[:, 0:S]
    for k in range(1, CONV_W):
        y = y + w[k] * xp[:, k:k + S]
    return y, xp[:, xp.shape[1] - (CONV_W - 1):]


def rg_lru(x, h0, w_a, b_a, w_i, b_i, lam):
    B, S, _ = x.shape
    xb = x.reshape(B, S, LRU_BLOCKS, LRU_BLOCK)
    r = jax.nn.sigmoid(jnp.einsum('bsnd,nde->bsne', xb, w_a).reshape(B, S, D_LRU) + b_a)
    i = jax.nn.sigmoid(jnp.einsum('bsnd,nde->bsne', xb, w_i).reshape(B, S, D_LRU) + b_i)
    log_a = -LRU_C * r.astype(jnp.float32) * jax.nn.softplus(-lam.astype(jnp.float32))
    a = jnp.exp(log_a)
    u = jnp.sqrt(-jnp.expm1(2.0 * log_a)) * (i * x).astype(jnp.float32)

    def step(h, au):
        a_t, u_t = au
        h = a_t * h + u_t
        return h, h

    h_last, hs = lax.scan(step, h0.astype(jnp.float32), (a.swapaxes(0, 1), u.swapaxes(0, 1)))
    return hs.swapaxes(0, 1).astype(x.dtype), h_last.astype(h0.dtype)


def mla_attend(q_lat, q_rope, q_pos, c_kv, k_rope, k_pos):
    B, S, H, C = q_lat.shape
    R = q_rope.shape[-1]
    qb = min(Q_BLOCK, S)
    nqb = S // qb
    scale = (QK_NOPE + QK_ROPE) ** -0.5

    def block(args):
        ql, qr, qp = args
        s = (jnp.einsum('bqhc,btc->bhqt', ql, c_kv)
             + jnp.einsum('bqhr,btr->bhqt', qr, k_rope)).astype(jnp.float32) * scale
        mask = k_pos[None, :] <= qp[:, None]
        s = jnp.where(mask[None, None], s, -jnp.inf)
        p = jax.nn.softmax(s, axis=-1).astype(c_kv.dtype)
        return jnp.einsum('bhqt,btc->bqhc', p, c_kv)

    xs = (q_lat.reshape(B, nqb, qb, H, C).swapaxes(0, 1),
          q_rope.reshape(B, nqb, qb, H, R).swapaxes(0, 1),
          q_pos.reshape(nqb, qb))
    o = lax.map(block, xs)
    return o.swapaxes(0, 1).reshape(B, S, H, C)


def mixer(hn, pos, past_c, past_kr, h0, conv0, p):
    B, S, _ = hn.shape
    z = hn @ p['w_in']
    o1 = D_LRU
    o2 = 2 * D_LRU
    o3 = o2 + Q_LORA
    o4 = o3 + KV_LORA
    x_l, g_l, c_q, c_kv, k_r = z[..., :o1], z[..., o1:o2], z[..., o2:o3], z[..., o3:o4], z[..., o4:]
    xc, conv_new = causal_conv(x_l, conv0, p['conv_w'], p['conv_b'])
    hs, h_new = rg_lru(xc, h0, p['lru_w_a'], p['lru_b_a'], p['lru_w_i'], p['lru_b_i'], p['lru_lambda'])
    y_lru = jax.nn.gelu(g_l) * hs
    q = (rmsnorm(c_q, p['q_norm']) @ p['w_q_up']).reshape(B, S, MLA_HEADS, QK_NOPE + QK_ROPE)
    q_nope = q[..., :QK_NOPE]
    q_rope = rope(q[..., QK_NOPE:], pos)
    c_kv = rmsnorm(c_kv, p['kv_norm'])
    k_r = rope(k_r[:, :, None, :], pos)[:, :, 0, :]
    q_lat = jnp.einsum('bshn,chn->bshc', q_nope, p['w_uk'])
    c_all = jnp.concatenate([past_c.astype(c_kv.dtype), c_kv], axis=1)
    kr_all = jnp.concatenate([past_kr.astype(k_r.dtype), k_r], axis=1)
    k_pos = jnp.arange(c_all.shape[1], dtype=jnp.int32)
    o_lat = mla_attend(q_lat, q_rope, pos, c_all, kr_all, k_pos)
    y_mla = jnp.einsum('bshc,chv->bshv', o_lat, p['w_uv']).reshape(B, S, D_MLA)
    y = jnp.concatenate([rmsnorm(y_lru, p['out_norm_lru']), rmsnorm(y_mla, p['out_norm_mla'])], axis=-1)
    return y @ p['w_out'], c_kv, k_r, h_new, conv_new


def layer(x, pos, past_c, past_kr, h0, conv0, p):
    x = x + 0.5 * swiglu(rmsnorm(x, p['ffn1_norm']), p['ffn1_w_gate'], p['ffn1_w_up'], p['ffn1_w_down'])
    y, c_new, kr_new, h_new, conv_new = mixer(rmsnorm(x, p['mix_norm']), pos, past_c, past_kr, h0, conv0, p)
    x = x + y
    x = x + 0.5 * swiglu(rmsnorm(x, p['ffn2_norm']), p['ffn2_w_gate'], p['ffn2_w_up'], p['ffn2_w_down'])
    return x, c_new, kr_new, h_new, conv_new


def setup_inputs(seed: int = 0) -> dict:
    key = jax.random.key(seed)
    ks = iter(jax.random.split(key, 40))
    n_pages = PAST_LEN // PAGE_SIZE
    n_used = DEC_BATCH * n_pages
    n_phys = (n_used * 5) // 4

    def nrm(shape, scale=1.0):
        return jax.random.normal(next(ks), shape, jnp.float32) * scale

    def gain(shape):
        return 1.0 + 0.05 * jax.random.normal(next(ks), shape, jnp.float32)

    L = DEPTH
    u = jax.random.uniform(next(ks), (L, D_LRU), jnp.float32, 0.9, 0.999)
    s = u ** (1.0 / LRU_C)
    lam = jnp.log(s) - jnp.log1p(-s)
    page_table = jax.random.permutation(next(ks), n_phys)[:n_used].reshape(DEC_BATCH, n_pages).astype(jnp.int32)
    return {
        'x_prompt': nrm((BATCH, SEQ, D_MODEL)),
        'x_sample': nrm((DEC_BATCH, DEC_SEQ, D_MODEL)),
        'cache_kv_latent': nrm((L, n_phys, PAGE_SIZE, KV_LORA)),
        'cache_k_rope': nrm((L, n_phys, PAGE_SIZE, QK_ROPE)),
        'state_lru_h': nrm((L, DEC_BATCH, D_LRU), 0.5),
        'state_conv': nrm((L, DEC_BATCH, CONV_W - 1, D_LRU)),
        'page_table': page_table,
        'ffn1_norm': gain((L, D_MODEL)),
        'ffn1_w_gate': nrm((L, D_MODEL, D_FF), D_MODEL ** -0.5),
        'ffn1_w_up': nrm((L, D_MODEL, D_FF), D_MODEL ** -0.5),
        'ffn1_w_down': nrm((L, D_FF, D_MODEL), D_FF ** -0.5),
        'mix_norm': gain((L, D_MODEL)),
        'w_in': nrm((L, D_MODEL, D_IN), D_MODEL ** -0.5),
        'conv_w': nrm((L, CONV_W, D_LRU), CONV_W ** -0.5),
        'conv_b': nrm((L, D_LRU), 0.02),
        'lru_w_a': nrm((L, LRU_BLOCKS, LRU_BLOCK, LRU_BLOCK), LRU_BLOCK ** -0.5),
        'lru_b_a': nrm((L, D_LRU), 0.02),
        'lru_w_i': nrm((L, LRU_BLOCKS, LRU_BLOCK, LRU_BLOCK), LRU_BLOCK ** -0.5),
        'lru_b_i': nrm((L, D_LRU), 0.02),
        'lru_lambda': lam,
        'q_norm': gain((L, Q_LORA)),
        'w_q_up': nrm((L, Q_LORA, MLA_HEADS * (QK_NOPE + QK_ROPE)), Q_LORA ** -0.5),
        'kv_norm': gain((L, KV_LORA)),
        'w_uk': nrm((L, KV_LORA, MLA_HEADS, QK_NOPE), KV_LORA ** -0.5),
        'w_uv': nrm((L, KV_LORA, MLA_HEADS, V_DIM), KV_LORA ** -0.5),
        'out_norm_lru': gain((L, D_LRU)),
        'out_norm_mla': gain((L, D_MLA)),
        'w_out': nrm((L, D_MIX, D_MODEL), D_MIX ** -0.5),
        'ffn2_norm': gain((L, D_MODEL)),
        'ffn2_w_gate': nrm((L, D_MODEL, D_FF), D_MODEL ** -0.5),
        'ffn2_w_up': nrm((L, D_MODEL, D_FF), D_MODEL ** -0.5),
        'ffn2_w_down': nrm((L, D_FF, D_MODEL), D_FF ** -0.5),
        'final_norm': gain((D_MODEL,)),
    }


def reference(x_prompt, x_sample, cache_kv_latent, cache_k_rope, state_lru_h, state_conv, page_table,
              ffn1_norm, ffn1_w_gate, ffn1_w_up, ffn1_w_down, mix_norm, w_in, conv_w, conv_b,
              lru_w_a, lru_b_a, lru_w_i, lru_b_i, lru_lambda, q_norm, w_q_up, kv_norm, w_uk, w_uv,
              out_norm_lru, out_norm_mla, w_out, ffn2_norm, ffn2_w_gate, ffn2_w_up, ffn2_w_down, final_norm):
    B, S = x_prompt.shape[0], x_prompt.shape[1]
    DB, DS = x_sample.shape[0], x_sample.shape[1]
    past_len = page_table.shape[1] * PAGE_SIZE
    pos_p = jnp.arange(S, dtype=jnp.int32)
    pos_s = past_len + jnp.arange(DS, dtype=jnp.int32)
    yp, ys = x_prompt, x_sample
    kvp, krp, hp, cvp, kvs, krs, hs_, cvs = [], [], [], [], [], [], [], []
    for l in range(DEPTH):
        p = {
            'ffn1_norm': ffn1_norm[l], 'ffn1_w_gate': ffn1_w_gate[l], 'ffn1_w_up': ffn1_w_up[l],
            'ffn1_w_down': ffn1_w_down[l], 'mix_norm': mix_norm[l], 'w_in': w_in[l],
            'conv_w': conv_w[l], 'conv_b': conv_b[l], 'lru_w_a': lru_w_a[l], 'lru_b_a': lru_b_a[l],
            'lru_w_i': lru_w_i[l], 'lru_b_i': lru_b_i[l], 'lru_lambda': lru_lambda[l],
            'q_norm': q_norm[l], 'w_q_up': w_q_up[l], 'kv_norm': kv_norm[l], 'w_uk': w_uk[l],
            'w_uv': w_uv[l], 'out_norm_lru': out_norm_lru[l], 'out_norm_mla': out_norm_mla[l],
            'w_out': w_out[l], 'ffn2_norm': ffn2_norm[l], 'ffn2_w_gate': ffn2_w_gate[l],
            'ffn2_w_up': ffn2_w_up[l], 'ffn2_w_down': ffn2_w_down[l],
        }
        zc = jnp.zeros((B, 0, KV_LORA), x_prompt.dtype)
        zr = jnp.zeros((B, 0, QK_ROPE), x_prompt.dtype)
        zh = jnp.zeros((B, D_LRU), jnp.float32)
        zv = jnp.zeros((B, CONV_W - 1, D_LRU), x_prompt.dtype)
        yp, c1, r1, h1, v1 = layer(yp, pos_p, zc, zr, zh, zv, p)
        past_c = cache_kv_latent[l, page_table].reshape(DB, past_len, KV_LORA)
        past_kr = cache_k_rope[l, page_table].reshape(DB, past_len, QK_ROPE)
        ys, c2, r2, h2, v2 = layer(ys, pos_s, past_c, past_kr, state_lru_h[l], state_conv[l], p)
        kvp.append(c1); krp.append(r1); hp.append(h1); cvp.append(v1)
        kvs.append(c2); krs.append(r2); hs_.append(h2); cvs.append(v2)
    yp = rmsnorm(yp, final_norm)
    ys = rmsnorm(ys, final_norm)
    return (yp, ys, jnp.stack(kvp), jnp.stack(krp), jnp.stack(hp), jnp.stack(cvp),
            jnp.stack(kvs), jnp.stack(krs), jnp.stack(hs_), jnp.stack(cvs))
```

```cpp
#include <hip/hip_runtime.h>
#include <cstdio>
#include <cstdint>
#include <cstring>
constexpr int DM = 1024, SEQ = 8192, NB = 2, RP = NB * SEQ, DB = 128, DS = 8, RS = DB * DS, R = RP + RS;
constexpr int PAST = 16384, PAGE = 128, NPAGES = PAST / PAGE;
constexpr int DLRU = 512, NBLK = 8, BLK = 64, CONVW = 4;
constexpr int NH = 8, NOPE = 64, ROPE = 32, VD = 64, QL = 256, KVL = 128, DMLA = 512, DMIX = 1024, DIN = 1440, DINP = 1536;
constexpr int DFF = 2816, NGU = 2 * DFF;
constexpr int NQ = NH * KVL + NH * ROPE;
constexpr int QD = KVL + ROPE;
constexpr float EPS = 1e-6f;
constexpr size_t O_YP = 0, O_YS = O_YP + (size_t)RP * DM, O_KVP = O_YS + (size_t)RS * DM, O_KRP = O_KVP + (size_t)RP * KVL, O_HP = O_KRP + (size_t)RP * ROPE,
                 O_CVP = O_HP + (size_t)NB * DLRU, O_KVS = O_CVP + (size_t)NB * 3 * DLRU, O_KRS = O_KVS + (size_t)RS * KVL, O_HS = O_KRS + (size_t)RS * ROPE,
                 O_CVS = O_HS + (size_t)DB * DLRU, O_END = O_CVS + (size_t)DB * 3 * DLRU;
static_assert(O_END == 20877312, "output size");
__device__ const float ROPE_FREQ[16] = {1.000000000e+00f, 5.623413324e-01f, 3.162277639e-01f, 1.778279394e-01f, 1.000000015e-01f, 5.623413250e-02f, 3.162277490e-02f, 1.778279431e-02f,
                                        9.999999776e-03f, 5.623413250e-03f, 3.162277630e-03f, 1.778279431e-03f, 1.000000047e-03f, 5.623413017e-04f, 3.162277571e-04f, 1.778279402e-04f};
namespace pg8 {
#define PG8_LAS __attribute__((address_space(3)))
typedef unsigned short bf16_t;
typedef short bf16x8 __attribute__((ext_vector_type(8)));
typedef float f32x4 __attribute__((ext_vector_type(4)));
typedef unsigned u32x4 __attribute__((ext_vector_type(4)));
constexpr int BM = 256, BK = 64, HALF = 128, HTB = HALF * BK * 2  , STAGE_BYTES = 8 * HTB, NXCD = 8, WGM = 8;

__host__ __device__ __forceinline__ int lds_byte(int r, int c) { const int st = (r >> 4) * 2 + (c >> 5), rr = r & 15, cc = c & 31, ob = rr * 64 + cc * 2; return st * 1024 + (ob ^ (((ob >> 9) & 1) << 5)); }
__host__ __device__ __forceinline__ void stage_rc(int b, int& R, int& C) { const int st = b / 1024, sb = b % 1024, swz = sb ^ (((sb >> 9) & 1) << 5); R = (st >> 1) * 16 + swz / 64; C = (st & 1) * 32 + (swz % 64) / 2; }
__host__ __device__ __forceinline__ int perm32(int rho) { const int n = rho >> 4, i = rho & 15; return 8 * (i >> 2) + 4 * n + (i & 3); }

struct Unit { int pm, pn; };
struct Gemm { const bf16_t* A; const bf16_t* Bt; int M, N, K; };

struct StaticOrder {
    int nM, nN, nwg, G, c;
    __host__ __device__ void init(int M, int N, int G_, int c_) { nM = M / BM; nN = N / BM; nwg = nM * nN; G = G_; c = c_; }
    __host__ __device__ bool next(int i, Unit& u) const {
        const long L = (long)i * G + c; if (L >= nwg) return false;
        int wgid = (int)L; { const int q = nwg / NXCD, r = nwg % NXCD, xcd = wgid % NXCD, off = wgid / NXCD; wgid = (xcd < r ? xcd * (q + 1) : r * (q + 1) + (xcd - r) * q) + off; }
        const int nig = WGM * nN, gid = wgid / nig, fm = gid * WGM, gsz = (nM - fm) < WGM ? (nM - fm) : WGM;
        u.pm = fm + ((wgid % nig) % gsz); u.pn = (wgid % nig) / gsz; return true;
    }
    __device__ __forceinline__ void a_ready(const Unit&) const {}
    __device__ __forceinline__ void done(const Unit&) const {}
};

__device__ __forceinline__ unsigned cvt_pk_bf16(float lo, float hi) { unsigned r; asm volatile("v_cvt_pk_bf16_f32 %0, %1, %2" : "=v"(r) : "v"(lo), "v"(hi)); return r; }
typedef float f32x2 __attribute__((ext_vector_type(2)));
typedef float f32x2 __attribute__((ext_vector_type(2)));
template <class Epi, class Sched, bool ALIGN_EPI = false, bool SP2 = false>
__device__ __forceinline__ void gemm_phase(PG8_LAS unsigned char* lds, const Gemm g, const Sched& S, const Epi& E) {
    const int tid = threadIdx.x, wid = __builtin_amdgcn_readfirstlane(tid >> 6), lane = tid & 63, wr = wid >> 2, wc = wid & 3, fr = lane & 15, fq = lane >> 4;
    const int K = g.K, nt = K / BK;
    unsigned voffA[2], voffB[2];
#pragma unroll
    for (int i = 0; i < 2; ++i) { int R, C; stage_rc(tid * 16 + i * 8192, R, C); const int Rb = Epi::PERM ? ((R & ~31) + perm32(R & 31)) : R;
        voffA[i] = (unsigned)(R * K + C) * 2u; voffB[i] = (unsigned)(Rb * K + C) * 2u; }
    const size_t kstep = (size_t)(BK * 2);
    const size_t hstep = (size_t)HALF * K * 2;
    const size_t tstep = 2 * hstep;
    const unsigned ldsw = (unsigned)wid * 1024u;
    const int aoff = lds_byte(wr * 64 + fr, fq * 8), boff = lds_byte(wc * 32 + fr, fq * 8);
#define PG8_SA(b, h) (((b) * 2 + (h)) * HTB)
#define PG8_SB(b, h) ((4 + (b) * 2 + (h)) * HTB)
#define PG8_STAGE(bufoff, gbase, voff) do { _Pragma("unroll") for (int _i = 0; _i < 2; ++_i) \
        __builtin_amdgcn_global_load_lds((const unsigned*)((const char*)(gbase) + (voff)[_i]), (PG8_LAS unsigned*)(lds + (bufoff) + ldsw + _i * 8192), 16, 0, 0); } while (0)
#define PG8_LDA(dst, b, h) do { _Pragma("unroll") for (int m = 0; m < 4; ++m) _Pragma("unroll") for (int k = 0; k < 2; ++k) dst[m][k] = *(const PG8_LAS bf16x8*)(lds + PG8_SA(b, h) + aoff + m * 2048 + k * 1024); } while (0)
#define PG8_LDB(dst, b, h) do { _Pragma("unroll") for (int n = 0; n < 2; ++n) _Pragma("unroll") for (int k = 0; k < 2; ++k) dst[n][k] = *(const PG8_LAS bf16x8*)(lds + PG8_SB(b, h) + boff + n * 2048 + k * 1024); } while (0)
#define PG8_MMA(ai, bj, At, Bt) do { __builtin_amdgcn_s_setprio(1); _Pragma("unroll") for (int m = 0; m < 4; ++m) _Pragma("unroll") for (int n = 0; n < 2; ++n) _Pragma("unroll") for (int k = 0; k < 2; ++k) \
        acc[ai][bj][m][n] = __builtin_amdgcn_mfma_f32_16x16x32_bf16(Bt[n][k], At[m][k], acc[ai][bj][m][n], 0, 0, 0); __builtin_amdgcn_s_setprio(0); } while (0)
#define PG8_WAIT_V(n) asm volatile("s_waitcnt vmcnt(" #n ")" ::: "memory")
#define PG8_WAIT_L(n) asm volatile("s_waitcnt lgkmcnt(" #n ")" ::: "memory")
#define PG8_BAR __builtin_amdgcn_s_barrier()
#define PG8_SCHED __builtin_amdgcn_sched_barrier(0)
    Unit cur, nxt; int ui = 0;
    if (!S.next(0, cur)) return;
    f32x4 acc[2][2][4][2];
#pragma unroll
    for (int a = 0; a < 2; ++a)
#pragma unroll
        for (int b = 0; b < 2; ++b)
#pragma unroll
            for (int m = 0; m < 4; ++m)
#pragma unroll
                for (int n = 0; n < 2; ++n) acc[a][b][m][n] = (f32x4){0.f, 0.f, 0.f, 0.f};
    bf16x8 At[4][2], B0[2][2], B1[2][2];
    const char* cA = (const char*)g.A + (size_t)cur.pm * tstep; const char* cB = (const char*)g.Bt + (size_t)cur.pn * tstep;
    S.a_ready(cur);
    if constexpr (SP2) {
        PG8_STAGE(PG8_SB(0, 0), cB, voffB); PG8_STAGE(PG8_SB(0, 1), cB + hstep, voffB); PG8_STAGE(PG8_SA(0, 0), cA, voffA); PG8_STAGE(PG8_SA(0, 1), cA + hstep, voffA);
        if (wr == 1) PG8_BAR;
        PG8_WAIT_V(2); PG8_BAR;
        PG8_STAGE(PG8_SB(1, 0), cB + kstep, voffB); PG8_STAGE(PG8_SA(1, 0), cA + kstep, voffA); PG8_STAGE(PG8_SB(1, 1), cB + hstep + kstep, voffB);
        PG8_WAIT_V(6); PG8_BAR;
    } else {
        PG8_STAGE(PG8_SB(0, 0), cB, voffB); PG8_STAGE(PG8_SA(0, 0), cA, voffA); PG8_STAGE(PG8_SB(0, 1), cB + hstep, voffB); PG8_STAGE(PG8_SA(0, 1), cA + hstep, voffA);
        if (wr == 1) PG8_BAR;
        PG8_WAIT_V(4); PG8_BAR;
        PG8_STAGE(PG8_SB(1, 0), cB + kstep, voffB); PG8_STAGE(PG8_SA(1, 0), cA + kstep, voffA); PG8_STAGE(PG8_SB(1, 1), cB + hstep + kstep, voffB);
        PG8_WAIT_V(6); PG8_BAR;
    }
    for (;;) {
        const bool has_next = S.next(ui + 1, nxt);
        const char* nA = has_next ? (const char*)g.A + (size_t)nxt.pm * tstep : cA; const char* nB = has_next ? (const char*)g.Bt + (size_t)nxt.pn * tstep : cB;
        for (int t = 0; t < nt; t += 2) {
            const bool last = (t == nt - 2);
            const char* a1 = cA + (size_t)(t + 1) * kstep;
            const char* a2 = last ? nA : cA + (size_t)(t + 2) * kstep; const char* b2 = last ? nB : cB + (size_t)(t + 2) * kstep;
            const char* a3 = a2 + kstep; const char* b3 = b2 + kstep;
            if (last && has_next) S.a_ready(nxt);
            if constexpr (SP2) {
            PG8_LDB(B0, 0, 0); PG8_LDB(B1, 0, 1); PG8_SCHED; PG8_LDA(At, 0, 0); PG8_STAGE(PG8_SA(1, 1), a1 + hstep, voffA);
            PG8_WAIT_V(8); PG8_WAIT_L(0); PG8_BAR; PG8_MMA(0, 0, At, B0); PG8_MMA(0, 1, At, B1); PG8_BAR; PG8_SCHED;
            PG8_LDA(At, 0, 1); PG8_STAGE(PG8_SB(0, 0), b2, voffB); PG8_STAGE(PG8_SB(0, 1), b2 + hstep, voffB); PG8_STAGE(PG8_SA(0, 0), a2, voffA);
            PG8_WAIT_V(8); PG8_WAIT_L(0); PG8_BAR; PG8_MMA(1, 0, At, B0); PG8_MMA(1, 1, At, B1); PG8_BAR; PG8_SCHED;
            PG8_LDB(B0, 1, 0); PG8_LDB(B1, 1, 1); PG8_SCHED; PG8_LDA(At, 1, 0); PG8_STAGE(PG8_SA(0, 1), a2 + hstep, voffA);
            PG8_WAIT_V(8); PG8_WAIT_L(0); PG8_BAR; PG8_MMA(0, 0, At, B0); PG8_MMA(0, 1, At, B1); PG8_BAR; PG8_SCHED;
            PG8_LDA(At, 1, 1); PG8_STAGE(PG8_SB(1, 0), b3, voffB); PG8_STAGE(PG8_SB(1, 1), b3 + hstep, voffB); PG8_STAGE(PG8_SA(1, 0), a3, voffA);
            PG8_WAIT_V(8); PG8_WAIT_L(0); PG8_BAR; PG8_MMA(1, 0, At, B0); PG8_MMA(1, 1, At, B1); PG8_BAR; PG8_SCHED;
            } else {
            PG8_LDB(B0, 0, 0); PG8_SCHED; PG8_LDA(At, 0, 0); PG8_STAGE(PG8_SA(1, 1), a1 + hstep, voffA);
            PG8_WAIT_L(8); PG8_BAR; PG8_WAIT_L(0); PG8_MMA(0, 0, At, B0); PG8_BAR; PG8_SCHED;
            PG8_LDB(B1, 0, 1); PG8_STAGE(PG8_SB(0, 0), b2, voffB);
            PG8_BAR; PG8_WAIT_L(0); PG8_MMA(0, 1, At, B1); PG8_BAR;
            PG8_LDA(At, 0, 1); PG8_STAGE(PG8_SA(0, 0), a2, voffA);
            PG8_BAR; PG8_WAIT_L(0); PG8_MMA(1, 0, At, B0); PG8_BAR; PG8_SCHED;
            PG8_STAGE(PG8_SB(0, 1), b2 + hstep, voffB);
            PG8_WAIT_V(6); PG8_BAR; PG8_MMA(1, 1, At, B1); PG8_BAR;
            PG8_LDB(B0, 1, 0); PG8_SCHED; PG8_LDA(At, 1, 0); PG8_STAGE(PG8_SA(0, 1), a2 + hstep, voffA);
            PG8_WAIT_L(8); PG8_BAR; PG8_WAIT_L(0); PG8_MMA(0, 0, At, B0); PG8_BAR; PG8_SCHED;
            PG8_LDB(B1, 1, 1); PG8_STAGE(PG8_SB(1, 0), b3, voffB);
            PG8_BAR; PG8_WAIT_L(0); PG8_MMA(0, 1, At, B1); PG8_BAR;
            PG8_LDA(At, 1, 1); PG8_STAGE(PG8_SA(1, 0), a3, voffA);
            PG8_BAR; PG8_WAIT_L(0); PG8_MMA(1, 0, At, B0); PG8_BAR; PG8_SCHED;
            PG8_STAGE(PG8_SB(1, 1), b3 + hstep, voffB);
            PG8_WAIT_V(6); PG8_BAR; PG8_MMA(1, 1, At, B1); PG8_BAR;
            }
        }
        if constexpr (ALIGN_EPI) { if (wr == 0) PG8_BAR; }
        if constexpr (!Epi::AFTER_DRAIN) { E(acc, cur, wr, wc, fr, fq); S.done(cur); }
        if (!has_next) break;
#pragma unroll
        for (int a = 0; a < 2; ++a)
#pragma unroll
            for (int b = 0; b < 2; ++b)
#pragma unroll
                for (int m = 0; m < 4; ++m)
#pragma unroll
                    for (int n = 0; n < 2; ++n) acc[a][b][m][n] = (f32x4){0.f, 0.f, 0.f, 0.f};
        cur = nxt; cA = nA; cB = nB; ++ui;
        if constexpr (ALIGN_EPI) { if (wr == 1) PG8_BAR; }
    }
    PG8_WAIT_V(0);
    if constexpr (!ALIGN_EPI) { if (wr == 0) PG8_BAR; }
    PG8_BAR;
    if constexpr (Epi::AFTER_DRAIN) { E.fused(acc, cur, wr, wc, fr, fq, lds, wid, lane); S.done(cur); }
#undef PG8_SA
#undef PG8_SB
#undef PG8_STAGE
#undef PG8_LDA
#undef PG8_LDB
#undef PG8_MMA
#undef PG8_WAIT_V
#undef PG8_WAIT_L
#undef PG8_BAR
#undef PG8_SCHED
}
}
namespace pg8 {
struct EpiF32 {
    static constexpr bool PERM = false, AFTER_DRAIN = false;
    float* out; const float* base0; const float* base1; int ldc; int split; float alpha; int pad;
    __device__ __forceinline__ void operator()(const f32x4 (&acc)[2][2][4][2], const Unit& u, int wr, int wc, int fr, int fq) const {
        const int col0 = u.pn * BM + wc * 32 + 4 * fq;
        const float* bp = nullptr;
        if (base0) bp = (u.pm < split) ? base0 + (size_t)u.pm * BM * ldc : base1 + (size_t)(u.pm - split) * BM * ldc;
#pragma unroll
        for (int ai = 0; ai < 2; ++ai)
#pragma unroll
            for (int m = 0; m < 4; ++m) { const int rt = ai * HALF + wr * 64 + m * 16 + fr; const size_t off = (size_t)rt * ldc + col0;
                float* orow = out + (size_t)u.pm * BM * ldc + off;
#pragma unroll
                for (int bj = 0; bj < 2; ++bj)
#pragma unroll
                    for (int n = 0; n < 2; ++n) { f32x4 v = acc[ai][bj][m][n] * alpha; if (bp) v = v + *(const f32x4*)(bp + off + bj * HALF + n * 16);
                        *(f32x4*)(orow + bj * HALF + n * 16) = v; } }
    }
};
struct EpiSwiGLU {
    static constexpr bool PERM = true, AFTER_DRAIN = false;
    bf16_t* H; int ldh; int pad;
    __device__ __forceinline__ void operator()(const f32x4 (&acc)[2][2][4][2], const Unit& u, int wr, int wc, int fr, int fq) const {
        const int col0 = u.pn * HALF + wc * 32 + 8 * fq;
#pragma unroll
        for (int ai = 0; ai < 2; ++ai)
#pragma unroll
            for (int m = 0; m < 4; ++m) { bf16_t* rowp = H + (size_t)(u.pm * BM + ai * HALF + wr * 64 + m * 16 + fr) * ldh + col0;
                float hv[8];
#pragma unroll
                for (int n = 0; n < 2; ++n)
#pragma unroll
                    for (int i = 0; i < 4; ++i) { const float g = acc[ai][0][m][n][i], up = acc[ai][1][m][n][i];
                        hv[4 * n + i] = g * __builtin_amdgcn_rcpf(1.0f + __builtin_amdgcn_exp2f(-1.4426950408889634f * g)) * up; }
                u32x4 w; w.x = cvt_pk_bf16(hv[0], hv[1]); w.y = cvt_pk_bf16(hv[2], hv[3]); w.z = cvt_pk_bf16(hv[4], hv[5]); w.w = cvt_pk_bf16(hv[6], hv[7]);
                *(u32x4*)rowp = w; }
    }
};
}
typedef unsigned short bf16;
typedef float f32x4 __attribute__((ext_vector_type(4)));
typedef unsigned v4u __attribute__((ext_vector_type(4)));
__device__ __forceinline__ unsigned f2bf(float f) { unsigned u = __builtin_bit_cast(unsigned, f); return (u + 0x7fffu + ((u >> 16) & 1u)) >> 16; }
__device__ __forceinline__ unsigned pk2(float lo, float hi) { return f2bf(lo) | (f2bf(hi) << 16); }
__device__ __forceinline__ float wave_sum(float v) {
#pragma unroll
    for (int o = 1; o < 64; o <<= 1) v += __shfl_xor(v, o);
    return v;
}
__device__ __forceinline__ float block_sum256(float v, float* red) {
    v = wave_sum(v);
    __syncthreads();
    if ((threadIdx.x & 63) == 0) red[threadIdx.x >> 6] = v;
    __syncthreads();
    return (red[0] + red[1]) + (red[2] + red[3]);
}
__device__ __forceinline__ float sigmoidf_(float x) { return 1.0f / (1.0f + __expf(-x)); }
__device__ __forceinline__ float gelu_tanh(float x) { const float y = 0.7978845608028654f * (x + 0.044715f * x * x * x); return x * sigmoidf_(2.0f * y); }
__device__ __forceinline__ void rope_cs(int pos, int i, float& c, float& s) {
    const float ang = (float)pos * ROPE_FREQ[i];
    const double q4 = (double)ang * 0.6366197723675814;
    const double qr = rint(q4);
    const float r = (float)((q4 - qr) * 1.5707963267948966);
    const int qi = ((int)qr) & 3;
    const float r2 = r * r;
    const float sn = r * (1.0f + r2 * (-1.6666667e-1f + r2 * (8.3333333e-3f + r2 * (-1.9841270e-4f + r2 * 2.7557319e-6f))));
    const float cs = 1.0f + r2 * (-0.5f + r2 * (4.1666667e-2f + r2 * (-1.3888889e-3f + r2 * (2.4801587e-5f + r2 * -2.7557319e-7f))));
    c = (qi == 0) ? cs : (qi == 1) ? -sn : (qi == 2) ? -cs : sn;
    s = (qi == 0) ? sn : (qi == 1) ? cs : (qi == 2) ? -sn : -cs;
}

__global__ void __launch_bounds__(256) k_transpose(const float* __restrict__ W, int K, int N, bf16* __restrict__ WT, int mode) {
    __shared__ float scr_all[4][64 * 33];
    const int lane = threadIdx.x & 63, wave = threadIdx.x >> 6;
    float* scr = scr_all[wave];
    const int nblk = N / 32, nitems = (K / 64) * nblk;
    for (int item = blockIdx.x * 4 + wave; item < nitems; item += gridDim.x * 4) {
        const int kb = item / nblk, nb = item % nblk, k0 = 64 * kb, n0 = 32 * nb;
        const int drow0 = (mode == 0) ? n0 : 256 * (n0 / 128) + (n0 % 128) + (mode == 2 ? 128 : 0);
#pragma unroll 8
        for (int i = 0; i < 32; ++i) { const int kk = 2 * i + (lane >> 5); scr[kk * 33 + (lane & 31)] = W[(size_t)(k0 + kk) * N + n0 + (lane & 31)]; }
        __builtin_amdgcn_s_waitcnt(0); __builtin_amdgcn_wave_barrier();
        const int c = lane & 7;
#pragma unroll
        for (int j = 0; j < 4; ++j) { const int n = (lane >> 3) + 8 * j; const float* s = scr + (8 * c) * 33 + n;
            v4u o; o.x = pk2(s[0 * 33], s[1 * 33]); o.y = pk2(s[2 * 33], s[3 * 33]); o.z = pk2(s[4 * 33], s[5 * 33]); o.w = pk2(s[6 * 33], s[7 * 33]);
            *(v4u*)(WT + (size_t)(drow0 + n) * K + k0 + 8 * c) = o; }
        __builtin_amdgcn_s_waitcnt(0); __builtin_amdgcn_wave_barrier();
    }
}
__global__ void k_zero_u32(unsigned* p, int n) { for (int i = blockIdx.x * blockDim.x + threadIdx.x; i < n; i += gridDim.x * blockDim.x) p[i] = 0u; }
__global__ void k_wq_comb(const float* __restrict__ wq, const float* __restrict__ wuk, bf16* __restrict__ WqT) {
    const int idx = blockIdx.x * blockDim.x + threadIdx.x;
    if (idx >= NQ * QL) return;
    const int n = idx / QL, k = idx % QL;
    float v;
    if (n < NH * KVL) { const int h = n / KVL, c = n % KVL; const float* a = wq + (size_t)k * (NH * 96) + h * 96; const float* b = wuk + ((size_t)c * NH + h) * NOPE; float s = 0.f;
        for (int j = 0; j < NOPE; ++j) s += a[j] * b[j]; v = s; }
    else { const int h = (n - NH * KVL) / ROPE, r = (n - NH * KVL) % ROPE; v = wq[(size_t)k * (NH * 96) + h * 96 + NOPE + r]; }
    WqT[idx] = (bf16)f2bf(v);
}

template <bool OUT_BF16>
__global__ void __launch_bounds__(256) k_rmsnorm(const float* __restrict__ x0, const float* __restrict__ x1, int split, const float* __restrict__ gain, void* __restrict__ outp, int rows) {
    const int lane = threadIdx.x & 63;
    for (int row = blockIdx.x * 4 + (threadIdx.x >> 6); row < rows; row += gridDim.x * 4) {
        const float* xr = (row < split) ? x0 + (size_t)row * DM : x1 + (size_t)(row - split) * DM;
        f32x4 v[4]; float s = 0.f;
#pragma unroll
        for (int j = 0; j < 4; ++j) { v[j] = ((const f32x4*)xr)[lane + 64 * j]; s += (v[j].x * v[j].x + v[j].y * v[j].y) + (v[j].z * v[j].z + v[j].w * v[j].w); }
        const float rstd = 1.0f / sqrtf(wave_sum(s) * (1.0f / DM) + EPS);
#pragma unroll
        for (int j = 0; j < 4; ++j) { const f32x4 g = ((const f32x4*)gain)[lane + 64 * j]; const f32x4 o = v[j] * rstd * g;
            if (OUT_BF16) { unsigned long long w = (unsigned long long)pk2(o.x, o.y) | ((unsigned long long)pk2(o.z, o.w) << 32); ((unsigned long long*)((bf16*)outp + (size_t)row * DM))[lane + 64 * j] = w; }
            else ((f32x4*)((float*)outp + (size_t)row * DM))[lane + 64 * j] = o; }
    }
}

constexpr int LDS_BYTES = 147456;
struct GArgs { const void* A; const void* Bt; int M, N, K, pad; };
template <class Epi>
__global__ void __launch_bounds__(512, 2) k_gemm(GArgs ga, Epi E) {
    extern __shared__ __attribute__((aligned(16))) unsigned char lds[];
    pg8::Gemm g{(const pg8::bf16_t*)ga.A, (const pg8::bf16_t*)ga.Bt, ga.M, ga.N, ga.K};
    pg8::StaticOrder S; S.init(ga.M, ga.N, (int)gridDim.x, (int)blockIdx.x);
    pg8::gemm_phase<Epi, pg8::StaticOrder, true, true>((PG8_LAS unsigned char*)lds, g, S, E);
}

__global__ void __launch_bounds__(256) k_mixprep(const float* __restrict__ Z, float* __restrict__ out, bf16* __restrict__ CQN, float* __restrict__ Aout, float* __restrict__ Uout,
                                                 const float* __restrict__ q_norm, const float* __restrict__ kv_norm, const float* __restrict__ conv_w, const float* __restrict__ conv_b,
                                                 const float* __restrict__ w_a, const float* __restrict__ b_a, const float* __restrict__ w_i, const float* __restrict__ b_i,
                                                 const float* __restrict__ lam, const float* __restrict__ state_conv) {
    __shared__ float zs[DINP]; __shared__ float xcs[DLRU]; __shared__ float red[4];
    const int row = blockIdx.x, tid = threadIdx.x;
    const bool prompt = row < RP;
    const int b = prompt ? row / SEQ : (row - RP) / DS, t = prompt ? row % SEQ : (row - RP) % DS;
    const int pos = prompt ? t : PAST + t;
    const float* zr = Z + (size_t)row * DINP;
    for (int i = tid; i < DINP / 4; i += 256) ((f32x4*)zs)[i] = ((const f32x4*)zr)[i];
    __syncthreads();
    { const float v = zs[2 * DLRU + tid]; const float ssq = block_sum256(v * v, red); const float rstd = 1.0f / sqrtf(ssq * (1.0f / QL) + EPS);
      CQN[(size_t)row * QL + tid] = (bf16)f2bf(v * rstd * q_norm[tid]); }
    { const float v = tid < KVL ? zs[2 * DLRU + QL + tid] : 0.f; const float ssq = block_sum256(v * v, red); const float rstd = 1.0f / sqrtf(ssq * (1.0f / KVL) + EPS);
      float* o = prompt ? out + O_KVP + (size_t)row * KVL : out + O_KVS + (size_t)(row - RP) * KVL;
      if (tid < KVL) o[tid] = v * rstd * kv_norm[tid]; }
    if (tid < 16) { const float x1 = zs[2 * DLRU + QL + KVL + tid], x2 = zs[2 * DLRU + QL + KVL + 16 + tid]; float c, s; rope_cs(pos, tid, c, s);
      float* o = prompt ? out + O_KRP + (size_t)row * ROPE : out + O_KRS + (size_t)(row - RP) * ROPE;
      o[tid] = x1 * c - x2 * s; o[tid + 16] = x2 * c + x1 * s; }
    float xcv[2];
#pragma unroll
    for (int k = 0; k < 2; ++k) { const int ch = tid + 256 * k; float xm[3];
#pragma unroll
        for (int j = 1; j <= 3; ++j) { float v; if (t - j >= 0) v = Z[(size_t)(row - j) * DINP + ch]; else v = prompt ? 0.f : state_conv[((size_t)b * 3 + (3 + t - j)) * DLRU + ch]; xm[j - 1] = v; }
        const float xc = conv_b[ch] + conv_w[0 * DLRU + ch] * xm[2] + conv_w[1 * DLRU + ch] * xm[1] + conv_w[2 * DLRU + ch] * xm[0] + conv_w[3 * DLRU + ch] * zs[ch];
        xcv[k] = xc; xcs[ch] = xc;
        if (prompt) { if (t >= SEQ - 3) out[O_CVP + ((size_t)b * 3 + (t - (SEQ - 3))) * DLRU + ch] = zs[ch]; }
        else { if (t >= DS - 3) out[O_CVS + ((size_t)b * 3 + (t - (DS - 3))) * DLRU + ch] = zs[ch]; } }
    __syncthreads();
#pragma unroll
    for (int k = 0; k < 2; ++k) { const int ch = tid + 256 * k, n = ch / BLK, e = ch % BLK; float ra = b_a[ch], ia = b_i[ch];
        const float* wa = w_a + (size_t)n * BLK * BLK + e; const float* wi = w_i + (size_t)n * BLK * BLK + e; const float* xb = xcs + n * BLK;
        for (int d = 0; d < BLK; ++d) { const float x = xb[d]; ra += x * wa[d * BLK]; ia += x * wi[d * BLK]; }
        const float r = sigmoidf_(ra), ig = sigmoidf_(ia);
        const float nl = -lam[ch]; const float sp = fmaxf(nl, 0.f) + log1pf(__expf(-fabsf(nl)));
        const float log_a = -8.0f * r * sp; const float a = __expf(log_a); const float u = sqrtf(-expm1f(2.0f * log_a)) * (ig * xcv[k]);
        Aout[(size_t)row * DLRU + ch] = a; Uout[(size_t)row * DLRU + ch] = u; }
}

__global__ void __launch_bounds__(256) k_scan_prompt(const float* __restrict__ A, const float* __restrict__ U, const float* __restrict__ Z, float* __restrict__ YL, float* __restrict__ out) {
    const int gid = blockIdx.x * 256 + threadIdx.x; if (gid >= NB * DLRU) return;
    const int b = gid / DLRU, ch = gid % DLRU; float h = 0.f;
#pragma unroll 8
    for (int t = 0; t < SEQ; ++t) { const size_t row = (size_t)b * SEQ + t; h = A[row * DLRU + ch] * h + U[row * DLRU + ch]; YL[row * DLRU + ch] = gelu_tanh(Z[row * DINP + DLRU + ch]) * h; }
    out[O_HP + gid] = h;
}
__global__ void __launch_bounds__(256) k_scan_sample(const float* __restrict__ A, const float* __restrict__ U, const float* __restrict__ Z, float* __restrict__ YL, float* __restrict__ out, const float* __restrict__ h0) {
    const int gid = blockIdx.x * 256 + threadIdx.x; if (gid >= DB * DLRU) return;
    const int b = gid / DLRU, ch = gid % DLRU; float h = h0[gid];
#pragma unroll
    for (int t = 0; t < DS; ++t) { const size_t row = (size_t)RP + (size_t)b * DS + t; h = A[row * DLRU + ch] * h + U[row * DLRU + ch]; YL[row * DLRU + ch] = gelu_tanh(Z[row * DINP + DLRU + ch]) * h; }
    out[O_HS + gid] = h;
}

constexpr float QSCALE = 0.10206207261596577f * 1.4426950408889634f;
__device__ __forceinline__ void load_q(const float* __restrict__ qrow, int h, int pos, float (&q)[QD]) {
#pragma unroll
    for (int c = 0; c < KVL; c += 4) { const f32x4 v = *(const f32x4*)(qrow + h * KVL + c); q[c] = v.x * QSCALE; q[c + 1] = v.y * QSCALE; q[c + 2] = v.z * QSCALE; q[c + 3] = v.w * QSCALE; }
#pragma unroll
    for (int i = 0; i < 16; ++i) { const float x1 = qrow[NH * KVL + h * ROPE + i], x2 = qrow[NH * KVL + h * ROPE + 16 + i]; float c, s; rope_cs(pos, i, c, s);
        q[KVL + i] = (x1 * c - x2 * s) * QSCALE; q[KVL + 16 + i] = (x2 * c + x1 * s) * QSCALE; }
}
__device__ __forceinline__ void attend_key(const float* ks, const float (&q)[QD], float& m, float& l, float (&o)[KVL]) {
    float s0 = 0.f, s1 = 0.f, s2 = 0.f, s3 = 0.f;
#pragma unroll
    for (int d = 0; d < QD; d += 4) { const f32x4 kv = *(const f32x4*)(ks + d); s0 += q[d] * kv.x; s1 += q[d + 1] * kv.y; s2 += q[d + 2] * kv.z; s3 += q[d + 3] * kv.w; }
    const float s = (s0 + s1) + (s2 + s3);
    const float mn = fmaxf(m, s); const float al = __builtin_amdgcn_exp2f(m - mn), p = __builtin_amdgcn_exp2f(s - mn);
    m = mn; l = l * al + p;
#pragma unroll
    for (int c = 0; c < KVL; c += 4) { const f32x4 kv = *(const f32x4*)(ks + c); o[c] = o[c] * al + p * kv.x; o[c + 1] = o[c + 1] * al + p * kv.y; o[c + 2] = o[c + 2] * al + p * kv.z; o[c + 3] = o[c + 3] * al + p * kv.w; }
}
__global__ void __launch_bounds__(256) k_attn_prompt(const float* __restrict__ Qall, const float* __restrict__ out, float* __restrict__ OLAT) {
    __shared__ __attribute__((aligned(16))) float Ks[64 * QD];
    const int tid = threadIdx.x, tok = tid & 31, h = tid >> 5;
    const int b = blockIdx.x & 1, tb = (SEQ / 32 - 1) - (blockIdx.x >> 1);
    const int t = tb * 32 + tok; const size_t row = (size_t)b * SEQ + t;
    float q[QD]; load_q(Qall + row * NQ, h, t, q);
    float m = -INFINITY, l = 0.f, o[KVL];
#pragma unroll
    for (int c = 0; c < KVL; ++c) o[c] = 0.f;
    const float* kvp = out + O_KVP + (size_t)b * SEQ * KVL; const float* krp = out + O_KRP + (size_t)b * SEQ * ROPE;
    const int ntile = (tb * 32 + 31) / 64 + 1;
    for (int kt = 0; kt < ntile; ++kt) {
        __syncthreads();
        for (int i = tid; i < 64 * (QD / 4); i += 256) { const int j = i / (QD / 4), c4 = i % (QD / 4); const int key = kt * 64 + j;
            f32x4 v; if (c4 < KVL / 4) v = *(const f32x4*)(kvp + (size_t)key * KVL + c4 * 4); else v = *(const f32x4*)(krp + (size_t)key * ROPE + (c4 - KVL / 4) * 4);
            *(f32x4*)(Ks + j * QD + c4 * 4) = v; }
        __syncthreads();
        for (int j = 0; j < 64; ++j) { if (kt * 64 + j <= t) attend_key(Ks + j * QD, q, m, l, o); }
    }
    const float rl = 1.0f / l;
#pragma unroll
    for (int c = 0; c < KVL; c += 4) { f32x4 v = {o[c] * rl, o[c + 1] * rl, o[c + 2] * rl, o[c + 3] * rl}; *(f32x4*)(OLAT + row * (NH * KVL) + h * KVL + c) = v; }
}
__global__ void __launch_bounds__(256) k_attn_sample(const float* __restrict__ Qall, const float* __restrict__ out, float* __restrict__ OLAT,
                                                     const float* __restrict__ ckv, const float* __restrict__ ckr, const int* __restrict__ ptab) {
    __shared__ __attribute__((aligned(16))) float Ks[64 * QD];
    const int tid = threadIdx.x, qi = tid & 63, w = tid >> 6, s = qi >> 3, h = qi & 7, db = blockIdx.x;
    const size_t row = (size_t)RP + (size_t)db * DS + s;
    float q[QD]; load_q(Qall + row * NQ, h, PAST + s, q);
    float m = -INFINITY, l = 0.f, o[KVL];
#pragma unroll
    for (int c = 0; c < KVL; ++c) o[c] = 0.f;
    for (int kt = 0; kt <= PAST / 64; ++kt) {
        __syncthreads();
        for (int i = tid; i < 64 * (QD / 4); i += 256) { const int j = i / (QD / 4), c4 = i % (QD / 4); const int key = kt * 64 + j;
            f32x4 v = {0.f, 0.f, 0.f, 0.f};
            if (key < PAST) { const size_t slot = (size_t)ptab[db * NPAGES + key / PAGE] * PAGE + key % PAGE;
                if (c4 < KVL / 4) v = *(const f32x4*)(ckv + slot * KVL + c4 * 4); else v = *(const f32x4*)(ckr + slot * ROPE + (c4 - KVL / 4) * 4); }
            else if (key < PAST + DS) { const size_t r2 = (size_t)db * DS + (key - PAST);
                if (c4 < KVL / 4) v = *(const f32x4*)(out + O_KVS + r2 * KVL + c4 * 4); else v = *(const f32x4*)(out + O_KRS + r2 * ROPE + (c4 - KVL / 4) * 4); }
            *(f32x4*)(Ks + j * QD + c4 * 4) = v; }
        __syncthreads();
        for (int jj = 0; jj < 16; ++jj) { const int j = w * 16 + jj; if (kt * 64 + j <= PAST + s) attend_key(Ks + j * QD, q, m, l, o); }
    }
    float* mb = Ks + qi * 130;
    for (int ww = 0; ww < 4; ++ww) {
        __syncthreads();
        if (w == ww) {
            if (ww > 0) { const float m2 = mb[128], l2 = mb[129]; const float mn = fmaxf(m, m2); const float a1 = (m == -INFINITY) ? 0.f : __builtin_amdgcn_exp2f(m - mn), a2 = (m2 == -INFINITY) ? 0.f : __builtin_amdgcn_exp2f(m2 - mn);
#pragma unroll
                for (int c = 0; c < KVL; ++c) o[c] = o[c] * a1 + mb[c] * a2;
                l = l * a1 + l2 * a2; m = mn; }
            if (ww < 3) {
#pragma unroll
                for (int c = 0; c < KVL; ++c) mb[c] = o[c];
                mb[128] = m; mb[129] = l; }
            else { const float rl = 1.0f / l;
#pragma unroll
                for (int c = 0; c < KVL; c += 4) { f32x4 v = {o[c] * rl, o[c + 1] * rl, o[c + 2] * rl, o[c + 3] * rl}; *(f32x4*)(OLAT + row * (NH * KVL) + h * KVL + c) = v; } }
        }
    }
}

__global__ void __launch_bounds__(256) k_outprep(const float* __restrict__ OLAT, const float* __restrict__ YL, const float* __restrict__ w_uv, const float* __restrict__ gl, const float* __restrict__ gm, bf16* __restrict__ YC) {
    __shared__ float ol[NH * KVL]; __shared__ float red[4];
    const int row = blockIdx.x, tid = threadIdx.x;
    for (int i = tid; i < NH * KVL / 4; i += 256) ((f32x4*)ol)[i] = ((const f32x4*)(OLAT + (size_t)row * NH * KVL))[i];
    __syncthreads();
    float y[2], yl[2];
#pragma unroll
    for (int k = 0; k < 2; ++k) { const int oo = tid + 256 * k, h = oo / VD, v = oo % VD; float s = 0.f;
        for (int c = 0; c < KVL; ++c) s += ol[h * KVL + c] * w_uv[((size_t)c * NH + h) * VD + v];
        y[k] = s; yl[k] = YL[(size_t)row * DLRU + oo]; }
    const float rm = 1.0f / sqrtf(block_sum256(y[0] * y[0] + y[1] * y[1], red) * (1.0f / DMLA) + EPS);
    const float rl = 1.0f / sqrtf(block_sum256(yl[0] * yl[0] + yl[1] * yl[1], red) * (1.0f / DLRU) + EPS);
#pragma unroll
    for (int k = 0; k < 2; ++k) { const int oo = tid + 256 * k;
        YC[(size_t)row * DMIX + oo] = (bf16)f2bf(yl[k] * rl * gl[oo]); YC[(size_t)row * DMIX + DLRU + oo] = (bf16)f2bf(y[k] * rm * gm[oo]); }
}

constexpr size_t MiB = 1u << 20;
constexpr size_t WS_WGU1 = 2 * MiB, WS_WD1 = 14 * MiB, WS_WGU2 = 20 * MiB, WS_WD2 = 32 * MiB, WS_WIN = 38 * MiB, WS_WOUT = 42 * MiB, WS_WQ = 44 * MiB;
constexpr size_t WS_XN = 64 * MiB, WS_H = 100 * MiB, WS_X1 = 200 * MiB, WS_X2 = 270 * MiB, WS_Z = 340 * MiB, WS_QALL = 444 * MiB, WS_CQN = 530 * MiB;
constexpr size_t WS_A = 540 * MiB, WS_U = 576 * MiB, WS_YL = 612 * MiB, WS_OLAT = 648 * MiB, WS_YC = 720 * MiB, WS_END = 760 * MiB;

template <class Epi> static void launch_gemm(const void* A, const void* Bt, int M, int N, int K, const Epi& E, hipStream_t stream) {
    static bool attr = false;
    if (!attr) { (void)hipFuncSetAttribute((const void*)k_gemm<Epi>, hipFuncAttributeMaxDynamicSharedMemorySize, LDS_BYTES); attr = true; }
    GArgs ga; memset(&ga, 0, sizeof(ga)); ga.A = A; ga.Bt = Bt; ga.M = M; ga.N = N; ga.K = K;
    hipLaunchKernelGGL(k_gemm<Epi>, dim3(256), dim3(512), LDS_BYTES, stream, ga, E);
}
static pg8::EpiF32 mk_f32(float* out, int ldc, const float* b0, const float* b1, int split, float alpha) { pg8::EpiF32 e; memset(&e, 0, sizeof(e)); e.out = out; e.base0 = b0; e.base1 = b1; e.ldc = ldc; e.split = split; e.alpha = alpha; return e; }
static pg8::EpiSwiGLU mk_swi(bf16* H, int ldh) { pg8::EpiSwiGLU e; memset(&e, 0, sizeof(e)); e.H = H; e.ldh = ldh; return e; }

extern "C" void kernel_launch(void* const* d_in, const int* in_sizes, int n_in, void* d_out, int out_size, void* d_ws, size_t ws_size, hipStream_t stream) {
    if (n_in != 33 || out_size != (int)O_END || ws_size < WS_END) { fprintf(stderr, "kernel_launch: unexpected shapes (n_in %d, out %d, ws %zu)\n", n_in, out_size, ws_size); return; }
    const float* x_p = (const float*)d_in[0]; const float* x_s = (const float*)d_in[1];
    const float* ckv = (const float*)d_in[2]; const float* ckr = (const float*)d_in[3];
    const float* st_h = (const float*)d_in[4]; const float* st_cv = (const float*)d_in[5]; const int* ptab = (const int*)d_in[6];
    const float* f1n = (const float*)d_in[7]; const float* f1g = (const float*)d_in[8]; const float* f1u = (const float*)d_in[9]; const float* f1d = (const float*)d_in[10];
    const float* mixn = (const float*)d_in[11]; const float* w_in = (const float*)d_in[12]; const float* conv_w = (const float*)d_in[13]; const float* conv_b = (const float*)d_in[14];
    const float* lwa = (const float*)d_in[15]; const float* lba = (const float*)d_in[16]; const float* lwi = (const float*)d_in[17]; const float* lbi = (const float*)d_in[18]; const float* lam = (const float*)d_in[19];
    const float* qn = (const float*)d_in[20]; const float* wqu = (const float*)d_in[21]; const float* kvn = (const float*)d_in[22]; const float* wuk = (const float*)d_in[23]; const float* wuv = (const float*)d_in[24];
    const float* onl = (const float*)d_in[25]; const float* onm = (const float*)d_in[26]; const float* w_out = (const float*)d_in[27];
    const float* f2n = (const float*)d_in[28]; const float* f2g = (const float*)d_in[29]; const float* f2u = (const float*)d_in[30]; const float* f2d = (const float*)d_in[31]; const float* fin = (const float*)d_in[32];
    float* out = (float*)d_out; unsigned char* ws = (unsigned char*)d_ws;
    bf16 *Wgu1 = (bf16*)(ws + WS_WGU1), *Wd1 = (bf16*)(ws + WS_WD1), *Wgu2 = (bf16*)(ws + WS_WGU2), *Wd2 = (bf16*)(ws + WS_WD2), *Win = (bf16*)(ws + WS_WIN), *Wout = (bf16*)(ws + WS_WOUT), *Wq = (bf16*)(ws + WS_WQ);
    bf16 *XN = (bf16*)(ws + WS_XN), *H = (bf16*)(ws + WS_H), *CQN = (bf16*)(ws + WS_CQN), *YC = (bf16*)(ws + WS_YC);
    float *X1 = (float*)(ws + WS_X1), *X2 = (float*)(ws + WS_X2), *Z = (float*)(ws + WS_Z), *QALL = (float*)(ws + WS_QALL), *Ab = (float*)(ws + WS_A), *Ub = (float*)(ws + WS_U), *YL = (float*)(ws + WS_YL), *OLAT = (float*)(ws + WS_OLAT);

    k_transpose<<<512, 256, 0, stream>>>(f1g, DM, DFF, Wgu1, 1); k_transpose<<<512, 256, 0, stream>>>(f1u, DM, DFF, Wgu1, 2); k_transpose<<<512, 256, 0, stream>>>(f1d, DFF, DM, Wd1, 0);
    k_transpose<<<512, 256, 0, stream>>>(f2g, DM, DFF, Wgu2, 1); k_transpose<<<512, 256, 0, stream>>>(f2u, DM, DFF, Wgu2, 2); k_transpose<<<512, 256, 0, stream>>>(f2d, DFF, DM, Wd2, 0);
    k_transpose<<<512, 256, 0, stream>>>(w_in, DM, DIN, Win, 0); k_zero_u32<<<96, 256, 0, stream>>>((unsigned*)(Win + (size_t)DIN * DM), (DINP - DIN) * DM / 2);
    k_transpose<<<512, 256, 0, stream>>>(w_out, DMIX, DM, Wout, 0);
    k_wq_comb<<<(NQ * QL + 255) / 256, 256, 0, stream>>>(wqu, wuk, Wq);
    k_rmsnorm<true><<<1024, 256, 0, stream>>>(x_p, x_s, RP, f1n, XN, R);
    launch_gemm(XN, Wgu1, R, NGU, DM, mk_swi(H, DFF), stream);
    launch_gemm(H, Wd1, R, DM, DFF, mk_f32(X1, DM, x_p, x_s, RP / 256, 0.5f), stream);
    k_rmsnorm<true><<<1024, 256, 0, stream>>>(X1, X1, R, mixn, XN, R);
    launch_gemm(XN, Win, R, DINP, DM, mk_f32(Z, DINP, nullptr, nullptr, 0, 1.0f), stream);
    k_mixprep<<<R, 256, 0, stream>>>(Z, out, CQN, Ab, Ub, qn, kvn, conv_w, conv_b, lwa, lba, lwi, lbi, lam, st_cv);
    launch_gemm(CQN, Wq, R, NQ, QL, mk_f32(QALL, NQ, nullptr, nullptr, 0, 1.0f), stream);
    k_scan_prompt<<<NB * DLRU / 256, 256, 0, stream>>>(Ab, Ub, Z, YL, out);
    k_scan_sample<<<DB * DLRU / 256, 256, 0, stream>>>(Ab, Ub, Z, YL, out, st_h);
    k_attn_prompt<<<NB * SEQ / 32, 256, 0, stream>>>(QALL, out, OLAT);
    k_attn_sample<<<DB, 256, 0, stream>>>(QALL, out, OLAT, ckv, ckr, ptab);
    k_outprep<<<R, 256, 0, stream>>>(OLAT, YL, wuv, onl, onm, YC);
    launch_gemm(YC, Wout, R, DM, DMIX, mk_f32(X2, DM, X1, X1, 1 << 20, 1.0f), stream);
    k_rmsnorm<true><<<1024, 256, 0, stream>>>(X2, X2, R, f2n, XN, R);
    launch_gemm(XN, Wgu2, R, NGU, DM, mk_swi(H, DFF), stream);
    launch_gemm(H, Wd2, R, DM, DFF, mk_f32(X1, DM, X2, X2, 1 << 20, 0.5f), stream);
    k_rmsnorm<false><<<1024, 256, 0, stream>>>(X1, X1, R, fin, out, R);
}
```

```cpp
#include <hip/hip_runtime.h>
#include <cstdio>
#include <cstdint>
#include <cstring>
constexpr int DM = 1024, SEQ = 8192, NB = 2, RP = NB * SEQ, DB = 128, DS = 8, RS = DB * DS, R = RP + RS;
constexpr int PAST = 16384, PAGE = 128, NPAGES = PAST / PAGE;
constexpr int DLRU = 512, NBLK = 8, BLK = 64, CONVW = 4;
constexpr int NH = 8, NOPE = 64, ROPE = 32, VD = 64, QL = 256, KVL = 128, DMLA = 512, DMIX = 1024, DIN = 1440, DINP = 1536;
constexpr int DFF = 2816, NGU = 2 * DFF;
constexpr int NQ = NH * KVL + NH * ROPE;
constexpr int QD = KVL + ROPE;
constexpr float EPS = 1e-6f;
constexpr size_t O_YP = 0, O_YS = O_YP + (size_t)RP * DM, O_KVP = O_YS + (size_t)RS * DM, O_KRP = O_KVP + (size_t)RP * KVL, O_HP = O_KRP + (size_t)RP * ROPE,
                 O_CVP = O_HP + (size_t)NB * DLRU, O_KVS = O_CVP + (size_t)NB * 3 * DLRU, O_KRS = O_KVS + (size_t)RS * KVL, O_HS = O_KRS + (size_t)RS * ROPE,
                 O_CVS = O_HS + (size_t)DB * DLRU, O_END = O_CVS + (size_t)DB * 3 * DLRU;
static_assert(O_END == 20877312, "output size");
__device__ const float ROPE_FREQ[16] = {1.000000000e+00f, 5.623413324e-01f, 3.162277639e-01f, 1.778279394e-01f, 1.000000015e-01f, 5.623413250e-02f, 3.162277490e-02f, 1.778279431e-02f,
                                        9.999999776e-03f, 5.623413250e-03f, 3.162277630e-03f, 1.778279431e-03f, 1.000000047e-03f, 5.623413017e-04f, 3.162277571e-04f, 1.778279402e-04f};
namespace pg8 {
#define PG8_LAS __attribute__((address_space(3)))
typedef unsigned short bf16_t;
typedef short bf16x8 __attribute__((ext_vector_type(8)));
typedef float f32x4 __attribute__((ext_vector_type(4)));
typedef unsigned u32x4 __attribute__((ext_vector_type(4)));
constexpr int BM = 256, BK = 64, HALF = 128, HTB = HALF * BK * 2  , STAGE_BYTES = 8 * HTB, NXCD = 8, WGM = 8;

__host__ __device__ __forceinline__ int lds_byte(int r, int c) { const int st = (r >> 4) * 2 + (c >> 5), rr = r & 15, cc = c & 31, ob = rr * 64 + cc * 2; return st * 1024 + (ob ^ (((ob >> 9) & 1) << 5)); }
__host__ __device__ __forceinline__ void stage_rc(int b, int& R, int& C) { const int st = b / 1024, sb = b % 1024, swz = sb ^ (((sb >> 9) & 1) << 5); R = (st >> 1) * 16 + swz / 64; C = (st & 1) * 32 + (swz % 64) / 2; }
__host__ __device__ __forceinline__ int perm32(int rho) { const int n = rho >> 4, i = rho & 15; return 8 * (i >> 2) + 4 * n + (i & 3); }

struct Unit { int pm, pn; };
struct Gemm { const bf16_t* A; const bf16_t* Bt; int M, N, K; };

struct StaticOrder {
    int nM, nN, nwg, G, c;
    __host__ __device__ void init(int M, int N, int G_, int c_) { nM = M / BM; nN = N / BM; nwg = nM * nN; G = G_; c = c_; }
    __host__ __device__ bool next(int i, Unit& u) const {
        const long L = (long)i * G + c; if (L >= nwg) return false;
        int wgid = (int)L; { const int q = nwg / NXCD, r = nwg % NXCD, xcd = wgid % NXCD, off = wgid / NXCD; wgid = (xcd < r ? xcd * (q + 1) : r * (q + 1) + (xcd - r) * q) + off; }
        const int nig = WGM * nN, gid = wgid / nig, fm = gid * WGM, gsz = (nM - fm) < WGM ? (nM - fm) : WGM;
        u.pm = fm + ((wgid % nig) % gsz); u.pn = (wgid % nig) / gsz; return true;
    }
    __device__ __forceinline__ void a_ready(const Unit&) const {}
    __device__ __forceinline__ void done(const Unit&) const {}
};

__device__ __forceinline__ unsigned cvt_pk_bf16(float lo, float hi) { unsigned r; asm volatile("v_cvt_pk_bf16_f32 %0, %1, %2" : "=v"(r) : "v"(lo), "v"(hi)); return r; }
typedef float f32x2 __attribute__((ext_vector_type(2)));
typedef float f32x2 __attribute__((ext_vector_type(2)));
template <class Epi, class Sched, bool ALIGN_EPI = false, bool SP2 = false>
__device__ __forceinline__ void gemm_phase(PG8_LAS unsigned char* lds, const Gemm g, const Sched& S, const Epi& E) {
    const int tid = threadIdx.x, wid = __builtin_amdgcn_readfirstlane(tid >> 6), lane = tid & 63, wr = wid >> 2, wc = wid & 3, fr = lane & 15, fq = lane >> 4;
    const int K = g.K, nt = K / BK;
    unsigned voffA[2], voffB[2];
#pragma unroll
    for (int i = 0; i < 2; ++i) { int R, C; stage_rc(tid * 16 + i * 8192, R, C); const int Rb = Epi::PERM ? ((R & ~31) + perm32(R & 31)) : R;
        voffA[i] = (unsigned)(R * K + C) * 2u; voffB[i] = (unsigned)(Rb * K + C) * 2u; }
    const size_t kstep = (size_t)(BK * 2);
    const size_t hstep = (size_t)HALF * K * 2;
    const size_t tstep = 2 * hstep;
    const unsigned ldsw = (unsigned)wid * 1024u;
    const int aoff = lds_byte(wr * 64 + fr, fq * 8), boff = lds_byte(wc * 32 + fr, fq * 8);
#define PG8_SA(b, h) (((b) * 2 + (h)) * HTB)
#define PG8_SB(b, h) ((4 + (b) * 2 + (h)) * HTB)
#define PG8_STAGE(bufoff, gbase, voff) do { _Pragma("unroll") for (int _i = 0; _i < 2; ++_i) \
        __builtin_amdgcn_global_load_lds((const unsigned*)((const char*)(gbase) + (voff)[_i]), (PG8_LAS unsigned*)(lds + (bufoff) + ldsw + _i * 8192), 16, 0, 0); } while (0)
#define PG8_LDA(dst, b, h) do { _Pragma("unroll") for (int m = 0; m < 4; ++m) _Pragma("unroll") for (int k = 0; k < 2; ++k) dst[m][k] = *(const PG8_LAS bf16x8*)(lds + PG8_SA(b, h) + aoff + m * 2048 + k * 1024); } while (0)
#define PG8_LDB(dst, b, h) do { _Pragma("unroll") for (int n = 0; n < 2; ++n) _Pragma("unroll") for (int k = 0; k < 2; ++k) dst[n][k] = *(const PG8_LAS bf16x8*)(lds + PG8_SB(b, h) + boff + n * 2048 + k * 1024); } while (0)
#define PG8_MMA(ai, bj, At, Bt) do { __builtin_amdgcn_s_setprio(1); _Pragma("unroll") for (int m = 0; m < 4; ++m) _Pragma("unroll") for (int n = 0; n < 2; ++n) _Pragma("unroll") for (int k = 0; k < 2; ++k) \
        acc[ai][bj][m][n] = __builtin_amdgcn_mfma_f32_16x16x32_bf16(Bt[n][k], At[m][k], acc[ai][bj][m][n], 0, 0, 0); __builtin_amdgcn_s_setprio(0); } while (0)
#define PG8_WAIT_V(n) asm volatile("s_waitcnt vmcnt(" #n ")" ::: "memory")
#define PG8_WAIT_L(n) asm volatile("s_waitcnt lgkmcnt(" #n ")" ::: "memory")
#define PG8_BAR __builtin_amdgcn_s_barrier()
#define PG8_SCHED __builtin_amdgcn_sched_barrier(0)
    Unit cur, nxt; int ui = 0;
    if (!S.next(0, cur)) return;
    f32x4 acc[2][2][4][2];
#pragma unroll
    for (int a = 0; a < 2; ++a)
#pragma unroll
        for (int b = 0; b < 2; ++b)
#pragma unroll
            for (int m = 0; m < 4; ++m)
#pragma unroll
                for (int n = 0; n < 2; ++n) acc[a][b][m][n] = (f32x4){0.f, 0.f, 0.f, 0.f};
    bf16x8 At[4][2], B0[2][2], B1[2][2];
    const char* cA = (const char*)g.A + (size_t)cur.pm * tstep; const char* cB = (const char*)g.Bt + (size_t)cur.pn * tstep;
    S.a_ready(cur);
    if constexpr (SP2) {
        PG8_STAGE(PG8_SB(0, 0), cB, voffB); PG8_STAGE(PG8_SB(0, 1), cB + hstep, voffB); PG8_STAGE(PG8_SA(0, 0), cA, voffA); PG8_STAGE(PG8_SA(0, 1), cA + hstep, voffA);
        if (wr == 1) PG8_BAR;
        PG8_WAIT_V(2); PG8_BAR;
        PG8_STAGE(PG8_SB(1, 0), cB + kstep, voffB); PG8_STAGE(PG8_SA(1, 0), cA + kstep, voffA); PG8_STAGE(PG8_SB(1, 1), cB + hstep + kstep, voffB);
        PG8_WAIT_V(6); PG8_BAR;
    } else {
        PG8_STAGE(PG8_SB(0, 0), cB, voffB); PG8_STAGE(PG8_SA(0, 0), cA, voffA); PG8_STAGE(PG8_SB(0, 1), cB + hstep, voffB); PG8_STAGE(PG8_SA(0, 1), cA + hstep, voffA);
        if (wr == 1) PG8_BAR;
        PG8_WAIT_V(4); PG8_BAR;
        PG8_STAGE(PG8_SB(1, 0), cB + kstep, voffB); PG8_STAGE(PG8_SA(1, 0), cA + kstep, voffA); PG8_STAGE(PG8_SB(1, 1), cB + hstep + kstep, voffB);
        PG8_WAIT_V(6); PG8_BAR;
    }
    for (;;) {
        const bool has_next = S.next(ui + 1, nxt);
        const char* nA = has_next ? (const char*)g.A + (size_t)nxt.pm * tstep : cA; const char* nB = has_next ? (const char*)g.Bt + (size_t)nxt.pn * tstep : cB;
        for (int t = 0; t < nt; t += 2) {
            const bool last = (t == nt - 2);
            const char* a1 = cA + (size_t)(t + 1) * kstep;
            const char* a2 = last ? nA : cA + (size_t)(t + 2) * kstep; const char* b2 = last ? nB : cB + (size_t)(t + 2) * kstep;
            const char* a3 = a2 + kstep; const char* b3 = b2 + kstep;
            if (last && has_next) S.a_ready(nxt);
            if constexpr (SP2) {
            PG8_LDB(B0, 0, 0); PG8_LDB(B1, 0, 1); PG8_SCHED; PG8_LDA(At, 0, 0); PG8_STAGE(PG8_SA(1, 1), a1 + hstep, voffA);
            PG8_WAIT_V(8); PG8_WAIT_L(0); PG8_BAR; PG8_MMA(0, 0, At, B0); PG8_MMA(0, 1, At, B1); PG8_BAR; PG8_SCHED;
            PG8_LDA(At, 0, 1); PG8_STAGE(PG8_SB(0, 0), b2, voffB); PG8_STAGE(PG8_SB(0, 1), b2 + hstep, voffB); PG8_STAGE(PG8_SA(0, 0), a2, voffA);
            PG8_WAIT_V(8); PG8_WAIT_L(0); PG8_BAR; PG8_MMA(1, 0, At, B0); PG8_MMA(1, 1, At, B1); PG8_BAR; PG8_SCHED;
            PG8_LDB(B0, 1, 0); PG8_LDB(B1, 1, 1); PG8_SCHED; PG8_LDA(At, 1, 0); PG8_STAGE(PG8_SA(0, 1), a2 + hstep, voffA);
            PG8_WAIT_V(8); PG8_WAIT_L(0); PG8_BAR; PG8_MMA(0, 0, At, B0); PG8_MMA(0, 1, At, B1); PG8_BAR; PG8_SCHED;
            PG8_LDA(At, 1, 1); PG8_STAGE(PG8_SB(1, 0), b3, voffB); PG8_STAGE(PG8_SB(1, 1), b3 + hstep, voffB); PG8_STAGE(PG8_SA(1, 0), a3, voffA);
            PG8_WAIT_V(8); PG8_WAIT_L(0); PG8_BAR; PG8_MMA(1, 0, At, B0); PG8_MMA(1, 1, At, B1); PG8_BAR; PG8_SCHED;
            } else {
            PG8_LDB(B0, 0, 0); PG8_SCHED; PG8_LDA(At, 0, 0); PG8_STAGE(PG8_SA(1, 1), a1 + hstep, voffA);
            PG8_WAIT_L(8); PG8_BAR; PG8_WAIT_L(0); PG8_MMA(0, 0, At, B0); PG8_BAR; PG8_SCHED;
            PG8_LDB(B1, 0, 1); PG8_STAGE(PG8_SB(0, 0), b2, voffB);
            PG8_BAR; PG8_WAIT_L(0); PG8_MMA(0, 1, At, B1); PG8_BAR;
            PG8_LDA(At, 0, 1); PG8_STAGE(PG8_SA(0, 0), a2, voffA);
            PG8_BAR; PG8_WAIT_L(0); PG8_MMA(1, 0, At, B0); PG8_BAR; PG8_SCHED;
            PG8_STAGE(PG8_SB(0, 1), b2 + hstep, voffB);
            PG8_WAIT_V(6); PG8_BAR; PG8_MMA(1, 1, At, B1); PG8_BAR;
            PG8_LDB(B0, 1, 0); PG8_SCHED; PG8_LDA(At, 1, 0); PG8_STAGE(PG8_SA(0, 1), a2 + hstep, voffA);
            PG8_WAIT_L(8); PG8_BAR; PG8_WAIT_L(0); PG8_MMA(0, 0, At, B0); PG8_BAR; PG8_SCHED;
            PG8_LDB(B1, 1, 1); PG8_STAGE(PG8_SB(1, 0), b3, voffB);
            PG8_BAR; PG8_WAIT_L(0); PG8_MMA(0, 1, At, B1); PG8_BAR;
            PG8_LDA(At, 1, 1); PG8_STAGE(PG8_SA(1, 0), a3, voffA);
            PG8_BAR; PG8_WAIT_L(0); PG8_MMA(1, 0, At, B0); PG8_BAR; PG8_SCHED;
            PG8_STAGE(PG8_SB(1, 1), b3 + hstep, voffB);
            PG8_WAIT_V(6); PG8_BAR; PG8_MMA(1, 1, At, B1); PG8_BAR;
            }
        }
        if constexpr (ALIGN_EPI) { if (wr == 0) PG8_BAR; }
        if constexpr (!Epi::AFTER_DRAIN) { E(acc, cur, wr, wc, fr, fq); S.done(cur); }
        if (!has_next) break;
#pragma unroll
        for (int a = 0; a < 2; ++a)
#pragma unroll
            for (int b = 0; b < 2; ++b)
#pragma unroll
                for (int m = 0; m < 4; ++m)
#pragma unroll
                    for (int n = 0; n < 2; ++n) acc[a][b][m][n] = (f32x4){0.f, 0.f, 0.f, 0.f};
        cur = nxt; cA = nA; cB = nB; ++ui;
        if constexpr (ALIGN_EPI) { if (wr == 1) PG8_BAR; }
    }
    PG8_WAIT_V(0);
    if constexpr (!ALIGN_EPI) { if (wr == 0) PG8_BAR; }
    PG8_BAR;
    if constexpr (Epi::AFTER_DRAIN) { E.fused(acc, cur, wr, wc, fr, fq, lds, wid, lane); S.done(cur); }
#undef PG8_SA
#undef PG8_SB
#undef PG8_STAGE
#undef PG8_LDA
#undef PG8_LDB
#undef PG8_MMA
#undef PG8_WAIT_V
#undef PG8_WAIT_L
#undef PG8_BAR
#undef PG8_SCHED
}
}
namespace pg8 {
struct EpiF32 {
    static constexpr bool PERM = false, AFTER_DRAIN = false;
    float* out; const float* base0; const float* base1; int ldc; int split; float alpha; int pad;
    __device__ __forceinline__ void operator()(const f32x4 (&acc)[2][2][4][2], const Unit& u, int wr, int wc, int fr, int fq) const {
        const int col0 = u.pn * BM + wc * 32 + 4 * fq;
        const float* bp = nullptr;
        if (base0) bp = (u.pm < split) ? base0 + (size_t)u.pm * BM * ldc : base1 + (size_t)(u.pm - split) * BM * ldc;
#pragma unroll
        for (int ai = 0; ai < 2; ++ai)
#pragma unroll
            for (int m = 0; m < 4; ++m) { const int rt = ai * HALF + wr * 64 + m * 16 + fr; const size_t off = (size_t)rt * ldc + col0;
                float* orow = out + (size_t)u.pm * BM * ldc + off;
#pragma unroll
                for (int bj = 0; bj < 2; ++bj)
#pragma unroll
                    for (int n = 0; n < 2; ++n) { f32x4 v = acc[ai][bj][m][n] * alpha; if (bp) v = v + *(const f32x4*)(bp + off + bj * HALF + n * 16);
                        *(f32x4*)(orow + bj * HALF + n * 16) = v; } }
    }
};
struct EpiSwiGLU {
    static constexpr bool PERM = true, AFTER_DRAIN = false;
    bf16_t* H; int ldh; int pad;
    __device__ __forceinline__ void operator()(const f32x4 (&acc)[2][2][4][2], const Unit& u, int wr, int wc, int fr, int fq) const {
        const int col0 = u.pn * HALF + wc * 32 + 8 * fq;
#pragma unroll
        for (int ai = 0; ai < 2; ++ai)
#pragma unroll
            for (int m = 0; m < 4; ++m) { bf16_t* rowp = H + (size_t)(u.pm * BM + ai * HALF + wr * 64 + m * 16 + fr) * ldh + col0;
                float hv[8];
#pragma unroll
                for (int n = 0; n < 2; ++n)
#pragma unroll
                    for (int i = 0; i < 4; ++i) { const float g = acc[ai][0][m][n][i], up = acc[ai][1][m][n][i];
                        hv[4 * n + i] = g * __builtin_amdgcn_rcpf(1.0f + __builtin_amdgcn_exp2f(-1.4426950408889634f * g)) * up; }
                u32x4 w; w.x = cvt_pk_bf16(hv[0], hv[1]); w.y = cvt_pk_bf16(hv[2], hv[3]); w.z = cvt_pk_bf16(hv[4], hv[5]); w.w = cvt_pk_bf16(hv[6], hv[7]);
                *(u32x4*)rowp = w; }
    }
};
}
#define GAS __attribute__((address_space(1)))
#define LAS __attribute__((address_space(3)))
typedef unsigned short bf16;
typedef unsigned v4u __attribute__((ext_vector_type(4)));
typedef float f32x4 __attribute__((ext_vector_type(4)));
typedef short bf16x8 __attribute__((ext_vector_type(8)));
typedef GAS unsigned gu32;
typedef GAS unsigned long long gu64;
#define RLX_AGENT __ATOMIC_RELAXED, __HIP_MEMORY_SCOPE_AGENT
#define LDS_WAIT() asm volatile("s_waitcnt lgkmcnt(0)" ::: "memory")
#define VM_WAIT() asm volatile("s_waitcnt vmcnt(0)" ::: "memory")
__device__ __forceinline__ unsigned long long rt() { return __builtin_amdgcn_s_memrealtime(); }
__device__ __forceinline__ unsigned f2bf(float f) { unsigned u = __builtin_bit_cast(unsigned, f); return (u + 0x7fffu + ((u >> 16) & 1u)) >> 16; }
__device__ __forceinline__ unsigned pk2(float lo, float hi) { return f2bf(lo) | (f2bf(hi) << 16); }

#define XB_TMO      128
#define XB_XCNT(j)  (256  + 64 * (j))
#define XB_XSUB(j)  (1280 + 64 * (j))
#define XB_XGEN(j)  (2304 + 64 * (j))
#define XB_TOP      3328
#define XB_TOPGEN   3392
#define XCD_BAR_WORDS 3456
#define XB_SPIN_CAP (1u << 18)

__device__ __forceinline__ unsigned xb_ld(unsigned* p)              { return __hip_atomic_load(p, __ATOMIC_RELAXED, __HIP_MEMORY_SCOPE_AGENT); }
__device__ __forceinline__ unsigned xb_add(unsigned* p, unsigned v) { return __hip_atomic_fetch_add(p, v, __ATOMIC_RELAXED, __HIP_MEMORY_SCOPE_AGENT); }
__device__ __forceinline__ unsigned xb_xcc_id() { return (unsigned)__builtin_amdgcn_s_getreg((3 << 11) | 20) & 0xFu; }
#define XB_SPIN(cond, bar) do { unsigned _sp = 0; while (cond) { __builtin_amdgcn_s_sleep(1); \
    if ((++_sp & 255u) == 0u) { if (xb_ld(&(bar)[XB_TMO])) break; if (_sp > XB_SPIN_CAP) { atomicAdd(&(bar)[XB_TMO], 1u); break; } } } } while (0)

struct XcdBarrier {
    unsigned* bar; unsigned x;
    volatile LAS unsigned* st;
};

__device__ __forceinline__ XcdBarrier xcd_barrier_post(unsigned* bar, volatile LAS unsigned* st) {
    XcdBarrier b; b.bar = bar; b.x = xb_xcc_id(); b.st = st;
    if (threadIdx.x == 0) (void)xb_add(&bar[XB_XCNT(b.x)], 1u);
    return b;
}
__device__ __forceinline__ void xcd_barrier_complete(unsigned* bar, unsigned x, unsigned& nloc, unsigned& nx) {
    const unsigned G = gridDim.x * gridDim.y * gridDim.z;
    unsigned sum, cnt, mine, sp = 0u;
    for (;;) {
        sum = 0u; cnt = 0u; mine = 0u;
#pragma unroll
        for (unsigned j = 0; j < 16; ++j) { const unsigned c = xb_ld(&bar[XB_XCNT(j)]); sum += c; cnt += (c > 0u) ? 1u : 0u; mine = (j == x) ? c : mine; }
        if (sum == G) break;
        __builtin_amdgcn_s_sleep(1);
        if ((++sp & 255u) == 0u) { if (xb_ld(&bar[XB_TMO])) break; if (sp > XB_SPIN_CAP) { atomicAdd(&bar[XB_TMO], 1u); break; } }
    }
    nloc = mine > 0u ? mine : 1u; nx = cnt > 0u ? cnt : 1u;
}

__device__ __forceinline__ void xcd_barrier(const XcdBarrier& b) {
    asm volatile("s_waitcnt vmcnt(0)" ::: "memory");
    __syncthreads();
    if (threadIdx.x == 0) {
        unsigned* bar = b.bar;
        __builtin_amdgcn_s_waitcnt(0);
        unsigned nloc = b.st[0], nx = b.st[1];
        if (nloc == 0u) { xcd_barrier_complete(bar, b.x, nloc, nx); b.st[0] = nloc; b.st[1] = nx; }
        const unsigned old = xb_add(&bar[XB_XSUB(b.x)], 1u);
        const unsigned gen = old / nloc;
        if (old + 1u == (gen + 1u) * nloc) {
            __builtin_amdgcn_fence(__ATOMIC_RELEASE, "agent");
            asm volatile("s_waitcnt vmcnt(0)" ::: "memory");
            const unsigned og = xb_add(&bar[XB_TOP], 1u);
            const unsigned tg = og / nx;
            if (og + 1u == (tg + 1u) * nx) xb_add(&bar[XB_TOPGEN], 1u);
            else XB_SPIN(xb_ld(&bar[XB_TOPGEN]) == tg, bar);
            __builtin_amdgcn_fence(__ATOMIC_ACQUIRE, "agent");
            xb_add(&bar[XB_XGEN(b.x)], 1u);
            asm volatile("s_waitcnt vmcnt(0)" ::: "memory");
        } else {
            XB_SPIN(xb_ld(&bar[XB_XGEN(b.x)]) == gen, bar);
            __builtin_amdgcn_fence(__ATOMIC_ACQUIRE, "agent");
            asm volatile("s_waitcnt vmcnt(0)" ::: "memory");
        }
    }
    __syncthreads();
}
__device__ __forceinline__ float wave_sum(float v) {
#pragma unroll
    for (int o = 1; o < 64; o <<= 1) v += __shfl_xor(v, o);
    return v;
}
__device__ __forceinline__ float sigmoidf_(float x) { return 1.0f / (1.0f + __expf(-x)); }
__device__ __forceinline__ float gelu_tanh(float x) { const float y = 0.7978845608028654f * (x + 0.044715f * x * x * x); return x * sigmoidf_(2.0f * y); }
__device__ __forceinline__ void rope_cs(int pos, int i, float& c, float& s) {
    const float ang = (float)pos * ROPE_FREQ[i];
    const double q4 = (double)ang * 0.6366197723675814;
    const double qr = rint(q4);
    const float r = (float)((q4 - qr) * 1.5707963267948966);
    const int qi = ((int)qr) & 3;
    const float r2 = r * r;
    const float sn = r * (1.0f + r2 * (-1.6666667e-1f + r2 * (8.3333333e-3f + r2 * (-1.9841270e-4f + r2 * 2.7557319e-6f))));
    const float cs = 1.0f + r2 * (-0.5f + r2 * (4.1666667e-2f + r2 * (-1.3888889e-3f + r2 * (2.4801587e-5f + r2 * -2.7557319e-7f))));
    c = (qi == 0) ? cs : (qi == 1) ? -sn : (qi == 2) ? -cs : sn;
    s = (qi == 0) ? sn : (qi == 1) ? cs : (qi == 2) ? -sn : -cs;
}
constexpr float QSCALE = 0.10206207261596577f * 1.4426950408889634f;
namespace att {
#define ATT_LAS __attribute__((address_space(3)))
typedef short bf16x8 __attribute__((ext_vector_type(8)));
typedef float f32x16 __attribute__((ext_vector_type(16)));
typedef short s16x4 __attribute__((ext_vector_type(4)));
typedef short v4i16_t __attribute__((ext_vector_type(4)));
typedef unsigned u32x4 __attribute__((ext_vector_type(4)));
typedef float f32x2_t __attribute__((ext_vector_type(2)));
typedef __bf16 bf16x2_t __attribute__((ext_vector_type(2)));
typedef ATT_LAS unsigned char* ldsp;
#define ATT_MFMA(a, b, c) __builtin_amdgcn_mfma_f32_32x32x16_bf16((a), (b), (c), 0, 0, 0)
__device__ __forceinline__ int crow(int r, int hi) { return (r & 3) + 8 * (r >> 2) + 4 * hi; }
__device__ __forceinline__ unsigned cvtpk(float lo, float hi) { f32x2_t v = {lo, hi}; bf16x2_t b = __builtin_convertvector(v, bf16x2_t); return __builtin_bit_cast(unsigned, b); }
__device__ __forceinline__ unsigned offL(unsigned row, unsigned ch) { return 256u * row + 16u * (ch ^ (((row & 3u) << 2) | ((row >> 2) & 3u))); }
__device__ __forceinline__ unsigned offR(unsigned row, unsigned ch) { return 64u * row + 16u * (ch ^ ((row >> 2) & 3u)); }
__device__ __forceinline__ bf16x8 lds_b128(ldsp p) { return *(const ATT_LAS bf16x8*)p; }
__device__ __forceinline__ s16x4 lds_tr(ldsp p) { return __builtin_bit_cast(s16x4, __builtin_amdgcn_ds_read_tr16_b64_v4i16((ATT_LAS v4i16_t*)p)); }
__device__ __forceinline__ float swapmax(float m) { auto rr = __builtin_amdgcn_permlane32_swap(__float_as_uint(m), __float_as_uint(m), false, false); return fmaxf(__uint_as_float(rr[0]), __uint_as_float(rr[1])); }
__device__ __forceinline__ float swapsum(float m) { auto rr = __builtin_amdgcn_permlane32_swap(__float_as_uint(m), __float_as_uint(m), false, false); return __uint_as_float(rr[0]) + __uint_as_float(rr[1]); }

constexpr int TILE_LAT = 64 * 256, TILE_ROPE = 64 * 64, TILE_BYTES = TILE_LAT + TILE_ROPE;
constexpr float THR = 8.0f;

__device__ __forceinline__ void softmax_step(f32x16& s0, f32x16& s1, float& m, float& l, f32x16 (&o)[4], bool first) {
    float rm = fmaxf(s0[0], s1[0]);
#pragma unroll
    for (int r = 1; r < 16; ++r) rm = fmaxf(rm, fmaxf(s0[r], s1[r]));
    rm = swapmax(rm);
    if (first) m = rm;
    rm -= m;
    if (!first && __any(rm > THR)) {
        const float dl = fmaxf(rm, 0.f);
        m += dl;
        const float f = __builtin_amdgcn_exp2f(-dl); l *= f;
#pragma unroll
        for (int c = 0; c < 4; ++c)
#pragma unroll
            for (int r = 0; r < 16; ++r) o[c][r] *= f;
    }
    float sum = 0.f;
#pragma unroll
    for (int r = 0; r < 16; ++r) { s0[r] = __builtin_amdgcn_exp2f(s0[r] - m); s1[r] = __builtin_amdgcn_exp2f(s1[r] - m); sum += s0[r] + s1[r]; }
    l += sum;
}

__device__ __forceinline__ void stage_load(u32x4 (&st)[3], const bf16* __restrict__ tilep, int tid) {
    const bf16* pl = tilep + (size_t)(tid >> 4) * QD + (tid & 15) * 8;
    st[0] = *(const u32x4*)pl; st[1] = *(const u32x4*)(pl + 32 * QD);
    if (tid < 256) st[2] = *(const u32x4*)(tilep + (size_t)(tid >> 2) * QD + KVL + (tid & 3) * 8);
}
__device__ __forceinline__ void stage_store(const u32x4 (&st)[3], ldsp tile, unsigned dl, unsigned dr, int tid) {
    *(ATT_LAS u32x4*)(tile + dl) = st[0]; *(ATT_LAS u32x4*)(tile + dl + 8192) = st[1];
    if (tid < 256) *(ATT_LAS u32x4*)(tile + TILE_LAT + dr) = st[2];
}
__device__ __forceinline__ void prompt_unit(ldsp lds, const bf16* __restrict__ Qb, const bf16* __restrict__ KC, float* __restrict__ OLAT, int b, int tb) {
    const int tid = threadIdx.x, lane = tid & 63, wid = __builtin_amdgcn_readfirstlane(tid >> 6), r32 = lane & 31, hi = lane >> 5;
    const int t0 = tb * 32; const size_t row0 = (size_t)b * SEQ + t0;
    const bf16* KCseq = KC + (size_t)b * SEQ * QD;
    const int ntile = (t0 + 31) / 64 + 1;
    const unsigned dl = offL((unsigned)tid >> 4, (unsigned)tid & 15u), dr = offR(((unsigned)tid >> 2) & 63u, (unsigned)tid & 3u);
    u32x4 st[3];
    stage_load(st, KCseq, tid);
    bf16x8 qf[10];
    { const bf16* qp = Qb + ((row0 + r32) * NH + wid) * QD + 8 * hi;
#pragma unroll
      for (int s = 0; s < 10; ++s) qf[s] = *(const bf16x8*)(qp + 16 * s); }
    stage_store(st, lds, dl, dr, tid);
    __syncthreads();
    float m = 0.f, l = 0.f; f32x16 o[4];
#pragma unroll
    for (int r = 0; r < 16; ++r) { o[0][r] = 0.f; o[1][r] = 0.f; o[2][r] = 0.f; o[3][r] = 0.f; }
    const unsigned xk = (unsigned)(((r32 & 3) << 1) | ((r32 >> 3) & 1));
    const unsigned ka = 256u * (unsigned)r32 + 16u * ((unsigned)hi ^ ((unsigned)(r32 >> 2) & 1u));
    const unsigned kr0 = TILE_LAT + offR((unsigned)r32, (unsigned)hi), kr1 = TILE_LAT + offR((unsigned)r32, 2u + (unsigned)hi);
    const unsigned blk = (lane >> 4) & 1, qq = (lane & 15) >> 2, pp = lane & 3;
    const unsigned vb0 = 256u * (unsigned)(4 * hi + qq) + 16u * ((2u * blk + (pp >> 1)) ^ (unsigned)hi) + 8u * (pp & 1u);
    const unsigned vb1 = 256u * (unsigned)(8 + 4 * hi + qq) + 16u * ((2u * blk + (pp >> 1)) ^ (2u + (unsigned)hi)) + 8u * (pp & 1u);
    for (int kt = 0; kt < ntile; ++kt) {
        ldsp tile = lds + (kt & 1) * TILE_BYTES;
        if (kt + 1 < ntile) stage_load(st, KCseq + (size_t)(kt + 1) * 64 * QD, tid);
        unsigned xko = xk, qqo = qq; asm volatile("" : "+v"(xko), "+v"(qqo));
        f32x16 s0, s1;
#pragma unroll
        for (int r = 0; r < 16; ++r) { s0[r] = 0.f; s1[r] = 0.f; }
#pragma unroll
        for (int k = 0; k < 8; ++k) { const unsigned a = ka + 32u * ((unsigned)k ^ xko);
            s0 = ATT_MFMA(lds_b128(tile + a), qf[k], s0); s1 = ATT_MFMA(lds_b128(tile + a + 8192), qf[k], s1); }
        s0 = ATT_MFMA(lds_b128(tile + kr0), qf[8], s0); s1 = ATT_MFMA(lds_b128(tile + kr0 + 2048), qf[8], s1);
        s0 = ATT_MFMA(lds_b128(tile + kr1), qf[9], s0); s1 = ATT_MFMA(lds_b128(tile + kr1 + 2048), qf[9], s1);
        if (kt == ntile - 1) {
            const int tok = t0 + r32, kb = kt * 64;
#pragma unroll
            for (int r = 0; r < 16; ++r) { const int key = kb + crow(r, hi); if (key > tok) s0[r] = -INFINITY; if (key + 32 > tok) s1[r] = -INFINITY; }
        }
        softmax_step(s0, s1, m, l, o, kt == 0);
#pragma unroll
        for (int ks = 0; ks < 4; ++ks) {
            const f32x16& pv = (ks < 2) ? s0 : s1; const int bb = 8 * (ks & 1);
            u32x4 pw; pw.x = cvtpk(pv[bb + 0], pv[bb + 1]); pw.y = cvtpk(pv[bb + 2], pv[bb + 3]); pw.z = cvtpk(pv[bb + 4], pv[bb + 5]); pw.w = cvtpk(pv[bb + 6], pv[bb + 7]);
            const bf16x8 pf = __builtin_bit_cast(bf16x8, pw);
#pragma unroll
            for (int c = 0; c < 4; ++c) {
                const unsigned co = 64u * ((unsigned)c ^ qqo);
                const s16x4 lo = lds_tr(tile + vb0 + co + 4096 * ks);
                const s16x4 hv = lds_tr(tile + vb1 + co + 4096 * ks);
                const bf16x8 vf = {lo[0], lo[1], lo[2], lo[3], hv[0], hv[1], hv[2], hv[3]};
                o[c] = ATT_MFMA(vf, pf, o[c]);
            }
        }
        if (kt + 1 < ntile) stage_store(st, lds + ((kt + 1) & 1) * TILE_BYTES, dl, dr, tid);
        __syncthreads();
    }
    l = swapsum(l);
    const float rl = 1.0f / l;
    float* op = OLAT + (row0 + r32) * (NH * KVL) + wid * KVL;
#pragma unroll
    for (int c = 0; c < 4; ++c)
#pragma unroll
        for (int g = 0; g < 4; ++g) { f32x4 v = {o[c][4 * g] * rl, o[c][4 * g + 1] * rl, o[c][4 * g + 2] * rl, o[c][4 * g + 3] * rl}; *(f32x4*)(op + 32 * c + 8 * g + 4 * hi) = v; }
}
}
namespace att {
constexpr int PG_LAT = 128 * 256, PG_ROPE = 128 * 64, PG_BYTES = PG_LAT + PG_ROPE;
constexpr int PART_ROWS = 66, PART_FLOATS = PART_ROWS * 64;

__device__ __forceinline__ void page_load(f32x4 (&st)[10], const float* __restrict__ ckv, const float* __restrict__ ckr, size_t slot0, int tid) {
    const f32x4* pl = (const f32x4*)(ckv + slot0 * KVL) + tid; const f32x4* pr = (const f32x4*)(ckr + slot0 * ROPE) + tid;
#pragma unroll
    for (int i = 0; i < 8; ++i) st[i] = pl[512 * i];
#pragma unroll
    for (int i = 0; i < 2; ++i) st[8 + i] = pr[512 * i];
}
__device__ __forceinline__ void page_store(const f32x4 (&st)[10], ldsp pg, unsigned dl, unsigned dr) {
    typedef unsigned u32x2 __attribute__((ext_vector_type(2)));
#pragma unroll
    for (int i = 0; i < 8; ++i) { u32x2 w; w.x = cvtpk(st[i].x, st[i].y); w.y = cvtpk(st[i].z, st[i].w); *(ATT_LAS u32x2*)(pg + dl + 4096 * i) = w; }
#pragma unroll
    for (int i = 0; i < 2; ++i) { u32x2 w; w.x = cvtpk(st[8 + i].x, st[8 + i].y); w.y = cvtpk(st[8 + i].z, st[8 + i].w); *(ATT_LAS u32x2*)(pg + PG_LAT + dr + 4096 * i) = w; }
}
__device__ __forceinline__ void decode_item(ldsp lds, const bf16* __restrict__ Qb, const float* __restrict__ ckv, const float* __restrict__ ckr, const int* __restrict__ ptab,
                                            float* __restrict__ PART, int db, int pg0, int npg) {
    const int tid = threadIdx.x, lane = tid & 63, wid = __builtin_amdgcn_readfirstlane(tid >> 6), r32 = lane & 31, hi = lane >> 5;
    const int qb = wid & 1, rb = 64 * (wid >> 2) + 32 * ((wid >> 1) & 1), grp = wid >> 1;
    const int* pt = ptab + db * NPAGES + pg0;
    unsigned dl, dr;
    { const unsigned row = (unsigned)tid >> 5, c4 = (unsigned)tid & 31u; dl = offL(row, c4 >> 1) + 8u * (c4 & 1u);
      const unsigned rr = (unsigned)tid >> 3, c4r = (unsigned)tid & 7u; dr = offR(rr, c4r >> 1) + 8u * (c4r & 1u); }
    f32x4 st[10];
    page_load(st, ckv, ckr, (size_t)pt[0] * PAGE, tid);
    bf16x8 qf[10];
    { const bf16* qp = Qb + (((size_t)RP + (size_t)db * DS) * NH + 32 * qb + r32) * QD + 8 * hi;
#pragma unroll
      for (int s = 0; s < 10; ++s) qf[s] = *(const bf16x8*)(qp + 16 * s); }
    page_store(st, lds, dl, dr);
    __syncthreads();
    float m = 0.f, l = 0.f; f32x16 o[4];
#pragma unroll
    for (int r = 0; r < 16; ++r) { o[0][r] = 0.f; o[1][r] = 0.f; o[2][r] = 0.f; o[3][r] = 0.f; }
    const unsigned xk = (unsigned)(((r32 & 3) << 1) | ((r32 >> 3) & 1));
    const unsigned ka = 256u * (unsigned)(rb + r32) + 16u * ((unsigned)hi ^ ((unsigned)(r32 >> 2) & 1u));
    const unsigned kr0 = PG_LAT + offR((unsigned)(rb + r32), (unsigned)hi), kr1 = PG_LAT + offR((unsigned)(rb + r32), 2u + (unsigned)hi);
    const unsigned blk = (lane >> 4) & 1, qq = (lane & 15) >> 2, pp = lane & 3;
    const unsigned vb0 = 256u * (unsigned)(rb + 4 * hi + qq) + 16u * ((2u * blk + (pp >> 1)) ^ (unsigned)hi) + 8u * (pp & 1u);
    const unsigned vb1 = 256u * (unsigned)(rb + 8 + 4 * hi + qq) + 16u * ((2u * blk + (pp >> 1)) ^ (2u + (unsigned)hi)) + 8u * (pp & 1u);
    for (int pi = 0; pi < npg; ++pi) {
        ldsp pg = lds + (pi & 1) * PG_BYTES;
        if (pi + 1 < npg) page_load(st, ckv, ckr, (size_t)pt[pi + 1] * PAGE, tid);
        unsigned xko = xk, qqo = qq; asm volatile("" : "+v"(xko), "+v"(qqo));
        f32x16 s;
#pragma unroll
        for (int r = 0; r < 16; ++r) s[r] = 0.f;
#pragma unroll
        for (int k = 0; k < 8; ++k) s = ATT_MFMA(lds_b128(pg + ka + 32u * ((unsigned)k ^ xko)), qf[k], s);
        s = ATT_MFMA(lds_b128(pg + kr0), qf[8], s);
        s = ATT_MFMA(lds_b128(pg + kr1), qf[9], s);
        float rm = s[0];
#pragma unroll
        for (int r = 1; r < 16; ++r) rm = fmaxf(rm, s[r]);
        rm = swapmax(rm);
        const bool first = (pi == 0);
        if (first) m = rm;
        rm -= m;
        if (!first && __any(rm > THR)) {
            const float dlt = fmaxf(rm, 0.f);
            m += dlt;
            { const float f = __builtin_amdgcn_exp2f(-dlt); l *= f;
#pragma unroll
                for (int c = 0; c < 4; ++c)
#pragma unroll
                    for (int r = 0; r < 16; ++r) o[c][r] *= f; }
        }
        float sum = 0.f;
#pragma unroll
        for (int r = 0; r < 16; ++r) { s[r] = __builtin_amdgcn_exp2f(s[r] - m); sum += s[r]; }
        l += sum;
#pragma unroll
        for (int ks = 0; ks < 2; ++ks) {
            u32x4 pw; pw.x = cvtpk(s[8 * ks + 0], s[8 * ks + 1]); pw.y = cvtpk(s[8 * ks + 2], s[8 * ks + 3]); pw.z = cvtpk(s[8 * ks + 4], s[8 * ks + 5]); pw.w = cvtpk(s[8 * ks + 6], s[8 * ks + 7]);
            const bf16x8 pf = __builtin_bit_cast(bf16x8, pw);
#pragma unroll
            for (int c = 0; c < 4; ++c) {
                const unsigned co = 64u * ((unsigned)c ^ qqo);
                const s16x4 lo = lds_tr(pg + vb0 + co + 4096 * ks);
                const s16x4 hv = lds_tr(pg + vb1 + co + 4096 * ks);
                const bf16x8 vf = {lo[0], lo[1], lo[2], lo[3], hv[0], hv[1], hv[2], hv[3]};
                o[c] = ATT_MFMA(vf, pf, o[c]);
            }
        }
        if (pi + 1 < npg) page_store(st, lds + ((pi + 1) & 1) * PG_BYTES, dl, dr);
        __syncthreads();
    }
    ATT_LAS float* reg = (ATT_LAS float*)(lds) + qb * PART_FLOATS;
    for (int g = 0; g < 4; ++g) {
        if (grp == g) {
            if (g > 0) { const float m2 = reg[64 * 64 + lane], l2 = reg[65 * 64 + lane]; const float mn = fmaxf(m, m2); const float a1 = __builtin_amdgcn_exp2f(m - mn), a2 = __builtin_amdgcn_exp2f(m2 - mn);
#pragma unroll
                for (int c = 0; c < 4; ++c)
#pragma unroll
                    for (int r = 0; r < 16; ++r) o[c][r] = o[c][r] * a1 + reg[(c * 16 + r) * 64 + lane] * a2;
                l = l * a1 + l2 * a2; m = mn; }
            if (g < 3) {
#pragma unroll
                for (int c = 0; c < 4; ++c)
#pragma unroll
                    for (int r = 0; r < 16; ++r) reg[(c * 16 + r) * 64 + lane] = o[c][r];
                reg[64 * 64 + lane] = m; reg[65 * 64 + lane] = l; }
            else { float* gp = PART + (size_t)qb * PART_FLOATS;
#pragma unroll
                for (int c = 0; c < 4; ++c)
#pragma unroll
                    for (int r = 0; r < 16; ++r) gp[(c * 16 + r) * 64 + lane] = o[c][r];
                gp[64 * 64 + lane] = m; gp[65 * 64 + lane] = l; }
        }
        __syncthreads();
    }
}
__device__ __forceinline__ void decode_combine(ldsp lds, const bf16* __restrict__ Qb, const float* __restrict__ KN, const float* __restrict__ KR, const float* __restrict__ PARTdb, int ns,
                                               const float* __restrict__ w_uv, const float* __restrict__ gm, bf16* __restrict__ YC, int db) {
    const int tid = threadIdx.x, lane = tid & 63, wid = tid >> 6, qb = wid >> 2, rg = wid & 3, r32 = lane & 31, hi = lane >> 5;
    ATT_LAS float* sc = (ATT_LAS float*)lds;
    ATT_LAS float* ol = (ATT_LAS float*)(lds + 2048);
    ATT_LAS float* red = (ATT_LAS float*)(lds + 2048 + 32768);
    __syncthreads();
    { const int q = tid >> 3, sp = tid & 7;
      const bf16* qp = Qb + (((size_t)RP + (size_t)db * DS) * NH + q) * QD; const float* kn = KN + ((size_t)db * DS + sp) * KVL; const float* kr = KR + ((size_t)db * DS + sp) * ROPE;
      float a = 0.f;
      for (int d = 0; d < KVL; ++d) a += __uint_as_float((unsigned)qp[d] << 16) * kn[d];
      for (int d = 0; d < ROPE; ++d) a += __uint_as_float((unsigned)qp[KVL + d] << 16) * kr[d];
      sc[q * 8 + sp] = a; }
    __syncthreads();
    const int q = 32 * qb + r32, stok = q >> 3, hq = q & 7;
    float M = -INFINITY;
    for (int i = 0; i < ns; ++i) M = fmaxf(M, PARTdb[((size_t)i * 2 + qb) * PART_FLOATS + 64 * 64 + lane]);
    for (int sp = 0; sp <= stok; ++sp) M = fmaxf(M, sc[q * 8 + sp]);
    float acc[16], lsum = 0.f;
#pragma unroll
    for (int r = 0; r < 16; ++r) acc[r] = 0.f;
    for (int i = 0; i < ns; ++i) { const float* pp = PARTdb + ((size_t)i * 2 + qb) * PART_FLOATS; const float f = __builtin_amdgcn_exp2f(pp[64 * 64 + lane] - M);
        lsum += f * pp[65 * 64 + lane];
#pragma unroll
        for (int r = 0; r < 16; ++r) acc[r] += f * pp[(rg * 16 + r) * 64 + lane]; }
    lsum += __shfl_xor(lsum, 32);
    for (int sp = 0; sp <= stok; ++sp) { const float p = __builtin_amdgcn_exp2f(sc[q * 8 + sp] - M); lsum += p; const float* kn = KN + ((size_t)db * DS + sp) * KVL;
#pragma unroll
        for (int r = 0; r < 16; ++r) acc[r] += p * kn[32 * rg + crow(r, hi)]; }
    const float rl = 1.0f / lsum;
#pragma unroll
    for (int r = 0; r < 16; ++r) ol[q * KVL + 32 * rg + crow(r, hi)] = acc[r] * rl;
    __syncthreads();
    float y[8];
#pragma unroll
    for (int s = 0; s < 8; ++s) y[s] = 0.f;
    for (int c = 0; c < KVL; ++c) { const float w = w_uv[((size_t)c * NH + wid) * VD + lane];
#pragma unroll
        for (int s = 0; s < 8; ++s) y[s] += ol[(s * 8 + wid) * KVL + c] * w; }
    (void)hq;
#pragma unroll
    for (int s = 0; s < 8; ++s) { float v = y[s] * y[s];
#pragma unroll
        for (int o = 1; o < 64; o <<= 1) v += __shfl_xor(v, o);
        if (lane == 0) red[wid * 8 + s] = v; }
    __syncthreads();
#pragma unroll
    for (int s = 0; s < 8; ++s) { float t = 0.f;
#pragma unroll
        for (int w = 0; w < 8; ++w) t += red[w * 8 + s];
        const float rstd = 1.0f / sqrtf(t * (1.0f / DMLA) + EPS);
        YC[((size_t)RP + (size_t)db * DS + s) * DMIX + DLRU + wid * VD + lane] = (bf16)f2bf(y[s] * rstd * gm[wid * VD + lane]); }
}
}
constexpr size_t MiB = 1u << 20;
constexpr size_t WS_CTL = 0, CTL_ZERO_BYTES = 64 * 1024;
constexpr size_t WS_WGU1 = 2 * MiB, WS_WD1 = 14 * MiB, WS_WGU2 = 20 * MiB, WS_WD2 = 32 * MiB, WS_WIN = 38 * MiB, WS_WOUT = 42 * MiB, WS_WQ = 44 * MiB, WS_SUM = 46 * MiB;
constexpr size_t WS_XN = 64 * MiB, WS_H = 100 * MiB, WS_X1 = 200 * MiB, WS_X2 = 270 * MiB, WS_Z = 340 * MiB, WS_QALL = 444 * MiB, WS_CQN = 530 * MiB;
constexpr size_t WS_A = 540 * MiB, WS_U = 576 * MiB, WS_YL = 612 * MiB, WS_OLAT = 648 * MiB, WS_YC = 720 * MiB, WS_QB = 760 * MiB, WS_KC = 820 * MiB, WS_PART = 830 * MiB, WS_END = 900 * MiB;
constexpr int CW_BAR = 1024;
static_assert((CW_BAR + XCD_BAR_WORDS) * 4 <= (int)CTL_ZERO_BYTES, "CTL");
constexpr int RING_BYTES = 131072, LDSCTL_OFF = RING_BYTES, MISC_OFF = LDSCTL_OFF + 320, LDS_BYTES = 147456;
constexpr int NSPLIT = 2;
constexpr int CHUNK = 64, NCHUNK = SEQ / CHUNK;

struct Params { const float* in[33]; float* out; unsigned char* ws; int ph_lo, ph_hi; };
static_assert(sizeof(Params) == 33 * 8 + 8 + 8 + 8, "Params has no padding");

__device__ __forceinline__ void transpose_item(const float* __restrict__ W, int K, int N, bf16* __restrict__ WT, int mode, LAS float* scr, int item, int lane) {
    const int nblk = N / 32, kb = item / nblk, nb = item % nblk, k0 = 64 * kb, n0 = 32 * nb;
    const int drow0 = (mode == 0) ? n0 : 256 * (n0 / 128) + (n0 % 128) + (mode == 2 ? 128 : 0);
#pragma unroll 8
    for (int i = 0; i < 32; ++i) { const int kk = 2 * i + (lane >> 5); scr[kk * 33 + (lane & 31)] = W[(size_t)(k0 + kk) * N + n0 + (lane & 31)]; }
    LDS_WAIT(); asm volatile("" ::: "memory");
    const int c = lane & 7;
#pragma unroll
    for (int j = 0; j < 4; ++j) { const int n = (lane >> 3) + 8 * j; const LAS float* s = scr + (8 * c) * 33 + n;
        v4u o; o.x = pk2(s[0 * 33], s[1 * 33]); o.y = pk2(s[2 * 33], s[3 * 33]); o.z = pk2(s[4 * 33], s[5 * 33]); o.w = pk2(s[6 * 33], s[7 * 33]);
        *(v4u*)(WT + (size_t)(drow0 + n) * K + k0 + 8 * c) = o; }
    LDS_WAIT(); asm volatile("" ::: "memory");
}
template <bool OUT_BF16>
__device__ __forceinline__ void rmsnorm_rows(const float* __restrict__ x0, const float* __restrict__ x1, int split, const float* __restrict__ gain, void* __restrict__ outp) {
    const int lane = threadIdx.x & 63, gw = blockIdx.x * 8 + (threadIdx.x >> 6), NGW = gridDim.x * 8;
    for (int row = gw; row < R; row += NGW) {
        const float* xr = (row < split) ? x0 + (size_t)row * DM : x1 + (size_t)(row - split) * DM;
        f32x4 v[4]; float s = 0.f;
#pragma unroll
        for (int j = 0; j < 4; ++j) { v[j] = ((const f32x4*)xr)[lane + 64 * j]; s += (v[j].x * v[j].x + v[j].y * v[j].y) + (v[j].z * v[j].z + v[j].w * v[j].w); }
        const float rstd = 1.0f / sqrtf(wave_sum(s) * (1.0f / DM) + EPS);
#pragma unroll
        for (int j = 0; j < 4; ++j) { const f32x4 g = ((const f32x4*)gain)[lane + 64 * j]; const f32x4 o = v[j] * rstd * g;
            if (OUT_BF16) { unsigned long long w = (unsigned long long)pk2(o.x, o.y) | ((unsigned long long)pk2(o.z, o.w) << 32); ((unsigned long long*)((bf16*)outp + (size_t)row * DM))[lane + 64 * j] = w; }
            else ((f32x4*)((float*)outp + (size_t)row * DM))[lane + 64 * j] = o; }
    }
}
__device__ __forceinline__ void p_prologue(const Params& p, LAS unsigned char* lds) {
    const int tid = threadIdx.x, lane = tid & 63, wave = tid >> 6, gw = blockIdx.x * 8 + wave, NGW = gridDim.x * 8;
    unsigned char* ws = p.ws;
    LAS float* scr = (LAS float*)(lds + wave * 16384);
    constexpr int I_F = (DM / 64) * (DFF / 32), I_IN = (DM / 64) * (DIN / 32), I_OUT = (DMIX / 64) * (DM / 32), NITEMS = 6 * I_F + I_IN + I_OUT;
    static_assert((DFF / 64) * (DM / 32) == I_F, "down items");
    for (int it = gw; it < NITEMS; it += NGW) {
        int r = it;
        if (r < I_F) { transpose_item(p.in[8], DM, DFF, (bf16*)(ws + WS_WGU1), 1, scr, r, lane); continue; } r -= I_F;
        if (r < I_F) { transpose_item(p.in[9], DM, DFF, (bf16*)(ws + WS_WGU1), 2, scr, r, lane); continue; } r -= I_F;
        if (r < I_F) { transpose_item(p.in[10], DFF, DM, (bf16*)(ws + WS_WD1), 0, scr, r, lane); continue; } r -= I_F;
        if (r < I_F) { transpose_item(p.in[29], DM, DFF, (bf16*)(ws + WS_WGU2), 1, scr, r, lane); continue; } r -= I_F;
        if (r < I_F) { transpose_item(p.in[30], DM, DFF, (bf16*)(ws + WS_WGU2), 2, scr, r, lane); continue; } r -= I_F;
        if (r < I_F) { transpose_item(p.in[31], DFF, DM, (bf16*)(ws + WS_WD2), 0, scr, r, lane); continue; } r -= I_F;
        if (r < I_IN) { transpose_item(p.in[12], DM, DIN, (bf16*)(ws + WS_WIN), 0, scr, r, lane); continue; } r -= I_IN;
        transpose_item(p.in[27], DMIX, DM, (bf16*)(ws + WS_WOUT), 0, scr, r, lane);
    }
    const int gt = blockIdx.x * 512 + tid, NGT = gridDim.x * 512;
    { unsigned* z = (unsigned*)((bf16*)(ws + WS_WIN) + (size_t)DIN * DM); for (int i = gt; i < (DINP - DIN) * DM / 2; i += NGT) z[i] = 0u; }
    { const float* wq = p.in[21]; const float* wuk = p.in[23]; bf16* WqT = (bf16*)(ws + WS_WQ);
      for (int idx = gt; idx < NQ * QL; idx += NGT) { const int n = idx / QL, k = idx % QL; float v;
          if (n < NH * KVL) { const int h = n / KVL, c = n % KVL; const float* a = wq + (size_t)k * (NH * 96) + h * 96; const float* b = wuk + ((size_t)c * NH + h) * NOPE; float s = 0.f;
              for (int j = 0; j < NOPE; ++j) s += a[j] * b[j]; v = s; }
          else { const int h = (n - NH * KVL) / ROPE, r = (n - NH * KVL) % ROPE; v = wq[(size_t)k * (NH * 96) + h * 96 + NOPE + r]; }
          WqT[idx] = (bf16)f2bf(v); } }
    rmsnorm_rows<true>(p.in[0], p.in[1], RP, p.in[7], ws + WS_XN);
}

__device__ __forceinline__ float half_sum(float v, LAS float* red4) {
    v = wave_sum(v);
    __syncthreads();
    if ((threadIdx.x & 63) == 0) red4[(threadIdx.x >> 6) & 3] = v;
    __syncthreads();
    return (red4[0] + red4[1]) + (red4[2] + red4[3]);
}
__device__ __forceinline__ void p_mixprep(const Params& p, LAS unsigned char* lds) {
    const int sub = threadIdx.x >> 8, tid = threadIdx.x & 255;
    LAS float* zs = (LAS float*)lds + sub * DINP; LAS float* xcs = (LAS float*)lds + 2 * DINP + sub * DLRU; LAS float* red = (LAS float*)lds + 2 * DINP + 2 * DLRU + sub * 4;
    const float* Z = (const float*)(p.ws + WS_Z); float* out = p.out; bf16* CQN = (bf16*)(p.ws + WS_CQN); float* Aout = (float*)(p.ws + WS_A); float* Uout = (float*)(p.ws + WS_U);
    const float* conv_w = p.in[13]; const float* conv_b = p.in[14]; const float* w_a = p.in[15]; const float* b_a = p.in[16]; const float* w_i = p.in[17]; const float* b_i = p.in[18];
    const float* lam = p.in[19]; const float* q_norm = p.in[20]; const float* kv_norm = p.in[22]; const float* state_conv = p.in[5];
    for (int rp = blockIdx.x; rp < R / 2; rp += gridDim.x) {
        const int row = 2 * rp + sub;
        const bool prompt = row < RP;
        const int b = prompt ? row / SEQ : (row - RP) / DS, t = prompt ? row % SEQ : (row - RP) % DS;
        const int pos = prompt ? t : PAST + t;
        const float* zr = Z + (size_t)row * DINP;
        __syncthreads();
        for (int i = tid; i < DINP / 4; i += 256) ((LAS f32x4*)zs)[i] = ((const f32x4*)zr)[i];
        __syncthreads();
        { const float v = zs[2 * DLRU + tid]; const float ssq = half_sum(v * v, red); const float rstd = 1.0f / sqrtf(ssq * (1.0f / QL) + EPS);
          CQN[(size_t)row * QL + tid] = (bf16)f2bf(v * rstd * q_norm[tid]); }
        { const float v = tid < KVL ? zs[2 * DLRU + QL + tid] : 0.f; const float ssq = half_sum(v * v, red); const float rstd = 1.0f / sqrtf(ssq * (1.0f / KVL) + EPS);
          float* o = prompt ? out + O_KVP + (size_t)row * KVL : out + O_KVS + (size_t)(row - RP) * KVL;
          if (tid < KVL) o[tid] = v * rstd * kv_norm[tid]; }
        if (tid < 16) { const float x1 = zs[2 * DLRU + QL + KVL + tid], x2 = zs[2 * DLRU + QL + KVL + 16 + tid]; float c, s; rope_cs(pos, tid, c, s);
          float* o = prompt ? out + O_KRP + (size_t)row * ROPE : out + O_KRS + (size_t)(row - RP) * ROPE;
          o[tid] = x1 * c - x2 * s; o[tid + 16] = x2 * c + x1 * s; }
        float xcv[2];
#pragma unroll
        for (int k = 0; k < 2; ++k) { const int ch = tid + 256 * k; float xm[3];
#pragma unroll
            for (int j = 1; j <= 3; ++j) { float v; if (t - j >= 0) v = Z[(size_t)(row - j) * DINP + ch]; else v = prompt ? 0.f : state_conv[((size_t)b * 3 + (3 + t - j)) * DLRU + ch]; xm[j - 1] = v; }
            const float xc = conv_b[ch] + conv_w[0 * DLRU + ch] * xm[2] + conv_w[1 * DLRU + ch] * xm[1] + conv_w[2 * DLRU + ch] * xm[0] + conv_w[3 * DLRU + ch] * zs[ch];
            xcv[k] = xc; xcs[ch] = xc;
            if (prompt) { if (t >= SEQ - 3) out[O_CVP + ((size_t)b * 3 + (t - (SEQ - 3))) * DLRU + ch] = zs[ch]; }
            else { if (t >= DS - 3) out[O_CVS + ((size_t)b * 3 + (t - (DS - 3))) * DLRU + ch] = zs[ch]; } }
        __syncthreads();
#pragma unroll
        for (int k = 0; k < 2; ++k) { const int ch = tid + 256 * k, n = ch / BLK, e = ch % BLK; float ra = b_a[ch], ia = b_i[ch];
            const float* wa = w_a + (size_t)n * BLK * BLK + e; const float* wi = w_i + (size_t)n * BLK * BLK + e; const LAS float* xb = xcs + n * BLK;
#pragma unroll 4
            for (int d = 0; d < BLK; ++d) { const float x = xb[d]; ra += x * wa[d * BLK]; ia += x * wi[d * BLK]; }
            const float r = sigmoidf_(ra), ig = sigmoidf_(ia);
            const float nl = -lam[ch]; const float sp = fmaxf(nl, 0.f) + log1pf(__expf(-fabsf(nl)));
            const float log_a = -8.0f * r * sp; const float a = __expf(log_a); const float u = sqrtf(-expm1f(2.0f * log_a)) * (ig * xcv[k]);
            Aout[(size_t)row * DLRU + ch] = a; Uout[(size_t)row * DLRU + ch] = u; }
    }
}

__device__ __forceinline__ void p_cvt_qk(const Params& p) {
    const int tid = threadIdx.x; const float* Qall = (const float*)(p.ws + WS_QALL); bf16* Qb = (bf16*)(p.ws + WS_QB); bf16* KC = (bf16*)(p.ws + WS_KC); const float* out = p.out;
    for (int row = blockIdx.x; row < R; row += gridDim.x) {
        const int pos = row < RP ? row % SEQ : PAST + (row - RP) % DS;
        const float* qr = Qall + (size_t)row * NQ;
        for (int i = tid; i < NH * KVL; i += 512) { const int h = i / KVL, c = i % KVL; Qb[((size_t)row * NH + h) * QD + c] = (bf16)f2bf(qr[i] * QSCALE); }
        if (tid < NH * 16) { const int h = tid / 16, i = tid % 16; const float x1 = qr[NH * KVL + h * ROPE + i], x2 = qr[NH * KVL + h * ROPE + 16 + i]; float c, s; rope_cs(pos, i, c, s);
            Qb[((size_t)row * NH + h) * QD + KVL + i] = (bf16)f2bf((x1 * c - x2 * s) * QSCALE); Qb[((size_t)row * NH + h) * QD + KVL + 16 + i] = (bf16)f2bf((x2 * c + x1 * s) * QSCALE); }
        if (row < RP && tid >= 256) { const int j = tid - 256; if (j < KVL) KC[(size_t)row * QD + j] = (bf16)f2bf(out[O_KVP + (size_t)row * KVL + j]); else if (j < QD) KC[(size_t)row * QD + j] = (bf16)f2bf(out[O_KRP + (size_t)row * ROPE + (j - KVL)]); }
    }
}

__device__ __forceinline__ void p_scan_local(const Params& p) {
    const float* A = (const float*)(p.ws + WS_A); const float* U = (const float*)(p.ws + WS_U); float* SUM = (float*)(p.ws + WS_SUM);
    for (int g = blockIdx.x * 512 + threadIdx.x; g < NB * NCHUNK * DLRU; g += gridDim.x * 512) {
        const int ch = g % DLRU, c = (g / DLRU) % NCHUNK, b = g / (DLRU * NCHUNK);
        const size_t base = ((size_t)b * SEQ + (size_t)c * CHUNK) * DLRU + ch; float h = 0.f, pr = 1.f;
#pragma unroll 8
        for (int t = 0; t < CHUNK; ++t) { const float a = A[base + (size_t)t * DLRU]; h = a * h + U[base + (size_t)t * DLRU]; pr *= a; }
        SUM[(size_t)g * 2] = pr; SUM[(size_t)g * 2 + 1] = h;
    }
}
__device__ __forceinline__ void p_scan_fix(const Params& p) {
    const float* A = (const float*)(p.ws + WS_A); const float* U = (const float*)(p.ws + WS_U); const float* SUM = (const float*)(p.ws + WS_SUM); const float* Z = (const float*)(p.ws + WS_Z);
    float* YL = (float*)(p.ws + WS_YL); float* out = p.out;
    for (int g = blockIdx.x * 512 + threadIdx.x; g < NB * NCHUNK * DLRU; g += gridDim.x * 512) {
        const int ch = g % DLRU, c = (g / DLRU) % NCHUNK, b = g / (DLRU * NCHUNK);
        float h = 0.f;
        for (int k = 0; k < c; ++k) { const size_t si = (((size_t)b * NCHUNK + k) * DLRU + ch) * 2; h = SUM[si] * h + SUM[si + 1]; }
        const size_t row0 = (size_t)b * SEQ + (size_t)c * CHUNK;
#pragma unroll 4
        for (int t = 0; t < CHUNK; ++t) { const size_t row = row0 + t; h = A[row * DLRU + ch] * h + U[row * DLRU + ch]; YL[row * DLRU + ch] = gelu_tanh(Z[row * DINP + DLRU + ch]) * h; }
        if (c == NCHUNK - 1) out[O_HP + (size_t)b * DLRU + ch] = h;
    }
    const float* h0 = p.in[4];
    for (int g = blockIdx.x * 512 + threadIdx.x; g < DB * DLRU; g += gridDim.x * 512) {
        const int b = g / DLRU, ch = g % DLRU; float h = h0[g];
#pragma unroll
        for (int t = 0; t < DS; ++t) { const size_t row = (size_t)RP + (size_t)b * DS + t; h = A[row * DLRU + ch] * h + U[row * DLRU + ch]; YL[row * DLRU + ch] = gelu_tanh(Z[row * DINP + DLRU + ch]) * h; }
        out[O_HS + g] = h;
    }
}

__device__ __forceinline__ void p_outprep(const Params& p, LAS unsigned char* lds) {
    const int sub = threadIdx.x >> 8, tid = threadIdx.x & 255;
    LAS float* ol = (LAS float*)lds + sub * (NH * KVL); LAS float* red = (LAS float*)lds + 2 * NH * KVL + sub * 4;
    const float* OLAT = (const float*)(p.ws + WS_OLAT); const float* YL = (const float*)(p.ws + WS_YL); bf16* YC = (bf16*)(p.ws + WS_YC);
    const float* w_uv = p.in[24]; const float* gl = p.in[25]; const float* gm = p.in[26];
    for (int rp = blockIdx.x; rp < R / 2; rp += gridDim.x) {
        const int row = 2 * rp + sub; const bool prompt = row < RP;
        __syncthreads();
        if (prompt) for (int i = tid; i < NH * KVL / 4; i += 256) ((LAS f32x4*)ol)[i] = ((const f32x4*)(OLAT + (size_t)row * NH * KVL))[i];
        __syncthreads();
        float y[2], yl[2];
#pragma unroll
        for (int k = 0; k < 2; ++k) { const int oo = tid + 256 * k, h = oo / VD, v = oo % VD; float s = 0.f;
            if (prompt) for (int c = 0; c < KVL; ++c) s += ol[h * KVL + c] * w_uv[((size_t)c * NH + h) * VD + v];
            y[k] = s; yl[k] = YL[(size_t)row * DLRU + oo]; }
        const float rm = 1.0f / sqrtf(half_sum(y[0] * y[0] + y[1] * y[1], red) * (1.0f / DMLA) + EPS);
        const float rl = 1.0f / sqrtf(half_sum(yl[0] * yl[0] + yl[1] * yl[1], red) * (1.0f / DLRU) + EPS);
#pragma unroll
        for (int k = 0; k < 2; ++k) { const int oo = tid + 256 * k;
            YC[(size_t)row * DMIX + oo] = (bf16)f2bf(yl[k] * rl * gl[oo]); if (prompt) YC[(size_t)row * DMIX + DLRU + oo] = (bf16)f2bf(y[k] * rm * gm[oo]); }
    }
}

#define GEMM_PHASE(Epi, Aptr, Bptr, Nn, Kk, Eobj) do { pg8::Gemm g_{(const pg8::bf16_t*)(Aptr), (const pg8::bf16_t*)(Bptr), R, (Nn), (Kk)}; pg8::StaticOrder S_; S_.init(R, (Nn), (int)gridDim.x, (int)blockIdx.x); \
    pg8::gemm_phase<Epi, pg8::StaticOrder, true, true>((PG8_LAS unsigned char*)lds, g_, S_, (Eobj)); } while (0)
constexpr int N_PHASES = 15;
__global__ void __launch_bounds__(512, 2) mega(Params p) {
    extern __shared__ __attribute__((aligned(16))) unsigned char lds_raw[];
    LAS unsigned char* lds = (LAS unsigned char*)lds_raw;
    volatile LAS unsigned* MISC = (volatile LAS unsigned*)(lds + MISC_OFF);
    for (int u = threadIdx.x; u < (LDS_BYTES - LDSCTL_OFF) / 4; u += 512) ((LAS unsigned*)(lds + LDSCTL_OFF))[u] = 0u;
    __syncthreads();
    unsigned char* ws = p.ws; float* out = p.out;
    XcdBarrier bar = xcd_barrier_post((unsigned*)(ws + WS_CTL) + CW_BAR, MISC + 8);
    const int lo = p.ph_lo, hi = p.ph_hi;
#ifdef ONLY_PHASE
#define IN(k) ((k) == ONLY_PHASE && lo <= (k) && (k) < hi)
#else
#define IN(k) (lo <= (k) && (k) < hi)
#endif
#define SEAM(k) do { if (IN(k) && IN((k) + 1)) xcd_barrier(bar); } while (0)
    bf16 *Wgu1 = (bf16*)(ws + WS_WGU1), *Wd1 = (bf16*)(ws + WS_WD1), *Wgu2 = (bf16*)(ws + WS_WGU2), *Wd2 = (bf16*)(ws + WS_WD2), *Win = (bf16*)(ws + WS_WIN), *Wout = (bf16*)(ws + WS_WOUT), *Wq = (bf16*)(ws + WS_WQ);
    bf16 *XN = (bf16*)(ws + WS_XN), *H = (bf16*)(ws + WS_H), *CQN = (bf16*)(ws + WS_CQN), *YC = (bf16*)(ws + WS_YC), *Qb = (bf16*)(ws + WS_QB), *KC = (bf16*)(ws + WS_KC);
    float *X1 = (float*)(ws + WS_X1), *X2 = (float*)(ws + WS_X2), *Z = (float*)(ws + WS_Z), *QALL = (float*)(ws + WS_QALL), *OLAT = (float*)(ws + WS_OLAT), *PART = (float*)(ws + WS_PART);

    if (IN(0)) p_prologue(p, lds);
    SEAM(0);
    if (IN(1)) { pg8::EpiSwiGLU E{H, DFF, 0}; GEMM_PHASE(pg8::EpiSwiGLU, XN, Wgu1, NGU, DM, E); }
    SEAM(1);
    if (IN(2)) { pg8::EpiF32 E{X1, p.in[0], p.in[1], DM, RP / 256, 0.5f, 0}; GEMM_PHASE(pg8::EpiF32, H, Wd1, DM, DFF, E); }
    SEAM(2);
    if (IN(3)) rmsnorm_rows<true>(X1, X1, R, p.in[11], XN);
    SEAM(3);
    if (IN(4)) { pg8::EpiF32 E{Z, nullptr, nullptr, DINP, 0, 1.0f, 0}; GEMM_PHASE(pg8::EpiF32, XN, Win, DINP, DM, E); }
    SEAM(4);
    if (IN(5)) p_mixprep(p, lds);
    SEAM(5);
    if (IN(6)) { pg8::EpiF32 E{QALL, nullptr, nullptr, NQ, 0, 1.0f, 0}; GEMM_PHASE(pg8::EpiF32, CQN, Wq, NQ, QL, E); }
    SEAM(6);
    if (IN(7)) { p_cvt_qk(p); p_scan_local(p); }
    SEAM(7);
    if (IN(8)) {
        p_scan_fix(p);
#pragma unroll 1
        for (int u2 = 2 * (int)blockIdx.x; u2 < NB * SEQ / 32; ++u2) { const int pr = u2 >> 1, b = pr & 1, i = pr >> 1;
            att::prompt_unit((att::ldsp)lds, Qb, KC, OLAT, b, (u2 & 1) ? i : SEQ / 32 - 1 - i);
            if (u2 & 1) u2 += 2 * ((int)gridDim.x - 1); }
        for (int item = blockIdx.x; item < DB * NSPLIT; item += gridDim.x) { const int db = item / NSPLIT, ch = item % NSPLIT;
            att::decode_item((att::ldsp)lds, Qb, p.in[2], p.in[3], (const int*)p.in[6], PART + (size_t)item * 2 * att::PART_FLOATS, db, ch * (NPAGES / NSPLIT), NPAGES / NSPLIT); }
    }
    SEAM(8);
    if (IN(9)) {
        p_outprep(p, lds);
        for (int db = blockIdx.x; db < DB; db += gridDim.x)
            att::decode_combine((att::ldsp)lds, Qb, out + O_KVS, out + O_KRS, PART + (size_t)db * NSPLIT * 2 * att::PART_FLOATS, NSPLIT, p.in[24], p.in[26], YC, db);
    }
    SEAM(9);
    if (IN(10)) { pg8::EpiF32 E{X2, X1, X1, DM, 1 << 20, 1.0f, 0}; GEMM_PHASE(pg8::EpiF32, YC, Wout, DM, DMIX, E); }
    SEAM(10);
    if (IN(11)) rmsnorm_rows<true>(X2, X2, R, p.in[28], XN);
    SEAM(11);
    if (IN(12)) { pg8::EpiSwiGLU E{H, DFF, 0}; GEMM_PHASE(pg8::EpiSwiGLU, XN, Wgu2, NGU, DM, E); }
    SEAM(12);
    if (IN(13)) { pg8::EpiF32 E{X1, X2, X2, DM, 1 << 20, 0.5f, 0}; GEMM_PHASE(pg8::EpiF32, H, Wd2, DM, DFF, E); }
    SEAM(13);
    if (IN(14)) rmsnorm_rows<false>(X1, X1, R, p.in[32], out);
#undef IN
#undef SEAM
}

#ifndef MK_N_LAUNCHES
#define MK_N_LAUNCHES 1
#endif
extern "C" void kernel_launch(void* const* d_in, const int* in_sizes, int n_in, void* d_out, int out_size, void* d_ws, size_t ws_size, hipStream_t stream) {
    static int grid = 0;
    if (grid == 0) {
        if (n_in != 33 || out_size != (int)O_END || ws_size < WS_END) { fprintf(stderr, "kernel_launch: unexpected shapes (n_in %d, out %d, ws %zu)\n", n_in, out_size, ws_size); grid = -1; return; }
        int dev = 0, cus = 0, per_cu = 0;
        if (hipGetDevice(&dev) != hipSuccess || hipDeviceGetAttribute(&cus, hipDeviceAttributeMultiprocessorCount, dev) != hipSuccess) { grid = -1; return; }
        if (hipFuncSetAttribute((const void*)mega, hipFuncAttributeMaxDynamicSharedMemorySize, LDS_BYTES) != hipSuccess) { fprintf(stderr, "kernel_launch: hipFuncSetAttribute failed\n"); grid = -1; return; }
        if (hipOccupancyMaxActiveBlocksPerMultiprocessor(&per_cu, (const void*)mega, 512, LDS_BYTES) != hipSuccess || per_cu < 1) fprintf(stderr, "kernel_launch: occupancy query says %d\n", per_cu);
        (void)hipGetLastError();
        grid = cus;
    }
    if (grid < 0) return;
    (void)hipMemsetAsync((char*)d_ws + WS_CTL, 0, CTL_ZERO_BYTES, stream);
    Params prm; memset(&prm, 0, sizeof(prm));
    for (int i = 0; i < 33; ++i) prm.in[i] = (const float*)d_in[i];
    prm.out = (float*)d_out; prm.ws = (unsigned char*)d_ws;
    if (MK_N_LAUNCHES == 1) { prm.ph_lo = 0; prm.ph_hi = N_PHASES; hipLaunchKernelGGL(mega, dim3(grid), dim3(512), LDS_BYTES, stream, prm); }
    else for (int k = 0; k < N_PHASES; ++k) { prm.ph_lo = k; prm.ph_hi = k + 1; hipLaunchKernelGGL(mega, dim3(grid), dim3(512), LDS_BYTES, stream, prm); }
}
```

```cpp
#include <hip/hip_runtime.h>
#include <cstdio>
#include <cstdint>
#include <cstring>
constexpr int DM = 1024, SEQ = 8192, NB = 2, RP = NB * SEQ, DB = 128, DS = 8, RS = DB * DS, R = RP + RS;
constexpr int PAST = 16384, PAGE = 128, NPAGES = PAST / PAGE;
constexpr int DLRU = 512, NBLK = 8, BLK = 64, CONVW = 4;
constexpr int NH = 8, NOPE = 64, ROPE = 32, VD = 64, QL = 256, KVL = 128, DMLA = 512, DMIX = 1024, DIN = 1440, DINP = 1536;
constexpr int DFF = 2816, NGU = 2 * DFF;
constexpr int NQ = NH * KVL + NH * ROPE;
constexpr int QD = KVL + ROPE;
constexpr float EPS = 1e-6f;
constexpr size_t O_YP = 0, O_YS = O_YP + (size_t)RP * DM, O_KVP = O_YS + (size_t)RS * DM, O_KRP = O_KVP + (size_t)RP * KVL, O_HP = O_KRP + (size_t)RP * ROPE,
                 O_CVP = O_HP + (size_t)NB * DLRU, O_KVS = O_CVP + (size_t)NB * 3 * DLRU, O_KRS = O_KVS + (size_t)RS * KVL, O_HS = O_KRS + (size_t)RS * ROPE,
                 O_CVS = O_HS + (size_t)DB * DLRU, O_END = O_CVS + (size_t)DB * 3 * DLRU;
static_assert(O_END == 20877312, "output size");
__device__ const float ROPE_FREQ[16] = {1.000000000e+00f, 5.623413324e-01f, 3.162277639e-01f, 1.778279394e-01f, 1.000000015e-01f, 5.623413250e-02f, 3.162277490e-02f, 1.778279431e-02f,
                                        9.999999776e-03f, 5.623413250e-03f, 3.162277630e-03f, 1.778279431e-03f, 1.000000047e-03f, 5.623413017e-04f, 3.162277571e-04f, 1.778279402e-04f};
namespace pg8 {
#define PG8_LAS __attribute__((address_space(3)))
typedef unsigned short bf16_t;
typedef short bf16x8 __attribute__((ext_vector_type(8)));
typedef float f32x4 __attribute__((ext_vector_type(4)));
typedef unsigned u32x4 __attribute__((ext_vector_type(4)));
constexpr int BM = 256, BK = 64, HALF = 128, HTB = HALF * BK * 2  , STAGE_BYTES = 8 * HTB, NXCD = 8, WGM = 8;

__host__ __device__ __forceinline__ int lds_byte(int r, int c) { const int st = (r >> 4) * 2 + (c >> 5), rr = r & 15, cc = c & 31, ob = rr * 64 + cc * 2; return st * 1024 + (ob ^ (((ob >> 9) & 1) << 5)); }
__host__ __device__ __forceinline__ void stage_rc(int b, int& R, int& C) { const int st = b / 1024, sb = b % 1024, swz = sb ^ (((sb >> 9) & 1) << 5); R = (st >> 1) * 16 + swz / 64; C = (st & 1) * 32 + (swz % 64) / 2; }
__host__ __device__ __forceinline__ int perm32(int rho) { const int n = rho >> 4, i = rho & 15; return 8 * (i >> 2) + 4 * n + (i & 3); }

struct Unit { int pm, pn; };
struct Gemm { const bf16_t* A; const bf16_t* Bt; int M, N, K; };

struct StaticOrder {
    int nM, nN, nwg, G, c;
    __host__ __device__ void init(int M, int N, int G_, int c_) { nM = M / BM; nN = N / BM; nwg = nM * nN; G = G_; c = c_; }
    __host__ __device__ bool next(int i, Unit& u) const {
        const long L = (long)i * G + c; if (L >= nwg) return false;
        int wgid = (int)L; { const int q = nwg / NXCD, r = nwg % NXCD, xcd = wgid % NXCD, off = wgid / NXCD; wgid = (xcd < r ? xcd * (q + 1) : r * (q + 1) + (xcd - r) * q) + off; }
        const int nig = WGM * nN, gid = wgid / nig, fm = gid * WGM, gsz = (nM - fm) < WGM ? (nM - fm) : WGM;
        u.pm = fm + ((wgid % nig) % gsz); u.pn = (wgid % nig) / gsz; return true;
    }
    __device__ __forceinline__ void a_ready(const Unit&) const {}
    __device__ __forceinline__ void done(const Unit&) const {}
};

__device__ __forceinline__ unsigned cvt_pk_bf16(float lo, float hi) { unsigned r; asm volatile("v_cvt_pk_bf16_f32 %0, %1, %2" : "=v"(r) : "v"(lo), "v"(hi)); return r; }
typedef float f32x2 __attribute__((ext_vector_type(2)));
typedef float f32x2 __attribute__((ext_vector_type(2)));
template <class Epi, class Sched, bool ALIGN_EPI = false, bool SP2 = false>
__device__ __forceinline__ void gemm_phase(PG8_LAS unsigned char* lds, const Gemm g, const Sched& S, const Epi& E) {
    const int tid = threadIdx.x, wid = __builtin_amdgcn_readfirstlane(tid >> 6), lane = tid & 63, wr = wid >> 2, wc = wid & 3, fr = lane & 15, fq = lane >> 4;
    const int K = g.K, nt = K / BK;
    unsigned voffA[2], voffB[2];
#pragma unroll
    for (int i = 0; i < 2; ++i) { int R, C; stage_rc(tid * 16 + i * 8192, R, C); const int Rb = Epi::PERM ? ((R & ~31) + perm32(R & 31)) : R;
        voffA[i] = (unsigned)(R * K + C) * 2u; voffB[i] = (unsigned)(Rb * K + C) * 2u; }
    const size_t kstep = (size_t)(BK * 2);
    const size_t hstep = (size_t)HALF * K * 2;
    const size_t tstep = 2 * hstep;
    const unsigned ldsw = (unsigned)wid * 1024u;
    const int aoff = lds_byte(wr * 64 + fr, fq * 8), boff = lds_byte(wc * 32 + fr, fq * 8);
#define PG8_SA(b, h) (((b) * 2 + (h)) * HTB)
#define PG8_SB(b, h) ((4 + (b) * 2 + (h)) * HTB)
#define PG8_STAGE(bufoff, gbase, voff) do { _Pragma("unroll") for (int _i = 0; _i < 2; ++_i) \
        __builtin_amdgcn_global_load_lds((const unsigned*)((const char*)(gbase) + (voff)[_i]), (PG8_LAS unsigned*)(lds + (bufoff) + ldsw + _i * 8192), 16, 0, 0); } while (0)
#define PG8_LDA(dst, b, h) do { _Pragma("unroll") for (int m = 0; m < 4; ++m) _Pragma("unroll") for (int k = 0; k < 2; ++k) dst[m][k] = *(const PG8_LAS bf16x8*)(lds + PG8_SA(b, h) + aoff + m * 2048 + k * 1024); } while (0)
#define PG8_LDB(dst, b, h) do { _Pragma("unroll") for (int n = 0; n < 2; ++n) _Pragma("unroll") for (int k = 0; k < 2; ++k) dst[n][k] = *(const PG8_LAS bf16x8*)(lds + PG8_SB(b, h) + boff + n * 2048 + k * 1024); } while (0)
#define PG8_MMA(ai, bj, At, Bt) do { __builtin_amdgcn_s_setprio(1); _Pragma("unroll") for (int m = 0; m < 4; ++m) _Pragma("unroll") for (int n = 0; n < 2; ++n) _Pragma("unroll") for (int k = 0; k < 2; ++k) \
        acc[ai][bj][m][n] = __builtin_amdgcn_mfma_f32_16x16x32_bf16(Bt[n][k], At[m][k], acc[ai][bj][m][n], 0, 0, 0); __builtin_amdgcn_s_setprio(0); } while (0)
#define PG8_WAIT_V(n) asm volatile("s_waitcnt vmcnt(" #n ")" ::: "memory")
#define PG8_WAIT_L(n) asm volatile("s_waitcnt lgkmcnt(" #n ")" ::: "memory")
#define PG8_BAR __builtin_amdgcn_s_barrier()
#define PG8_SCHED __builtin_amdgcn_sched_barrier(0)
    Unit cur, nxt; int ui = 0;
    if (!S.next(0, cur)) return;
    f32x4 acc[2][2][4][2];
#pragma unroll
    for (int a = 0; a < 2; ++a)
#pragma unroll
        for (int b = 0; b < 2; ++b)
#pragma unroll
            for (int m = 0; m < 4; ++m)
#pragma unroll
                for (int n = 0; n < 2; ++n) acc[a][b][m][n] = (f32x4){0.f, 0.f, 0.f, 0.f};
    bf16x8 At[4][2], B0[2][2], B1[2][2];
    const char* cA = (const char*)g.A + (size_t)cur.pm * tstep; const char* cB = (const char*)g.Bt + (size_t)cur.pn * tstep;
    S.a_ready(cur);
    if constexpr (SP2) {
        PG8_STAGE(PG8_SB(0, 0), cB, voffB); PG8_STAGE(PG8_SB(0, 1), cB + hstep, voffB); PG8_STAGE(PG8_SA(0, 0), cA, voffA); PG8_STAGE(PG8_SA(0, 1), cA + hstep, voffA);
        if (wr == 1) PG8_BAR;
        PG8_WAIT_V(2); PG8_BAR;
        PG8_STAGE(PG8_SB(1, 0), cB + kstep, voffB); PG8_STAGE(PG8_SA(1, 0), cA + kstep, voffA); PG8_STAGE(PG8_SB(1, 1), cB + hstep + kstep, voffB);
        PG8_WAIT_V(6); PG8_BAR;
    } else {
        PG8_STAGE(PG8_SB(0, 0), cB, voffB); PG8_STAGE(PG8_SA(0, 0), cA, voffA); PG8_STAGE(PG8_SB(0, 1), cB + hstep, voffB); PG8_STAGE(PG8_SA(0, 1), cA + hstep, voffA);
        if (wr == 1) PG8_BAR;
        PG8_WAIT_V(4); PG8_BAR;
        PG8_STAGE(PG8_SB(1, 0), cB + kstep, voffB); PG8_STAGE(PG8_SA(1, 0), cA + kstep, voffA); PG8_STAGE(PG8_SB(1, 1), cB + hstep + kstep, voffB);
        PG8_WAIT_V(6); PG8_BAR;
    }
    for (;;) {
        const bool has_next = S.next(ui + 1, nxt);
        const char* nA = has_next ? (const char*)g.A + (size_t)nxt.pm * tstep : cA; const char* nB = has_next ? (const char*)g.Bt + (size_t)nxt.pn * tstep : cB;
        for (int t = 0; t < nt; t += 2) {
            const bool last = (t == nt - 2);
            const char* a1 = cA + (size_t)(t + 1) * kstep;
            const char* a2 = last ? nA : cA + (size_t)(t + 2) * kstep; const char* b2 = last ? nB : cB + (size_t)(t + 2) * kstep;
            const char* a3 = a2 + kstep; const char* b3 = b2 + kstep;
            if (last && has_next) S.a_ready(nxt);
            if constexpr (SP2) {
            PG8_LDB(B0, 0, 0); PG8_LDB(B1, 0, 1); PG8_SCHED; PG8_LDA(At, 0, 0); PG8_STAGE(PG8_SA(1, 1), a1 + hstep, voffA);
            PG8_WAIT_V(8); PG8_WAIT_L(0); PG8_BAR; PG8_MMA(0, 0, At, B0); PG8_MMA(0, 1, At, B1); PG8_BAR; PG8_SCHED;
            PG8_LDA(At, 0, 1); PG8_STAGE(PG8_SB(0, 0), b2, voffB); PG8_STAGE(PG8_SB(0, 1), b2 + hstep, voffB); PG8_STAGE(PG8_SA(0, 0), a2, voffA);
            PG8_WAIT_V(8); PG8_WAIT_L(0); PG8_BAR; PG8_MMA(1, 0, At, B0); PG8_MMA(1, 1, At, B1); PG8_BAR; PG8_SCHED;
            PG8_LDB(B0, 1, 0); PG8_LDB(B1, 1, 1); PG8_SCHED; PG8_LDA(At, 1, 0); PG8_STAGE(PG8_SA(0, 1), a2 + hstep, voffA);
            PG8_WAIT_V(8); PG8_WAIT_L(0); PG8_BAR; PG8_MMA(0, 0, At, B0); PG8_MMA(0, 1, At, B1); PG8_BAR; PG8_SCHED;
            PG8_LDA(At, 1, 1); PG8_STAGE(PG8_SB(1, 0), b3, voffB); PG8_STAGE(PG8_SB(1, 1), b3 + hstep, voffB); PG8_STAGE(PG8_SA(1, 0), a3, voffA);
            PG8_WAIT_V(8); PG8_WAIT_L(0); PG8_BAR; PG8_MMA(1, 0, At, B0); PG8_MMA(1, 1, At, B1); PG8_BAR; PG8_SCHED;
            } else {
            PG8_LDB(B0, 0, 0); PG8_SCHED; PG8_LDA(At, 0, 0); PG8_STAGE(PG8_SA(1, 1), a1 + hstep, voffA);
            PG8_WAIT_L(8); PG8_BAR; PG8_WAIT_L(0); PG8_MMA(0, 0, At, B0); PG8_BAR; PG8_SCHED;
            PG8_LDB(B1, 0, 1); PG8_STAGE(PG8_SB(0, 0), b2, voffB);
            PG8_BAR; PG8_WAIT_L(0); PG8_MMA(0, 1, At, B1); PG8_BAR;
            PG8_LDA(At, 0, 1); PG8_STAGE(PG8_SA(0, 0), a2, voffA);
            PG8_BAR; PG8_WAIT_L(0); PG8_MMA(1, 0, At, B0); PG8_BAR; PG8_SCHED;
            PG8_STAGE(PG8_SB(0, 1), b2 + hstep, voffB);
            PG8_WAIT_V(6); PG8_BAR; PG8_MMA(1, 1, At, B1); PG8_BAR;
            PG8_LDB(B0, 1, 0); PG8_SCHED; PG8_LDA(At, 1, 0); PG8_STAGE(PG8_SA(0, 1), a2 + hstep, voffA);
            PG8_WAIT_L(8); PG8_BAR; PG8_WAIT_L(0); PG8_MMA(0, 0, At, B0); PG8_BAR; PG8_SCHED;
            PG8_LDB(B1, 1, 1); PG8_STAGE(PG8_SB(1, 0), b3, voffB);
            PG8_BAR; PG8_WAIT_L(0); PG8_MMA(0, 1, At, B1); PG8_BAR;
            PG8_LDA(At, 1, 1); PG8_STAGE(PG8_SA(1, 0), a3, voffA);
            PG8_BAR; PG8_WAIT_L(0); PG8_MMA(1, 0, At, B0); PG8_BAR; PG8_SCHED;
            PG8_STAGE(PG8_SB(1, 1), b3 + hstep, voffB);
            PG8_WAIT_V(6); PG8_BAR; PG8_MMA(1, 1, At, B1); PG8_BAR;
            }
        }
        if constexpr (ALIGN_EPI) { if (wr == 0) PG8_BAR; }
        if constexpr (!Epi::AFTER_DRAIN) { E(acc, cur, wr, wc, fr, fq); S.done(cur); }
        if (!has_next) break;
#pragma unroll
        for (int a = 0; a < 2; ++a)
#pragma unroll
            for (int b = 0; b < 2; ++b)
#pragma unroll
                for (int m = 0; m < 4; ++m)
#pragma unroll
                    for (int n = 0; n < 2; ++n) acc[a][b][m][n] = (f32x4){0.f, 0.f, 0.f, 0.f};
        cur = nxt; cA = nA; cB = nB; ++ui;
        if constexpr (ALIGN_EPI) { if (wr == 1) PG8_BAR; }
    }
    PG8_WAIT_V(0);
    if constexpr (!ALIGN_EPI) { if (wr == 0) PG8_BAR; }
    PG8_BAR;
    if constexpr (Epi::AFTER_DRAIN) { E.fused(acc, cur, wr, wc, fr, fq, lds, wid, lane); S.done(cur); }
#undef PG8_SA
#undef PG8_SB
#undef PG8_STAGE
#undef PG8_LDA
#undef PG8_LDB
#undef PG8_MMA
#undef PG8_WAIT_V
#undef PG8_WAIT_L
#undef PG8_BAR
#undef PG8_SCHED
}
}
namespace pg8 {
struct EpiF32 {
    static constexpr bool PERM = false, AFTER_DRAIN = false;
    float* out; const float* base0; const float* base1; int ldc; int split; float alpha; int pad;
    __device__ __forceinline__ void operator()(const f32x4 (&acc)[2][2][4][2], const Unit& u, int wr, int wc, int fr, int fq) const {
        const int col0 = u.pn * BM + wc * 32 + 4 * fq;
        const float* bp = nullptr;
        if (base0) bp = (u.pm < split) ? base0 + (size_t)u.pm * BM * ldc : base1 + (size_t)(u.pm - split) * BM * ldc;
#pragma unroll
        for (int ai = 0; ai < 2; ++ai)
#pragma unroll
            for (int m = 0; m < 4; ++m) { const int rt = ai * HALF + wr * 64 + m * 16 + fr; const size_t off = (size_t)rt * ldc + col0;
                float* orow = out + (size_t)u.pm * BM * ldc + off;
#pragma unroll
                for (int bj = 0; bj < 2; ++bj)
#pragma unroll
                    for (int n = 0; n < 2; ++n) { f32x4 v = acc[ai][bj][m][n] * alpha; if (bp) v = v + *(const f32x4*)(bp + off + bj * HALF + n * 16);
                        *(f32x4*)(orow + bj * HALF + n * 16) = v; } }
    }
};
struct EpiSwiGLU {
    static constexpr bool PERM = true, AFTER_DRAIN = false;
    bf16_t* H; int ldh; int pad;
    __device__ __forceinline__ void operator()(const f32x4 (&acc)[2][2][4][2], const Unit& u, int wr, int wc, int fr, int fq) const {
        const int col0 = u.pn * HALF + wc * 32 + 8 * fq;
#pragma unroll
        for (int ai = 0; ai < 2; ++ai)
#pragma unroll
            for (int m = 0; m < 4; ++m) { bf16_t* rowp = H + (size_t)(u.pm * BM + ai * HALF + wr * 64 + m * 16 + fr) * ldh + col0;
                float hv[8];
#pragma unroll
                for (int n = 0; n < 2; ++n)
#pragma unroll
                    for (int i = 0; i < 4; ++i) { const float g = acc[ai][0][m][n][i], up = acc[ai][1][m][n][i];
                        hv[4 * n + i] = g * __builtin_amdgcn_rcpf(1.0f + __builtin_amdgcn_exp2f(-1.4426950408889634f * g)) * up; }
                u32x4 w; w.x = cvt_pk_bf16(hv[0], hv[1]); w.y = cvt_pk_bf16(hv[2], hv[3]); w.z = cvt_pk_bf16(hv[4], hv[5]); w.w = cvt_pk_bf16(hv[6], hv[7]);
                *(u32x4*)rowp = w; }
    }
};
}
namespace pg8 {
__device__ __forceinline__ void rope_cs_e(int pos, int i, float& c, float& s) {
    const float ang = (float)pos * ROPE_FREQ[i];
    const double q4 = (double)ang * 0.6366197723675814; const double qr = rint(q4);
    const float r = (float)((q4 - qr) * 1.5707963267948966); const int qi = ((int)qr) & 3; const float r2 = r * r;
    const float sn = r * (1.0f + r2 * (-1.6666667e-1f + r2 * (8.3333333e-3f + r2 * (-1.9841270e-4f + r2 * 2.7557319e-6f))));
    const float cs = 1.0f + r2 * (-0.5f + r2 * (4.1666667e-2f + r2 * (-1.3888889e-3f + r2 * (2.4801587e-5f + r2 * -2.7557319e-7f))));
    c = (qi == 0) ? cs : (qi == 1) ? -sn : (qi == 2) ? -cs : sn;
    s = (qi == 0) ? sn : (qi == 1) ? cs : (qi == 2) ? -sn : -cs;
}
__device__ __forceinline__ float gelu_e(float x) { const float y = 0.7978845608028654f * (x + 0.044715f * x * x * x); return x * __builtin_amdgcn_rcpf(1.0f + __builtin_amdgcn_exp2f(-2.8853900817779268f * y)); }
typedef unsigned u32x2 __attribute__((ext_vector_type(2)));
struct EpiZ {
    static constexpr bool PERM = false, AFTER_DRAIN = false;
    bf16_t* XL; bf16_t* GG; bf16_t* CQ; float* CKV; float* SSQ; float* out; bf16_t* KC; bf16_t* KCS;
    __device__ __forceinline__ void operator()(const f32x4 (&acc)[2][2][4][2], const Unit& u, int wr, int wc, int fr, int fq) const {
        const int pn = u.pn;
#pragma unroll
        for (int ai = 0; ai < 2; ++ai)
#pragma unroll
            for (int m = 0; m < 4; ++m) { const int row = u.pm * BM + ai * HALF + wr * 64 + m * 16 + fr;
                if (pn < 4) { bf16_t* dst = (pn < 2 ? XL : GG) + (size_t)row * 512 + (pn & 1) * 256 + wc * 32 + 4 * fq;
#pragma unroll
                    for (int bj = 0; bj < 2; ++bj)
#pragma unroll
                        for (int n = 0; n < 2; ++n) { f32x4 v = acc[ai][bj][m][n]; if (pn >= 2) { v[0] = gelu_e(v[0]); v[1] = gelu_e(v[1]); v[2] = gelu_e(v[2]); v[3] = gelu_e(v[3]); }
                            u32x2 w; w.x = cvt_pk_bf16(v[0], v[1]); w.y = cvt_pk_bf16(v[2], v[3]); *(u32x2*)(dst + bj * HALF + n * 16) = w; } }
                else if (pn == 4) { bf16_t* dst = CQ + (size_t)row * 256 + wc * 32 + 4 * fq; float ss = 0.f;
#pragma unroll
                    for (int bj = 0; bj < 2; ++bj)
#pragma unroll
                        for (int n = 0; n < 2; ++n) { const f32x4 v = acc[ai][bj][m][n]; ss += (v[0] * v[0] + v[1] * v[1]) + (v[2] * v[2] + v[3] * v[3]);
                            u32x2 w; w.x = cvt_pk_bf16(v[0], v[1]); w.y = cvt_pk_bf16(v[2], v[3]); *(u32x2*)(dst + bj * HALF + n * 16) = w; }
                    ss += __shfl_xor(ss, 16); ss += __shfl_xor(ss, 32);
                    if (fq == 0) SSQ[(size_t)row * 8 + wc] = ss; }
                else { float* dst = CKV + (size_t)row * 128 + wc * 32 + 4 * fq; float ss = 0.f;
#pragma unroll
                    for (int n = 0; n < 2; ++n) { const f32x4 v = acc[ai][0][m][n]; ss += (v[0] * v[0] + v[1] * v[1]) + (v[2] * v[2] + v[3] * v[3]); *(f32x4*)(dst + n * 16) = v; }
                    ss += __shfl_xor(ss, 16); ss += __shfl_xor(ss, 32);
                    if (fq == 0) SSQ[(size_t)row * 8 + 4 + wc] = ss;
                    if (wc == 0) { const bool prompt = row < 16384; const int pos = prompt ? (row & 8191) : 16384 + ((row - 16384) & 7);
                        float* ko = prompt ? out + O_KRP + (size_t)row * 32 : out + O_KRS + (size_t)(row - 16384) * 32;
                        bf16_t* kb = prompt ? KC + (size_t)row * 160 + 128 : KCS + (size_t)(row - 16384) * 160 + 128;
                        const f32x4 x1 = acc[ai][1][m][0], x2 = acc[ai][1][m][1]; f32x4 o1, o2;
#pragma unroll
                        for (int i = 0; i < 4; ++i) { float c, s; rope_cs_e(pos, 4 * fq + i, c, s); o1[i] = x1[i] * c - x2[i] * s; o2[i] = x2[i] * c + x1[i] * s; }
                        *(f32x4*)(ko + 4 * fq) = o1; *(f32x4*)(ko + 16 + 4 * fq) = o2;
                        u32x2 w1, w2; w1.x = cvt_pk_bf16(o1[0], o1[1]); w1.y = cvt_pk_bf16(o1[2], o1[3]); w2.x = cvt_pk_bf16(o2[0], o2[1]); w2.y = cvt_pk_bf16(o2[2], o2[3]);
                        *(u32x2*)(kb + 4 * fq) = w1; *(u32x2*)(kb + 16 + 4 * fq) = w2; } }
            }
    }
};
struct EpiQ {
    static constexpr bool PERM = false, AFTER_DRAIN = false;
    bf16_t* Qb; const float* SSQ; float qscale; int pad;
    __device__ __forceinline__ void operator()(const f32x4 (&acc)[2][2][4][2], const Unit& u, int wr, int wc, int fr, int fq) const {
        const int pn = u.pn;
#pragma unroll
        for (int ai = 0; ai < 2; ++ai)
#pragma unroll
            for (int m = 0; m < 4; ++m) { const int row = u.pm * BM + ai * HALF + wr * 64 + m * 16 + fr;
                const f32x4 sq = *(const f32x4*)(SSQ + (size_t)row * 8);
                const float sc = qscale * __builtin_amdgcn_rsqf(((sq[0] + sq[1]) + (sq[2] + sq[3])) * (1.0f / 256.0f) + 1e-6f);
                if (pn < 4) {
#pragma unroll
                    for (int bj = 0; bj < 2; ++bj) { bf16_t* dst = Qb + ((size_t)row * 8 + 2 * pn + bj) * 160 + wc * 32 + 4 * fq;
#pragma unroll
                        for (int n = 0; n < 2; ++n) { const f32x4 v = acc[ai][bj][m][n] * sc; u32x2 w; w.x = cvt_pk_bf16(v[0], v[1]); w.y = cvt_pk_bf16(v[2], v[3]); *(u32x2*)(dst + n * 16) = w; } } }
                else { const int pos = (row < 16384) ? (row & 8191) : 16384 + ((row - 16384) & 7);
                    float cs[4], sn[4];
#pragma unroll
                    for (int i = 0; i < 4; ++i) rope_cs_e(pos, 4 * fq + i, cs[i], sn[i]);
#pragma unroll
                    for (int bj = 0; bj < 2; ++bj) { bf16_t* dst = Qb + ((size_t)row * 8 + 4 * bj + wc) * 160 + 128 + 4 * fq;
                        const f32x4 x1 = acc[ai][bj][m][0] * sc, x2 = acc[ai][bj][m][1] * sc; f32x4 o1, o2;
#pragma unroll
                        for (int i = 0; i < 4; ++i) { o1[i] = x1[i] * cs[i] - x2[i] * sn[i]; o2[i] = x2[i] * cs[i] + x1[i] * sn[i]; }
                        u32x2 w1, w2; w1.x = cvt_pk_bf16(o1[0], o1[1]); w1.y = cvt_pk_bf16(o1[2], o1[3]); w2.x = cvt_pk_bf16(o2[0], o2[1]); w2.y = cvt_pk_bf16(o2[2], o2[3]);
                        *(u32x2*)dst = w1; *(u32x2*)(dst + 16) = w2; } }
            }
    }
};
}
#define GAS __attribute__((address_space(1)))
#define LAS __attribute__((address_space(3)))
typedef unsigned short bf16;
typedef unsigned v4u __attribute__((ext_vector_type(4)));
typedef float f32x4 __attribute__((ext_vector_type(4)));
typedef short bf16x8 __attribute__((ext_vector_type(8)));
typedef GAS unsigned gu32;
typedef GAS unsigned long long gu64;
#define RLX_AGENT __ATOMIC_RELAXED, __HIP_MEMORY_SCOPE_AGENT
#define LDS_WAIT() asm volatile("s_waitcnt lgkmcnt(0)" ::: "memory")
#define VM_WAIT() asm volatile("s_waitcnt vmcnt(0)" ::: "memory")
__device__ __forceinline__ unsigned long long rt() { return __builtin_amdgcn_s_memrealtime(); }
__device__ __forceinline__ unsigned f2bf(float f) { unsigned u = __builtin_bit_cast(unsigned, f); return (u + 0x7fffu + ((u >> 16) & 1u)) >> 16; }
__device__ __forceinline__ unsigned pk2(float lo, float hi) { return f2bf(lo) | (f2bf(hi) << 16); }

#define XB_TMO      128
#define XB_XCNT(j)  (256  + 64 * (j))
#define XB_XSUB(j)  (1280 + 64 * (j))
#define XB_XGEN(j)  (2304 + 64 * (j))
#define XB_TOP      3328
#define XB_TOPGEN   3392
#define XCD_BAR_WORDS 3456
#define XB_SPIN_CAP (1u << 18)

__device__ __forceinline__ unsigned xb_ld(unsigned* p)              { return __hip_atomic_load(p, __ATOMIC_RELAXED, __HIP_MEMORY_SCOPE_AGENT); }
__device__ __forceinline__ unsigned xb_add(unsigned* p, unsigned v) { return __hip_atomic_fetch_add(p, v, __ATOMIC_RELAXED, __HIP_MEMORY_SCOPE_AGENT); }
__device__ __forceinline__ unsigned xb_xcc_id() { return (unsigned)__builtin_amdgcn_s_getreg((3 << 11) | 20) & 0xFu; }
#define XB_SPIN(cond, bar) do { unsigned _sp = 0; while (cond) { __builtin_amdgcn_s_sleep(1); \
    if ((++_sp & 255u) == 0u) { if (xb_ld(&(bar)[XB_TMO])) break; if (_sp > XB_SPIN_CAP) { atomicAdd(&(bar)[XB_TMO], 1u); break; } } } } while (0)

struct XcdBarrier {
    unsigned* bar; unsigned x;
    volatile LAS unsigned* st;
};

__device__ __forceinline__ XcdBarrier xcd_barrier_post(unsigned* bar, volatile LAS unsigned* st) {
    XcdBarrier b; b.bar = bar; b.x = xb_xcc_id(); b.st = st;
    if (threadIdx.x == 0) (void)xb_add(&bar[XB_XCNT(b.x)], 1u);
    return b;
}
__device__ __forceinline__ void xcd_barrier_complete(unsigned* bar, unsigned x, unsigned& nloc, unsigned& nx) {
    const unsigned G = gridDim.x * gridDim.y * gridDim.z;
    unsigned sum, cnt, mine, sp = 0u;
    for (;;) {
        sum = 0u; cnt = 0u; mine = 0u;
#pragma unroll
        for (unsigned j = 0; j < 16; ++j) { const unsigned c = xb_ld(&bar[XB_XCNT(j)]); sum += c; cnt += (c > 0u) ? 1u : 0u; mine = (j == x) ? c : mine; }
        if (sum == G) break;
        __builtin_amdgcn_s_sleep(1);
        if ((++sp & 255u) == 0u) { if (xb_ld(&bar[XB_TMO])) break; if (sp > XB_SPIN_CAP) { atomicAdd(&bar[XB_TMO], 1u); break; } }
    }
    nloc = mine > 0u ? mine : 1u; nx = cnt > 0u ? cnt : 1u;
}

__device__ __forceinline__ void xcd_barrier(const XcdBarrier& b) {
    asm volatile("s_waitcnt vmcnt(0)" ::: "memory");
    __syncthreads();
    if (threadIdx.x == 0) {
        unsigned* bar = b.bar;
        __builtin_amdgcn_s_waitcnt(0);
        unsigned nloc = b.st[0], nx = b.st[1];
        if (nloc == 0u) { xcd_barrier_complete(bar, b.x, nloc, nx); b.st[0] = nloc; b.st[1] = nx; }
        const unsigned old = xb_add(&bar[XB_XSUB(b.x)], 1u);
        const unsigned gen = old / nloc;
        if (old + 1u == (gen + 1u) * nloc) {
            __builtin_amdgcn_fence(__ATOMIC_RELEASE, "agent");
            asm volatile("s_waitcnt vmcnt(0)" ::: "memory");
            const unsigned og = xb_add(&bar[XB_TOP], 1u);
            const unsigned tg = og / nx;
            if (og + 1u == (tg + 1u) * nx) xb_add(&bar[XB_TOPGEN], 1u);
            else XB_SPIN(xb_ld(&bar[XB_TOPGEN]) == tg, bar);
            __builtin_amdgcn_fence(__ATOMIC_ACQUIRE, "agent");
            xb_add(&bar[XB_XGEN(b.x)], 1u);
            asm volatile("s_waitcnt vmcnt(0)" ::: "memory");
        } else {
            XB_SPIN(xb_ld(&bar[XB_XGEN(b.x)]) == gen, bar);
            __builtin_amdgcn_fence(__ATOMIC_ACQUIRE, "agent");
            asm volatile("s_waitcnt vmcnt(0)" ::: "memory");
        }
    }
    __syncthreads();
}
__device__ __forceinline__ float wave_sum(float v) {
#pragma unroll
    for (int o = 1; o < 64; o <<= 1) v += __shfl_xor(v, o);
    return v;
}
__device__ __forceinline__ float sigmoidf_(float x) { return 1.0f / (1.0f + __expf(-x)); }
__device__ __forceinline__ float gelu_tanh(float x) { const float y = 0.7978845608028654f * (x + 0.044715f * x * x * x); return x * sigmoidf_(2.0f * y); }
__device__ __forceinline__ void rope_cs(int pos, int i, float& c, float& s) {
    const float ang = (float)pos * ROPE_FREQ[i];
    const double q4 = (double)ang * 0.6366197723675814;
    const double qr = rint(q4);
    const float r = (float)((q4 - qr) * 1.5707963267948966);
    const int qi = ((int)qr) & 3;
    const float r2 = r * r;
    const float sn = r * (1.0f + r2 * (-1.6666667e-1f + r2 * (8.3333333e-3f + r2 * (-1.9841270e-4f + r2 * 2.7557319e-6f))));
    const float cs = 1.0f + r2 * (-0.5f + r2 * (4.1666667e-2f + r2 * (-1.3888889e-3f + r2 * (2.4801587e-5f + r2 * -2.7557319e-7f))));
    c = (qi == 0) ? cs : (qi == 1) ? -sn : (qi == 2) ? -cs : sn;
    s = (qi == 0) ? sn : (qi == 1) ? cs : (qi == 2) ? -sn : -cs;
}
constexpr float QSCALE = 0.10206207261596577f * 1.4426950408889634f;
namespace att {
#define ATT_LAS __attribute__((address_space(3)))
typedef short bf16x8 __attribute__((ext_vector_type(8)));
typedef float f32x16 __attribute__((ext_vector_type(16)));
typedef short s16x4 __attribute__((ext_vector_type(4)));
typedef short v4i16_t __attribute__((ext_vector_type(4)));
typedef unsigned u32x4 __attribute__((ext_vector_type(4)));
typedef float f32x2_t __attribute__((ext_vector_type(2)));
typedef __bf16 bf16x2_t __attribute__((ext_vector_type(2)));
typedef ATT_LAS unsigned char* ldsp;
#define ATT_MFMA(a, b, c) __builtin_amdgcn_mfma_f32_32x32x16_bf16((a), (b), (c), 0, 0, 0)
__device__ __forceinline__ int crow(int r, int hi) { return (r & 3) + 8 * (r >> 2) + 4 * hi; }
__device__ __forceinline__ unsigned cvtpk(float lo, float hi) { f32x2_t v = {lo, hi}; bf16x2_t b = __builtin_convertvector(v, bf16x2_t); return __builtin_bit_cast(unsigned, b); }
__device__ __forceinline__ unsigned offL(unsigned row, unsigned ch) { return 256u * row + 16u * (ch ^ (((row & 3u) << 2) | ((row >> 2) & 3u))); }
__device__ __forceinline__ unsigned offR(unsigned row, unsigned ch) { return 64u * row + 16u * (ch ^ ((row >> 2) & 3u)); }
__device__ __forceinline__ bf16x8 lds_b128(ldsp p) { return *(const ATT_LAS bf16x8*)p; }
__device__ __forceinline__ s16x4 lds_tr(ldsp p) { return __builtin_bit_cast(s16x4, __builtin_amdgcn_ds_read_tr16_b64_v4i16((ATT_LAS v4i16_t*)p)); }
__device__ __forceinline__ float swapmax(float m) { auto rr = __builtin_amdgcn_permlane32_swap(__float_as_uint(m), __float_as_uint(m), false, false); return fmaxf(__uint_as_float(rr[0]), __uint_as_float(rr[1])); }
__device__ __forceinline__ float swapsum(float m) { auto rr = __builtin_amdgcn_permlane32_swap(__float_as_uint(m), __float_as_uint(m), false, false); return __uint_as_float(rr[0]) + __uint_as_float(rr[1]); }

constexpr int TILE_LAT = 64 * 256, TILE_ROPE = 64 * 64, TILE_BYTES = TILE_LAT + TILE_ROPE;
constexpr float THR = 8.0f;

__device__ __forceinline__ void softmax_step(f32x16& s0, f32x16& s1, float& m, float& l, f32x16 (&o)[4], bool first) {
    float rm = fmaxf(s0[0], s1[0]);
#pragma unroll
    for (int r = 1; r < 16; ++r) rm = fmaxf(rm, fmaxf(s0[r], s1[r]));
    rm = swapmax(rm);
    if (first) m = rm;
    rm -= m;
    if (!first && __any(rm > THR)) {
        const float dl = fmaxf(rm, 0.f);
        m += dl;
        const float f = __builtin_amdgcn_exp2f(-dl); l *= f;
#pragma unroll
        for (int c = 0; c < 4; ++c)
#pragma unroll
            for (int r = 0; r < 16; ++r) o[c][r] *= f;
    }
    float sum = 0.f;
#pragma unroll
    for (int r = 0; r < 16; ++r) { s0[r] = __builtin_amdgcn_exp2f(s0[r] - m); s1[r] = __builtin_amdgcn_exp2f(s1[r] - m); sum += s0[r] + s1[r]; }
    l += sum;
}

__device__ __forceinline__ void stage_load(u32x4 (&st)[3], const bf16* __restrict__ tilep, int tid) {
    const bf16* pl = tilep + (size_t)(tid >> 4) * QD + (tid & 15) * 8;
    st[0] = *(const u32x4*)pl; st[1] = *(const u32x4*)(pl + 32 * QD);
    if (tid < 256) st[2] = *(const u32x4*)(tilep + (size_t)(tid >> 2) * QD + KVL + (tid & 3) * 8);
}
__device__ __forceinline__ void stage_store(const u32x4 (&st)[3], ldsp tile, unsigned dl, unsigned dr, int tid) {
    *(ATT_LAS u32x4*)(tile + dl) = st[0]; *(ATT_LAS u32x4*)(tile + dl + 8192) = st[1];
    if (tid < 256) *(ATT_LAS u32x4*)(tile + TILE_LAT + dr) = st[2];
}
__device__ __forceinline__ void prompt_unit(ldsp lds, const bf16* __restrict__ Qb, const bf16* __restrict__ KC, const bf16* __restrict__ WUVF, const float* __restrict__ gm, bf16* __restrict__ YC, int b, int tb) {
    const int tid = threadIdx.x, lane = tid & 63, wid = __builtin_amdgcn_readfirstlane(tid >> 6), r32 = lane & 31, hi = lane >> 5;
    const int t0 = tb * 32; const size_t row0 = (size_t)b * SEQ + t0;
    const bf16* KCseq = KC + (size_t)b * SEQ * QD;
    const int ntile = (t0 + 31) / 64 + 1;
    const unsigned dl = offL((unsigned)tid >> 4, (unsigned)tid & 15u), dr = offR(((unsigned)tid >> 2) & 63u, (unsigned)tid & 3u);
    u32x4 st[3];
    stage_load(st, KCseq, tid);
    bf16x8 qf[10];
    { const bf16* qp = Qb + ((row0 + r32) * NH + wid) * QD + 8 * hi;
#pragma unroll
      for (int s = 0; s < 10; ++s) qf[s] = *(const bf16x8*)(qp + 16 * s); }
    stage_store(st, lds, dl, dr, tid);
    __syncthreads();
    float m = 0.f, l = 0.f; f32x16 o[4];
#pragma unroll
    for (int r = 0; r < 16; ++r) { o[0][r] = 0.f; o[1][r] = 0.f; o[2][r] = 0.f; o[3][r] = 0.f; }
    const unsigned xk = (unsigned)(((r32 & 3) << 1) | ((r32 >> 3) & 1));
    const unsigned ka = 256u * (unsigned)r32 + 16u * ((unsigned)hi ^ ((unsigned)(r32 >> 2) & 1u));
    const unsigned kr0 = TILE_LAT + offR((unsigned)r32, (unsigned)hi), kr1 = TILE_LAT + offR((unsigned)r32, 2u + (unsigned)hi);
    const unsigned blk = (lane >> 4) & 1, qq = (lane & 15) >> 2, pp = lane & 3;
    const unsigned vb0 = 256u * (unsigned)(4 * hi + qq) + 16u * ((2u * blk + (pp >> 1)) ^ (unsigned)hi) + 8u * (pp & 1u);
    const unsigned vb1 = 256u * (unsigned)(8 + 4 * hi + qq) + 16u * ((2u * blk + (pp >> 1)) ^ (2u + (unsigned)hi)) + 8u * (pp & 1u);
    for (int kt = 0; kt < ntile; ++kt) {
        ldsp tile = lds + (kt & 1) * TILE_BYTES;
        if (kt + 1 < ntile) stage_load(st, KCseq + (size_t)(kt + 1) * 64 * QD, tid);
        unsigned xko = xk, qqo = qq; asm volatile("" : "+v"(xko), "+v"(qqo));
        f32x16 s0, s1;
#pragma unroll
        for (int r = 0; r < 16; ++r) { s0[r] = 0.f; s1[r] = 0.f; }
#pragma unroll
        for (int k = 0; k < 8; ++k) { const unsigned a = ka + 32u * ((unsigned)k ^ xko);
            s0 = ATT_MFMA(lds_b128(tile + a), qf[k], s0); s1 = ATT_MFMA(lds_b128(tile + a + 8192), qf[k], s1); }
        s0 = ATT_MFMA(lds_b128(tile + kr0), qf[8], s0); s1 = ATT_MFMA(lds_b128(tile + kr0 + 2048), qf[8], s1);
        s0 = ATT_MFMA(lds_b128(tile + kr1), qf[9], s0); s1 = ATT_MFMA(lds_b128(tile + kr1 + 2048), qf[9], s1);
        if (kt == ntile - 1) {
            const int tok = t0 + r32, kb = kt * 64;
#pragma unroll
            for (int r = 0; r < 16; ++r) { const int key = kb + crow(r, hi); if (key > tok) s0[r] = -INFINITY; if (key + 32 > tok) s1[r] = -INFINITY; }
        }
        softmax_step(s0, s1, m, l, o, kt == 0);
#pragma unroll
        for (int ks = 0; ks < 4; ++ks) {
            const f32x16& pv = (ks < 2) ? s0 : s1; const int bb = 8 * (ks & 1);
            u32x4 pw; pw.x = cvtpk(pv[bb + 0], pv[bb + 1]); pw.y = cvtpk(pv[bb + 2], pv[bb + 3]); pw.z = cvtpk(pv[bb + 4], pv[bb + 5]); pw.w = cvtpk(pv[bb + 6], pv[bb + 7]);
            const bf16x8 pf = __builtin_bit_cast(bf16x8, pw);
#pragma unroll
            for (int c = 0; c < 4; ++c) {
                const unsigned co = 64u * ((unsigned)c ^ qqo);
                const s16x4 lo = lds_tr(tile + vb0 + co + 4096 * ks);
                const s16x4 hv = lds_tr(tile + vb1 + co + 4096 * ks);
                const bf16x8 vf = {lo[0], lo[1], lo[2], lo[3], hv[0], hv[1], hv[2], hv[3]};
                o[c] = ATT_MFMA(vf, pf, o[c]);
            }
        }
        if (kt + 1 < ntile) stage_store(st, lds + ((kt + 1) & 1) * TILE_BYTES, dl, dr, tid);
        __syncthreads();
    }
    l = swapsum(l);
    const float rl = 1.0f / l;
    f32x16 y[2];
#pragma unroll
    for (int r = 0; r < 16; ++r) { y[0][r] = 0.f; y[1][r] = 0.f; }
#pragma unroll
    for (int c = 0; c < 4; ++c)
#pragma unroll
        for (int s = 0; s < 2; ++s) {
            u32x4 pw; pw.x = cvtpk(o[c][8 * s + 0] * rl, o[c][8 * s + 1] * rl); pw.y = cvtpk(o[c][8 * s + 2] * rl, o[c][8 * s + 3] * rl); pw.z = cvtpk(o[c][8 * s + 4] * rl, o[c][8 * s + 5] * rl); pw.w = cvtpk(o[c][8 * s + 6] * rl, o[c][8 * s + 7] * rl);
            const bf16x8 pf = __builtin_bit_cast(bf16x8, pw);
#pragma unroll
            for (int vb = 0; vb < 2; ++vb) { const bf16x8 wf = *(const bf16x8*)(WUVF + ((size_t)((((wid * 2 + vb) * 4 + c) * 2 + s) * 64 + lane)) * 8); y[vb] = ATT_MFMA(wf, pf, y[vb]); }
        }
    float ss = 0.f;
#pragma unroll
    for (int r = 0; r < 16; ++r) ss += y[0][r] * y[0][r] + y[1][r] * y[1][r];
    ss = swapsum(ss);
    ATT_LAS float* nrm = (ATT_LAS float*)(lds + 2 * TILE_BYTES);
    if (hi == 0) nrm[wid * 32 + r32] = ss;
    __syncthreads();
    float tot = 0.f;
#pragma unroll
    for (int w = 0; w < 8; ++w) tot += nrm[w * 32 + r32];
    const float rstd = __builtin_amdgcn_rsqf(tot * (1.0f / DMLA) + EPS);
    bf16* yp = YC + (row0 + r32) * DMIX + DLRU + wid * VD + 4 * hi;
    const float* gp = gm + wid * VD + 4 * hi;
#pragma unroll
    for (int vb = 0; vb < 2; ++vb)
#pragma unroll
        for (int g = 0; g < 4; ++g) { const f32x4 gv = *(const f32x4*)(gp + 32 * vb + 8 * g);
            typedef unsigned u32x2 __attribute__((ext_vector_type(2)));
            u32x2 w; w.x = cvtpk(y[vb][4 * g] * rstd * gv[0], y[vb][4 * g + 1] * rstd * gv[1]); w.y = cvtpk(y[vb][4 * g + 2] * rstd * gv[2], y[vb][4 * g + 3] * rstd * gv[3]);
            *(u32x2*)(yp + 32 * vb + 8 * g) = w; }
    __syncthreads();
}
}
namespace att {
constexpr int PG_LAT = 128 * 256, PG_ROPE = 128 * 64, PG_BYTES = PG_LAT + PG_ROPE;
constexpr int PART_ROWS = 66, PART_FLOATS = PART_ROWS * 64;

__device__ __forceinline__ void page_load(f32x4 (&st)[10], const float* __restrict__ ckv, const float* __restrict__ ckr, size_t slot0, int tid) {
    const f32x4* pl = (const f32x4*)(ckv + slot0 * KVL) + tid; const f32x4* pr = (const f32x4*)(ckr + slot0 * ROPE) + tid;
#pragma unroll
    for (int i = 0; i < 8; ++i) st[i] = pl[512 * i];
#pragma unroll
    for (int i = 0; i < 2; ++i) st[8 + i] = pr[512 * i];
}
__device__ __forceinline__ void page_store(const f32x4 (&st)[10], ldsp pg, unsigned dl, unsigned dr) {
    typedef unsigned u32x2 __attribute__((ext_vector_type(2)));
#pragma unroll
    for (int i = 0; i < 8; ++i) { u32x2 w; w.x = cvtpk(st[i].x, st[i].y); w.y = cvtpk(st[i].z, st[i].w); *(ATT_LAS u32x2*)(pg + dl + 4096 * i) = w; }
#pragma unroll
    for (int i = 0; i < 2; ++i) { u32x2 w; w.x = cvtpk(st[8 + i].x, st[8 + i].y); w.y = cvtpk(st[8 + i].z, st[8 + i].w); *(ATT_LAS u32x2*)(pg + PG_LAT + dr + 4096 * i) = w; }
}
__device__ __forceinline__ void decode_item(ldsp lds, const bf16* __restrict__ Qb, const float* __restrict__ ckv, const float* __restrict__ ckr, const int* __restrict__ ptab,
                                            float* __restrict__ PART, int db, int pg0, int npg) {
    const int tid = threadIdx.x, lane = tid & 63, wid = __builtin_amdgcn_readfirstlane(tid >> 6), r32 = lane & 31, hi = lane >> 5;
    const int qb = wid & 1, rb = 64 * (wid >> 2) + 32 * ((wid >> 1) & 1), grp = wid >> 1;
    const int* pt = ptab + db * NPAGES + pg0;
    unsigned dl, dr;
    { const unsigned row = (unsigned)tid >> 5, c4 = (unsigned)tid & 31u; dl = offL(row, c4 >> 1) + 8u * (c4 & 1u);
      const unsigned rr = (unsigned)tid >> 3, c4r = (unsigned)tid & 7u; dr = offR(rr, c4r >> 1) + 8u * (c4r & 1u); }
    f32x4 st[10];
    page_load(st, ckv, ckr, (size_t)pt[0] * PAGE, tid);
    bf16x8 qf[10];
    { const bf16* qp = Qb + (((size_t)RP + (size_t)db * DS) * NH + 32 * qb + r32) * QD + 8 * hi;
#pragma unroll
      for (int s = 0; s < 10; ++s) qf[s] = *(const bf16x8*)(qp + 16 * s); }
    page_store(st, lds, dl, dr);
    __syncthreads();
    float m = 0.f, l = 0.f; f32x16 o[4];
#pragma unroll
    for (int r = 0; r < 16; ++r) { o[0][r] = 0.f; o[1][r] = 0.f; o[2][r] = 0.f; o[3][r] = 0.f; }
    const unsigned xk = (unsigned)(((r32 & 3) << 1) | ((r32 >> 3) & 1));
    const unsigned ka = 256u * (unsigned)(rb + r32) + 16u * ((unsigned)hi ^ ((unsigned)(r32 >> 2) & 1u));
    const unsigned kr0 = PG_LAT + offR((unsigned)(rb + r32), (unsigned)hi), kr1 = PG_LAT + offR((unsigned)(rb + r32), 2u + (unsigned)hi);
    const unsigned blk = (lane >> 4) & 1, qq = (lane & 15) >> 2, pp = lane & 3;
    const unsigned vb0 = 256u * (unsigned)(rb + 4 * hi + qq) + 16u * ((2u * blk + (pp >> 1)) ^ (unsigned)hi) + 8u * (pp & 1u);
    const unsigned vb1 = 256u * (unsigned)(rb + 8 + 4 * hi + qq) + 16u * ((2u * blk + (pp >> 1)) ^ (2u + (unsigned)hi)) + 8u * (pp & 1u);
    for (int pi = 0; pi < npg; ++pi) {
        ldsp pg = lds + (pi & 1) * PG_BYTES;
        if (pi + 1 < npg) page_load(st, ckv, ckr, (size_t)pt[pi + 1] * PAGE, tid);
        unsigned xko = xk, qqo = qq; asm volatile("" : "+v"(xko), "+v"(qqo));
        f32x16 s;
#pragma unroll
        for (int r = 0; r < 16; ++r) s[r] = 0.f;
#pragma unroll
        for (int k = 0; k < 8; ++k) s = ATT_MFMA(lds_b128(pg + ka + 32u * ((unsigned)k ^ xko)), qf[k], s);
        s = ATT_MFMA(lds_b128(pg + kr0), qf[8], s);
        s = ATT_MFMA(lds_b128(pg + kr1), qf[9], s);
        float rm = s[0];
#pragma unroll
        for (int r = 1; r < 16; ++r) rm = fmaxf(rm, s[r]);
        rm = swapmax(rm);
        const bool first = (pi == 0);
        if (first) m = rm;
        rm -= m;
        if (!first && __any(rm > THR)) {
            const float dlt = fmaxf(rm, 0.f);
            m += dlt;
            { const float f = __builtin_amdgcn_exp2f(-dlt); l *= f;
#pragma unroll
                for (int c = 0; c < 4; ++c)
#pragma unroll
                    for (int r = 0; r < 16; ++r) o[c][r] *= f; }
        }
        float sum = 0.f;
#pragma unroll
        for (int r = 0; r < 16; ++r) { s[r] = __builtin_amdgcn_exp2f(s[r] - m); sum += s[r]; }
        l += sum;
#pragma unroll
        for (int ks = 0; ks < 2; ++ks) {
            u32x4 pw; pw.x = cvtpk(s[8 * ks + 0], s[8 * ks + 1]); pw.y = cvtpk(s[8 * ks + 2], s[8 * ks + 3]); pw.z = cvtpk(s[8 * ks + 4], s[8 * ks + 5]); pw.w = cvtpk(s[8 * ks + 6], s[8 * ks + 7]);
            const bf16x8 pf = __builtin_bit_cast(bf16x8, pw);
#pragma unroll
            for (int c = 0; c < 4; ++c) {
                const unsigned co = 64u * ((unsigned)c ^ qqo);
                const s16x4 lo = lds_tr(pg + vb0 + co + 4096 * ks);
                const s16x4 hv = lds_tr(pg + vb1 + co + 4096 * ks);
                const bf16x8 vf = {lo[0], lo[1], lo[2], lo[3], hv[0], hv[1], hv[2], hv[3]};
                o[c] = ATT_MFMA(vf, pf, o[c]);
            }
        }
        if (pi + 1 < npg) page_store(st, lds + ((pi + 1) & 1) * PG_BYTES, dl, dr);
        __syncthreads();
    }
    ATT_LAS float* reg = (ATT_LAS float*)(lds) + qb * PART_FLOATS;
    for (int g = 0; g < 4; ++g) {
        if (grp == g) {
            if (g > 0) { const float m2 = reg[64 * 64 + lane], l2 = reg[65 * 64 + lane]; const float mn = fmaxf(m, m2); const float a1 = __builtin_amdgcn_exp2f(m - mn), a2 = __builtin_amdgcn_exp2f(m2 - mn);
#pragma unroll
                for (int c = 0; c < 4; ++c)
#pragma unroll
                    for (int r = 0; r < 16; ++r) o[c][r] = o[c][r] * a1 + reg[(c * 16 + r) * 64 + lane] * a2;
                l = l * a1 + l2 * a2; m = mn; }
            if (g < 3) {
#pragma unroll
                for (int c = 0; c < 4; ++c)
#pragma unroll
                    for (int r = 0; r < 16; ++r) reg[(c * 16 + r) * 64 + lane] = o[c][r];
                reg[64 * 64 + lane] = m; reg[65 * 64 + lane] = l; }
            else { float* gp = PART + (size_t)qb * PART_FLOATS;
#pragma unroll
                for (int c = 0; c < 4; ++c)
#pragma unroll
                    for (int r = 0; r < 16; ++r) gp[(c * 16 + r) * 64 + lane] = o[c][r];
                gp[64 * 64 + lane] = m; gp[65 * 64 + lane] = l; }
        }
        __syncthreads();
    }
}
__device__ __forceinline__ void decode_combine(ldsp lds, const bf16* __restrict__ Qb, const float* __restrict__ KN, const float* __restrict__ KR, const float* __restrict__ PARTdb, int ns,
                                               const float* __restrict__ w_uv, const float* __restrict__ gm, bf16* __restrict__ YC, int db) {
    const int tid = threadIdx.x, lane = tid & 63, wid = tid >> 6, qb = wid >> 2, rg = wid & 3, r32 = lane & 31, hi = lane >> 5;
    ATT_LAS float* sc = (ATT_LAS float*)lds;
    ATT_LAS float* ol = (ATT_LAS float*)(lds + 2048);
    ATT_LAS float* red = (ATT_LAS float*)(lds + 2048 + 32768);
    __syncthreads();
    { const int q = tid >> 3, sp = tid & 7;
      const bf16* qp = Qb + (((size_t)RP + (size_t)db * DS) * NH + q) * QD; const float* kn = KN + ((size_t)db * DS + sp) * KVL; const float* kr = KR + ((size_t)db * DS + sp) * ROPE;
      float a = 0.f;
      for (int d = 0; d < KVL; ++d) a += __uint_as_float((unsigned)qp[d] << 16) * kn[d];
      for (int d = 0; d < ROPE; ++d) a += __uint_as_float((unsigned)qp[KVL + d] << 16) * kr[d];
      sc[q * 8 + sp] = a; }
    __syncthreads();
    const int q = 32 * qb + r32, stok = q >> 3, hq = q & 7;
    float M = -INFINITY;
    for (int i = 0; i < ns; ++i) M = fmaxf(M, PARTdb[((size_t)i * 2 + qb) * PART_FLOATS + 64 * 64 + lane]);
    for (int sp = 0; sp <= stok; ++sp) M = fmaxf(M, sc[q * 8 + sp]);
    float acc[16], lsum = 0.f;
#pragma unroll
    for (int r = 0; r < 16; ++r) acc[r] = 0.f;
    for (int i = 0; i < ns; ++i) { const float* pp = PARTdb + ((size_t)i * 2 + qb) * PART_FLOATS; const float f = __builtin_amdgcn_exp2f(pp[64 * 64 + lane] - M);
        lsum += f * pp[65 * 64 + lane];
#pragma unroll
        for (int r = 0; r < 16; ++r) acc[r] += f * pp[(rg * 16 + r) * 64 + lane]; }
    lsum += __shfl_xor(lsum, 32);
    for (int sp = 0; sp <= stok; ++sp) { const float p = __builtin_amdgcn_exp2f(sc[q * 8 + sp] - M); lsum += p; const float* kn = KN + ((size_t)db * DS + sp) * KVL;
#pragma unroll
        for (int r = 0; r < 16; ++r) acc[r] += p * kn[32 * rg + crow(r, hi)]; }
    const float rl = 1.0f / lsum;
#pragma unroll
    for (int r = 0; r < 16; ++r) ol[q * KVL + 32 * rg + crow(r, hi)] = acc[r] * rl;
    __syncthreads();
    float y[8];
#pragma unroll
    for (int s = 0; s < 8; ++s) y[s] = 0.f;
    for (int c = 0; c < KVL; ++c) { const float w = w_uv[((size_t)c * NH + wid) * VD + lane];
#pragma unroll
        for (int s = 0; s < 8; ++s) y[s] += ol[(s * 8 + wid) * KVL + c] * w; }
    (void)hq;
#pragma unroll
    for (int s = 0; s < 8; ++s) { float v = y[s] * y[s];
#pragma unroll
        for (int o = 1; o < 64; o <<= 1) v += __shfl_xor(v, o);
        if (lane == 0) red[wid * 8 + s] = v; }
    __syncthreads();
#pragma unroll
    for (int s = 0; s < 8; ++s) { float t = 0.f;
#pragma unroll
        for (int w = 0; w < 8; ++w) t += red[w * 8 + s];
        const float rstd = 1.0f / sqrtf(t * (1.0f / DMLA) + EPS);
        YC[((size_t)RP + (size_t)db * DS + s) * DMIX + DLRU + wid * VD + lane] = (bf16)f2bf(y[s] * rstd * gm[wid * VD + lane]); }
}
}
namespace lru {
using att::bf16x8; using att::f32x16; using att::u32x4; using att::ldsp; using att::cvtpk; using att::crow;
constexpr int XCT_STRIDE = 72;
constexpr int XCT_WAVE_BYTES = 64 * XCT_STRIDE * 2;
constexpr int LDS_RED = 0;
constexpr int LDS_RS = LDS_RED + 8 * 64 * 32 * 4;
__device__ __forceinline__ float bf2f(unsigned short v) { return __uint_as_float((unsigned)v << 16); }
__device__ __forceinline__ float sigm(float x) { return __builtin_amdgcn_rcpf(1.0f + __builtin_amdgcn_exp2f(-1.4426950408889634f * x)); }

struct State { f32x16 P[2][2]; f32x16 H[2][2]; };

template <bool SAMPLE>
__device__ __forceinline__ void unit_pre(ldsp lds, State& st, const bf16* __restrict__ XL, const bf16* __restrict__ WGT, const float* __restrict__ conv_w, const float* __restrict__ conv_b,
                                         const float* __restrict__ b_a, const float* __restrict__ b_i, const float* __restrict__ lam, const float* __restrict__ state_conv, const float* __restrict__ state_h,
                                         float* __restrict__ out, size_t rowbase, int b0, int tpos0, float* __restrict__ SUMp  ) {
    const int tid = threadIdx.x, lane = tid & 63, n = __builtin_amdgcn_readfirstlane(tid >> 6), r32 = lane & 31, hi = lane >> 5;
    ATT_LAS unsigned short* xct = (ATT_LAS unsigned short*)(lds + n * XCT_WAVE_BYTES);
    bf16x8 af[2][4];
#pragma unroll
    for (int s = 0; s < 4; ++s) { const int ch0 = 64 * n + 16 * s + 8 * hi;
        float w[4][8], bb[8];
#pragma unroll
        for (int k = 0; k < 4; ++k) { const f32x4 a = *(const f32x4*)(conv_w + k * DLRU + ch0), c = *(const f32x4*)(conv_w + k * DLRU + ch0 + 4);
            w[k][0] = a[0]; w[k][1] = a[1]; w[k][2] = a[2]; w[k][3] = a[3]; w[k][4] = c[0]; w[k][5] = c[1]; w[k][6] = c[2]; w[k][7] = c[3]; }
        { const f32x4 a = *(const f32x4*)(conv_b + ch0), c = *(const f32x4*)(conv_b + ch0 + 4); bb[0] = a[0]; bb[1] = a[1]; bb[2] = a[2]; bb[3] = a[3]; bb[4] = c[0]; bb[5] = c[1]; bb[6] = c[2]; bb[7] = c[3]; }
#pragma unroll
        for (int rb = 0; rb < 2; ++rb) { const int tk = 32 * rb + r32;
            const int tseq = SAMPLE ? (tk & 7) : tpos0 + tk;
            float xc[8];
#pragma unroll
            for (int j = 0; j < 8; ++j) xc[j] = bb[j];
#pragma unroll
            for (int k = 0; k < 4; ++k) { const int back = 3 - k;
                float xv[8];
                if (tseq - back >= 0) { const bf16x8 v = *(const bf16x8*)(XL + (rowbase + tk - back) * DLRU + ch0);
#pragma unroll
                    for (int j = 0; j < 8; ++j) xv[j] = bf2f((unsigned short)v[j]); }
                else if (SAMPLE) { const float* sp = state_conv + ((size_t)(b0 + (tk >> 3)) * 3 + (3 + tseq - back)) * DLRU + ch0; const f32x4 a = *(const f32x4*)sp, c = *(const f32x4*)(sp + 4);
                    xv[0] = a[0]; xv[1] = a[1]; xv[2] = a[2]; xv[3] = a[3]; xv[4] = c[0]; xv[5] = c[1]; xv[6] = c[2]; xv[7] = c[3]; }
                else {
#pragma unroll
                    for (int j = 0; j < 8; ++j) xv[j] = 0.f; }
#pragma unroll
                for (int j = 0; j < 8; ++j) xc[j] += w[k][j] * xv[j]; }
            u32x4 pw; pw.x = cvtpk(xc[0], xc[1]); pw.y = cvtpk(xc[2], xc[3]); pw.z = cvtpk(xc[4], xc[5]); pw.w = cvtpk(xc[6], xc[7]);
            af[rb][s] = __builtin_bit_cast(bf16x8, pw);
            *(ATT_LAS u32x4*)(xct + tk * XCT_STRIDE + 16 * s + 8 * hi) = pw;
            if (SAMPLE) { if (tseq >= DS - 3) { const bf16x8 v = *(const bf16x8*)(XL + (rowbase + tk) * DLRU + ch0); float* o = out + O_CVS + ((size_t)(b0 + (tk >> 3)) * 3 + (tseq - (DS - 3))) * DLRU + ch0;
#pragma unroll
                    for (int j = 0; j < 8; ++j) o[j] = bf2f((unsigned short)v[j]); } }
            else { if (tseq >= SEQ - 3) { const bf16x8 v = *(const bf16x8*)(XL + (rowbase + tk) * DLRU + ch0); float* o = out + O_CVP + ((size_t)b0 * 3 + (tseq - (SEQ - 3))) * DLRU + ch0;
#pragma unroll
                    for (int j = 0; j < 8; ++j) o[j] = bf2f((unsigned short)v[j]); } }
        }
    }
#pragma unroll
    for (int g = 0; g < 2; ++g)
#pragma unroll
        for (int cb = 0; cb < 2; ++cb) { f32x16 c0, c1;
#pragma unroll
            for (int r = 0; r < 16; ++r) { c0[r] = 0.f; c1[r] = 0.f; }
#pragma unroll
            for (int s = 0; s < 4; ++s) { const bf16x8 bf = *(const bf16x8*)(WGT + (((size_t)n * 2 + g) * 64 + 32 * cb + r32) * 64 + 16 * s + 8 * hi);
                c0 = ATT_MFMA(af[0][s], bf, c0); c1 = ATT_MFMA(af[1][s], bf, c1); }
            if (g == 0) { st.P[0][cb] = c0; st.P[1][cb] = c1; } else { st.H[0][cb] = c0; st.H[1][cb] = c1; }
            __builtin_amdgcn_sched_barrier(0); }
    asm volatile("s_waitcnt lgkmcnt(0)" ::: "memory");
#pragma unroll
    for (int cb = 0; cb < 2; ++cb) { const int ch = 64 * n + 32 * cb + r32;
        const float ba = b_a[ch], bi = b_i[ch]; const float nl = -lam[ch]; const float sp8 = 8.0f * (fmaxf(nl, 0.f) + log1pf(__expf(-fabsf(nl))));
#pragma unroll
        for (int rb = 0; rb < 2; ++rb)
#pragma unroll
            for (int r = 0; r < 16; ++r) { const int tk = 32 * rb + crow(r, hi);
                const float xc = bf2f(xct[tk * XCT_STRIDE + 32 * cb + r32]);
                const float rg = sigm(st.P[rb][cb][r] + ba), ig = sigm(st.H[rb][cb][r] + bi);
                const float la = -rg * sp8;
                const float a = __builtin_amdgcn_exp2f(1.4426950408889634f * la);
                const float y = -2.0f * la;
                const float poly = y * (1.0f + y * (-0.5f + y * (1.6666667e-1f + y * (-4.1666667e-2f + y * (8.3333333e-3f + y * -1.3888889e-3f)))));
                const float wgt = __builtin_amdgcn_fmed3f(10.0f * y - 2.0f, 0.0f, 1.0f);
                const float om = poly + wgt * ((1.0f - a * a) - poly);
                st.P[rb][cb][r] = a; st.H[rb][cb][r] = __builtin_amdgcn_sqrtf(om) * (ig * xc); }
        __builtin_amdgcn_sched_barrier(0); }
#pragma unroll
    for (int cb = 0; cb < 2; ++cb) { const int ch = 64 * n + 32 * cb + r32;
        float h = 0.f, pr = 1.f;
#pragma unroll
        for (int k = 0; k < 16; ++k) { const int rb = k >> 3, g = (k >> 1) & 3, owner = k & 1;
            if (SAMPLE && (k & 1) == 0) { h = state_h[(size_t)(b0 + (k >> 1)) * DLRU + ch]; pr = 1.f; }
            if (hi == owner) {
#pragma unroll
                for (int i = 0; i < 4; ++i) { const float a = st.P[rb][cb][4 * g + i]; h = a * h + st.H[rb][cb][4 * g + i]; pr *= a; st.H[rb][cb][4 * g + i] = h; st.P[rb][cb][4 * g + i] = pr; } }
            const float ho = __shfl_xor(h, 32), po = __shfl_xor(pr, 32);
            if (hi != owner) { h = ho; pr = po; }
            if (SAMPLE && (k & 1) == 1 && hi == 0) out[O_HS + (size_t)(b0 + (k >> 1)) * DLRU + ch] = h; }
        if (!SAMPLE && hi == 0) { SUMp[2 * ch] = pr; SUMp[2 * ch + 1] = h; } }
}
__device__ __forceinline__ void unit_post(ldsp lds, State& st, const bf16* __restrict__ GG, const float* __restrict__ gain, bf16* __restrict__ YC, size_t rowbase, float carry0, float carry1) {
    const int tid = threadIdx.x, lane = tid & 63, n = __builtin_amdgcn_readfirstlane(tid >> 6), r32 = lane & 31, hi = lane >> 5;
    ATT_LAS float* red = (ATT_LAS float*)(lds + LDS_RED); ATT_LAS float* rs = (ATT_LAS float*)(lds + LDS_RS);
    __syncthreads();
#pragma unroll
    for (int rb = 0; rb < 2; ++rb)
#pragma unroll
        for (int r = 0; r < 16; ++r) { const int tk = 32 * rb + crow(r, hi); float ss = 0.f;
#pragma unroll
            for (int cb = 0; cb < 2; ++cb) { const int ch = 64 * n + 32 * cb + r32; const float cr = cb ? carry1 : carry0;
                const float h = st.H[rb][cb][r] + st.P[rb][cb][r] * cr;
                const float y = bf2f(GG[(rowbase + tk) * DLRU + ch]) * h;
                st.H[rb][cb][r] = y; ss += y * y; }
            red[(n * 64 + tk) * 32 + r32] = ss; }
    __syncthreads();
    { const int tk = tid >> 3, part = tid & 7; float s = 0.f;
#pragma unroll
      for (int j = 0; j < 8; ++j) { const f32x4 v = *(const ATT_LAS f32x4*)(red + (part * 64 + tk) * 32 + 4 * j); s += (v[0] + v[1]) + (v[2] + v[3]); }
      s += __shfl_xor(s, 1); s += __shfl_xor(s, 2); s += __shfl_xor(s, 4);
      if (part == 0) rs[tk] = __builtin_amdgcn_rsqf(s * (1.0f / DLRU) + EPS); }
    __syncthreads();
#pragma unroll
    for (int cb = 0; cb < 2; ++cb) { const int ch = 64 * n + 32 * cb + r32; const float gn = gain[ch];
#pragma unroll
        for (int rb = 0; rb < 2; ++rb)
#pragma unroll
            for (int r = 0; r < 16; ++r) { const int tk = 32 * rb + crow(r, hi);
                YC[(rowbase + tk) * DMIX + ch] = (bf16)f2bf(st.H[rb][cb][r] * rs[tk] * gn); } }
    __syncthreads();
}
__device__ __forceinline__ float chunk_carry(const float* __restrict__ SUMb, int c, int ch) {
    float h = 0.f;
#pragma unroll 8
    for (int k = 0; k < c; ++k) { const float2 v = *(const float2*)(SUMb + ((size_t)k * DLRU + ch) * 2); h = v.x * h + v.y; }
    return h;
}
}
constexpr size_t MiB = 1u << 20;
constexpr size_t WS_CTL = 0, CTL_ZERO_BYTES = 64 * 1024;
constexpr size_t WS_WGU1 = 2 * MiB, WS_WD1 = 14 * MiB, WS_WGU2 = 20 * MiB, WS_WD2 = 32 * MiB, WS_WIN = 38 * MiB, WS_WOUT = 42 * MiB, WS_WQ = 44 * MiB, WS_SUM = 46 * MiB, WS_WGT = 48 * MiB, WS_SSQ = 49 * MiB, WS_KCS = 50 * MiB, WS_WUVF = 51 * MiB, WS_CKV = 52 * MiB;
constexpr size_t WS_XN = 64 * MiB, WS_H = 100 * MiB, WS_X1 = 200 * MiB, WS_X2 = 270 * MiB, WS_Z = 340 * MiB, WS_QALL = 444 * MiB, WS_CQN = 530 * MiB;
constexpr size_t WS_A = 540 * MiB, WS_U = 576 * MiB, WS_YL = 612 * MiB, WS_OLAT = 648 * MiB, WS_YC = 720 * MiB, WS_QB = 760 * MiB, WS_KC = 820 * MiB, WS_PART = 830 * MiB, WS_XL = 900 * MiB, WS_GG = 920 * MiB, WS_CQ = 940 * MiB, WS_END = 950 * MiB;
constexpr int CW_BAR = 1024;
static_assert((CW_BAR + XCD_BAR_WORDS) * 4 <= (int)CTL_ZERO_BYTES, "CTL");
constexpr int RING_BYTES = 131072, LDSCTL_OFF = RING_BYTES, MISC_OFF = LDSCTL_OFF + 320, LDS_BYTES = 147456;
constexpr int NSPLIT = 2;
constexpr int CHUNK = 64, NCHUNK = SEQ / CHUNK;

struct Params { const float* in[33]; float* out; unsigned char* ws; int ph_lo, ph_hi; };
static_assert(sizeof(Params) == 33 * 8 + 8 + 8 + 8, "Params has no padding");

__device__ __forceinline__ void transpose_item(const float* __restrict__ W, int K, int N, bf16* __restrict__ WT, int mode, LAS float* scr, int item, int lane) {
    const int nblk = N / 32, kb = item / nblk, nb = item % nblk, k0 = 64 * kb, n0 = 32 * nb;
    const int drow0 = (mode == 0) ? n0 : 256 * (n0 / 128) + (n0 % 128) + (mode == 2 ? 128 : 0);
#pragma unroll 8
    for (int i = 0; i < 32; ++i) { const int kk = 2 * i + (lane >> 5); scr[kk * 33 + (lane & 31)] = W[(size_t)(k0 + kk) * N + n0 + (lane & 31)]; }
    LDS_WAIT(); asm volatile("" ::: "memory");
    const int c = lane & 7;
#pragma unroll
    for (int j = 0; j < 4; ++j) { const int n = (lane >> 3) + 8 * j; const LAS float* s = scr + (8 * c) * 33 + n;
        v4u o; o.x = pk2(s[0 * 33], s[1 * 33]); o.y = pk2(s[2 * 33], s[3 * 33]); o.z = pk2(s[4 * 33], s[5 * 33]); o.w = pk2(s[6 * 33], s[7 * 33]);
        *(v4u*)(WT + (size_t)(drow0 + n) * K + k0 + 8 * c) = o; }
    LDS_WAIT(); asm volatile("" ::: "memory");
}
template <bool OUT_BF16>
__device__ __forceinline__ void rmsnorm_rows(const float* __restrict__ x0, const float* __restrict__ x1, int split, const float* __restrict__ gain, void* __restrict__ outp) {
    const int lane = threadIdx.x & 63, gw = blockIdx.x * 8 + (threadIdx.x >> 6), NGW = gridDim.x * 8;
    for (int row = gw; row < R; row += NGW) {
        const float* xr = (row < split) ? x0 + (size_t)row * DM : x1 + (size_t)(row - split) * DM;
        f32x4 v[4]; float s = 0.f;
#pragma unroll
        for (int j = 0; j < 4; ++j) { v[j] = ((const f32x4*)xr)[lane + 64 * j]; s += (v[j].x * v[j].x + v[j].y * v[j].y) + (v[j].z * v[j].z + v[j].w * v[j].w); }
        const float rstd = 1.0f / sqrtf(wave_sum(s) * (1.0f / DM) + EPS);
#pragma unroll
        for (int j = 0; j < 4; ++j) { const f32x4 g = ((const f32x4*)gain)[lane + 64 * j]; const f32x4 o = v[j] * rstd * g;
            if (OUT_BF16) { unsigned long long w = (unsigned long long)pk2(o.x, o.y) | ((unsigned long long)pk2(o.z, o.w) << 32); ((unsigned long long*)((bf16*)outp + (size_t)row * DM))[lane + 64 * j] = w; }
            else ((f32x4*)((float*)outp + (size_t)row * DM))[lane + 64 * j] = o; }
    }
}
__device__ __forceinline__ void p_prologue(const Params& p, LAS unsigned char* lds) {
    const int tid = threadIdx.x, lane = tid & 63, wave = tid >> 6, gw = blockIdx.x * 8 + wave, NGW = gridDim.x * 8;
    unsigned char* ws = p.ws;
    LAS float* scr = (LAS float*)(lds + wave * 16384);
    constexpr int I_F = (DM / 64) * (DFF / 32), I_IN = (DM / 64) * (DIN / 32), I_OUT = (DMIX / 64) * (DM / 32), NITEMS = 6 * I_F + I_IN + I_OUT;
    static_assert((DFF / 64) * (DM / 32) == I_F, "down items");
    for (int it = gw; it < NITEMS; it += NGW) {
        int r = it;
        if (r < I_F) { transpose_item(p.in[8], DM, DFF, (bf16*)(ws + WS_WGU1), 1, scr, r, lane); continue; } r -= I_F;
        if (r < I_F) { transpose_item(p.in[9], DM, DFF, (bf16*)(ws + WS_WGU1), 2, scr, r, lane); continue; } r -= I_F;
        if (r < I_F) { transpose_item(p.in[10], DFF, DM, (bf16*)(ws + WS_WD1), 0, scr, r, lane); continue; } r -= I_F;
        if (r < I_F) { transpose_item(p.in[29], DM, DFF, (bf16*)(ws + WS_WGU2), 1, scr, r, lane); continue; } r -= I_F;
        if (r < I_F) { transpose_item(p.in[30], DM, DFF, (bf16*)(ws + WS_WGU2), 2, scr, r, lane); continue; } r -= I_F;
        if (r < I_F) { transpose_item(p.in[31], DFF, DM, (bf16*)(ws + WS_WD2), 0, scr, r, lane); continue; } r -= I_F;
        if (r < I_IN) { transpose_item(p.in[12], DM, DIN, (bf16*)(ws + WS_WIN), 0, scr, r, lane); continue; } r -= I_IN;
        transpose_item(p.in[27], DMIX, DM, (bf16*)(ws + WS_WOUT), 0, scr, r, lane);
    }
    const int gt = blockIdx.x * 512 + tid, NGT = gridDim.x * 512;
    { unsigned* z = (unsigned*)((bf16*)(ws + WS_WIN) + (size_t)DIN * DM); for (int i = gt; i < (DINP - DIN) * DM / 2; i += NGT) z[i] = 0u; }
    { const float* wq = p.in[21]; const float* wuk = p.in[23]; bf16* WqT = (bf16*)(ws + WS_WQ);
      for (int idx = gt; idx < NQ * QL; idx += NGT) { const int n = idx / QL, k = idx % QL; float v;
          if (n < NH * KVL) { const int h = n / KVL, c = n % KVL; const float* a = wq + (size_t)k * (NH * 96) + h * 96; const float* b = wuk + ((size_t)c * NH + h) * NOPE; float s = 0.f;
              for (int j = 0; j < NOPE; ++j) s += a[j] * b[j]; v = s; }
          else { const int h = (n - NH * KVL) / ROPE, r = (n - NH * KVL) % ROPE; v = wq[(size_t)k * (NH * 96) + h * 96 + NOPE + r]; }
          WqT[idx] = (bf16)f2bf(v * p.in[20][k]); } }
    { const float* wa = p.in[15]; const float* wi = p.in[17]; bf16* WGT = (bf16*)(ws + WS_WGT);
      for (int idx = gt; idx < NBLK * 2 * BLK * BLK; idx += NGT) { const int d = idx & 63, e = (idx >> 6) & 63, g = (idx >> 12) & 1, n = idx >> 13;
          WGT[idx] = (bf16)f2bf((g ? wi : wa)[((size_t)n * BLK + d) * BLK + e]); } }
    { const float* wuv = p.in[24]; bf16* WUVF = (bf16*)(ws + WS_WUVF);
      for (int idx = gt; idx < NH * 2 * 4 * 2 * 64 * 8; idx += NGT) { const int j = idx & 7, ln = (idx >> 3) & 63, s = (idx >> 9) & 1, cb = (idx >> 10) & 3, vb = (idx >> 12) & 1, h = idx >> 13;
          const int v = 32 * vb + (ln & 31), c = 32 * cb + 16 * s + 8 * (j >> 2) + 4 * (ln >> 5) + (j & 3);
          WUVF[idx] = (bf16)f2bf(wuv[((size_t)c * NH + h) * VD + v]); } }
    rmsnorm_rows<true>(p.in[0], p.in[1], RP, p.in[7], ws + WS_XN);
}

__device__ __forceinline__ float half_sum(float v, LAS float* red4) {
    v = wave_sum(v);
    __syncthreads();
    if ((threadIdx.x & 63) == 0) red4[(threadIdx.x >> 6) & 3] = v;
    __syncthreads();
    return (red4[0] + red4[1]) + (red4[2] + red4[3]);
}
__device__ __forceinline__ void p_ckv_norm(const Params& p) {
    const int lane = threadIdx.x & 63, gw = blockIdx.x * 8 + (threadIdx.x >> 6), NGW = gridDim.x * 8;
    const float* CKV = (const float*)(p.ws + WS_CKV); const float* SSQ = (const float*)(p.ws + WS_SSQ); bf16* KC = (bf16*)(p.ws + WS_KC); bf16* KCS = (bf16*)(p.ws + WS_KCS);
    const float2 g2 = ((const float2*)p.in[22])[lane];
    for (int row = gw; row < R; row += NGW) {
        const float2 v = ((const float2*)(CKV + (size_t)row * KVL))[lane]; const f32x4 sq = *(const f32x4*)(SSQ + (size_t)row * 8 + 4);
        const float rstd = 1.0f / sqrtf(((sq[0] + sq[1]) + (sq[2] + sq[3])) * (1.0f / KVL) + EPS);
        float2 o; o.x = v.x * rstd * g2.x; o.y = v.y * rstd * g2.y;
        if (row < RP) { ((float2*)(p.out + O_KVP + (size_t)row * KVL))[lane] = o; ((unsigned*)(KC + (size_t)row * QD))[lane] = pk2(o.x, o.y); }
        else { ((float2*)(p.out + O_KVS + (size_t)(row - RP) * KVL))[lane] = o; ((unsigned*)(KCS + (size_t)(row - RP) * QD))[lane] = pk2(o.x, o.y); }
    }
}

#define GEMM_PHASE(Epi, Aptr, Bptr, Nn, Kk, Eobj) do { pg8::Gemm g_{(const pg8::bf16_t*)(Aptr), (const pg8::bf16_t*)(Bptr), R, (Nn), (Kk)}; pg8::StaticOrder S_; S_.init(R, (Nn), (int)gridDim.x, (int)blockIdx.x); \
    pg8::gemm_phase<Epi, pg8::StaticOrder, true, true>((PG8_LAS unsigned char*)lds, g_, S_, (Eobj)); } while (0)
constexpr int N_PHASES = 13;
__global__ void __launch_bounds__(512, 2) mega(Params p) {
    extern __shared__ __attribute__((aligned(16))) unsigned char lds_raw[];
    LAS unsigned char* lds = (LAS unsigned char*)lds_raw;
    volatile LAS unsigned* MISC = (volatile LAS unsigned*)(lds + MISC_OFF);
    for (int u = threadIdx.x; u < (LDS_BYTES - LDSCTL_OFF) / 4; u += 512) ((LAS unsigned*)(lds + LDSCTL_OFF))[u] = 0u;
    __syncthreads();
    unsigned char* ws = p.ws; float* out = p.out;
    XcdBarrier bar = xcd_barrier_post((unsigned*)(ws + WS_CTL) + CW_BAR, MISC + 8);
    const int lo = p.ph_lo, hi = p.ph_hi;
#ifdef ONLY_PHASE
#define IN(k) ((k) == ONLY_PHASE && lo <= (k) && (k) < hi)
#else
#define IN(k) (lo <= (k) && (k) < hi)
#endif
#define SEAM(k) do { if (IN(k) && IN((k) + 1)) xcd_barrier(bar); } while (0)
    bf16 *Wgu1 = (bf16*)(ws + WS_WGU1), *Wd1 = (bf16*)(ws + WS_WD1), *Wgu2 = (bf16*)(ws + WS_WGU2), *Wd2 = (bf16*)(ws + WS_WD2), *Win = (bf16*)(ws + WS_WIN), *Wout = (bf16*)(ws + WS_WOUT), *Wq = (bf16*)(ws + WS_WQ);
    bf16 *XN = (bf16*)(ws + WS_XN), *H = (bf16*)(ws + WS_H), *YC = (bf16*)(ws + WS_YC), *Qb = (bf16*)(ws + WS_QB), *KC = (bf16*)(ws + WS_KC);
    float *X1 = (float*)(ws + WS_X1), *X2 = (float*)(ws + WS_X2), *PART = (float*)(ws + WS_PART), *CKV = (float*)(ws + WS_CKV), *SSQ = (float*)(ws + WS_SSQ), *SUM = (float*)(ws + WS_SUM);
    bf16 *XL = (bf16*)(ws + WS_XL), *GG = (bf16*)(ws + WS_GG), *CQ = (bf16*)(ws + WS_CQ), *KCS = (bf16*)(ws + WS_KCS), *WGT = (bf16*)(ws + WS_WGT), *WUVF = (bf16*)(ws + WS_WUVF);

    if (IN(0)) p_prologue(p, lds);
    SEAM(0);
    if (IN(1)) { pg8::EpiSwiGLU E{H, DFF, 0}; GEMM_PHASE(pg8::EpiSwiGLU, XN, Wgu1, NGU, DM, E); }
    SEAM(1);
    if (IN(2)) { pg8::EpiF32 E{X1, p.in[0], p.in[1], DM, RP / 256, 0.5f, 0}; GEMM_PHASE(pg8::EpiF32, H, Wd1, DM, DFF, E); }
    SEAM(2);
    if (IN(3)) rmsnorm_rows<true>(X1, X1, R, p.in[11], XN);
    SEAM(3);
    if (IN(4)) { pg8::EpiZ E{XL, GG, CQ, CKV, SSQ, out, KC, KCS}; GEMM_PHASE(pg8::EpiZ, XN, Win, DINP, DM, E); }
    SEAM(4);
    lru::State st;
    const bool has_chunk = blockIdx.x < NB * NCHUNK;
    const int cb_ = (int)blockIdx.x / NCHUNK, cc_ = (int)blockIdx.x % NCHUNK;
    const size_t crow0 = (size_t)cb_ * SEQ + (size_t)cc_ * CHUNK;
    if (IN(5)) {
        { pg8::EpiQ E{Qb, SSQ, QSCALE, 0}; GEMM_PHASE(pg8::EpiQ, CQ, Wq, NQ, QL, E); }
        p_ckv_norm(p);
        if (has_chunk) lru::unit_pre<false>((att::ldsp)lds, st, XL, WGT, p.in[13], p.in[14], p.in[16], p.in[18], p.in[19], p.in[5], p.in[4], out, crow0, cb_, cc_ * CHUNK, SUM + ((size_t)blockIdx.x * DLRU) * 2);
    }
    SEAM(5);
    if (IN(6)) {
        if (has_chunk) {
            const int ch = 64 * ((int)threadIdx.x >> 6) + ((int)threadIdx.x & 63);
            const float cr = lru::chunk_carry(SUM + (size_t)cb_ * NCHUNK * DLRU * 2, cc_, ch);
            if (cc_ == NCHUNK - 1) { const float2 sv = *(const float2*)(SUM + ((size_t)blockIdx.x * DLRU + ch) * 2); out[O_HP + (size_t)cb_ * DLRU + ch] = sv.y + sv.x * cr; }
            const float c0 = __shfl(cr, (int)threadIdx.x & 31), c1 = __shfl(cr, 32 + ((int)threadIdx.x & 31));
            lru::unit_post((att::ldsp)lds, st, GG, p.in[25], YC, crow0, c0, c1);
        }
        if (blockIdx.x < RS / 64) {
            lru::State s2; const int su = (int)blockIdx.x; const size_t r0 = (size_t)RP + 64 * su;
            lru::unit_pre<true>((att::ldsp)lds, s2, XL, WGT, p.in[13], p.in[14], p.in[16], p.in[18], p.in[19], p.in[5], p.in[4], out, r0, 8 * su, 0, nullptr);
            lru::unit_post((att::ldsp)lds, s2, GG, p.in[25], YC, r0, 0.f, 0.f);
        }
#pragma unroll 1
        for (int u2 = 2 * (int)blockIdx.x; u2 < NB * SEQ / 32; ++u2) { const int pr = u2 >> 1, b = pr & 1, i = pr >> 1;
            att::prompt_unit((att::ldsp)lds, Qb, KC, WUVF, p.in[26], YC, b, (u2 & 1) ? i : SEQ / 32 - 1 - i);
            if (u2 & 1) u2 += 2 * ((int)gridDim.x - 1); }
        for (int item = blockIdx.x; item < DB * NSPLIT; item += gridDim.x) { const int db = item / NSPLIT, ch = item % NSPLIT;
            att::decode_item((att::ldsp)lds, Qb, p.in[2], p.in[3], (const int*)p.in[6], PART + (size_t)item * 2 * att::PART_FLOATS, db, ch * (NPAGES / NSPLIT), NPAGES / NSPLIT); }
    }
    SEAM(6);
    if (IN(7)) {
        for (int db = blockIdx.x; db < DB; db += gridDim.x)
            att::decode_combine((att::ldsp)lds, Qb, out + O_KVS, out + O_KRS, PART + (size_t)db * NSPLIT * 2 * att::PART_FLOATS, NSPLIT, p.in[24], p.in[26], YC, db);
    }
    SEAM(7);
    if (IN(8)) { pg8::EpiF32 E{X2, X1, X1, DM, 1 << 20, 1.0f, 0}; GEMM_PHASE(pg8::EpiF32, YC, Wout, DM, DMIX, E); }
    SEAM(8);
    if (IN(9)) rmsnorm_rows<true>(X2, X2, R, p.in[28], XN);
    SEAM(9);
    if (IN(10)) { pg8::EpiSwiGLU E{H, DFF, 0}; GEMM_PHASE(pg8::EpiSwiGLU, XN, Wgu2, NGU, DM, E); }
    SEAM(10);
    if (IN(11)) { pg8::EpiF32 E{X1, X2, X2, DM, 1 << 20, 0.5f, 0}; GEMM_PHASE(pg8::EpiF32, H, Wd2, DM, DFF, E); }
    SEAM(11);
    if (IN(12)) rmsnorm_rows<false>(X1, X1, R, p.in[32], out);
#undef IN
#undef SEAM
}

#ifndef MK_N_LAUNCHES
#define MK_N_LAUNCHES 1
#endif
extern "C" void kernel_launch(void* const* d_in, const int* in_sizes, int n_in, void* d_out, int out_size, void* d_ws, size_t ws_size, hipStream_t stream) {
    static int grid = 0;
    if (grid == 0) {
        if (n_in != 33 || out_size != (int)O_END || ws_size < WS_END) { fprintf(stderr, "kernel_launch: unexpected shapes (n_in %d, out %d, ws %zu)\n", n_in, out_size, ws_size); grid = -1; return; }
        int dev = 0, cus = 0, per_cu = 0;
        if (hipGetDevice(&dev) != hipSuccess || hipDeviceGetAttribute(&cus, hipDeviceAttributeMultiprocessorCount, dev) != hipSuccess) { grid = -1; return; }
        if (hipFuncSetAttribute((const void*)mega, hipFuncAttributeMaxDynamicSharedMemorySize, LDS_BYTES) != hipSuccess) { fprintf(stderr, "kernel_launch: hipFuncSetAttribute failed\n"); grid = -1; return; }
        if (hipOccupancyMaxActiveBlocksPerMultiprocessor(&per_cu, (const void*)mega, 512, LDS_BYTES) != hipSuccess || per_cu < 1) fprintf(stderr, "kernel_launch: occupancy query says %d\n", per_cu);
        (void)hipGetLastError();
        grid = cus;
    }
    if (grid < 0) return;
    (void)hipMemsetAsync((char*)d_ws + WS_CTL, 0, CTL_ZERO_BYTES, stream);
    Params prm; memset(&prm, 0, sizeof(prm));
    for (int i = 0; i < 33; ++i) prm.in[i] = (const float*)d_in[i];
    prm.out = (float*)d_out; prm.ws = (unsigned char*)d_ws;
    if (MK_N_LAUNCHES == 1) { prm.ph_lo = 0; prm.ph_hi = N_PHASES; hipLaunchKernelGGL(mega, dim3(grid), dim3(512), LDS_BYTES, stream, prm); }
    else for (int k = 0; k < N_PHASES; ++k) { prm.ph_lo = k; prm.ph_hi = k + 1; hipLaunchKernelGGL(mega, dim3(grid), dim3(512), LDS_BYTES, stream, prm); }
}
```

```cpp
#include <hip/hip_runtime.h>
#include <cstdio>
#include <cstdint>
#include <cstring>
constexpr int DM = 1024, SEQ = 8192, NB = 2, RP = NB * SEQ, DB = 128, DS = 8, RS = DB * DS, R = RP + RS;
constexpr int PAST = 16384, PAGE = 128, NPAGES = PAST / PAGE;
constexpr int DLRU = 512, NBLK = 8, BLK = 64, CONVW = 4;
constexpr int NH = 8, NOPE = 64, ROPE = 32, VD = 64, QL = 256, KVL = 128, DMLA = 512, DMIX = 1024, DIN = 1440, DINP = 1536;
constexpr int DFF = 2816, NGU = 2 * DFF;
constexpr int NQ = NH * KVL + NH * ROPE;
constexpr int QD = KVL + ROPE;
constexpr float EPS = 1e-6f;
constexpr size_t O_YP = 0, O_YS = O_YP + (size_t)RP * DM, O_KVP = O_YS + (size_t)RS * DM, O_KRP = O_KVP + (size_t)RP * KVL, O_HP = O_KRP + (size_t)RP * ROPE,
                 O_CVP = O_HP + (size_t)NB * DLRU, O_KVS = O_CVP + (size_t)NB * 3 * DLRU, O_KRS = O_KVS + (size_t)RS * KVL, O_HS = O_KRS + (size_t)RS * ROPE,
                 O_CVS = O_HS + (size_t)DB * DLRU, O_END = O_CVS + (size_t)DB * 3 * DLRU;
static_assert(O_END == 20877312, "output size");
__device__ const float ROPE_FREQ[16] = {1.000000000e+00f, 5.623413324e-01f, 3.162277639e-01f, 1.778279394e-01f, 1.000000015e-01f, 5.623413250e-02f, 3.162277490e-02f, 1.778279431e-02f,
                                        9.999999776e-03f, 5.623413250e-03f, 3.162277630e-03f, 1.778279431e-03f, 1.000000047e-03f, 5.623413017e-04f, 3.162277571e-04f, 1.778279402e-04f};
namespace pg8 {
#define PG8_LAS __attribute__((address_space(3)))
typedef unsigned short bf16_t;
typedef short bf16x8 __attribute__((ext_vector_type(8)));
typedef float f32x4 __attribute__((ext_vector_type(4)));
typedef unsigned u32x4 __attribute__((ext_vector_type(4)));
constexpr int BM = 256, BK = 64, HALF = 128, HTB = HALF * BK * 2  , STAGE_BYTES = 8 * HTB, NXCD = 8, WGM = 8;

__host__ __device__ __forceinline__ int lds_byte(int r, int c) { const int st = (r >> 4) * 2 + (c >> 5), rr = r & 15, cc = c & 31, ob = rr * 64 + cc * 2; return st * 1024 + (ob ^ (((ob >> 9) & 1) << 5)); }
__host__ __device__ __forceinline__ void stage_rc(int b, int& R, int& C) { const int st = b / 1024, sb = b % 1024, swz = sb ^ (((sb >> 9) & 1) << 5); R = (st >> 1) * 16 + swz / 64; C = (st & 1) * 32 + (swz % 64) / 2; }
__host__ __device__ __forceinline__ int perm32(int rho) { const int n = rho >> 4, i = rho & 15; return 8 * (i >> 2) + 4 * n + (i & 3); }

struct Unit { int pm, pn; };
struct Gemm { const bf16_t* A; const bf16_t* Bt; int M, N, K; };

struct StaticOrder {
    int nM, nN, nwg, G, c;
    __host__ __device__ void init(int M, int N, int G_, int c_) { nM = M / BM; nN = N / BM; nwg = nM * nN; G = G_; c = c_; }
    __host__ __device__ bool next(int i, Unit& u) const {
        const long L = (long)i * G + c; if (L >= nwg) return false;
        int wgid = (int)L; { const int q = nwg / NXCD, r = nwg % NXCD, xcd = wgid % NXCD, off = wgid / NXCD; wgid = (xcd < r ? xcd * (q + 1) : r * (q + 1) + (xcd - r) * q) + off; }
        const int nig = WGM * nN, gid = wgid / nig, fm = gid * WGM, gsz = (nM - fm) < WGM ? (nM - fm) : WGM;
        u.pm = fm + ((wgid % nig) % gsz); u.pn = (wgid % nig) / gsz; return true;
    }
    __device__ __forceinline__ void a_ready(const Unit&) const {}
    __device__ __forceinline__ void done(const Unit&) const {}
};

__device__ __forceinline__ unsigned cvt_pk_bf16(float lo, float hi) { unsigned r; asm volatile("v_cvt_pk_bf16_f32 %0, %1, %2" : "=v"(r) : "v"(lo), "v"(hi)); return r; }
typedef float f32x2 __attribute__((ext_vector_type(2)));
typedef float f32x2 __attribute__((ext_vector_type(2)));
template <class Epi, class Sched, bool ALIGN_EPI = false, bool SP2 = false>
__device__ __forceinline__ void gemm_phase(PG8_LAS unsigned char* lds, const Gemm g, const Sched& S, const Epi& E) {
    int tid_ = threadIdx.x; asm volatile("" : "+v"(tid_));
    const int tid = tid_, wid = __builtin_amdgcn_readfirstlane(tid >> 6), lane = tid & 63, wr = wid >> 2, wc = wid & 3, fr = lane & 15, fq = lane >> 4;
    const int K = g.K, nt = K / BK;
    unsigned voffA[2], voffB[2];
#pragma unroll
    for (int i = 0; i < 2; ++i) { int R, C; stage_rc(tid * 16 + i * 8192, R, C); const int Rb = Epi::PERM ? ((R & ~31) + perm32(R & 31)) : R;
        voffA[i] = (unsigned)(R * K + C) * 2u; voffB[i] = (unsigned)(Rb * K + C) * 2u; }
    const size_t kstep = (size_t)(BK * 2);
    const size_t hstep = (size_t)HALF * K * 2;
    const size_t tstep = 2 * hstep;
    const unsigned ldsw = (unsigned)wid * 1024u;
    const int aoff = lds_byte(wr * 64 + fr, fq * 8), boff = lds_byte(wc * 32 + fr, fq * 8);
#define PG8_SA(b, h) (((b) * 2 + (h)) * HTB)
#define PG8_SB(b, h) ((4 + (b) * 2 + (h)) * HTB)
#define PG8_STAGE(bufoff, gbase, voff) do { _Pragma("unroll") for (int _i = 0; _i < 2; ++_i) \
        __builtin_amdgcn_global_load_lds((const unsigned*)((const char*)(gbase) + (voff)[_i]), (PG8_LAS unsigned*)(lds + (bufoff) + ldsw + _i * 8192), 16, 0, 0); } while (0)
#define PG8_LDA(dst, b, h) do { _Pragma("unroll") for (int m = 0; m < 4; ++m) _Pragma("unroll") for (int k = 0; k < 2; ++k) dst[m][k] = *(const PG8_LAS bf16x8*)(lds + PG8_SA(b, h) + aoff + m * 2048 + k * 1024); } while (0)
#define PG8_LDB(dst, b, h) do { _Pragma("unroll") for (int n = 0; n < 2; ++n) _Pragma("unroll") for (int k = 0; k < 2; ++k) dst[n][k] = *(const PG8_LAS bf16x8*)(lds + PG8_SB(b, h) + boff + n * 2048 + k * 1024); } while (0)
#define PG8_MMA(ai, bj, At, Bt) do { __builtin_amdgcn_s_setprio(1); _Pragma("unroll") for (int m = 0; m < 4; ++m) _Pragma("unroll") for (int n = 0; n < 2; ++n) _Pragma("unroll") for (int k = 0; k < 2; ++k) \
        acc[ai][bj][m][n] = __builtin_amdgcn_mfma_f32_16x16x32_bf16(Bt[n][k], At[m][k], acc[ai][bj][m][n], 0, 0, 0); __builtin_amdgcn_s_setprio(0); } while (0)
#define PG8_WAIT_V(n) asm volatile("s_waitcnt vmcnt(" #n ")" ::: "memory")
#define PG8_WAIT_L(n) asm volatile("s_waitcnt lgkmcnt(" #n ")" ::: "memory")
#define PG8_BAR __builtin_amdgcn_s_barrier()
#define PG8_SCHED __builtin_amdgcn_sched_barrier(0)
    Unit cur, nxt; int ui = 0;
    if (!S.next(0, cur)) return;
    f32x4 acc[2][2][4][2];
#pragma unroll
    for (int a = 0; a < 2; ++a)
#pragma unroll
        for (int b = 0; b < 2; ++b)
#pragma unroll
            for (int m = 0; m < 4; ++m)
#pragma unroll
                for (int n = 0; n < 2; ++n) acc[a][b][m][n] = (f32x4){0.f, 0.f, 0.f, 0.f};
    bf16x8 At[4][2], B0[2][2], B1[2][2];
    const char* cA = (const char*)g.A + (size_t)cur.pm * tstep; const char* cB = (const char*)g.Bt + (size_t)cur.pn * tstep;
    S.a_ready(cur);
    if constexpr (SP2) {
        PG8_STAGE(PG8_SB(0, 0), cB, voffB); PG8_STAGE(PG8_SB(0, 1), cB + hstep, voffB); PG8_STAGE(PG8_SA(0, 0), cA, voffA); PG8_STAGE(PG8_SA(0, 1), cA + hstep, voffA);
        if (wr == 1) PG8_BAR;
        PG8_WAIT_V(2); PG8_BAR;
        PG8_STAGE(PG8_SB(1, 0), cB + kstep, voffB); PG8_STAGE(PG8_SA(1, 0), cA + kstep, voffA); PG8_STAGE(PG8_SB(1, 1), cB + hstep + kstep, voffB);
        PG8_WAIT_V(6); PG8_BAR;
    } else {
        PG8_STAGE(PG8_SB(0, 0), cB, voffB); PG8_STAGE(PG8_SA(0, 0), cA, voffA); PG8_STAGE(PG8_SB(0, 1), cB + hstep, voffB); PG8_STAGE(PG8_SA(0, 1), cA + hstep, voffA);
        if (wr == 1) PG8_BAR;
        PG8_WAIT_V(4); PG8_BAR;
        PG8_STAGE(PG8_SB(1, 0), cB + kstep, voffB); PG8_STAGE(PG8_SA(1, 0), cA + kstep, voffA); PG8_STAGE(PG8_SB(1, 1), cB + hstep + kstep, voffB);
        PG8_WAIT_V(6); PG8_BAR;
    }
    for (;;) {
        const bool has_next = S.next(ui + 1, nxt);
        const char* nA = has_next ? (const char*)g.A + (size_t)nxt.pm * tstep : cA; const char* nB = has_next ? (const char*)g.Bt + (size_t)nxt.pn * tstep : cB;
        for (int t = 0; t < nt; t += 2) {
            const bool last = (t == nt - 2);
            const char* a1 = cA + (size_t)(t + 1) * kstep;
            const char* a2 = last ? nA : cA + (size_t)(t + 2) * kstep; const char* b2 = last ? nB : cB + (size_t)(t + 2) * kstep;
            const char* a3 = a2 + kstep; const char* b3 = b2 + kstep;
            if (last && has_next) S.a_ready(nxt);
            if constexpr (SP2) {
            PG8_LDB(B0, 0, 0); PG8_LDB(B1, 0, 1); PG8_SCHED; PG8_LDA(At, 0, 0); PG8_STAGE(PG8_SA(1, 1), a1 + hstep, voffA);
            PG8_WAIT_V(8); PG8_WAIT_L(0); PG8_BAR; PG8_MMA(0, 0, At, B0); PG8_MMA(0, 1, At, B1); PG8_BAR; PG8_SCHED;
            PG8_LDA(At, 0, 1); PG8_STAGE(PG8_SB(0, 0), b2, voffB); PG8_STAGE(PG8_SB(0, 1), b2 + hstep, voffB); PG8_STAGE(PG8_SA(0, 0), a2, voffA);
            PG8_WAIT_V(8); PG8_WAIT_L(0); PG8_BAR; PG8_MMA(1, 0, At, B0); PG8_MMA(1, 1, At, B1); PG8_BAR; PG8_SCHED;
            PG8_LDB(B0, 1, 0); PG8_LDB(B1, 1, 1); PG8_SCHED; PG8_LDA(At, 1, 0); PG8_STAGE(PG8_SA(0, 1), a2 + hstep, voffA);
            PG8_WAIT_V(8); PG8_WAIT_L(0); PG8_BAR; PG8_MMA(0, 0, At, B0); PG8_MMA(0, 1, At, B1); PG8_BAR; PG8_SCHED;
            PG8_LDA(At, 1, 1); PG8_STAGE(PG8_SB(1, 0), b3, voffB); PG8_STAGE(PG8_SB(1, 1), b3 + hstep, voffB); PG8_STAGE(PG8_SA(1, 0), a3, voffA);
            PG8_WAIT_V(8); PG8_WAIT_L(0); PG8_BAR; PG8_MMA(1, 0, At, B0); PG8_MMA(1, 1, At, B1); PG8_BAR; PG8_SCHED;
            } else {
            PG8_LDB(B0, 0, 0); PG8_SCHED; PG8_LDA(At, 0, 0); PG8_STAGE(PG8_SA(1, 1), a1 + hstep, voffA);
            PG8_WAIT_L(8); PG8_BAR; PG8_WAIT_L(0); PG8_MMA(0, 0, At, B0); PG8_BAR; PG8_SCHED;
            PG8_LDB(B1, 0, 1); PG8_STAGE(PG8_SB(0, 0), b2, voffB);
            PG8_BAR; PG8_WAIT_L(0); PG8_MMA(0, 1, At, B1); PG8_BAR;
            PG8_LDA(At, 0, 1); PG8_STAGE(PG8_SA(0, 0), a2, voffA);
            PG8_BAR; PG8_WAIT_L(0); PG8_MMA(1, 0, At, B0); PG8_BAR; PG8_SCHED;
            PG8_STAGE(PG8_SB(0, 1), b2 + hstep, voffB);
            PG8_WAIT_V(6); PG8_BAR; PG8_MMA(1, 1, At, B1); PG8_BAR;
            PG8_LDB(B0, 1, 0); PG8_SCHED; PG8_LDA(At, 1, 0); PG8_STAGE(PG8_SA(0, 1), a2 + hstep, voffA);
            PG8_WAIT_L(8); PG8_BAR; PG8_WAIT_L(0); PG8_MMA(0, 0, At, B0); PG8_BAR; PG8_SCHED;
            PG8_LDB(B1, 1, 1); PG8_STAGE(PG8_SB(1, 0), b3, voffB);
            PG8_BAR; PG8_WAIT_L(0); PG8_MMA(0, 1, At, B1); PG8_BAR;
            PG8_LDA(At, 1, 1); PG8_STAGE(PG8_SA(1, 0), a3, voffA);
            PG8_BAR; PG8_WAIT_L(0); PG8_MMA(1, 0, At, B0); PG8_BAR; PG8_SCHED;
            PG8_STAGE(PG8_SB(1, 1), b3 + hstep, voffB);
            PG8_WAIT_V(6); PG8_BAR; PG8_MMA(1, 1, At, B1); PG8_BAR;
            }
        }
        if constexpr (ALIGN_EPI) { if (wr == 0) PG8_BAR; }
        if constexpr (!Epi::AFTER_DRAIN) { E(acc, cur, wr, wc, fr, fq); S.done(cur); }
        if (!has_next) break;
#pragma unroll
        for (int a = 0; a < 2; ++a)
#pragma unroll
            for (int b = 0; b < 2; ++b)
#pragma unroll
                for (int m = 0; m < 4; ++m)
#pragma unroll
                    for (int n = 0; n < 2; ++n) acc[a][b][m][n] = (f32x4){0.f, 0.f, 0.f, 0.f};
        cur = nxt; cA = nA; cB = nB; ++ui;
        if constexpr (ALIGN_EPI) { if (wr == 1) PG8_BAR; }
    }
    PG8_WAIT_V(0);
    if constexpr (!ALIGN_EPI) { if (wr == 0) PG8_BAR; }
    PG8_BAR;
    if constexpr (Epi::AFTER_DRAIN) { E.fused(acc, cur, wr, wc, fr, fq, lds, wid, lane); S.done(cur); }
#undef PG8_SA
#undef PG8_SB
#undef PG8_STAGE
#undef PG8_LDA
#undef PG8_LDB
#undef PG8_MMA
#undef PG8_WAIT_V
#undef PG8_WAIT_L
#undef PG8_BAR
#undef PG8_SCHED
}
}
namespace pg8 {
struct EpiF32 {
    static constexpr bool PERM = false, AFTER_DRAIN = false;
    float* out; const float* base0; const float* base1; int ldc; int split; float alpha; int pad;
    __device__ __forceinline__ void operator()(const f32x4 (&acc)[2][2][4][2], const Unit& u, int wr, int wc, int fr, int fq) const {
        const int col0 = u.pn * BM + wc * 32 + 4 * fq;
        const float* bp = nullptr;
        if (base0) bp = (u.pm < split) ? base0 + (size_t)u.pm * BM * ldc : base1 + (size_t)(u.pm - split) * BM * ldc;
#pragma unroll
        for (int ai = 0; ai < 2; ++ai)
#pragma unroll
            for (int m = 0; m < 4; ++m) { const int rt = ai * HALF + wr * 64 + m * 16 + fr; const size_t off = (size_t)rt * ldc + col0;
                float* orow = out + (size_t)u.pm * BM * ldc + off;
#pragma unroll
                for (int bj = 0; bj < 2; ++bj)
#pragma unroll
                    for (int n = 0; n < 2; ++n) { f32x4 v = acc[ai][bj][m][n] * alpha; if (bp) v = v + *(const f32x4*)(bp + off + bj * HALF + n * 16);
                        *(f32x4*)(orow + bj * HALF + n * 16) = v; } }
    }
};
struct EpiSwiGLU {
    static constexpr bool PERM = true, AFTER_DRAIN = false;
    bf16_t* H; const float* SSQX; int ldh; int pad;
    __device__ __forceinline__ void operator()(const f32x4 (&acc)[2][2][4][2], const Unit& u, int wr, int wc, int fr, int fq) const {
        const int col0 = u.pn * HALF + wc * 32 + 8 * fq;
#pragma unroll
        for (int ai = 0; ai < 2; ++ai)
#pragma unroll
            for (int m = 0; m < 4; ++m) { const int row = u.pm * BM + ai * HALF + wr * 64 + m * 16 + fr; bf16_t* rowp = H + (size_t)row * ldh + col0;
                float rs = 1.0f;
                if (SSQX) { const f32x4* sp = (const f32x4*)(SSQX + (size_t)row * 16); const f32x4 s0 = sp[0], s1 = sp[1], s2 = sp[2], s3 = sp[3]; const f32x4 t = (s0 + s1) + (s2 + s3);
                    rs = __builtin_amdgcn_rsqf(((t[0] + t[1]) + (t[2] + t[3])) * (1.0f / 1024.0f) + 1e-6f); }
                float hv[8];
#pragma unroll
                for (int n = 0; n < 2; ++n)
#pragma unroll
                    for (int i = 0; i < 4; ++i) { const float g = acc[ai][0][m][n][i] * rs, up = acc[ai][1][m][n][i] * rs;
                        hv[4 * n + i] = g * __builtin_amdgcn_rcpf(1.0f + __builtin_amdgcn_exp2f(-1.4426950408889634f * g)) * up; }
                u32x4 w; w.x = cvt_pk_bf16(hv[0], hv[1]); w.y = cvt_pk_bf16(hv[2], hv[3]); w.z = cvt_pk_bf16(hv[4], hv[5]); w.w = cvt_pk_bf16(hv[6], hv[7]);
                *(u32x4*)rowp = w; }
    }
};
template <bool BASE_F32> struct EpiRes {
    static constexpr bool PERM = false, AFTER_DRAIN = false;
    const float* basef; bf16_t* Xb; float* SSQX; float alpha; int pad;
    __device__ __forceinline__ void operator()(const f32x4 (&acc)[2][2][4][2], const Unit& u, int wr, int wc, int fr, int fq) const {
        typedef unsigned u32x2 __attribute__((ext_vector_type(2)));
        constexpr int ldc = 1024;
        const int col0 = u.pn * BM + wc * 32 + 4 * fq;
#pragma unroll
        for (int ai = 0; ai < 2; ++ai)
#pragma unroll
            for (int m = 0; m < 4; ++m) { const size_t row = (size_t)u.pm * BM + ai * HALF + wr * 64 + m * 16 + fr; float ss = 0.f;
#pragma unroll
                for (int bj = 0; bj < 2; ++bj)
#pragma unroll
                    for (int n = 0; n < 2; ++n) { const size_t off = row * ldc + col0 + bj * HALF + n * 16; f32x4 bv;
                        if (BASE_F32) bv = __builtin_nontemporal_load((const f32x4*)(basef + off));
                        else { const u32x2 bw = *(const u32x2*)(Xb + off); bv[0] = __uint_as_float(bw.x << 16); bv[1] = __uint_as_float(bw.x & 0xffff0000u); bv[2] = __uint_as_float(bw.y << 16); bv[3] = __uint_as_float(bw.y & 0xffff0000u); }
                        const f32x4 v = acc[ai][bj][m][n] * alpha + bv;
                        u32x2 w; w.x = cvt_pk_bf16(v[0], v[1]); w.y = cvt_pk_bf16(v[2], v[3]); *(u32x2*)(Xb + off) = w;
                        ss += (v[0] * v[0] + v[1] * v[1]) + (v[2] * v[2] + v[3] * v[3]); }
                ss += __shfl_xor(ss, 16); ss += __shfl_xor(ss, 32); if (fq == 0) SSQX[row * 16 + u.pn * 4 + wc] = ss; }
    }
};
struct EpiFinal {
    static constexpr bool PERM = false, AFTER_DRAIN = true;
    const bf16_t* Xb; float* out; const float* gain; float* xch; unsigned* cnt; float alpha; int pad;
    __device__ __forceinline__ void fused(f32x4 (&acc)[2][2][4][2], const Unit& u, int wr, int wc, int fr, int fq, PG8_LAS unsigned char* lds, int wid, int lane) const {
        typedef unsigned u32x2 __attribute__((ext_vector_type(2)));
        constexpr int ldc = 1024;
        PG8_LAS float* S = (PG8_LAS float*)(lds + 8192);
        const int col0 = u.pn * BM + wc * 32 + 4 * fq;
        float ssv[2][4];
        {
            u32x2 bw[2][4][2][2];
#pragma unroll
            for (int ai = 0; ai < 2; ++ai)
#pragma unroll
                for (int m = 0; m < 4; ++m) { const size_t row = (size_t)u.pm * BM + ai * HALF + wr * 64 + m * 16 + fr;
#pragma unroll
                    for (int bj = 0; bj < 2; ++bj)
#pragma unroll
                        for (int n = 0; n < 2; ++n) bw[ai][m][bj][n] = *(const u32x2*)(Xb + row * ldc + col0 + bj * HALF + n * 16); }
#pragma unroll
            for (int ai = 0; ai < 2; ++ai)
#pragma unroll
                for (int m = 0; m < 4; ++m) { float ss = 0.f;
#pragma unroll
                    for (int bj = 0; bj < 2; ++bj)
#pragma unroll
                        for (int n = 0; n < 2; ++n) { const u32x2 w_ = bw[ai][m][bj][n]; f32x4 bv;
                            bv[0] = __uint_as_float(w_.x << 16); bv[1] = __uint_as_float(w_.x & 0xffff0000u); bv[2] = __uint_as_float(w_.y << 16); bv[3] = __uint_as_float(w_.y & 0xffff0000u);
                            const f32x4 v = acc[ai][bj][m][n] * alpha + bv; acc[ai][bj][m][n] = v;
                            ss += (v[0] * v[0] + v[1] * v[1]) + (v[2] * v[2] + v[3] * v[3]); }
                    ss += __shfl_xor(ss, 16); ss += __shfl_xor(ss, 32); ssv[ai][m] = ss; } }
        if (fq == 0) {
#pragma unroll
            for (int ai = 0; ai < 2; ++ai)
#pragma unroll
                for (int m = 0; m < 4; ++m) { const size_t row = (size_t)u.pm * BM + ai * HALF + wr * 64 + m * 16 + fr;
                    __hip_atomic_store(xch + row * 16 + u.pn * 4 + wc, ssv[ai][m], __ATOMIC_RELAXED, __HIP_MEMORY_SCOPE_AGENT); } }
        asm volatile("s_waitcnt vmcnt(0)" ::: "memory");
        if (lane == 0) __hip_atomic_fetch_add(cnt + 64 * u.pm, 1u, __ATOMIC_RELAXED, __HIP_MEMORY_SCOPE_AGENT);
        if (wid == 0) { unsigned sp = 0u;
            while ((unsigned)__builtin_amdgcn_readfirstlane(__hip_atomic_load(cnt + 64 * u.pm, __ATOMIC_RELAXED, __HIP_MEMORY_SCOPE_AGENT)) < 32u) { __builtin_amdgcn_s_sleep(2); if (++sp > (1u << 22)) break; }
            __builtin_amdgcn_fence(__ATOMIC_ACQUIRE, "agent"); }
        asm volatile("s_waitcnt vmcnt(0) lgkmcnt(0)" ::: "memory"); __builtin_amdgcn_s_barrier(); asm volatile("" ::: "memory");
        if (lane < 32) { const int r = wid * 32 + lane; const unsigned long long* sl = (const unsigned long long*)(xch + ((size_t)u.pm * BM + r) * 16); float t = 0.f;
#pragma unroll
            for (int j = 0; j < 8; ++j) { const unsigned long long w = __hip_atomic_load(sl + j, __ATOMIC_RELAXED, __HIP_MEMORY_SCOPE_AGENT); t += __uint_as_float((unsigned)w) + __uint_as_float((unsigned)(w >> 32)); }
            S[r] = 1.0f / sqrtf(t * (1.0f / 1024.0f) + 1e-6f); }
        asm volatile("s_waitcnt lgkmcnt(0)" ::: "memory"); __builtin_amdgcn_s_barrier(); asm volatile("" ::: "memory");
        f32x4 gv[2][2];
#pragma unroll
        for (int bj = 0; bj < 2; ++bj)
#pragma unroll
            for (int n = 0; n < 2; ++n) gv[bj][n] = *(const f32x4*)(gain + col0 + bj * HALF + n * 16);
#pragma unroll
        for (int ai = 0; ai < 2; ++ai)
#pragma unroll
            for (int m = 0; m < 4; ++m) { const int r = ai * HALF + wr * 64 + m * 16 + fr; const float rs = S[r]; float* op = out + ((size_t)u.pm * BM + r) * ldc + col0;
#pragma unroll
                for (int bj = 0; bj < 2; ++bj)
#pragma unroll
                    for (int n = 0; n < 2; ++n) *(f32x4*)(op + bj * HALF + n * 16) = acc[ai][bj][m][n] * rs * gv[bj][n]; }
    }
};
}
namespace pg8 {
__device__ __forceinline__ void rope_cs_e(int pos, int i, float& c, float& s) {
    const float ang = (float)pos * ROPE_FREQ[i];
    const double q4 = (double)ang * 0.6366197723675814; const double qr = rint(q4);
    const float r = (float)((q4 - qr) * 1.5707963267948966); const int qi = ((int)qr) & 3; const float r2 = r * r;
    const float sn = r * (1.0f + r2 * (-1.6666667e-1f + r2 * (8.3333333e-3f + r2 * (-1.9841270e-4f + r2 * 2.7557319e-6f))));
    const float cs = 1.0f + r2 * (-0.5f + r2 * (4.1666667e-2f + r2 * (-1.3888889e-3f + r2 * (2.4801587e-5f + r2 * -2.7557319e-7f))));
    c = (qi == 0) ? cs : (qi == 1) ? -sn : (qi == 2) ? -cs : sn;
    s = (qi == 0) ? sn : (qi == 1) ? cs : (qi == 2) ? -sn : -cs;
}
__device__ __forceinline__ float gelu_e(float x) { const float y = 0.7978845608028654f * (x + 0.044715f * x * x * x); return x * __builtin_amdgcn_rcpf(1.0f + __builtin_amdgcn_exp2f(-2.8853900817779268f * y)); }
typedef unsigned u32x2 __attribute__((ext_vector_type(2)));
struct EpiZ {
    static constexpr bool PERM = false, AFTER_DRAIN = false;
    bf16_t* XL; bf16_t* GG; bf16_t* CQ; float* CKV; float* SSQ; float* out; bf16_t* KC; bf16_t* KCS; const float* SSQX; bf16_t* CKVB;
    __device__ __forceinline__ void operator()(const f32x4 (&acc0)[2][2][4][2], const Unit& u, int wr, int wc, int fr, int fq) const {
        const int pn = u.pn;
#pragma unroll
        for (int ai = 0; ai < 2; ++ai)
#pragma unroll
            for (int m = 0; m < 4; ++m) { const int row = u.pm * BM + ai * HALF + wr * 64 + m * 16 + fr;
                f32x4 acc[2][2][4][2];
                { const f32x4* sp = (const f32x4*)(SSQX + (size_t)row * 16); const f32x4 s0 = sp[0], s1 = sp[1], s2 = sp[2], s3 = sp[3]; const f32x4 t = (s0 + s1) + (s2 + s3);
                  const float rs = __builtin_amdgcn_rsqf(((t[0] + t[1]) + (t[2] + t[3])) * (1.0f / 1024.0f) + 1e-6f);
#pragma unroll
                  for (int bj = 0; bj < 2; ++bj)
#pragma unroll
                      for (int n = 0; n < 2; ++n) acc[ai][bj][m][n] = acc0[ai][bj][m][n] * rs; }
                if (pn < 4) { bf16_t* dst = (pn < 2 ? XL : GG) + (size_t)row * 512 + (pn & 1) * 256 + wc * 32 + 4 * fq;
#pragma unroll
                    for (int bj = 0; bj < 2; ++bj)
#pragma unroll
                        for (int n = 0; n < 2; ++n) { f32x4 v = acc[ai][bj][m][n]; if (pn >= 2) { v[0] = gelu_e(v[0]); v[1] = gelu_e(v[1]); v[2] = gelu_e(v[2]); v[3] = gelu_e(v[3]); }
                            u32x2 w; w.x = cvt_pk_bf16(v[0], v[1]); w.y = cvt_pk_bf16(v[2], v[3]); *(u32x2*)(dst + bj * HALF + n * 16) = w; } }
                else if (pn == 4) { bf16_t* dst = CQ + (size_t)row * 256 + wc * 32 + 4 * fq; float ss = 0.f;
#pragma unroll
                    for (int bj = 0; bj < 2; ++bj)
#pragma unroll
                        for (int n = 0; n < 2; ++n) { const f32x4 v = acc[ai][bj][m][n]; ss += (v[0] * v[0] + v[1] * v[1]) + (v[2] * v[2] + v[3] * v[3]);
                            u32x2 w; w.x = cvt_pk_bf16(v[0], v[1]); w.y = cvt_pk_bf16(v[2], v[3]); *(u32x2*)(dst + bj * HALF + n * 16) = w; }
                    ss += __shfl_xor(ss, 16); ss += __shfl_xor(ss, 32);
                    if (fq == 0) SSQ[(size_t)row * 8 + wc] = ss; }
                else { float* dst = CKV + (size_t)row * 128 + wc * 32 + 4 * fq; float ss = 0.f;
#pragma unroll
                    for (int n = 0; n < 2; ++n) { const f32x4 v = acc[ai][0][m][n]; ss += (v[0] * v[0] + v[1] * v[1]) + (v[2] * v[2] + v[3] * v[3]); *(f32x4*)(dst + n * 16) = v;
                        u32x2 w; w.x = cvt_pk_bf16(v[0], v[1]); w.y = cvt_pk_bf16(v[2], v[3]); *(u32x2*)(CKVB + (size_t)row * 128 + wc * 32 + 4 * fq + n * 16) = w; }
                    ss += __shfl_xor(ss, 16); ss += __shfl_xor(ss, 32);
                    if (fq == 0) SSQ[(size_t)row * 8 + 4 + wc] = ss;
                    if (wc == 0) { const bool prompt = row < 16384; const int pos = prompt ? (row & 8191) : 16384 + ((row - 16384) & 7);
                        float* ko = prompt ? out + O_KRP + (size_t)row * 32 : out + O_KRS + (size_t)(row - 16384) * 32;
                        bf16_t* kb = prompt ? KC + (size_t)row * 160 + 128 : KCS + (size_t)(row - 16384) * 160 + 128;
                        const f32x4 x1 = acc[ai][1][m][0], x2 = acc[ai][1][m][1]; f32x4 o1, o2;
#pragma unroll
                        for (int i = 0; i < 4; ++i) { float c, s; rope_cs_e(pos, 4 * fq + i, c, s); o1[i] = x1[i] * c - x2[i] * s; o2[i] = x2[i] * c + x1[i] * s; }
                        *(f32x4*)(ko + 4 * fq) = o1; *(f32x4*)(ko + 16 + 4 * fq) = o2;
                        u32x2 w1, w2; w1.x = cvt_pk_bf16(o1[0], o1[1]); w1.y = cvt_pk_bf16(o1[2], o1[3]); w2.x = cvt_pk_bf16(o2[0], o2[1]); w2.y = cvt_pk_bf16(o2[2], o2[3]);
                        *(u32x2*)(kb + 4 * fq) = w1; *(u32x2*)(kb + 16 + 4 * fq) = w2; } }
            }
    }
};
struct EpiQ {
    static constexpr bool PERM = false, AFTER_DRAIN = false;
    bf16_t* Qb; const float* SSQ; float qscale; int sample;
    __device__ __forceinline__ void operator()(const f32x4 (&acc)[2][2][4][2], const Unit& u, int wr, int wc, int fr, int fq) const {
        const int pn = u.pn;
#pragma unroll
        for (int ai = 0; ai < 2; ++ai)
#pragma unroll
            for (int m = 0; m < 4; ++m) { const int row = u.pm * BM + ai * HALF + wr * 64 + m * 16 + fr;
                const f32x4 sq = *(const f32x4*)(SSQ + (size_t)row * 8);
                const float sc = qscale * __builtin_amdgcn_rsqf(((sq[0] + sq[1]) + (sq[2] + sq[3])) * (1.0f / 256.0f) + 1e-6f);
                if (pn < 4) {
#pragma unroll
                    for (int bj = 0; bj < 2; ++bj) { bf16_t* dst = Qb + ((size_t)row * 8 + 2 * pn + bj) * 160 + wc * 32 + 4 * fq;
#pragma unroll
                        for (int n = 0; n < 2; ++n) { const f32x4 v = acc[ai][bj][m][n] * sc; u32x2 w; w.x = cvt_pk_bf16(v[0], v[1]); w.y = cvt_pk_bf16(v[2], v[3]); *(u32x2*)(dst + n * 16) = w; } } }
                else { const int pos = sample ? 16384 + (row & 7) : (row & 8191);
                    float cs[4], sn[4];
#pragma unroll
                    for (int i = 0; i < 4; ++i) rope_cs_e(pos, 4 * fq + i, cs[i], sn[i]);
#pragma unroll
                    for (int bj = 0; bj < 2; ++bj) { bf16_t* dst = Qb + ((size_t)row * 8 + 4 * bj + wc) * 160 + 128 + 4 * fq;
                        const f32x4 x1 = acc[ai][bj][m][0] * sc, x2 = acc[ai][bj][m][1] * sc; f32x4 o1, o2;
#pragma unroll
                        for (int i = 0; i < 4; ++i) { o1[i] = x1[i] * cs[i] - x2[i] * sn[i]; o2[i] = x2[i] * cs[i] + x1[i] * sn[i]; }
                        u32x2 w1, w2; w1.x = cvt_pk_bf16(o1[0], o1[1]); w1.y = cvt_pk_bf16(o1[2], o1[3]); w2.x = cvt_pk_bf16(o2[0], o2[1]); w2.y = cvt_pk_bf16(o2[2], o2[3]);
                        *(u32x2*)dst = w1; *(u32x2*)(dst + 16) = w2; } }
            }
    }
};
struct EpiQP {
    static constexpr bool PERM = false, AFTER_DRAIN = false;
    bf16_t* Qb; const float* SSQ; float qscale; int pad;
    __device__ __forceinline__ void operator()(const f32x4 (&acc)[2][2][4][2], const Unit& u, int wr, int wc, int fr, int fq) const {
        const int pn = u.pn;
#pragma unroll
        for (int ai = 0; ai < 2; ++ai)
#pragma unroll
            for (int m = 0; m < 4; ++m) { const int row = u.pm * BM + ai * HALF + wr * 64 + m * 16 + fr;
                const f32x4 sq = *(const f32x4*)(SSQ + (size_t)row * 8);
                const float sc = qscale * __builtin_amdgcn_rsqf(((sq[0] + sq[1]) + (sq[2] + sq[3])) * (1.0f / 256.0f) + 1e-6f);
                if (pn < 2) {
#pragma unroll
                    for (int bj = 0; bj < 2; ++bj) { bf16_t* dst = Qb + ((size_t)row * 8 + 4 * pn + 2 * bj + (wc >> 1)) * 96 + 32 * (wc & 1) + 4 * fq;
#pragma unroll
                        for (int n = 0; n < 2; ++n) { const f32x4 v = acc[ai][bj][m][n] * sc; u32x2 w; w.x = cvt_pk_bf16(v[0], v[1]); w.y = cvt_pk_bf16(v[2], v[3]); *(u32x2*)(dst + n * 16) = w; } } }
                else { const int pos = row & 8191;
                    float cs[4], sn[4];
#pragma unroll
                    for (int i = 0; i < 4; ++i) rope_cs_e(pos, 4 * fq + i, cs[i], sn[i]);
#pragma unroll
                    for (int bj = 0; bj < 2; ++bj) { bf16_t* dst = Qb + ((size_t)row * 8 + 4 * bj + wc) * 96 + 64 + 4 * fq;
                        const f32x4 x1 = acc[ai][bj][m][0] * sc, x2 = acc[ai][bj][m][1] * sc; f32x4 o1, o2;
#pragma unroll
                        for (int i = 0; i < 4; ++i) { o1[i] = x1[i] * cs[i] - x2[i] * sn[i]; o2[i] = x2[i] * cs[i] + x1[i] * sn[i]; }
                        u32x2 w1, w2; w1.x = cvt_pk_bf16(o1[0], o1[1]); w1.y = cvt_pk_bf16(o1[2], o1[3]); w2.x = cvt_pk_bf16(o2[0], o2[1]); w2.y = cvt_pk_bf16(o2[2], o2[3]);
                        *(u32x2*)dst = w1; *(u32x2*)(dst + 16) = w2; } }
            }
    }
};
struct EpiKV {
    static constexpr bool PERM = false, AFTER_DRAIN = false;
    bf16_t* KVH; const float* SSQ; const bf16_t* KC;
    __device__ __forceinline__ void operator()(const f32x4 (&acc)[2][2][4][2], const Unit& u, int wr, int wc, int fr, int fq) const {
#pragma unroll
        for (int ai = 0; ai < 2; ++ai)
#pragma unroll
            for (int m = 0; m < 4; ++m) { const int row = u.pm * BM + ai * HALF + wr * 64 + m * 16 + fr; const int b = row >> 13, t = row & 8191;
                const f32x4 sq = *(const f32x4*)(SSQ + (size_t)row * 8 + 4);
                const float sc = __builtin_amdgcn_rsqf(((sq[0] + sq[1]) + (sq[2] + sq[3])) * (1.0f / 128.0f) + 1e-6f);
#pragma unroll
                for (int bj = 0; bj < 2; ++bj) { bf16_t* dst = KVH + (((size_t)b * 8 + 2 * u.pn + bj) * 8192 + t) * 160;
#pragma unroll
                    for (int n = 0; n < 2; ++n) { const f32x4 v = acc[ai][bj][m][n] * sc; u32x2 w; w.x = cvt_pk_bf16(v[0], v[1]); w.y = cvt_pk_bf16(v[2], v[3]); *(u32x2*)(dst + wc * 32 + 4 * fq + n * 16) = w; }
                    if (wc == 0) *(u32x4*)(dst + 128 + 8 * fq) = *(const u32x4*)(KC + (size_t)row * 160 + 128 + 8 * fq); }
            }
    }
};
}
#define GAS __attribute__((address_space(1)))
#define LAS __attribute__((address_space(3)))
typedef unsigned short bf16;
typedef unsigned v4u __attribute__((ext_vector_type(4)));
typedef float f32x4 __attribute__((ext_vector_type(4)));
typedef short bf16x8 __attribute__((ext_vector_type(8)));
typedef GAS unsigned gu32;
typedef GAS unsigned long long gu64;
#define RLX_AGENT __ATOMIC_RELAXED, __HIP_MEMORY_SCOPE_AGENT
#define LDS_WAIT() asm volatile("s_waitcnt lgkmcnt(0)" ::: "memory")
#define VM_WAIT() asm volatile("s_waitcnt vmcnt(0)" ::: "memory")
__device__ __forceinline__ unsigned long long rt() { return __builtin_amdgcn_s_memrealtime(); }
__device__ __forceinline__ unsigned f2bf(float f) { unsigned u = __builtin_bit_cast(unsigned, f); return (u + 0x7fffu + ((u >> 16) & 1u)) >> 16; }
__device__ __forceinline__ unsigned pk2(float lo, float hi) { return f2bf(lo) | (f2bf(hi) << 16); }

#define XB_TMO      128
#define XB_XCNT(j)  (256  + 64 * (j))
#define XB_XSUB(j)  (1280 + 64 * (j))
#define XB_XGEN(j)  (2304 + 64 * (j))
#define XB_TOP      3328
#define XB_TOPGEN   3392
#define XCD_BAR_WORDS 3456
#define XB_SPIN_CAP (1u << 18)

__device__ __forceinline__ unsigned xb_ld(unsigned* p)              { return __hip_atomic_load(p, __ATOMIC_RELAXED, __HIP_MEMORY_SCOPE_AGENT); }
__device__ __forceinline__ unsigned xb_add(unsigned* p, unsigned v) { return __hip_atomic_fetch_add(p, v, __ATOMIC_RELAXED, __HIP_MEMORY_SCOPE_AGENT); }
__device__ __forceinline__ unsigned xb_xcc_id() { return (unsigned)__builtin_amdgcn_s_getreg((3 << 11) | 20) & 0xFu; }
#define XB_SPIN(cond, bar) do { unsigned _sp = 0; while (cond) { __builtin_amdgcn_s_sleep(1); \
    if ((++_sp & 255u) == 0u) { if (xb_ld(&(bar)[XB_TMO])) break; if (_sp > XB_SPIN_CAP) { atomicAdd(&(bar)[XB_TMO], 1u); break; } } } } while (0)

struct XcdBarrier {
    unsigned* bar; unsigned x;
    volatile LAS unsigned* st;
};

__device__ __forceinline__ XcdBarrier xcd_barrier_post(unsigned* bar, volatile LAS unsigned* st) {
    XcdBarrier b; b.bar = bar; b.x = xb_xcc_id(); b.st = st;
    if (threadIdx.x == 0) (void)xb_add(&bar[XB_XCNT(b.x)], 1u);
    return b;
}
__device__ __forceinline__ void xcd_barrier_complete(unsigned* bar, unsigned x, unsigned& nloc, unsigned& nx) {
    const unsigned G = gridDim.x * gridDim.y * gridDim.z;
    unsigned sum, cnt, mine, sp = 0u;
    for (;;) {
        sum = 0u; cnt = 0u; mine = 0u;
#pragma unroll
        for (unsigned j = 0; j < 16; ++j) { const unsigned c = xb_ld(&bar[XB_XCNT(j)]); sum += c; cnt += (c > 0u) ? 1u : 0u; mine = (j == x) ? c : mine; }
        if (sum == G) break;
        __builtin_amdgcn_s_sleep(1);
        if ((++sp & 255u) == 0u) { if (xb_ld(&bar[XB_TMO])) break; if (sp > XB_SPIN_CAP) { atomicAdd(&bar[XB_TMO], 1u); break; } }
    }
    nloc = mine > 0u ? mine : 1u; nx = cnt > 0u ? cnt : 1u;
}

__device__ __forceinline__ void xcd_barrier(const XcdBarrier& b) {
    asm volatile("s_waitcnt vmcnt(0)" ::: "memory");
    __syncthreads();
    if (threadIdx.x == 0) {
        unsigned* bar = b.bar;
        __builtin_amdgcn_s_waitcnt(0);
        unsigned nloc = b.st[0], nx = b.st[1];
        if (nloc == 0u) { xcd_barrier_complete(bar, b.x, nloc, nx); b.st[0] = nloc; b.st[1] = nx; }
        const unsigned old = xb_add(&bar[XB_XSUB(b.x)], 1u);
        const unsigned gen = old / nloc;
        if (old + 1u == (gen + 1u) * nloc) {
            __builtin_amdgcn_fence(__ATOMIC_RELEASE, "agent");
            asm volatile("s_waitcnt vmcnt(0)" ::: "memory");
            const unsigned og = xb_add(&bar[XB_TOP], 1u);
            const unsigned tg = og / nx;
            if (og + 1u == (tg + 1u) * nx) xb_add(&bar[XB_TOPGEN], 1u);
            else XB_SPIN(xb_ld(&bar[XB_TOPGEN]) == tg, bar);
            __builtin_amdgcn_fence(__ATOMIC_ACQUIRE, "agent");
            xb_add(&bar[XB_XGEN(b.x)], 1u);
            asm volatile("s_waitcnt vmcnt(0)" ::: "memory");
        } else {
            XB_SPIN(xb_ld(&bar[XB_XGEN(b.x)]) == gen, bar);
            __builtin_amdgcn_fence(__ATOMIC_ACQUIRE, "agent");
            asm volatile("s_waitcnt vmcnt(0)" ::: "memory");
        }
    }
    __syncthreads();
}
__device__ __forceinline__ float wave_sum(float v) {
#pragma unroll
    for (int o = 1; o < 64; o <<= 1) v += __shfl_xor(v, o);
    return v;
}
__device__ __forceinline__ float sigmoidf_(float x) { return 1.0f / (1.0f + __expf(-x)); }
__device__ __forceinline__ float gelu_tanh(float x) { const float y = 0.7978845608028654f * (x + 0.044715f * x * x * x); return x * sigmoidf_(2.0f * y); }
__device__ __forceinline__ void rope_cs(int pos, int i, float& c, float& s) {
    const float ang = (float)pos * ROPE_FREQ[i];
    const double q4 = (double)ang * 0.6366197723675814;
    const double qr = rint(q4);
    const float r = (float)((q4 - qr) * 1.5707963267948966);
    const int qi = ((int)qr) & 3;
    const float r2 = r * r;
    const float sn = r * (1.0f + r2 * (-1.6666667e-1f + r2 * (8.3333333e-3f + r2 * (-1.9841270e-4f + r2 * 2.7557319e-6f))));
    const float cs = 1.0f + r2 * (-0.5f + r2 * (4.1666667e-2f + r2 * (-1.3888889e-3f + r2 * (2.4801587e-5f + r2 * -2.7557319e-7f))));
    c = (qi == 0) ? cs : (qi == 1) ? -sn : (qi == 2) ? -cs : sn;
    s = (qi == 0) ? sn : (qi == 1) ? cs : (qi == 2) ? -sn : -cs;
}
constexpr float QSCALE = 0.10206207261596577f * 1.4426950408889634f;
namespace att {
#define ATT_LAS __attribute__((address_space(3)))
typedef short bf16x8 __attribute__((ext_vector_type(8)));
typedef float f32x16 __attribute__((ext_vector_type(16)));
typedef short s16x4 __attribute__((ext_vector_type(4)));
typedef short v4i16_t __attribute__((ext_vector_type(4)));
typedef unsigned u32x4 __attribute__((ext_vector_type(4)));
typedef float f32x2_t __attribute__((ext_vector_type(2)));
typedef __bf16 bf16x2_t __attribute__((ext_vector_type(2)));
typedef ATT_LAS unsigned char* ldsp;
#define ATT_MFMA(a, b, c) __builtin_amdgcn_mfma_f32_32x32x16_bf16((a), (b), (c), 0, 0, 0)
__device__ __forceinline__ int crow(int r, int hi) { return (r & 3) + 8 * (r >> 2) + 4 * hi; }
__device__ __forceinline__ unsigned cvtpk(float lo, float hi) { f32x2_t v = {lo, hi}; bf16x2_t b = __builtin_convertvector(v, bf16x2_t); return __builtin_bit_cast(unsigned, b); }
__device__ __forceinline__ unsigned offL(unsigned row, unsigned ch) { return 256u * row + 16u * (ch ^ (((row & 3u) << 2) | ((row >> 2) & 3u))); }
__device__ __forceinline__ unsigned offR(unsigned row, unsigned ch) { return 64u * row + 16u * (ch ^ ((row >> 2) & 3u)); }
__device__ __forceinline__ bf16x8 lds_b128(ldsp p) { return *(const ATT_LAS bf16x8*)p; }
__device__ __forceinline__ s16x4 lds_tr(ldsp p) { return __builtin_bit_cast(s16x4, __builtin_amdgcn_ds_read_tr16_b64_v4i16((ATT_LAS v4i16_t*)p)); }
__device__ __forceinline__ float swapmax(float m) { auto rr = __builtin_amdgcn_permlane32_swap(__float_as_uint(m), __float_as_uint(m), false, false); return fmaxf(__uint_as_float(rr[0]), __uint_as_float(rr[1])); }
__device__ __forceinline__ float swapsum(float m) { auto rr = __builtin_amdgcn_permlane32_swap(__float_as_uint(m), __float_as_uint(m), false, false); return __uint_as_float(rr[0]) + __uint_as_float(rr[1]); }

constexpr int TILE_LAT = 64 * 256, TILE_ROPE = 64 * 64, TILE_BYTES = TILE_LAT + TILE_ROPE;
constexpr float THR = 8.0f;

__device__ __forceinline__ void softmax_step(f32x16& s0, f32x16& s1, float& m, float& l, f32x16 (&o)[4], bool first) {
    float rm = fmaxf(s0[0], s1[0]);
#pragma unroll
    for (int r = 1; r < 16; ++r) rm = fmaxf(rm, fmaxf(s0[r], s1[r]));
    rm = swapmax(rm);
    if (first) m = rm;
    rm -= m;
    if (!first && __any(rm > THR)) {
        const float dl = fmaxf(rm, 0.f);
        m += dl;
        const float f = __builtin_amdgcn_exp2f(-dl); l *= f;
#pragma unroll
        for (int c = 0; c < 4; ++c)
#pragma unroll
            for (int r = 0; r < 16; ++r) o[c][r] *= f;
    }
    float sum = 0.f;
#pragma unroll
    for (int r = 0; r < 16; ++r) { s0[r] = __builtin_amdgcn_exp2f(s0[r] - m); s1[r] = __builtin_amdgcn_exp2f(s1[r] - m); sum += s0[r] + s1[r]; }
    l += sum;
}

__device__ __forceinline__ void stage_load(u32x4 (&st)[3], const bf16* __restrict__ tilep, int tid) {
    const bf16* pl = tilep + (size_t)(tid >> 4) * QD + (tid & 15) * 8;
    st[0] = *(const u32x4*)pl; st[1] = *(const u32x4*)(pl + 32 * QD);
    if (tid < 256) st[2] = *(const u32x4*)(tilep + (size_t)(tid >> 2) * QD + KVL + (tid & 3) * 8);
}
__device__ __forceinline__ void stage_store(const u32x4 (&st)[3], ldsp tile, unsigned dl, unsigned dr, int tid) {
    *(ATT_LAS u32x4*)(tile + dl) = st[0]; *(ATT_LAS u32x4*)(tile + dl + 8192) = st[1];
    if (tid < 256) *(ATT_LAS u32x4*)(tile + TILE_LAT + dr) = st[2];
}
constexpr int PR_Q = 3 * TILE_BYTES, PR_QW = 32 * 256 + 32 * 64;
constexpr int PR_LDS_END = PR_Q + 8 * PR_QW;
__device__ __forceinline__ void softmax_step2(f32x16& s0, f32x16& s1, float& m, float& l, f32x16 (&o)[2], bool first) {
    float rm = fmaxf(s0[0], s1[0]);
#pragma unroll
    for (int r = 1; r < 16; ++r) rm = fmaxf(rm, fmaxf(s0[r], s1[r]));
    rm = swapmax(rm);
    if (first) m = rm;
    rm -= m;
    if (!first && __any(rm > THR)) {
        const float dl = fmaxf(rm, 0.f);
        m += dl;
        const float f = __builtin_amdgcn_exp2f(-dl); l *= f;
#pragma unroll
        for (int c = 0; c < 2; ++c)
#pragma unroll
            for (int r = 0; r < 16; ++r) o[c][r] *= f;
    }
    float sum = 0.f;
#pragma unroll
    for (int r = 0; r < 16; ++r) { s0[r] = __builtin_amdgcn_exp2f(s0[r] - m); s1[r] = __builtin_amdgcn_exp2f(s1[r] - m); sum += s0[r] + s1[r]; }
    l += sum;
}
__device__ __forceinline__ void prompt_unit(ldsp lds, const bf16* __restrict__ QbP, const bf16* __restrict__ KVH, float* __restrict__ SSQM, bf16* __restrict__ YC, int b, int h, int qb) {
    const int tid = threadIdx.x, lane = tid & 63, wid = __builtin_amdgcn_readfirstlane(tid >> 6), r32 = lane & 31, hi = lane >> 5;
    const int tq0 = 256 * qb + 32 * wid; const size_t row0 = (size_t)b * SEQ + tq0;
    const bf16* KVseq = KVH + ((size_t)(b * NH + h) * SEQ) * QD;
    const int ntile_u = 4 * qb + 4, ntile_w = 4 * qb + (wid >> 1) + 1;
    const unsigned lsrc = (unsigned)(4 * wid + (lane >> 4)) * (QD * 2) + 16u * ((unsigned)(lane & 15) ^ ((((unsigned)(lane >> 4) & 3u) << 2) | ((unsigned)wid & 3u)));
    const unsigned rsrc = (unsigned)(16 * wid + (lane >> 2)) * (QD * 2) + 2 * KVL + 16u * ((unsigned)(lane & 3) ^ ((unsigned)(lane >> 4) & 3u));
#define PR_GLDS(gptr, ldsaddr) do { unsigned keep_; asm volatile("s_mov_b32 %0, m0\n\ts_mov_b32 m0, %2\n\ts_nop 0\n\tglobal_load_lds_dwordx4 %1, off\n\ts_mov_b32 m0, %0" : "=&s"(keep_) : "v"(gptr), "s"(ldsaddr) : "memory"); } while (0)
#ifdef PR_SYNC_STAGE
#define PR_DMA(gtile, slot) do { const char* g_ = (const char*)(gtile); ldsp d_ = lds + (slot) + wid * 1024 + 16 * lane; \
        *(ATT_LAS u32x4*)(d_) = *(const u32x4*)(g_ + lsrc); *(ATT_LAS u32x4*)(d_ + 8192) = *(const u32x4*)(g_ + lsrc + 32 * QD * 2); \
        if (wid < 4) *(ATT_LAS u32x4*)(d_ + TILE_LAT) = *(const u32x4*)(g_ + rsrc); } while (0)
#else
#define PR_DMA(gtile, slot) do { const char* g_ = (const char*)(gtile); const unsigned l_ = (unsigned)__builtin_amdgcn_readfirstlane((int)(lds0 + (unsigned)(slot) + (unsigned)wid * 1024u)); \
        PR_GLDS(g_ + lsrc, l_); PR_GLDS(g_ + lsrc + 32 * QD * 2, l_ + 8192u); \
        if (wid < 4) PR_GLDS(g_ + rsrc, l_ + (unsigned)TILE_LAT); } while (0)
#endif
    const unsigned lds0 = (unsigned)(size_t)lds;
    PR_DMA(KVseq, 0);
    ldsp qimg = lds + PR_Q + wid * PR_QW;
    { const bf16* qp = QbP + ((row0 + r32) * NH + h) * 96 + 8 * hi;
#pragma unroll
      for (int s = 0; s < 4; ++s) *(ATT_LAS bf16x8*)(qimg + offL((unsigned)r32, (unsigned)(2 * s + hi))) = *(const bf16x8*)(qp + 16 * s);
#pragma unroll
      for (int s = 0; s < 2; ++s) *(ATT_LAS bf16x8*)(qimg + 32 * 256 + offR((unsigned)r32, (unsigned)(2 * s + hi))) = *(const bf16x8*)(qp + 64 + 16 * s); }
    PR_DMA(KVseq + (size_t)64 * QD, TILE_BYTES);
    asm volatile("s_waitcnt vmcnt(0) lgkmcnt(0)" ::: "memory");
    __syncthreads();
    float m = 0.f, l = 0.f; f32x16 o[2];
#pragma unroll
    for (int r = 0; r < 16; ++r) { o[0][r] = 0.f; o[1][r] = 0.f; }
    const unsigned xk = (unsigned)(((r32 & 3) << 1) | ((r32 >> 3) & 1));
    const unsigned ka = 256u * (unsigned)r32 + 16u * ((unsigned)hi ^ ((unsigned)(r32 >> 2) & 1u));
    const unsigned kr0 = TILE_LAT + offR((unsigned)r32, (unsigned)hi), kr1 = TILE_LAT + offR((unsigned)r32, 2u + (unsigned)hi);
    const unsigned blk = (lane >> 4) & 1, qq = (lane & 15) >> 2, pp = lane & 3;
    const unsigned vb0 = 256u * (unsigned)(4 * hi + qq) + 16u * ((2u * blk + (pp >> 1)) ^ (unsigned)hi) + 8u * (pp & 1u);
    const unsigned vb1 = 256u * (unsigned)(8 + 4 * hi + qq) + 16u * ((2u * blk + (pp >> 1)) ^ (2u + (unsigned)hi)) + 8u * (pp & 1u);
#define PR_QK(S0, S1, tile) do { unsigned xko = xk; asm volatile("" : "+v"(xko)); \
        _Pragma("unroll") for (int r = 0; r < 16; ++r) { S0[r] = 0.f; S1[r] = 0.f; } \
        _Pragma("unroll") for (int k = 0; k < 4; ++k) { const unsigned a_ = ka + 32u * ((unsigned)k ^ xko); const bf16x8 q_ = lds_b128(qimg + a_); \
            S0 = ATT_MFMA(lds_b128((tile) + a_), q_, S0); S1 = ATT_MFMA(lds_b128((tile) + a_ + 8192), q_, S1); } \
        { const bf16x8 q_ = lds_b128(qimg + 32 * 256 + (kr0 - TILE_LAT)); S0 = ATT_MFMA(lds_b128((tile) + kr0), q_, S0); S1 = ATT_MFMA(lds_b128((tile) + kr0 + 2048), q_, S1); } \
        { const bf16x8 q_ = lds_b128(qimg + 32 * 256 + (kr1 - TILE_LAT)); S0 = ATT_MFMA(lds_b128((tile) + kr1), q_, S0); S1 = ATT_MFMA(lds_b128((tile) + kr1 + 2048), q_, S1); } } while (0)
#define PR_STEP(A0, A1, B0, B1, kt) do { \
        ldsp tcur = lds + cur; \
        if ((kt) + 2 < ntile_u) PR_DMA(KVseq + (size_t)((kt) + 2) * 64 * QD, nn); \
        if ((kt) + 1 < ntile_w) PR_QK(B0, B1, lds + nxt); \
        if ((kt) < ntile_w) { \
          if ((kt) == ntile_w - 1) { const int tok = tq0 + r32, kb = (kt) * 64; \
            _Pragma("unroll") for (int r = 0; r < 16; ++r) { const int key = kb + crow(r, hi); if (key > tok) A0[r] = -INFINITY; if (key + 32 > tok) A1[r] = -INFINITY; } } \
          softmax_step2(A0, A1, m, l, o, (kt) == 0); \
          unsigned qqo = qq; asm volatile("" : "+v"(qqo)); \
          _Pragma("unroll") for (int ks = 0; ks < 4; ++ks) { \
            const f32x16& pv = (ks < 2) ? A0 : A1; const int bb = 8 * (ks & 1); \
            u32x4 pw; pw.x = cvtpk(pv[bb + 0], pv[bb + 1]); pw.y = cvtpk(pv[bb + 2], pv[bb + 3]); pw.z = cvtpk(pv[bb + 4], pv[bb + 5]); pw.w = cvtpk(pv[bb + 6], pv[bb + 7]); \
            const bf16x8 pf = __builtin_bit_cast(bf16x8, pw); \
            _Pragma("unroll") for (int c = 2; c < 4; ++c) { const unsigned co = 64u * ((unsigned)c ^ qqo); \
                const s16x4 lo = lds_tr(tcur + vb0 + co + 4096 * ks), hv = lds_tr(tcur + vb1 + co + 4096 * ks); \
                const bf16x8 vf = {lo[0], lo[1], lo[2], lo[3], hv[0], hv[1], hv[2], hv[3]}; \
                o[c - 2] = ATT_MFMA(vf, pf, o[c - 2]); } } } \
        asm volatile("s_waitcnt vmcnt(0)" ::: "memory"); \
        __syncthreads(); \
        { const int t_ = cur; cur = nxt; nxt = nn; nn = t_; } } while (0)
    int cur = 0, nxt = TILE_BYTES, nn = 2 * TILE_BYTES;
    f32x16 sa0, sa1, sb0, sb1;
    PR_QK(sa0, sa1, lds);
    for (int kt = 0; kt < ntile_u; kt += 2) { PR_STEP(sa0, sa1, sb0, sb1, kt); PR_STEP(sb0, sb1, sa0, sa1, kt + 1); }
#undef PR_STEP
#undef PR_QK
#undef PR_DMA
#undef PR_GLDS
    l = swapsum(l);
    const float rl = 1.0f / l;
    float ss = 0.f;
#pragma unroll
    for (int c = 0; c < 2; ++c)
#pragma unroll
        for (int r = 0; r < 16; ++r) { o[c][r] *= rl; ss += o[c][r] * o[c][r]; }
    ss = swapsum(ss);
    if (hi == 0) SSQM[(row0 + r32) * NH + h] = ss;
    bf16* yp = YC + (row0 + r32) * DMIX + DLRU + h * VD + 4 * hi;
#pragma unroll
    for (int c = 0; c < 2; ++c)
#pragma unroll
        for (int g = 0; g < 4; ++g) { typedef unsigned u32x2 __attribute__((ext_vector_type(2)));
            u32x2 w; w.x = cvtpk(o[c][4 * g], o[c][4 * g + 1]); w.y = cvtpk(o[c][4 * g + 2], o[c][4 * g + 3]); *(u32x2*)(yp + 32 * c + 8 * g) = w; }
    __syncthreads();
}
}
namespace att {
constexpr int PG_LAT = 128 * 256, PG_ROPE = 128 * 64, PG_BYTES = PG_LAT + PG_ROPE;
constexpr int PART_ROWS = 66, PART_FLOATS = PART_ROWS * 64;

__device__ __forceinline__ void page_load(f32x4 (&st)[10], const float* __restrict__ ckv, const float* __restrict__ ckr, size_t slot0, int tid) {
    const f32x4* pl = (const f32x4*)(ckv + slot0 * KVL) + tid; const f32x4* pr = (const f32x4*)(ckr + slot0 * ROPE) + tid;
#pragma unroll
    for (int i = 0; i < 8; ++i) st[i] = __builtin_nontemporal_load(pl + 512 * i);
#pragma unroll
    for (int i = 0; i < 2; ++i) st[8 + i] = __builtin_nontemporal_load(pr + 512 * i);
}
__device__ __forceinline__ void page_store(const f32x4 (&st)[10], ldsp pg, unsigned dl, unsigned dr) {
    typedef unsigned u32x2 __attribute__((ext_vector_type(2)));
#pragma unroll
    for (int i = 0; i < 8; ++i) { u32x2 w; w.x = cvtpk(st[i].x, st[i].y); w.y = cvtpk(st[i].z, st[i].w); *(ATT_LAS u32x2*)(pg + dl + 4096 * i) = w; }
#pragma unroll
    for (int i = 0; i < 2; ++i) { u32x2 w; w.x = cvtpk(st[8 + i].x, st[8 + i].y); w.y = cvtpk(st[8 + i].z, st[8 + i].w); *(ATT_LAS u32x2*)(pg + PG_LAT + dr + 4096 * i) = w; }
}
constexpr int Q_OFF = 2 * PG_BYTES;
__device__ __forceinline__ void decode_item(ldsp lds, const bf16* __restrict__ Qb, const float* __restrict__ ckv, const float* __restrict__ ckr, const int* __restrict__ ptab,
                                            float* __restrict__ PART, int db, int pg0, int npg) {
    const int tid = threadIdx.x, lane = tid & 63, wid = __builtin_amdgcn_readfirstlane(tid >> 6), r32 = lane & 31, hi = lane >> 5;
    const int qb = wid & 1, rb = 64 * (wid >> 2) + 32 * ((wid >> 1) & 1), grp = wid >> 1;
    const int* pt = ptab + db * NPAGES + pg0;
    unsigned dl, dr;
    { const unsigned row = (unsigned)tid >> 5, c4 = (unsigned)tid & 31u; dl = offL(row, c4 >> 1) + 8u * (c4 & 1u);
      const unsigned rr = (unsigned)tid >> 3, c4r = (unsigned)tid & 7u; dr = offR(rr, c4r >> 1) + 8u * (c4r & 1u); }
    f32x4 sa[10], sb[10];
    page_load(sa, ckv, ckr, (size_t)pt[0] * PAGE, tid);
    if (npg > 1) page_load(sb, ckv, ckr, (size_t)pt[1] * PAGE, tid);
    {
      const bf16* qsrc = Qb + ((size_t)RP + (size_t)db * DS) * NH * QD;
      const u32x4 q0 = *(const u32x4*)(qsrc + (size_t)(tid >> 4) * QD + (tid & 15) * 8), q1 = *(const u32x4*)(qsrc + (size_t)((tid >> 4) + 32) * QD + (tid & 15) * 8);
      const unsigned dq = offL((unsigned)tid >> 4, (unsigned)tid & 15u);
      *(ATT_LAS u32x4*)(lds + Q_OFF + dq) = q0; *(ATT_LAS u32x4*)(lds + Q_OFF + dq + 8192) = q1;
      if (tid < 256) { const u32x4 q2 = *(const u32x4*)(qsrc + (size_t)(tid >> 2) * QD + KVL + (tid & 3) * 8); *(ATT_LAS u32x4*)(lds + Q_OFF + TILE_LAT + offR((unsigned)tid >> 2, (unsigned)tid & 3u)) = q2; } }
    page_store(sa, lds, dl, dr);
    __syncthreads();
    float m = 0.f, l = 0.f; f32x16 o[4];
#pragma unroll
    for (int r = 0; r < 16; ++r) { o[0][r] = 0.f; o[1][r] = 0.f; o[2][r] = 0.f; o[3][r] = 0.f; }
    const unsigned xk = (unsigned)(((r32 & 3) << 1) | ((r32 >> 3) & 1));
    const unsigned x0 = (unsigned)hi ^ ((unsigned)(r32 >> 2) & 1u);
    const unsigned ka = 256u * (unsigned)(rb + r32) + 16u * x0, qa = Q_OFF + 256u * (unsigned)(32 * qb + r32) + 16u * x0;
    const unsigned kr0 = PG_LAT + offR((unsigned)(rb + r32), (unsigned)hi), kr1 = PG_LAT + offR((unsigned)(rb + r32), 2u + (unsigned)hi);
    const unsigned qr0 = Q_OFF + TILE_LAT + offR((unsigned)(32 * qb + r32), (unsigned)hi), qr1 = Q_OFF + TILE_LAT + offR((unsigned)(32 * qb + r32), 2u + (unsigned)hi);
    const unsigned blk = (lane >> 4) & 1, qq = (lane & 15) >> 2, pp = lane & 3;
    const unsigned vb0 = 256u * (unsigned)(rb + 4 * hi + qq) + 16u * ((2u * blk + (pp >> 1)) ^ (unsigned)hi) + 8u * (pp & 1u);
    const unsigned vb1 = 256u * (unsigned)(rb + 8 + 4 * hi + qq) + 16u * ((2u * blk + (pp >> 1)) ^ (2u + (unsigned)hi)) + 8u * (pp & 1u);
#define DEC_PAGE(pg, first) do { \
        unsigned xko = xk, qqo = qq; asm volatile("" : "+v"(xko), "+v"(qqo)); \
        f32x16 s; \
        _Pragma("unroll") for (int r = 0; r < 16; ++r) s[r] = 0.f; \
        _Pragma("unroll") for (int k = 0; k < 8; ++k) { const unsigned co = 32u * ((unsigned)k ^ xko); s = ATT_MFMA(lds_b128((pg) + ka + co), lds_b128(lds + qa + co), s); } \
        s = ATT_MFMA(lds_b128((pg) + kr0), lds_b128(lds + qr0), s); \
        s = ATT_MFMA(lds_b128((pg) + kr1), lds_b128(lds + qr1), s); \
        float rm = s[0]; \
        _Pragma("unroll") for (int r = 1; r < 16; ++r) rm = fmaxf(rm, s[r]); \
        rm = swapmax(rm); \
        if (first) m = rm; \
        rm -= m; \
        if (!(first) && __any(rm > THR)) { const float dlt = fmaxf(rm, 0.f); m += dlt; const float f = __builtin_amdgcn_exp2f(-dlt); l *= f; \
            _Pragma("unroll") for (int c = 0; c < 4; ++c) _Pragma("unroll") for (int r = 0; r < 16; ++r) o[c][r] *= f; } \
        float sum = 0.f; \
        _Pragma("unroll") for (int r = 0; r < 16; ++r) { s[r] = __builtin_amdgcn_exp2f(s[r] - m); sum += s[r]; } \
        l += sum; \
        _Pragma("unroll") for (int ks = 0; ks < 2; ++ks) { \
            u32x4 pw; pw.x = cvtpk(s[8 * ks + 0], s[8 * ks + 1]); pw.y = cvtpk(s[8 * ks + 2], s[8 * ks + 3]); pw.z = cvtpk(s[8 * ks + 4], s[8 * ks + 5]); pw.w = cvtpk(s[8 * ks + 6], s[8 * ks + 7]); \
            const bf16x8 pf = __builtin_bit_cast(bf16x8, pw); \
            _Pragma("unroll") for (int c = 0; c < 4; ++c) { const unsigned co = 64u * ((unsigned)c ^ qqo); \
                const s16x4 lo = lds_tr((pg) + vb0 + co + 4096 * ks), hv = lds_tr((pg) + vb1 + co + 4096 * ks); \
                const bf16x8 vf = {lo[0], lo[1], lo[2], lo[3], hv[0], hv[1], hv[2], hv[3]}; \
                o[c] = ATT_MFMA(vf, pf, o[c]); } } \
    } while (0)
    for (int pi = 0; pi < npg; pi += 2) {
        if (pi + 2 < npg) page_load(sa, ckv, ckr, (size_t)pt[pi + 2] * PAGE, tid);
        DEC_PAGE(lds, pi == 0);
        page_store(sb, lds + PG_BYTES, dl, dr);
        __syncthreads();
        if (pi + 3 < npg) page_load(sb, ckv, ckr, (size_t)pt[pi + 3] * PAGE, tid);
        DEC_PAGE(lds + PG_BYTES, false);
        if (pi + 2 < npg) page_store(sa, lds, dl, dr);
        __syncthreads();
    }
#undef DEC_PAGE
    ATT_LAS float* reg = (ATT_LAS float*)(lds) + qb * PART_FLOATS;
    for (int g = 0; g < 4; ++g) {
        if (grp == g) {
            if (g > 0) { const float m2 = reg[64 * 64 + lane], l2 = reg[65 * 64 + lane]; const float mn = fmaxf(m, m2); const float a1 = __builtin_amdgcn_exp2f(m - mn), a2 = __builtin_amdgcn_exp2f(m2 - mn);
#pragma unroll
                for (int c = 0; c < 4; ++c)
#pragma unroll
                    for (int r = 0; r < 16; ++r) o[c][r] = o[c][r] * a1 + reg[(c * 16 + r) * 64 + lane] * a2;
                l = l * a1 + l2 * a2; m = mn; }
            if (g < 3) {
#pragma unroll
                for (int c = 0; c < 4; ++c)
#pragma unroll
                    for (int r = 0; r < 16; ++r) reg[(c * 16 + r) * 64 + lane] = o[c][r];
                reg[64 * 64 + lane] = m; reg[65 * 64 + lane] = l; }
            else { float* gp = PART + (size_t)qb * PART_FLOATS;
#pragma unroll
                for (int c = 0; c < 4; ++c)
#pragma unroll
                    for (int r = 0; r < 16; ++r) gp[(c * 16 + r) * 64 + lane] = o[c][r];
                gp[64 * 64 + lane] = m; gp[65 * 64 + lane] = l; }
        }
        __syncthreads();
    }
}
__device__ __forceinline__ void decode_combine(ldsp lds, const bf16* __restrict__ Qb, const float* __restrict__ KN, const float* __restrict__ KR, const float* __restrict__ PARTdb, int ns,
                                               const float* __restrict__ w_uv, const float* __restrict__ gm, bf16* __restrict__ YC, int db) {
    const int tid = threadIdx.x, lane = tid & 63, wid = __builtin_amdgcn_readfirstlane(tid >> 6), qb = wid >> 2, rg = wid & 3, r32 = lane & 31, hi = lane >> 5;
    ATT_LAS float* sc = (ATT_LAS float*)lds;
    ATT_LAS float* ol = (ATT_LAS float*)(lds + 2048);
    ATT_LAS float* red = (ATT_LAS float*)(lds + 2048 + 32768);
    __syncthreads();
    { const int q = tid >> 3, sp = tid & 7;
      const bf16* qp = Qb + (((size_t)RP + (size_t)db * DS) * NH + q) * QD; const float* kn = KN + ((size_t)db * DS + sp) * KVL; const float* kr = KR + ((size_t)db * DS + sp) * ROPE;
      float a = 0.f; const u32x4* qv = (const u32x4*)qp;
#pragma unroll
      for (int part = 0; part < 3; ++part) { const int nq = part < 2 ? 8 : 4; const f32x4* kv = part < 2 ? (const f32x4*)kn + 16 * part : (const f32x4*)kr;
          u32x4 qq[8]; f32x4 kk[16];
#pragma unroll
          for (int j = 0; j < 8; ++j) if (j < nq) qq[j] = qv[8 * part + j];
#pragma unroll
          for (int j = 0; j < 16; ++j) if (j < 2 * nq) kk[j] = kv[j];
#pragma unroll
          for (int j = 0; j < 8; ++j) if (j < nq) { const f32x4 k0 = kk[2 * j], k1 = kk[2 * j + 1];
              a += __uint_as_float(qq[j].x << 16) * k0[0] + __uint_as_float(qq[j].x & 0xffff0000u) * k0[1] + __uint_as_float(qq[j].y << 16) * k0[2] + __uint_as_float(qq[j].y & 0xffff0000u) * k0[3]
                 + __uint_as_float(qq[j].z << 16) * k1[0] + __uint_as_float(qq[j].z & 0xffff0000u) * k1[1] + __uint_as_float(qq[j].w << 16) * k1[2] + __uint_as_float(qq[j].w & 0xffff0000u) * k1[3]; } }
      sc[q * 8 + sp] = a; }
    __syncthreads();
    const int q = 32 * qb + r32, stok = q >> 3, hq = q & 7;
    float M = -INFINITY;
    for (int i = 0; i < ns; ++i) M = fmaxf(M, PARTdb[((size_t)i * 2 + qb) * PART_FLOATS + 64 * 64 + lane]);
    for (int sp = 0; sp <= stok; ++sp) M = fmaxf(M, sc[q * 8 + sp]);
    float acc[16], lsum = 0.f;
#pragma unroll
    for (int r = 0; r < 16; ++r) acc[r] = 0.f;
    for (int i = 0; i < ns; ++i) { const float* pp = PARTdb + ((size_t)i * 2 + qb) * PART_FLOATS; const float f = __builtin_amdgcn_exp2f(pp[64 * 64 + lane] - M);
        lsum += f * pp[65 * 64 + lane];
#pragma unroll
        for (int r = 0; r < 16; ++r) acc[r] += f * pp[(rg * 16 + r) * 64 + lane]; }
    lsum += __shfl_xor(lsum, 32);
    for (int sp = 0; sp <= stok; ++sp) { const float p = __builtin_amdgcn_exp2f(sc[q * 8 + sp] - M); lsum += p; const float* kn = KN + ((size_t)db * DS + sp) * KVL;
#pragma unroll
        for (int r = 0; r < 16; ++r) acc[r] += p * kn[32 * rg + crow(r, hi)]; }
    const float rl = 1.0f / lsum;
#pragma unroll
    for (int r = 0; r < 16; ++r) ol[q * KVL + 32 * rg + crow(r, hi)] = acc[r] * rl;
    __syncthreads();
    float y[8];
#pragma unroll
    for (int s = 0; s < 8; ++s) y[s] = 0.f;
#pragma unroll 1
    for (int c0 = 0; c0 < KVL; c0 += 16) { float w[16];
#pragma unroll
        for (int j = 0; j < 16; ++j) w[j] = w_uv[((size_t)(c0 + j) * NH + wid) * VD + lane];
#pragma unroll
        for (int s = 0; s < 8; ++s) {
#pragma unroll
            for (int j4 = 0; j4 < 4; ++j4) { const f32x4 o4 = *(const ATT_LAS f32x4*)(ol + (s * 8 + wid) * KVL + c0 + 4 * j4);
                y[s] += (o4[0] * w[4 * j4] + o4[1] * w[4 * j4 + 1]) + (o4[2] * w[4 * j4 + 2] + o4[3] * w[4 * j4 + 3]); }
            __builtin_amdgcn_sched_barrier(0); } }
    (void)hq;
#pragma unroll
    for (int s = 0; s < 8; ++s) { float v = y[s] * y[s];
#pragma unroll
        for (int o = 1; o < 64; o <<= 1) v += __shfl_xor(v, o);
        if (lane == 0) red[wid * 8 + s] = v; }
    __syncthreads();
#pragma unroll
    for (int s = 0; s < 8; ++s) { float t = 0.f;
#pragma unroll
        for (int w = 0; w < 8; ++w) t += red[w * 8 + s];
        const float rstd = 1.0f / sqrtf(t * (1.0f / DMLA) + EPS);
        YC[((size_t)RP + (size_t)db * DS + s) * DMIX + DLRU + wid * VD + lane] = (bf16)f2bf(y[s] * rstd * gm[wid * VD + lane]); }
}
}
namespace att2 {
using att::bf16x8; using att::f32x16; using att::s16x4; using att::u32x4; using att::ldsp; using att::cvtpk; using att::crow; using att::offL; using att::offR; using att::lds_b128; using att::lds_tr;
using att::swapmax; using att::swapsum; using att::TILE_LAT; using att::TILE_BYTES; using att::THR; using att::PART_FLOATS;
typedef unsigned u32x2 __attribute__((ext_vector_type(2)));
constexpr int L_PT = 0, L_DT = 3 * TILE_BYTES, L_MG = L_DT + 2 * TILE_BYTES, L_BAR = L_MG + 2 * PART_FLOATS * 4 + 1024;
static_assert(L_BAR + 128 <= 146432, "attention LDS map");

__device__ __forceinline__ void role_bar(ATT_LAS unsigned* cnt, unsigned& target) {
    target += 4u;
    asm volatile("s_waitcnt lgkmcnt(0)" ::: "memory");
    if ((threadIdx.x & 63) == 0) (void)__hip_atomic_fetch_add(cnt, 1u, __ATOMIC_RELAXED, __HIP_MEMORY_SCOPE_WORKGROUP);
    while (__hip_atomic_load(cnt, __ATOMIC_RELAXED, __HIP_MEMORY_SCOPE_WORKGROUP) < target) __builtin_amdgcn_s_sleep(1);
    asm volatile("" ::: "memory");
}

typedef float f32x2 __attribute__((ext_vector_type(2)));
__device__ __forceinline__ float max3(float a, float b, float c) { float d; asm("v_max3_f32 %0, %1, %2, %3" : "=v"(d) : "v"(a), "v"(b), "v"(c)); return d; }
__device__ __forceinline__ void sm_max(const f32x16& s0, const f32x16& s1, float& m, float& l, f32x16 (&o)[2], bool first) {
    float r0 = max3(s0[0], s1[0], s0[1]), r1 = max3(s1[1], s0[2], s1[2]);
#pragma unroll
    for (int r = 3; r < 15; r += 2) { r0 = max3(r0, s0[r], s1[r]); r1 = max3(r1, s0[r + 1], s1[r + 1]); }
    float rm = swapmax(max3(r0, r1, fmaxf(s0[15], s1[15])));
    if (first) m = rm;
    rm -= m;
    if (!first && __any(rm > THR)) { const float dl = fmaxf(rm, 0.f); m += dl; const float f = __builtin_amdgcn_exp2f(-dl); l *= f;
#pragma unroll
        for (int c = 0; c < 2; ++c)
#pragma unroll
            for (int r = 0; r < 16; ++r) o[c][r] *= f; }
}
__device__ __forceinline__ void sm_fin(float rm, float& m, float& l, f32x16 (&o)[2], bool first) {
    rm = swapmax(rm);
    if (first) m = rm;
    rm -= m;
    if (!first && __any(rm > THR)) { const float dl = fmaxf(rm, 0.f); m += dl; const float f = __builtin_amdgcn_exp2f(-dl); l *= f;
#pragma unroll
        for (int c = 0; c < 2; ++c)
#pragma unroll
            for (int r = 0; r < 16; ++r) o[c][r] *= f; }
}
__device__ __forceinline__ void sm_exp(f32x16& s0, f32x16& s1, const float m, float& l) {
    float sum0 = 0.f, sum1 = 0.f;
#pragma unroll
    for (int r = 0; r < 16; ++r) { s0[r] = __builtin_amdgcn_exp2f(s0[r] - m); s1[r] = __builtin_amdgcn_exp2f(s1[r] - m); sum0 += s0[r]; sum1 += s1[r]; }
    l += sum0 + sum1;
}
__device__ __forceinline__ void prompt_role(ldsp lds, const bf16* __restrict__ QbP, const bf16* __restrict__ KVH, float* __restrict__ SSQM, bf16* __restrict__ YC, int b, int h, int qb, unsigned& bt) {
    const int t4 = threadIdx.x & 255, lane = t4 & 63, wid = __builtin_amdgcn_readfirstlane(t4 >> 6), r32 = lane & 31, hi = lane >> 5;
    ATT_LAS unsigned* cnt = (ATT_LAS unsigned*)(lds + L_BAR);
    const int tq0 = 256 * qb + 64 * wid; const size_t row0 = (size_t)b * SEQ + tq0;
    const bf16* KVseq = KVH + ((size_t)(b * NH + h) * SEQ) * QD;
    const int ntile_u = 4 * qb + 4, ntile_w = 4 * qb + wid + 1;
    const unsigned lsrc = (unsigned)(4 * wid + (lane >> 4)) * (QD * 2) + 16u * ((unsigned)(lane & 15) ^ ((((unsigned)(lane >> 4) & 3u) << 2) | ((unsigned)wid & 3u)));
    const unsigned rsrc = (unsigned)(16 * wid + (lane >> 2)) * (QD * 2) + 2 * KVL + 16u * ((unsigned)(lane & 3) ^ ((unsigned)(lane >> 4) & 3u));
    const unsigned lds0 = (unsigned)(size_t)lds + L_PT;
#define R_GLDS(gptr, ldsaddr) do { unsigned keep_; asm volatile("s_mov_b32 %0, m0\n\ts_mov_b32 m0, %2\n\ts_nop 0\n\tglobal_load_lds_dwordx4 %1, off\n\ts_mov_b32 m0, %0" : "=&s"(keep_) : "v"(gptr), "s"(ldsaddr) : "memory"); } while (0)
#define R_DMA(gtile, slot) do { const char* g_ = (const char*)(gtile); const unsigned l_ = (unsigned)__builtin_amdgcn_readfirstlane((int)(lds0 + (unsigned)(slot) + (unsigned)wid * 1024u)); \
        R_GLDS(g_ + lsrc, l_); R_GLDS(g_ + lsrc + 16 * QD * 2, l_ + 4096u); R_GLDS(g_ + lsrc + 32 * QD * 2, l_ + 8192u); R_GLDS(g_ + lsrc + 48 * QD * 2, l_ + 12288u); \
        R_GLDS(g_ + rsrc, l_ + (unsigned)TILE_LAT); } while (0)
    R_DMA(KVseq, 0);
    bf16x8 qa[6], qbf[6];
    { const bf16* qp = QbP + ((row0 + r32) * NH + h) * 96 + 8 * hi;
#pragma unroll
      for (int s = 0; s < 6; ++s) { qa[s] = *(const bf16x8*)(qp + 16 * s); qbf[s] = *(const bf16x8*)(qp + (size_t)32 * NH * 96 + 16 * s); } }
    R_DMA(KVseq + (size_t)64 * QD, TILE_BYTES);
    asm volatile("s_waitcnt vmcnt(0)" ::: "memory");
#pragma unroll
    for (int s = 0; s < 6; ++s) asm volatile("" : "+v"(qa[s]), "+v"(qbf[s]));
    role_bar(cnt, bt);
    float mA = 0.f, lA = 0.f, mB = 0.f, lB = 0.f; f32x16 oA[2], oB[2];
#pragma unroll
    for (int r = 0; r < 16; ++r) { oA[0][r] = 0.f; oA[1][r] = 0.f; oB[0][r] = 0.f; oB[1][r] = 0.f; }
    const unsigned xk = (unsigned)(((r32 & 3) << 1) | ((r32 >> 3) & 1));
    const unsigned ka = 256u * (unsigned)r32 + 16u * ((unsigned)hi ^ ((unsigned)(r32 >> 2) & 1u));
    const unsigned kr0 = TILE_LAT + offR((unsigned)r32, (unsigned)hi), kr1 = TILE_LAT + offR((unsigned)r32, 2u + (unsigned)hi);
    const unsigned blk = (lane >> 4) & 1, qq = (lane & 15) >> 2, pp = lane & 3;
    const unsigned vb0 = 256u * (unsigned)(4 * hi + qq) + 16u * ((2u * blk + (pp >> 1)) ^ (unsigned)hi) + 8u * (pp & 1u);
    const unsigned vb1 = 256u * (unsigned)(8 + 4 * hi + qq) + 16u * ((2u * blk + (pp >> 1)) ^ (2u + (unsigned)hi)) + 8u * (pp & 1u);
    ldsp ring = lds + L_PT;
    int cur = 0, nxt = TILE_BYTES, nn = 2 * TILE_BYTES;
    for (int kt = 0; kt < ntile_u; ++kt) {
        ldsp tile = ring + cur;
        const char* gsrc = (const char*)(KVseq + (size_t)min(kt + 2, ntile_u - 1) * 64 * QD);
        const unsigned ldst = (unsigned)__builtin_amdgcn_readfirstlane((int)(lds0 + (unsigned)nn + (unsigned)wid * 1024u));
#define R_GLDS_S(sbase, voff, ldsaddr) do { unsigned keep_; asm volatile("s_mov_b32 %0, m0\n\ts_mov_b32 m0, %2\n\ts_nop 0\n\tglobal_load_lds_dwordx4 %1, %3\n\ts_mov_b32 m0, %0" : "=&s"(keep_) : "v"(voff), "s"(ldsaddr), "s"(sbase) : "memory"); } while (0)
#define R_PIECE(j) do { if ((j) < 4) R_GLDS_S(gsrc + (j) * 16 * QD * 2, lsrc, ldst + 4096u * (unsigned)(j)); else R_GLDS_S(gsrc, rsrc, ldst + (unsigned)TILE_LAT); } while (0)
        { R_PIECE(0); R_PIECE(1); R_PIECE(2); R_PIECE(3); R_PIECE(4); }
        if (kt < ntile_w) {
            unsigned xko = xk, qqo = qq; asm volatile("" : "+v"(xko), "+v"(qqo));
            const bool lastt = kt == ntile_w - 1; const int kb = kt * 64;
            f32x16 a0, a1, b0, b1;
#define R_QK(s0_, s1_, qf_) do { \
            _Pragma("unroll") for (int r = 0; r < 16; ++r) { s0_[r] = 0.f; s1_[r] = 0.f; } \
            _Pragma("unroll") for (int k = 0; k < 4; ++k) { const unsigned a_ = ka + 32u * ((unsigned)k ^ xko); const bf16x8 k0 = lds_b128(tile + a_), k1 = lds_b128(tile + a_ + 8192); \
                s0_ = ATT_MFMA(k0, qf_[k], s0_); s1_ = ATT_MFMA(k1, qf_[k], s1_); } \
            { const bf16x8 k0 = lds_b128(tile + kr0), k1 = lds_b128(tile + kr0 + 2048); s0_ = ATT_MFMA(k0, qf_[4], s0_); s1_ = ATT_MFMA(k1, qf_[4], s1_); } \
            { const bf16x8 k0 = lds_b128(tile + kr1), k1 = lds_b128(tile + kr1 + 2048); s0_ = ATT_MFMA(k0, qf_[5], s0_); s1_ = ATT_MFMA(k1, qf_[5], s1_); } } while (0)
#define R_MASK(s0_, s1_, tok_) do { int ln_ = lane; asm volatile("" : "+v"(ln_)); int d_ = (tok_) + (ln_ & 31) - kb - 4 * (ln_ >> 5); asm volatile("" : "+v"(d_));   \
            _Pragma("unroll") for (int r = 0; r < 16; ++r) { const int c_ = (r & 3) + 8 * (r >> 2); if (c_ > d_) s0_[r] = -INFINITY; if (c_ + 32 > d_) s1_[r] = -INFINITY; } } while (0)
#define R_PV(s0_, s1_, o_) do { \
            _Pragma("unroll") for (int ks = 0; ks < 4; ++ks) { const int bb = 8 * (ks & 1); const f32x16& pa = (ks < 2) ? s0_ : s1_; \
                u32x4 wa; wa.x = cvtpk(pa[bb + 0], pa[bb + 1]); wa.y = cvtpk(pa[bb + 2], pa[bb + 3]); wa.z = cvtpk(pa[bb + 4], pa[bb + 5]); wa.w = cvtpk(pa[bb + 6], pa[bb + 7]); \
                const bf16x8 pfa = __builtin_bit_cast(bf16x8, wa); \
                _Pragma("unroll") for (int c = 2; c < 4; ++c) { const unsigned co = 64u * ((unsigned)c ^ qqo); \
                    const s16x4 lo = lds_tr(tile + vb0 + co + 4096 * ks), hv = lds_tr(tile + vb1 + co + 4096 * ks); \
                    const bf16x8 vf = {lo[0], lo[1], lo[2], lo[3], hv[0], hv[1], hv[2], hv[3]}; \
                    o_[c - 2] = ATT_MFMA(vf, pfa, o_[c - 2]); } } } while (0)
#define R_K0(i) ((i) < 4 ? ka + 32u * ((unsigned)(i) ^ xko) : ((i) == 4 ? kr0 : kr1))
#define R_K1(i) (R_K0(i) + ((i) < 4 ? 8192u : 2048u))
            { bf16x8 kc0 = lds_b128(tile + R_K0(0)), kc1 = lds_b128(tile + R_K1(0));
#pragma unroll
              for (int r = 0; r < 16; ++r) { a0[r] = 0.f; a1[r] = 0.f; }
#pragma unroll
              for (int i = 0; i < 6; ++i) { bf16x8 kn0 = kc0, kn1 = kc1;
                  if (i < 5) { kn0 = lds_b128(tile + R_K0(i + 1)); kn1 = lds_b128(tile + R_K1(i + 1)); }
                  a0 = ATT_MFMA(kc0, qa[i], a0);
                  __builtin_amdgcn_sched_barrier(0);
                  a1 = ATT_MFMA(kc1, qa[i], a1);
                  __builtin_amdgcn_sched_barrier(0);
                  kc0 = kn0; kc1 = kn1; } }
            if (lastt) R_MASK(a0, a1, tq0);
            sm_max(a0, a1, mA, lA, oA, kt == 0);
#define R_EXPS(v_, s_, n_, m_, acc_) do { \
            _Pragma("unroll") for (int r = 0; r < (n_); ++r) v_[(s_) + r] -= m_; \
            _Pragma("unroll") for (int r = 0; r < (n_); ++r) v_[(s_) + r] = __builtin_amdgcn_exp2f(v_[(s_) + r]); \
            _Pragma("unroll") for (int r = 0; r < (n_); ++r) acc_ += v_[(s_) + r]; } while (0)
            { float sum = 0.f; bf16x8 kc0 = lds_b128(tile + R_K0(0)), kc1 = lds_b128(tile + R_K1(0));
#pragma unroll
              for (int r = 0; r < 16; ++r) { b0[r] = 0.f; b1[r] = 0.f; }
#pragma unroll
              for (int i = 0; i < 6; ++i) { bf16x8 kn0 = kc0, kn1 = kc1;
                  if (i < 5) { kn0 = lds_b128(tile + R_K0(i + 1)); kn1 = lds_b128(tile + R_K1(i + 1)); }
                  const int st_ = i < 4 ? 3 * i : 12 + 2 * (i - 4), n_ = i < 4 ? 3 : 2;
                  b0 = ATT_MFMA(kc0, qbf[i], b0);
                  R_EXPS(a0, st_, n_, mA, sum);
                  __builtin_amdgcn_sched_barrier(0);
                  b1 = ATT_MFMA(kc1, qbf[i], b1);
                  R_EXPS(a1, st_, n_, mA, sum);
                  __builtin_amdgcn_sched_barrier(0);
                  kc0 = kn0; kc1 = kn1; }
              asm volatile("" : "+v"(a0), "+v"(a1), "+v"(sum));
              lA += sum; }
            if (lastt) R_MASK(b0, b1, tq0 + 32);
#define R_VF(g_, dst_) do { const unsigned co_ = 64u * ((unsigned)(2 + ((g_) & 1)) ^ qqo); const s16x4 lo_ = lds_tr(tile + vb0 + co_ + 4096 * ((g_) >> 1)), hv_ = lds_tr(tile + vb1 + co_ + 4096 * ((g_) >> 1)); \
            dst_ = bf16x8{lo_[0], lo_[1], lo_[2], lo_[3], hv_[0], hv_[1], hv_[2], hv_[3]}; } while (0)
#define R_PF(s0_, s1_, ks_, dst_) do { const int bb_ = 8 * ((ks_) & 1); const f32x16& pa_ = ((ks_) < 2) ? s0_ : s1_; u32x4 w_; w_.x = cvtpk(pa_[bb_ + 0], pa_[bb_ + 1]); w_.y = cvtpk(pa_[bb_ + 2], pa_[bb_ + 3]); \
            w_.z = cvtpk(pa_[bb_ + 4], pa_[bb_ + 5]); w_.w = cvtpk(pa_[bb_ + 6], pa_[bb_ + 7]); dst_ = __builtin_bit_cast(bf16x8, w_); } while (0)
            { bf16x8 vc, pf; R_VF(0, vc); R_PF(a0, a1, 0, pf);
              { bf16x8 vn, pn; float r0, r1;
                R_VF(1, vn);
                oA[0] = ATT_MFMA(vc, pf, oA[0]);
                r0 = max3(b0[0], b1[0], b0[1]); r1 = max3(b1[1], b0[2], b1[2]);
#pragma unroll
                for (int r = 3; r < 9; r += 2) { r0 = max3(r0, b0[r], b1[r]); r1 = max3(r1, b0[r + 1], b1[r + 1]); }
                __builtin_amdgcn_sched_barrier(0);
                vc = vn; R_VF(2, vn); R_PF(a0, a1, 1, pn);
                oA[1] = ATT_MFMA(vc, pf, oA[1]);
#pragma unroll
                for (int r = 9; r < 15; r += 2) { r0 = max3(r0, b0[r], b1[r]); r1 = max3(r1, b0[r + 1], b1[r + 1]); }
                r0 = max3(r0, r1, fmaxf(b0[15], b1[15]));
                __builtin_amdgcn_sched_barrier(0);
                vc = vn; pf = pn;
                sm_fin(r0, mB, lB, oB, kt == 0); }
              float sum = 0.f;
#pragma unroll
              for (int g = 2; g < 8; ++g) { bf16x8 vn = vc, pn = pf;
                  if (g < 7) R_VF(g + 1, vn);
                  if ((g & 1) && g < 7) R_PF(a0, a1, (g + 1) >> 1, pn);
                  oA[g & 1] = ATT_MFMA(vc, pf, oA[g & 1]);
                  if (g < 5) R_EXPS(b0, g == 2 ? 0 : 6 + 5 * (g - 3), g == 2 ? 6 : 5, mB, sum); else R_EXPS(b1, g == 5 ? 0 : 6 + 5 * (g - 6), g == 5 ? 6 : 5, mB, sum);
                  __builtin_amdgcn_sched_barrier(0);
                  vc = vn; pf = pn; }
              lB += sum; }
            R_PV(b0, b1, oB);
#undef R_K0
#undef R_K1
#undef R_PIECE
#undef R_GLDS_S
#undef R_EXPS
#undef R_VF
#undef R_PF
#undef R_QK
#undef R_MASK
#undef R_PV
        }
        if (kt + 2 < ntile_u) asm volatile("s_waitcnt vmcnt(5)" ::: "memory");
        else asm volatile("s_waitcnt vmcnt(0)" ::: "memory");
        role_bar(cnt, bt);
        { const int t_ = cur; cur = nxt; nxt = nn; nn = t_; }
    }
#undef R_DMA
#undef R_GLDS
    int lne = lane; asm volatile("" : "+v"(lne));
    const int r32e = lne & 31, hie = lne >> 5;
#pragma unroll
    for (int blkq = 0; blkq < 2; ++blkq) { f32x16 (&o)[2] = blkq ? oB : oA; float l = swapsum(blkq ? lB : lA);
        const float rl = 1.0f / l; float ss = 0.f;
#pragma unroll
        for (int c = 0; c < 2; ++c)
#pragma unroll
            for (int r = 0; r < 16; ++r) { o[c][r] *= rl; ss += o[c][r] * o[c][r]; }
        ss = swapsum(ss);
        const size_t row = row0 + 32 * blkq + r32e;
        if (hie == 0) SSQM[row * NH + h] = ss;
        bf16* yp = YC + row * DMIX + DLRU + h * VD + 4 * hie;
#pragma unroll
        for (int c = 0; c < 2; ++c)
#pragma unroll
            for (int g = 0; g < 4; ++g) { u32x2 w; w.x = cvtpk(o[c][4 * g], o[c][4 * g + 1]); w.y = cvtpk(o[c][4 * g + 2], o[c][4 * g + 3]); *(u32x2*)(yp + 32 * c + 8 * g) = w; } }
    asm volatile("s_waitcnt vmcnt(0)" ::: "memory");
}

__device__ __forceinline__ void dc_load(f32x4 (&st)[10], const float* __restrict__ ckv, const float* __restrict__ ckr, size_t slot0, int t4) {
    const f32x4* pl = (const f32x4*)(ckv + slot0 * KVL) + t4; const f32x4* pr = (const f32x4*)(ckr + slot0 * ROPE) + t4;
#pragma unroll
    for (int i = 0; i < 8; ++i) st[i] = __builtin_nontemporal_load(pl + 256 * i);
#pragma unroll
    for (int i = 0; i < 2; ++i) st[8 + i] = __builtin_nontemporal_load(pr + 256 * i);
}
__device__ __forceinline__ void dc_store(const f32x4 (&st)[10], ldsp img, unsigned dE, unsigned dO, unsigned dr) {
#pragma unroll
    for (int i = 0; i < 8; ++i) { u32x2 wv; wv.x = cvtpk(st[i].x, st[i].y); wv.y = cvtpk(st[i].z, st[i].w); *(ATT_LAS u32x2*)(img + ((i & 1) ? dO : dE) + 2048 * i) = wv; }
#pragma unroll
    for (int i = 0; i < 2; ++i) { u32x2 wv; wv.x = cvtpk(st[8 + i].x, st[8 + i].y); wv.y = cvtpk(st[8 + i].z, st[8 + i].w); *(ATT_LAS u32x2*)(img + TILE_LAT + dr + 2048 * i) = wv; }
}
__device__ __forceinline__ void decode_role(ldsp lds, const bf16* __restrict__ Qb, const float* __restrict__ ckv, const float* __restrict__ ckr, const int* __restrict__ ptab,
                                            float* __restrict__ PART, int db, int pg0, int npg, unsigned& bt) {
    const int t4 = threadIdx.x & 255, lane = t4 & 63, w = __builtin_amdgcn_readfirstlane(t4 >> 6), r32 = lane & 31, hi = lane >> 5;
    const int qb = w & 1, kb = w >> 1, rb = 32 * kb;
    ATT_LAS unsigned* cnt = (ATT_LAS unsigned*)(lds + L_BAR + 64);
    const int mypg = ptab[db * NPAGES + pg0 + (lane < npg ? lane : 0)];
#define DC_PG(i) ((size_t)__builtin_amdgcn_readlane(mypg, (i)))
    unsigned dE, dO, dr;
    { const unsigned r0 = (unsigned)t4 >> 5, c4 = (unsigned)t4 & 31u;
      const unsigned xE = ((r0 & 3u) << 2) | ((r0 >> 2) & 3u), xO = ((r0 & 3u) << 2) | (((r0 >> 2) + 2u) & 3u);
      dE = 256u * r0 + 16u * ((c4 >> 1) ^ xE) + 8u * (c4 & 1u); dO = 256u * r0 + 16u * ((c4 >> 1) ^ xO) + 8u * (c4 & 1u);
      const unsigned rr = (unsigned)t4 >> 3, c4r = (unsigned)t4 & 7u; dr = offR(rr, c4r >> 1) + 8u * (c4r & 1u); }
    f32x4 sa[10], sb[10];
    dc_load(sa, ckv, ckr, DC_PG(0) * PAGE, t4);
    dc_load(sb, ckv, ckr, DC_PG(0) * PAGE + 64, t4);
    {
      const bf16* qsrc = Qb + ((size_t)RP + (size_t)db * DS) * NH * QD; const unsigned dq = offL((unsigned)t4 >> 4, (unsigned)t4 & 15u);
#pragma unroll
      for (int i = 0; i < 4; ++i) *(ATT_LAS u32x4*)(lds + L_MG + dq + 4096 * i) = *(const u32x4*)(qsrc + (size_t)((t4 >> 4) + 16 * i) * QD + (t4 & 15) * 8);
      *(ATT_LAS u32x4*)(lds + L_MG + TILE_LAT + offR((unsigned)t4 >> 2, (unsigned)t4 & 3u)) = *(const u32x4*)(qsrc + (size_t)(t4 >> 2) * QD + KVL + (t4 & 3) * 8); }
    dc_store(sa, lds + L_DT, dE, dO, dr);
    role_bar(cnt, bt);
    const unsigned qa = L_MG + 256u * (unsigned)(32 * qb + r32) + 16u * ((unsigned)hi ^ ((unsigned)(r32 >> 2) & 1u));
    const unsigned qr0 = L_MG + TILE_LAT + offR((unsigned)(32 * qb + r32), (unsigned)hi), qr1 = L_MG + TILE_LAT + offR((unsigned)(32 * qb + r32), 2u + (unsigned)hi);
    float m = 0.f, l = 0.f; f32x16 o[4];
#pragma unroll
    for (int r = 0; r < 16; ++r) { o[0][r] = 0.f; o[1][r] = 0.f; o[2][r] = 0.f; o[3][r] = 0.f; }
    const unsigned xk = (unsigned)(((r32 & 3) << 1) | ((r32 >> 3) & 1));
    const unsigned ka = 256u * (unsigned)(rb + r32) + 16u * ((unsigned)hi ^ ((unsigned)(r32 >> 2) & 1u));
    const unsigned kr0 = TILE_LAT + offR((unsigned)(rb + r32), (unsigned)hi), kr1 = TILE_LAT + offR((unsigned)(rb + r32), 2u + (unsigned)hi);
    const unsigned blk = (lane >> 4) & 1, qq = (lane & 15) >> 2, pp = lane & 3;
    const unsigned vb0 = 256u * (unsigned)(rb + 4 * hi + qq) + 16u * ((2u * blk + (pp >> 1)) ^ (unsigned)hi) + 8u * (pp & 1u);
    const unsigned vb1 = 256u * (unsigned)(rb + 8 + 4 * hi + qq) + 16u * ((2u * blk + (pp >> 1)) ^ (2u + (unsigned)hi)) + 8u * (pp & 1u);
    const int nhp = 2 * npg;
    bf16x8 qf[6];
    { unsigned xq = xk; asm volatile("" : "+v"(xq));
#pragma unroll
      for (int k = 0; k < 6; ++k) qf[k] = lds_b128(lds + qa + 32u * ((unsigned)k ^ xq));
    }
#define DC_HALF(img, first) do { \
        unsigned xko = xk, qqo = qq; asm volatile("" : "+v"(xko), "+v"(qqo)); \
        f32x16 s; \
        _Pragma("unroll") for (int r = 0; r < 16; ++r) s[r] = 0.f; \
        _Pragma("unroll") for (int k = 0; k < 8; ++k) { const unsigned co_ = 32u * ((unsigned)k ^ xko); s = ATT_MFMA(lds_b128((img) + ka + co_), k < 6 ? qf[k < 6 ? k : 0] : lds_b128(lds + qa + co_), s); } \
        s = ATT_MFMA(lds_b128((img) + kr0), lds_b128(lds + qr0), s); \
        s = ATT_MFMA(lds_b128((img) + kr1), lds_b128(lds + qr1), s); \
        float rm = max3(s[0], s[1], s[2]); \
        _Pragma("unroll") for (int r = 3; r < 15; r += 2) rm = max3(rm, s[r], s[r + 1]); \
        rm = max3(rm, s[15], s[15]); \
        rm = swapmax(rm); \
        if (first) m = rm; \
        rm -= m; \
        if (!(first) && __any(rm > THR)) { const float dlt = fmaxf(rm, 0.f); m += dlt; const float f = __builtin_amdgcn_exp2f(-dlt); l *= f; \
            _Pragma("unroll") for (int c = 0; c < 4; ++c) _Pragma("unroll") for (int r = 0; r < 16; ++r) o[c][r] *= f; } \
        { float sum0 = 0.f, sum1 = 0.f;     \
          _Pragma("unroll") for (int r = 0; r < 16; r += 2) { s[r] = __builtin_amdgcn_exp2f(s[r] - m); s[r + 1] = __builtin_amdgcn_exp2f(s[r + 1] - m); sum0 += s[r]; sum1 += s[r + 1]; } \
          l += sum0 + sum1; } \
        _Pragma("unroll") for (int ks = 0; ks < 2; ++ks) { \
            u32x4 pw; pw.x = cvtpk(s[8 * ks + 0], s[8 * ks + 1]); pw.y = cvtpk(s[8 * ks + 2], s[8 * ks + 3]); pw.z = cvtpk(s[8 * ks + 4], s[8 * ks + 5]); pw.w = cvtpk(s[8 * ks + 6], s[8 * ks + 7]); \
            const bf16x8 pf = __builtin_bit_cast(bf16x8, pw); \
            _Pragma("unroll") for (int c = 0; c < 4; ++c) { const unsigned co = 64u * ((unsigned)c ^ qqo); \
                const s16x4 lo = lds_tr((img) + vb0 + co + 4096 * ks), hv = lds_tr((img) + vb1 + co + 4096 * ks); \
                const bf16x8 vf = {lo[0], lo[1], lo[2], lo[3], hv[0], hv[1], hv[2], hv[3]}; \
                o[c] = ATT_MFMA(vf, pf, o[c]); } } \
    } while (0)
    for (int hp = 0; hp < nhp; hp += 2) {
        dc_load(sa, ckv, ckr, DC_PG(min((hp + 2) >> 1, npg - 1)) * PAGE, t4);
        DC_HALF(lds + L_DT, hp == 0);
        dc_store(sb, lds + L_DT + TILE_BYTES, dE, dO, dr);
        role_bar(cnt, bt);
        dc_load(sb, ckv, ckr, DC_PG(min((hp + 3) >> 1, npg - 1)) * PAGE + 64, t4);
        DC_HALF(lds + L_DT + TILE_BYTES, false);
        if (hp + 2 < nhp) dc_store(sa, lds + L_DT, dE, dO, dr);
        role_bar(cnt, bt);
    }
#undef DC_HALF
#undef DC_PG
    ATT_LAS float* reg = (ATT_LAS float*)(lds + L_MG) + qb * PART_FLOATS + lane;
    if (kb == 0) {
#pragma unroll
        for (int c = 0; c < 4; ++c)
#pragma unroll
            for (int r = 0; r < 16; ++r) reg[(c * 16 + r) * 64] = o[c][r];
        reg[64 * 64] = m; reg[65 * 64] = l; }
    role_bar(cnt, bt);
    if (kb == 1) { const float m2 = reg[64 * 64], l2 = reg[65 * 64]; const float mn = fmaxf(m, m2); const float a1 = __builtin_amdgcn_exp2f(m - mn), a2 = __builtin_amdgcn_exp2f(m2 - mn);
        float* gp = PART + (size_t)qb * PART_FLOATS + lane;
#pragma unroll
        for (int c = 0; c < 4; ++c)
#pragma unroll
            for (int r = 0; r < 16; ++r) gp[(c * 16 + r) * 64] = o[c][r] * a1 + reg[(c * 16 + r) * 64] * a2;
        gp[64 * 64] = mn; gp[65 * 64] = l * a1 + l2 * a2; }
    role_bar(cnt, bt);
}
}
namespace lru {
using att::bf16x8; using att::f32x16; using att::u32x4; using att::ldsp; using att::cvtpk; using att::crow;
constexpr int XCT_STRIDE = 72;
constexpr int XCT_WAVE_BYTES = 64 * XCT_STRIDE * 2;
constexpr int LDS_RED = 0;
constexpr int LDS_RS = LDS_RED + 8 * 64 * 32 * 4;
__device__ __forceinline__ float bf2f(unsigned short v) { return __uint_as_float((unsigned)v << 16); }
__device__ __forceinline__ float sigm(float x) { return __builtin_amdgcn_rcpf(1.0f + __builtin_amdgcn_exp2f(-1.4426950408889634f * x)); }

struct State { f32x16 P[2][2]; f32x16 H[2][2]; };

template <bool SAMPLE, int NRB = 2>
__device__ __forceinline__ void unit_pre(ldsp lds, State& st, const bf16* __restrict__ XL, const bf16* __restrict__ WGT, const float* __restrict__ conv_w, const float* __restrict__ conv_b,
                                         const float* __restrict__ b_a, const float* __restrict__ b_i, const float* __restrict__ lam, const float* __restrict__ state_conv, const float* __restrict__ state_h,
                                         float* __restrict__ out, size_t rowbase, int b0, int tpos0, float* __restrict__ SUMp  ) {
    const int tid = threadIdx.x, lane = tid & 63, n = __builtin_amdgcn_readfirstlane(tid >> 6), r32 = lane & 31, hi = lane >> 5;
    ATT_LAS unsigned short* xct = (ATT_LAS unsigned short*)(lds + n * XCT_WAVE_BYTES);
    bf16x8 af[2][4];
#pragma unroll
    for (int s = 0; s < 4; ++s) { const int ch0 = 64 * n + 16 * s + 8 * hi;
        float w[4][8], bb[8];
#pragma unroll
        for (int k = 0; k < 4; ++k) { const f32x4 a = *(const f32x4*)(conv_w + k * DLRU + ch0), c = *(const f32x4*)(conv_w + k * DLRU + ch0 + 4);
            w[k][0] = a[0]; w[k][1] = a[1]; w[k][2] = a[2]; w[k][3] = a[3]; w[k][4] = c[0]; w[k][5] = c[1]; w[k][6] = c[2]; w[k][7] = c[3]; }
        { const f32x4 a = *(const f32x4*)(conv_b + ch0), c = *(const f32x4*)(conv_b + ch0 + 4); bb[0] = a[0]; bb[1] = a[1]; bb[2] = a[2]; bb[3] = a[3]; bb[4] = c[0]; bb[5] = c[1]; bb[6] = c[2]; bb[7] = c[3]; }
#pragma unroll
        for (int rb = 0; rb < NRB; ++rb) { const int tk = 32 * rb + r32;
            const int tseq = SAMPLE ? (tk & 7) : tpos0 + tk;
            float xc[8];
#pragma unroll
            for (int j = 0; j < 8; ++j) xc[j] = bb[j];
#pragma unroll
            for (int k = 0; k < 4; ++k) { const int back = 3 - k;
                float xv[8];
                const bool inseq = tseq - back >= 0;
                { const bf16x8 v = *(const bf16x8*)(XL + (rowbase + tk - (inseq ? back : 0)) * DLRU + ch0);
#pragma unroll
                  for (int j = 0; j < 8; ++j) xv[j] = inseq ? bf2f((unsigned short)v[j]) : 0.f; }
                if (SAMPLE && back > 0) { const int sr = inseq ? 0 : 3 + tseq - back;
                    const float* sp = state_conv + ((size_t)(b0 + (tk >> 3)) * 3 + sr) * DLRU + ch0; const f32x4 a = *(const f32x4*)sp, c = *(const f32x4*)(sp + 4);
                    if (!inseq) { xv[0] = a[0]; xv[1] = a[1]; xv[2] = a[2]; xv[3] = a[3]; xv[4] = c[0]; xv[5] = c[1]; xv[6] = c[2]; xv[7] = c[3]; } }
#pragma unroll
                for (int j = 0; j < 8; ++j) xc[j] += w[k][j] * xv[j]; }
            u32x4 pw; pw.x = cvtpk(xc[0], xc[1]); pw.y = cvtpk(xc[2], xc[3]); pw.z = cvtpk(xc[4], xc[5]); pw.w = cvtpk(xc[6], xc[7]);
            af[rb][s] = __builtin_bit_cast(bf16x8, pw);
            *(ATT_LAS u32x4*)(xct + tk * XCT_STRIDE + 16 * s + 8 * hi) = pw;
        }
    }
    if (SAMPLE || tpos0 + 32 * NRB > SEQ - 3) {
#pragma unroll
        for (int s = 0; s < 4; ++s) { const int ch0 = 64 * n + 16 * s + 8 * hi;
#pragma unroll
            for (int rb = 0; rb < NRB; ++rb) { const int tk = 32 * rb + r32; const int tseq = SAMPLE ? (tk & 7) : tpos0 + tk;
                if (tseq >= (SAMPLE ? DS : SEQ) - 3) { const bf16x8 v = *(const bf16x8*)(XL + (rowbase + tk) * DLRU + ch0);
                    float* o = out + (SAMPLE ? O_CVS : O_CVP) + ((size_t)(SAMPLE ? b0 + (tk >> 3) : b0) * 3 + (tseq - ((SAMPLE ? DS : SEQ) - 3))) * DLRU + ch0;
#pragma unroll
                    for (int j = 0; j < 8; ++j) o[j] = bf2f((unsigned short)v[j]); } } }
    }
#pragma unroll
    for (int g = 0; g < 2; ++g)
#pragma unroll
        for (int cb = 0; cb < 2; ++cb) { f32x16 c0, c1;
#pragma unroll
            for (int r = 0; r < 16; ++r) { c0[r] = 0.f; c1[r] = 0.f; }
#pragma unroll
            for (int s = 0; s < 4; ++s) { const bf16x8 bf = *(const bf16x8*)(WGT + (((size_t)n * 2 + g) * 64 + 32 * cb + r32) * 64 + 16 * s + 8 * hi);
                c0 = ATT_MFMA(af[0][s], bf, c0); if (NRB == 2) c1 = ATT_MFMA(af[1][s], bf, c1); }
            if (g == 0) { st.P[0][cb] = c0; st.P[1][cb] = c1; } else { st.H[0][cb] = c0; st.H[1][cb] = c1; }
            __builtin_amdgcn_sched_barrier(0); }
    asm volatile("s_waitcnt lgkmcnt(0)" ::: "memory");
#pragma unroll
    for (int cb = 0; cb < 2; ++cb) { const int ch = 64 * n + 32 * cb + r32;
        const float ba = b_a[ch], bi = b_i[ch]; const float nl = -lam[ch]; const float sp8 = 8.0f * (fmaxf(nl, 0.f) + log1pf(__expf(-fabsf(nl))));
#pragma unroll
        for (int rb = 0; rb < NRB; ++rb)
#pragma unroll
            for (int r = 0; r < 16; ++r) { const int tk = 32 * rb + crow(r, hi);
                const float xc = bf2f(xct[tk * XCT_STRIDE + 32 * cb + r32]);
                const float rg = sigm(st.P[rb][cb][r] + ba), ig = sigm(st.H[rb][cb][r] + bi);
                const float la = -rg * sp8;
                const float a = __builtin_amdgcn_exp2f(1.4426950408889634f * la);
                const float y = -2.0f * la;
                const float poly = y * (1.0f + y * (-0.5f + y * (1.6666667e-1f + y * (-4.1666667e-2f + y * (8.3333333e-3f + y * -1.3888889e-3f)))));
                const float wgt = __builtin_amdgcn_fmed3f(10.0f * y - 2.0f, 0.0f, 1.0f);
                const float om = poly + wgt * ((1.0f - a * a) - poly);
                st.P[rb][cb][r] = a; st.H[rb][cb][r] = __builtin_amdgcn_sqrtf(om) * (ig * xc); }
        __builtin_amdgcn_sched_barrier(0); }
#pragma unroll
    for (int cb = 0; cb < 2; ++cb) { const int ch = 64 * n + 32 * cb + r32;
        float h = 0.f, pr = 1.f;
#pragma unroll
        for (int k = 0; k < 8 * NRB; ++k) { const int rb = k >> 3, g = (k >> 1) & 3, owner = k & 1;
            if (SAMPLE && (k & 1) == 0) { h = state_h[(size_t)(b0 + (k >> 1)) * DLRU + ch]; pr = 1.f; }
            if (hi == owner) {
#pragma unroll
                for (int i = 0; i < 4; ++i) { const float a = st.P[rb][cb][4 * g + i]; h = a * h + st.H[rb][cb][4 * g + i]; pr *= a; st.H[rb][cb][4 * g + i] = h; st.P[rb][cb][4 * g + i] = pr; } }
            const float ho = __shfl_xor(h, 32), po = __shfl_xor(pr, 32);
            if (hi != owner) { h = ho; pr = po; }
            if (SAMPLE && (k & 1) == 1 && hi == 0) out[O_HS + (size_t)(b0 + (k >> 1)) * DLRU + ch] = h; }
        if (!SAMPLE && hi == 0) { SUMp[2 * ch] = pr; SUMp[2 * ch + 1] = h; } }
}
template <int NRB = 2>
__device__ __forceinline__ void unit_post(ldsp lds, State& st, const bf16* __restrict__ GG, const float* __restrict__ gain, bf16* __restrict__ YC, size_t rowbase, float carry0, float carry1) {
    const int tid = threadIdx.x, lane = tid & 63, n = __builtin_amdgcn_readfirstlane(tid >> 6), r32 = lane & 31, hi = lane >> 5;
    ATT_LAS float* red = (ATT_LAS float*)(lds + LDS_RED); ATT_LAS float* rs = (ATT_LAS float*)(lds + LDS_RS);
    __syncthreads();
#pragma unroll
    for (int rb = 0; rb < NRB; ++rb)
#pragma unroll
        for (int r = 0; r < 16; ++r) { const int tk = 32 * rb + crow(r, hi); float ss = 0.f;
#pragma unroll
            for (int cb = 0; cb < 2; ++cb) { const int ch = 64 * n + 32 * cb + r32; const float cr = cb ? carry1 : carry0;
                const float h = st.H[rb][cb][r] + st.P[rb][cb][r] * cr;
                const float y = bf2f(GG[(rowbase + tk) * DLRU + ch]) * h;
                st.H[rb][cb][r] = y; ss += y * y; }
            red[(n * 64 + tk) * 32 + r32] = ss; }
    __syncthreads();
    { const int tk = tid >> 3, part = tid & 7; float s = 0.f;
#pragma unroll
      for (int j = 0; j < 8; ++j) { const f32x4 v = *(const ATT_LAS f32x4*)(red + (part * 64 + tk) * 32 + 4 * j); s += (v[0] + v[1]) + (v[2] + v[3]); }
      s += __shfl_xor(s, 1); s += __shfl_xor(s, 2); s += __shfl_xor(s, 4);
      if (part == 0 && tk < 32 * NRB) rs[tk] = __builtin_amdgcn_rsqf(s * (1.0f / DLRU) + EPS); }
    __syncthreads();
#pragma unroll
    for (int cb = 0; cb < 2; ++cb) { const int ch = 64 * n + 32 * cb + r32; const float gn = gain[ch];
#pragma unroll
        for (int rb = 0; rb < NRB; ++rb)
#pragma unroll
            for (int r = 0; r < 16; ++r) { const int tk = 32 * rb + crow(r, hi);
                YC[(rowbase + tk) * DMIX + ch] = (bf16)f2bf(st.H[rb][cb][r] * rs[tk] * gn); } }
    __syncthreads();
}
__device__ __forceinline__ float chunk_carry(const float* __restrict__ SUMb, int c, int ch) {
    float h = 0.f;
    int k = 0;
    for (; k + 16 <= c; k += 16) { float2 v[16];
#pragma unroll
        for (int j = 0; j < 16; ++j) v[j] = *(const float2*)(SUMb + ((size_t)(k + j) * DLRU + ch) * 2);
#pragma unroll
        for (int j = 0; j < 16; ++j) h = v[j].x * h + v[j].y; }
#pragma unroll 8
    for (; k < c; ++k) { const float2 v = *(const float2*)(SUMb + ((size_t)k * DLRU + ch) * 2); h = v.x * h + v.y; }
    return h;
}
}
namespace sg {
typedef short bf16x8 __attribute__((ext_vector_type(8)));
typedef unsigned u32x2 __attribute__((ext_vector_type(2)));
using att::u32x4; using att::offL; using att::ldsp;
constexpr int CHK = 256, HALF_B = 64 * 256, TILE_B = 2 * HALF_B  , BUF_B = 2 * TILE_B;
__device__ __forceinline__ void ld_chunk(u32x4 (&st)[8], const bf16* __restrict__ ap, const bf16* __restrict__ bp, int K) {
#pragma unroll
    for (int i = 0; i < 4; ++i) { st[i] = *(const u32x4*)(ap + (size_t)16 * i * K); st[4 + i] = *(const u32x4*)(bp + (size_t)16 * i * K); }
}
__device__ __forceinline__ void st_chunk(const u32x4 (&st)[8], ldsp buf, unsigned d) {
#pragma unroll
    for (int i = 0; i < 4; ++i) { *(ATT_LAS u32x4*)(buf + d + 4096 * i) = st[i]; *(ATT_LAS u32x4*)(buf + TILE_B + d + 4096 * i) = st[4 + i]; }
}
__device__ __forceinline__ void unit64(ldsp lds, const bf16* __restrict__ A, const bf16* __restrict__ Bt, int K, int r0, int c0, const float* __restrict__ basef,
                                       bf16* Xb, float* __restrict__ SSQX, float alpha, float* __restrict__ outf = nullptr, const float* __restrict__ gain = nullptr, unsigned* cnt = nullptr) {
    const int tid = threadIdx.x, lane = tid & 63, w = __builtin_amdgcn_readfirstlane(tid >> 6), nt = w & 1, kq = w >> 1, r32 = lane & 31, hi = lane >> 5;
    const bf16* ap = A + (size_t)(r0 + (tid >> 5)) * K + 8 * (tid & 31); const bf16* bp = Bt + (size_t)(c0 + (tid >> 5)) * K + 8 * (tid & 31);
    const unsigned d = (unsigned)((tid & 31) >> 4) * HALF_B + offL((unsigned)tid >> 5, (unsigned)tid & 15u);
    const unsigned xa = (unsigned)(((r32 & 3) << 2) | ((r32 >> 2) & 3));
    const unsigned ra = (unsigned)(kq >> 1) * HALF_B + 256u * (unsigned)r32, rb = TILE_B + (unsigned)(kq >> 1) * HALF_B + 256u * (unsigned)(32 * nt + r32);
    typedef float f32x16 __attribute__((ext_vector_type(16)));
    f32x16 acc0, acc1;
#pragma unroll
    for (int r = 0; r < 16; ++r) { acc0[r] = 0.f; acc1[r] = 0.f; }
    u32x4 s0[8], s1[8], s2[8];
    const int nch = K / CHK;
    ld_chunk(s0, ap, bp, K);
    { const int c1 = min(1, nch - 1), c2 = min(2, nch - 1); ld_chunk(s1, ap + c1 * CHK, bp + c1 * CHK, K); ld_chunk(s2, ap + c2 * CHK, bp + c2 * CHK, K); }
    __syncthreads();
    st_chunk(s0, lds, d);
    __syncthreads();
#define SG_COMPUTE(buf) do { unsigned xo = xa; asm volatile("" : "+v"(xo)); \
        _Pragma("unroll") for (int j = 0; j < 4; ++j) { const unsigned co = 16u * ((unsigned)(8 * (kq & 1) + 2 * j + hi) ^ xo); \
            const bf16x8 b = *(const ATT_LAS bf16x8*)((buf) + rb + co), a0 = *(const ATT_LAS bf16x8*)((buf) + ra + co), a1 = *(const ATT_LAS bf16x8*)((buf) + ra + 8192 + co); \
            acc0 = __builtin_amdgcn_mfma_f32_32x32x16_bf16(b, a0, acc0, 0, 0, 0); acc1 = __builtin_amdgcn_mfma_f32_32x32x16_bf16(b, a1, acc1, 0, 0, 0); } } while (0)
#define SG_STEP(j, SETL, SETS) { const int cc = c + (j); if (cc >= nch) break; \
        { const int cn = min(cc + 3, nch - 1); ld_chunk(SETL, ap + cn * CHK, bp + cn * CHK, K); } \
        SG_COMPUTE(lds + ((j) & 1) * BUF_B); \
        if (cc + 1 < nch) st_chunk(SETS, lds + (((j) + 1) & 1) * BUF_B, d); \
        __syncthreads(); }
    for (int c = 0; c < nch; c += 6) { SG_STEP(0, s0, s1) SG_STEP(1, s1, s2) SG_STEP(2, s2, s0) SG_STEP(3, s0, s1) SG_STEP(4, s1, s2) SG_STEP(5, s2, s0) }
#undef SG_STEP
#undef SG_COMPUTE
    constexpr int PS = 68;
    ATT_LAS float* P = (ATT_LAS float*)lds;
#pragma unroll
    for (int f = 0; f < 2; ++f)
#pragma unroll
        for (int g = 0; g < 4; ++g) { const f32x16& a = f ? acc1 : acc0; f32x4 q = {a[4 * g], a[4 * g + 1], a[4 * g + 2], a[4 * g + 3]};
            *(ATT_LAS f32x4*)(P + ((size_t)(kq * 64 + 32 * f + r32) * PS + 32 * nt + 8 * g + 4 * hi)) = q; }
    __syncthreads();
    { const int m = tid >> 3, n8 = 8 * (tid & 7); f32x4 v0 = {0.f, 0.f, 0.f, 0.f}, v1 = {0.f, 0.f, 0.f, 0.f};
#pragma unroll
      for (int q = 0; q < 4; ++q) { const ATT_LAS f32x4* pp = (const ATT_LAS f32x4*)(P + ((size_t)(q * 64 + m) * PS + n8)); v0 = v0 + pp[0]; v1 = v1 + pp[1]; }
      const size_t off = ((size_t)r0 + m) * 1024 + c0 + n8; f32x4 b0, b1;
      if (basef) { b0 = __builtin_nontemporal_load((const f32x4*)(basef + off)); b1 = __builtin_nontemporal_load((const f32x4*)(basef + off + 4)); }
      else { const u32x4 bw = *(const u32x4*)(Xb + off);
          b0[0] = __uint_as_float(bw.x << 16); b0[1] = __uint_as_float(bw.x & 0xffff0000u); b0[2] = __uint_as_float(bw.y << 16); b0[3] = __uint_as_float(bw.y & 0xffff0000u);
          b1[0] = __uint_as_float(bw.z << 16); b1[1] = __uint_as_float(bw.z & 0xffff0000u); b1[2] = __uint_as_float(bw.w << 16); b1[3] = __uint_as_float(bw.w & 0xffff0000u); }
      v0 = v0 * alpha + b0; v1 = v1 * alpha + b1;
      float ss = ((v0[0] * v0[0] + v0[1] * v0[1]) + (v0[2] * v0[2] + v0[3] * v0[3])) + ((v1[0] * v1[0] + v1[1] * v1[1]) + (v1[2] * v1[2] + v1[3] * v1[3]));
      ss += __shfl_xor(ss, 1); ss += __shfl_xor(ss, 2); ss += __shfl_xor(ss, 4);
      if (!outf) { u32x4 pw; pw.x = att::cvtpk(v0[0], v0[1]); pw.y = att::cvtpk(v0[2], v0[3]); pw.z = att::cvtpk(v1[0], v1[1]); pw.w = att::cvtpk(v1[2], v1[3]); *(u32x4*)(Xb + off) = pw;
          if ((tid & 7) == 0) SSQX[((size_t)r0 + m) * 16 + (c0 >> 6)] = ss; }
      else {
          if ((tid & 7) == 0) __hip_atomic_store(SSQX + ((size_t)r0 + m) * 16 + (c0 >> 6), ss, __ATOMIC_RELAXED, __HIP_MEMORY_SCOPE_AGENT);
          asm volatile("s_waitcnt vmcnt(0)" ::: "memory");
          __syncthreads();
          if (tid == 0) { __hip_atomic_fetch_add(cnt, 1u, __ATOMIC_RELAXED, __HIP_MEMORY_SCOPE_AGENT); unsigned sp = 0u;
              while (__hip_atomic_load(cnt, __ATOMIC_RELAXED, __HIP_MEMORY_SCOPE_AGENT) < 16u) { __builtin_amdgcn_s_sleep(2); if (++sp > (1u << 22)) break; }
              __builtin_amdgcn_fence(__ATOMIC_ACQUIRE, "agent"); }
          asm volatile("s_waitcnt vmcnt(0)" ::: "memory");
          __syncthreads();
          const unsigned long long* sl = (const unsigned long long*)(SSQX + ((size_t)r0 + m) * 16); float t = 0.f;
#pragma unroll
          for (int j = 0; j < 8; ++j) { const unsigned long long w = __hip_atomic_load(sl + j, __ATOMIC_RELAXED, __HIP_MEMORY_SCOPE_AGENT); t += __uint_as_float((unsigned)w) + __uint_as_float((unsigned)(w >> 32)); }
          const float rs = 1.0f / sqrtf(t * (1.0f / 1024.0f) + 1e-6f);
          const f32x4 g0 = *(const f32x4*)(gain + c0 + n8), g1 = *(const f32x4*)(gain + c0 + n8 + 4);
          *(f32x4*)(outf + off) = v0 * rs * g0; *(f32x4*)(outf + off + 4) = v1 * rs * g1; } }
}
}
constexpr size_t MiB = 1u << 20;
constexpr size_t WS_CTL = 0, CTL_ZERO_BYTES = 64 * 1024;
constexpr size_t WS_WGU1 = 2 * MiB, WS_WD1 = 14 * MiB, WS_WGU2 = 20 * MiB, WS_WD2 = 32 * MiB, WS_WIN = 38 * MiB, WS_WOUT = 42 * MiB, WS_WQ = 44 * MiB, WS_SUM = 46 * MiB, WS_WGT = 48 * MiB, WS_SSQ = 49 * MiB, WS_KCS = 50 * MiB, WS_WUVF = 51 * MiB, WS_CKV = 52 * MiB, WS_SSQX = 61 * MiB, WS_WQP = 45 * MiB, WS_WKV = 45 * MiB + 512 * 1024;
static_assert(WS_SSQX + (size_t)R * 64 <= 64 * MiB && WS_WQ + (size_t)NQ * QL * 2 <= WS_WQP && WS_WQP + (size_t)NH * 96 * QL * 2 <= WS_WKV && WS_WKV + (size_t)NH * 128 * KVL * 2 <= WS_SUM, "workspace map");
constexpr size_t WS_XN = 64 * MiB, WS_H = 100 * MiB, WS_X1 = 200 * MiB, WS_X2 = 270 * MiB, WS_Z = 340 * MiB, WS_QALL = 444 * MiB, WS_CQN = 530 * MiB;
constexpr size_t WS_A = 540 * MiB, WS_U = 576 * MiB, WS_YL = 612 * MiB, WS_OLAT = 648 * MiB, WS_YC = 720 * MiB, WS_QB = 760 * MiB, WS_KC = 820 * MiB, WS_PART = 830 * MiB, WS_XL = 900 * MiB, WS_GG = 920 * MiB, WS_CQ = 940 * MiB, WS_QBP = 950 * MiB, WS_KVH = 980 * MiB, WS_CKVB = 1024 * MiB, WS_SSQM = 1030 * MiB, WS_XCH = 1032 * MiB  , WS_END = 1034 * MiB;
constexpr int CW_QUE = 256;
constexpr int CW_BAR = 1024;
constexpr int CW_FIN = 8192, CW_FINS = 12288;
static_assert((CW_BAR + XCD_BAR_WORDS) <= CW_FIN && (CW_FINS + 64 * (RS / 64)) * 4 <= (int)CTL_ZERO_BYTES && CW_FIN + 64 * (RP / 256) <= CW_FINS, "CTL");
constexpr int RING_BYTES = 131072, LDS_BYTES = 147456, LDSCTL_OFF = LDS_BYTES - 1024, MISC_OFF = LDSCTL_OFF + 320;
static_assert(att::PR_LDS_END <= LDSCTL_OFF, "prompt attention LDS map");
constexpr int NSPLIT = 2;
constexpr int CHUNK = 64, NCHUNK = SEQ / CHUNK;

struct Params { const float* in[33]; float* out; unsigned char* ws; int ph_lo, ph_hi; };
static_assert(sizeof(Params) == 33 * 8 + 8 + 8 + 8, "Params has no padding");

__device__ __forceinline__ void transpose_tile(const float* __restrict__ src, int ldw, bf16* __restrict__ dst, int ldt, LAS float* scr, int lane, const float* __restrict__ gain) {
    {
        const float* wp = src + (size_t)(lane >> 5) * ldw + (lane & 31); float v[32];
#pragma unroll
        for (int i = 0; i < 32; ++i) v[i] = __builtin_nontemporal_load(wp + (size_t)(2 * i) * ldw);
        if (gain) { float g[32];
#pragma unroll
            for (int i = 0; i < 32; ++i) g[i] = gain[2 * i + (lane >> 5)];
#pragma unroll
            for (int i = 0; i < 32; ++i) v[i] *= g[i]; }
#pragma unroll
        for (int i = 0; i < 32; ++i) scr[(2 * i + (lane >> 5)) * 33 + (lane & 31)] = v[i]; }
    LDS_WAIT(); asm volatile("" ::: "memory");
    const int c = lane & 7;
#pragma unroll
    for (int j = 0; j < 4; ++j) { const int n = (lane >> 3) + 8 * j; const LAS float* sp = scr + (8 * c) * 33 + n;
        v4u o; o.x = pk2(sp[0 * 33], sp[1 * 33]); o.y = pk2(sp[2 * 33], sp[3 * 33]); o.z = pk2(sp[4 * 33], sp[5 * 33]); o.w = pk2(sp[6 * 33], sp[7 * 33]);
        *(v4u*)(dst + (size_t)n * ldt + 8 * c) = o; }
    LDS_WAIT(); asm volatile("" ::: "memory");
}
template <bool OUT_BF16>
__device__ __forceinline__ void rmsnorm_rows(const float* __restrict__ x0, const float* __restrict__ x1, int split, const float* __restrict__ gain, void* __restrict__ outp) {
    const int lane = threadIdx.x & 63, gw = blockIdx.x * 8 + __builtin_amdgcn_readfirstlane(threadIdx.x >> 6), NGW = gridDim.x * 8;
    for (int row = gw; row < R; row += NGW) {
        const float* xr = (row < split) ? x0 + (size_t)row * DM : x1 + (size_t)(row - split) * DM;
        f32x4 v[4]; float s = 0.f;
#pragma unroll
        for (int j = 0; j < 4; ++j) { v[j] = ((const f32x4*)xr)[lane + 64 * j]; s += (v[j].x * v[j].x + v[j].y * v[j].y) + (v[j].z * v[j].z + v[j].w * v[j].w); }
        const float rstd = 1.0f / sqrtf(wave_sum(s) * (1.0f / DM) + EPS);
#pragma unroll
        for (int j = 0; j < 4; ++j) { const f32x4 g = ((const f32x4*)gain)[lane + 64 * j]; const f32x4 o = v[j] * rstd * g;
            if (OUT_BF16) { unsigned long long w = (unsigned long long)pk2(o.x, o.y) | ((unsigned long long)pk2(o.z, o.w) << 32); ((unsigned long long*)((bf16*)outp + (size_t)row * DM))[lane + 64 * j] = w; }
            else ((f32x4*)((float*)outp + (size_t)row * DM))[lane + 64 * j] = o; }
    }
}
__device__ __forceinline__ void final_norm_rows(const bf16* __restrict__ XB, const float* __restrict__ SSQX, const float* __restrict__ gain, float* __restrict__ outp) {
    const int lane = threadIdx.x & 63, gw = blockIdx.x * 8 + __builtin_amdgcn_readfirstlane(threadIdx.x >> 6), NGW = gridDim.x * 8;
    const f32x4 g00 = ((const f32x4*)gain)[2 * lane], g01 = ((const f32x4*)gain)[2 * lane + 1], g10 = ((const f32x4*)gain)[2 * (lane + 64)], g11 = ((const f32x4*)gain)[2 * (lane + 64) + 1];
    for (int row = gw; row < R; row += 2 * NGW) {
        const int row2 = row + NGW; const bool two = row2 < R; const int rb_ = two ? row2 : row;
        const v4u wa0 = ((const v4u*)(XB + (size_t)row * DM))[lane], wa1 = ((const v4u*)(XB + (size_t)row * DM))[lane + 64];
        const v4u wb0 = ((const v4u*)(XB + (size_t)rb_ * DM))[lane], wb1 = ((const v4u*)(XB + (size_t)rb_ * DM))[lane + 64];
        const f32x4* spa = (const f32x4*)(SSQX + (size_t)row * 16); const f32x4* spb = (const f32x4*)(SSQX + (size_t)rb_ * 16);
        const f32x4 ta = (spa[0] + spa[1]) + (spa[2] + spa[3]), tb = (spb[0] + spb[1]) + (spb[2] + spb[3]);
        const float ra = 1.0f / sqrtf(((ta[0] + ta[1]) + (ta[2] + ta[3])) * (1.0f / DM) + EPS), rbs = 1.0f / sqrtf(((tb[0] + tb[1]) + (tb[2] + tb[3])) * (1.0f / DM) + EPS);
#define FN_OUT(W_, RS_, GA_, GB_, DST_) do { f32x4 o0, o1; \
            o0[0] = __uint_as_float((W_).x << 16) * (RS_) * (GA_)[0]; o0[1] = __uint_as_float((W_).x & 0xffff0000u) * (RS_) * (GA_)[1]; o0[2] = __uint_as_float((W_).y << 16) * (RS_) * (GA_)[2]; o0[3] = __uint_as_float((W_).y & 0xffff0000u) * (RS_) * (GA_)[3]; \
            o1[0] = __uint_as_float((W_).z << 16) * (RS_) * (GB_)[0]; o1[1] = __uint_as_float((W_).z & 0xffff0000u) * (RS_) * (GB_)[1]; o1[2] = __uint_as_float((W_).w << 16) * (RS_) * (GB_)[2]; o1[3] = __uint_as_float((W_).w & 0xffff0000u) * (RS_) * (GB_)[3]; \
            (DST_)[0] = o0; (DST_)[1] = o1; } while (0)
        FN_OUT(wa0, ra, g00, g01, (f32x4*)(outp + (size_t)row * DM) + 2 * lane);
        FN_OUT(wa1, ra, g10, g11, (f32x4*)(outp + (size_t)row * DM) + 2 * (lane + 64));
        if (two) { FN_OUT(wb0, rbs, g00, g01, (f32x4*)(outp + (size_t)row2 * DM) + 2 * lane); FN_OUT(wb1, rbs, g10, g11, (f32x4*)(outp + (size_t)row2 * DM) + 2 * (lane + 64)); }
#undef FN_OUT
    }
}
template <int MODE>
__device__ __forceinline__ void weight_items(const Params& p, LAS unsigned char* lds, int gw, int NGW) {
    const int tid = threadIdx.x, lane = tid & 63, wave = __builtin_amdgcn_readfirstlane(tid >> 6);
    unsigned char* ws = p.ws;
    LAS float* scr = (LAS float*)(lds + wave * 16384);
    constexpr int I_F = (DM / 64) * (DFF / 32), I_IN = (DM / 64) * (DIN / 32), I_OUT = (DMIX / 64) * (DM / 32);
    constexpr int I_WQ = NH * (QL / 64) * (KVL / 8), I_QP = (QL / 64) * (NH * 96 / 32), I_QR = (QL / 64) * NH, I_KV = (KVL / 64) * NH * 4, I_GT = NBLK * 2 * 2;
    constexpr int NITEMS = I_WQ + 6 * I_F + I_IN + I_OUT + I_QP + I_QR + I_KV + I_GT;
    static_assert((DFF / 64) * (DM / 32) == I_F, "down items");
    const float* wq = p.in[21]; const float* wuk = p.in[23]; const float* qn = p.in[20]; bf16* WqT = (bf16*)(ws + WS_WQ);
    constexpr bool LATE = MODE == 2;
    constexpr int NE = 2 * I_F, NM = I_F + I_IN, NL = NITEMS - I_WQ - NE - NM;
    for (int it = gw; it < (MODE == 2 ? I_WQ + NL : MODE == 1 ? NM : NE); it += NGW) {
        int r;
        if (MODE == 2) { r = it; if (it >= I_WQ) { const int l = it - I_WQ; r = I_WQ + (l < 3 * I_F ? l + 3 * I_F : l + 3 * I_F + I_IN); } }
        else if (MODE == 1) r = I_WQ + (it < I_F ? it + 2 * I_F : it + 5 * I_F);
        else r = I_WQ + it;
        if (r < I_WQ) {
            const int h = r / ((QL / 64) * (KVL / 8)), kt = (r / (KVL / 8)) % (QL / 64), cg = r % (KVL / 8), k = 64 * kt + lane;
            f32x4 a[16];
#pragma unroll
            for (int j = 0; j < 16; ++j) a[j] = *(const f32x4*)(wq + (size_t)k * (NH * 96) + h * 96 + 4 * j);
            const float gk = qn[k];
#pragma unroll 1
            for (int c = 8 * cg; c < 8 * cg + 8; c += 2) { const f32x4* b0 = (const f32x4*)(wuk + ((size_t)c * NH + h) * NOPE); const f32x4* b1 = (const f32x4*)(wuk + ((size_t)(c + 1) * NH + h) * NOPE);
                f32x4 u[16], w[16];
#pragma unroll
                for (int j = 0; j < 16; ++j) { u[j] = b0[j]; w[j] = b1[j]; }
                f32x4 s4 = {0.f, 0.f, 0.f, 0.f}, t4 = {0.f, 0.f, 0.f, 0.f};
#pragma unroll
                for (int j = 0; j < 16; ++j) { s4 = s4 + a[j] * u[j]; t4 = t4 + a[j] * w[j]; }
                WqT[(size_t)(h * KVL + c) * QL + k] = (bf16)f2bf(((s4[0] + s4[1]) + (s4[2] + s4[3])) * gk);
                WqT[(size_t)(h * KVL + c + 1) * QL + k] = (bf16)f2bf(((t4[0] + t4[1]) + (t4[2] + t4[3])) * gk); }
            continue; }
        r -= I_WQ;
        const float* src; bf16* dst; const float* gain = nullptr; int ldw, ldt;
        if (r < 6 * I_F) { const int which = r / I_F, q = r % I_F;
            const bool down = which == 2 || which == 5; const int K = down ? DFF : DM, N = down ? DM : DFF, nblk = N / 32, k0 = 64 * (q / nblk), n0 = 32 * (q % nblk);
            const int inp = which == 0 ? 8 : which == 1 ? 9 : which == 2 ? 10 : which == 3 ? 29 : which == 4 ? 30 : 31;
            const size_t wsoff = which < 2 ? WS_WGU1 : which == 2 ? WS_WD1 : which < 5 ? WS_WGU2 : WS_WD2;
            const int drow0 = down ? n0 : 256 * (n0 / 128) + (n0 % 128) + ((which == 1 || which == 4) ? 128 : 0);
            src = p.in[inp] + (size_t)k0 * N + n0; ldw = N; dst = (bf16*)(ws + wsoff) + (size_t)drow0 * K + k0; ldt = K; if (which == 3 || which == 4) gain = p.in[28] + k0; }
        else if ((r -= 6 * I_F) < I_IN) { const int nblk = DIN / 32, k0 = 64 * (r / nblk), n0 = 32 * (r % nblk);
            src = p.in[12] + (size_t)k0 * DIN + n0; ldw = DIN; dst = (bf16*)(ws + WS_WIN) + (size_t)n0 * DM + k0; ldt = DM; gain = p.in[11] + k0; }
        else if ((r -= I_IN) < I_OUT) { const int nblk = DM / 32, k0 = 64 * (r / nblk), n0 = 32 * (r % nblk);
            src = p.in[27] + (size_t)k0 * DM + n0; ldw = DM; dst = (bf16*)(ws + WS_WOUT) + (size_t)n0 * DMIX + k0; ldt = DMIX; }
        else if ((r -= I_OUT) < I_QP) { const int nblk = NH * 96 / 32, k0 = 64 * (r / nblk), n0 = 32 * (r % nblk);
            const int col = (n0 < NH * NOPE) ? (n0 / NOPE) * 96 + (n0 % NOPE) : ((n0 - NH * NOPE) / ROPE) * 96 + NOPE;
            src = wq + (size_t)k0 * (NH * 96) + col; ldw = NH * 96; dst = (bf16*)(ws + WS_WQP) + (size_t)n0 * QL + k0; ldt = QL; gain = qn + k0; }
        else if ((r -= I_QP) < I_QR) { const int k0 = 64 * (r / NH), h = r % NH;
            src = wq + (size_t)k0 * (NH * 96) + h * 96 + NOPE; ldw = NH * 96; dst = WqT + (size_t)(NH * KVL + ROPE * h) * QL + k0; ldt = QL; gain = qn + k0; }
        else if ((r -= I_QR) < I_KV) { const int c0 = 64 * (r / (NH * 4)), h = (r >> 2) % NH, jb = r & 3;
            src = (jb < 2 ? wuk : p.in[24]) + (size_t)c0 * (NH * NOPE) + h * NOPE + 32 * (jb & 1); ldw = NH * NOPE; dst = (bf16*)(ws + WS_WKV) + (size_t)(h * 128 + 32 * jb) * KVL + c0; ldt = KVL; gain = p.in[22] + c0; }
        else { r -= I_KV; const int n = r >> 2, g = (r >> 1) & 1, eb = r & 1;
            src = (g ? p.in[17] : p.in[15]) + (size_t)n * BLK * BLK + 32 * eb; ldw = BLK; dst = (bf16*)(ws + WS_WGT) + (size_t)((n * 2 + g) * BLK + 32 * eb) * BLK; ldt = BLK; }
        transpose_tile(src, ldw, dst, ldt, scr, lane, gain);
    }
}
__device__ __forceinline__ void p_prologue(const Params& p, LAS unsigned char* lds) {
    const int tid = threadIdx.x, lane = tid & 63, wave = __builtin_amdgcn_readfirstlane(tid >> 6), gw = blockIdx.x * 8 + wave, NGW = gridDim.x * 8;
    unsigned char* ws = p.ws;
    LAS float* scr = (LAS float*)(lds + wave * 16384);
    weight_items<0>(p, lds, gw, NGW);
    const int gt = blockIdx.x * 512 + tid, NGT = gridDim.x * 512;
    { unsigned* z = (unsigned*)((bf16*)(ws + WS_WIN) + (size_t)DIN * DM); for (int i = gt; i < (DINP - DIN) * DM / 2; i += NGT) z[i] = 0u; }
    { const int xcd = (int)(blockIdx.x & 7), jb = (int)(blockIdx.x >> 3), nb = (int)(gridDim.x >> 3); const float* gain = p.in[7]; bf16* XNp = (bf16*)(ws + WS_XN);
      if ((gridDim.x & 7) == 0) {
          const int rows_x = R / 8, r_lo = xcd * rows_x + (jb * rows_x) / nb, r_hi = xcd * rows_x + ((jb + 1) * rows_x) / nb;
          for (int row = r_lo + 2 * wave; row < r_hi; row += 16) {
              const bool two = row + 1 < r_hi;
              const float* xa = (row < RP) ? p.in[0] + (size_t)row * DM : p.in[1] + (size_t)(row - RP) * DM;
              const float* xb = (row + 1 < RP) ? p.in[0] + (size_t)(row + 1) * DM : p.in[1] + (size_t)(row + 1 - RP) * DM;
              f32x4 va[4], vb[4]; float sa = 0.f, sb = 0.f;
#pragma unroll
              for (int j = 0; j < 4; ++j) { va[j] = ((const f32x4*)xa)[lane + 64 * j]; vb[j] = two ? ((const f32x4*)xb)[lane + 64 * j] : va[j]; }
#pragma unroll
              for (int j = 0; j < 4; ++j) { sa += (va[j].x * va[j].x + va[j].y * va[j].y) + (va[j].z * va[j].z + va[j].w * va[j].w); sb += (vb[j].x * vb[j].x + vb[j].y * vb[j].y) + (vb[j].z * vb[j].z + vb[j].w * vb[j].w); }
              const float ra = 1.0f / sqrtf(wave_sum(sa) * (1.0f / DM) + EPS), rb = 1.0f / sqrtf(wave_sum(sb) * (1.0f / DM) + EPS);
#pragma unroll
              for (int j = 0; j < 4; ++j) { const f32x4 g = ((const f32x4*)gain)[lane + 64 * j]; const f32x4 oa = va[j] * ra * g, ob = vb[j] * rb * g;
                  ((unsigned long long*)(XNp + (size_t)row * DM))[lane + 64 * j] = (unsigned long long)pk2(oa.x, oa.y) | ((unsigned long long)pk2(oa.z, oa.w) << 32);
                  if (two) ((unsigned long long*)(XNp + (size_t)(row + 1) * DM))[lane + 64 * j] = (unsigned long long)pk2(ob.x, ob.y) | ((unsigned long long)pk2(ob.z, ob.w) << 32); }
          }
      } else rmsnorm_rows<true>(p.in[0], p.in[1], RP, p.in[7], ws + WS_XN);
    }
}

__device__ __forceinline__ float half_sum(float v, LAS float* red4) {
    v = wave_sum(v);
    __syncthreads();
    if ((threadIdx.x & 63) == 0) red4[(threadIdx.x >> 6) & 3] = v;
    __syncthreads();
    return (red4[0] + red4[1]) + (red4[2] + red4[3]);
}
__device__ __forceinline__ void p_ckv_norm(const Params& p) {
    const int lane = threadIdx.x & 63, gw = blockIdx.x * 8 + __builtin_amdgcn_readfirstlane(threadIdx.x >> 6), NGW = gridDim.x * 8;
    const float* CKV = (const float*)(p.ws + WS_CKV); const float* SSQ = (const float*)(p.ws + WS_SSQ); bf16* KC = (bf16*)(p.ws + WS_KC); bf16* KCS = (bf16*)(p.ws + WS_KCS);
    const float2 g2 = ((const float2*)p.in[22])[lane];
    for (int row = gw; row < R; row += NGW) {
        const float2 v = ((const float2*)(CKV + (size_t)row * KVL))[lane]; const f32x4 sq = *(const f32x4*)(SSQ + (size_t)row * 8 + 4);
        const float rstd = 1.0f / sqrtf(((sq[0] + sq[1]) + (sq[2] + sq[3])) * (1.0f / KVL) + EPS);
        float2 o; o.x = v.x * rstd * g2.x; o.y = v.y * rstd * g2.y;
        if (row < RP) { ((float2*)(p.out + O_KVP + (size_t)row * KVL))[lane] = o; }
        else { ((float2*)(p.out + O_KVS + (size_t)(row - RP) * KVL))[lane] = o; ((unsigned*)(KCS + (size_t)(row - RP) * QD))[lane] = pk2(o.x, o.y); }
    }
}

__device__ __forceinline__ void p_mla_norm(const Params& p, int first_block, int nblocks) {
    const int lane = threadIdx.x & 63, gw = ((int)blockIdx.x - first_block) * 8 + __builtin_amdgcn_readfirstlane(threadIdx.x >> 6), NGW = nblocks * 8;
    bf16* YCp = (bf16*)(p.ws + WS_YC); const float* SSQM = (const float*)(p.ws + WS_SSQM); const float* gm = p.in[26];
    const f32x4 g0 = ((const f32x4*)gm)[2 * lane], g1 = ((const f32x4*)gm)[2 * lane + 1];
    for (int row0 = gw; row0 < RP; row0 += 4 * NGW) {
        v4u w[4]; f32x4 t[4];
#pragma unroll
        for (int i = 0; i < 4; ++i) { const int row = row0 + i * NGW < RP ? row0 + i * NGW : row0;
            w[i] = *((const v4u*)(YCp + (size_t)row * DMIX + DLRU) + lane); const f32x4* sp = (const f32x4*)(SSQM + (size_t)row * NH); t[i] = sp[0] + sp[1]; }
#pragma unroll
        for (int i = 0; i < 4; ++i) { const int row = row0 + i * NGW; if (row < RP) {
            const float rstd = 1.0f / sqrtf(((t[i][0] + t[i][1]) + (t[i][2] + t[i][3])) * (1.0f / DMLA) + EPS); v4u o;
            o.x = pk2(__uint_as_float(w[i].x << 16) * rstd * g0[0], __uint_as_float(w[i].x & 0xffff0000u) * rstd * g0[1]); o.y = pk2(__uint_as_float(w[i].y << 16) * rstd * g0[2], __uint_as_float(w[i].y & 0xffff0000u) * rstd * g0[3]);
            o.z = pk2(__uint_as_float(w[i].z << 16) * rstd * g1[0], __uint_as_float(w[i].z & 0xffff0000u) * rstd * g1[1]); o.w = pk2(__uint_as_float(w[i].w << 16) * rstd * g1[2], __uint_as_float(w[i].w & 0xffff0000u) * rstd * g1[3]);
            *((v4u*)(YCp + (size_t)row * DMIX + DLRU) + lane) = o; } }
    }
}

#define GEMM_PHASE_AT(Epi, shift, Mm, Aptr, Bptr, Nn, Kk, Eobj) do { pg8::Gemm g_{(const pg8::bf16_t*)(Aptr), (const pg8::bf16_t*)(Bptr), (Mm), (Nn), (Kk)}; pg8::StaticOrder S_; S_.init((Mm), (Nn), (int)gridDim.x, (int)((blockIdx.x + gridDim.x - (shift)) % gridDim.x)); \
    pg8::gemm_phase<Epi, pg8::StaticOrder, true, true>((PG8_LAS unsigned char*)lds, g_, S_, (Eobj)); } while (0)
#define GEMM_PHASE(Epi, Mm, Aptr, Bptr, Nn, Kk, Eobj) do { pg8::Gemm g_{(const pg8::bf16_t*)(Aptr), (const pg8::bf16_t*)(Bptr), (Mm), (Nn), (Kk)}; pg8::StaticOrder S_; S_.init((Mm), (Nn), (int)gridDim.x, (int)blockIdx.x); \
    pg8::gemm_phase<Epi, pg8::StaticOrder, true, true>((PG8_LAS unsigned char*)lds, g_, S_, (Eobj)); } while (0)
constexpr int N_PHASES = 13;
__global__ void __launch_bounds__(512, 2) mega(Params p) {
    extern __shared__ __attribute__((aligned(16))) unsigned char lds_raw[];
    LAS unsigned char* lds = (LAS unsigned char*)lds_raw;
    volatile LAS unsigned* MISC = (volatile LAS unsigned*)(lds + MISC_OFF);
    for (int u = threadIdx.x; u < (LDS_BYTES - LDSCTL_OFF) / 4; u += 512) ((LAS unsigned*)(lds + LDSCTL_OFF))[u] = 0u;
    __syncthreads();
    unsigned char* ws = p.ws; float* out = p.out;
    XcdBarrier bar = xcd_barrier_post((unsigned*)(ws + WS_CTL) + CW_BAR, MISC + 8);
    const int lo = p.ph_lo, hi = p.ph_hi;
#ifdef ONLY_PHASE
#define IN(k) ((k) == ONLY_PHASE && lo <= (k) && (k) < hi)
#else
#define IN(k) (lo <= (k) && (k) < hi)
#endif
#ifndef PROBE
#define PROBE -1
#endif
#define SEAM(k) do { if (IN(k) && IN((k) + 1)) { xcd_barrier(bar); if (PROBE == 99) xcd_barrier(bar); } } while (0)
#define REP(id, ...) do { __VA_ARGS__; if (PROBE == (id)) { __syncthreads(); __VA_ARGS__; } } while (0)
#define Wgu1 ((bf16*)(ws + WS_WGU1))
#define Wd1 ((bf16*)(ws + WS_WD1))
#define Wgu2 ((bf16*)(ws + WS_WGU2))
#define Wd2 ((bf16*)(ws + WS_WD2))
#define Win ((bf16*)(ws + WS_WIN))
#define Wout ((bf16*)(ws + WS_WOUT))
#define Wq ((bf16*)(ws + WS_WQ))
#define XN ((bf16*)(ws + WS_XN))
#define H ((bf16*)(ws + WS_H))
#define YC ((bf16*)(ws + WS_YC))
#define Qb ((bf16*)(ws + WS_QB))
#define KC ((bf16*)(ws + WS_KC))
#define PART ((float*)(ws + WS_PART))
#define CKV ((float*)(ws + WS_CKV))
#define SSQ ((float*)(ws + WS_SSQ))
#define SUM ((float*)(ws + WS_SUM))
#define SSQX ((float*)(ws + WS_SSQX))
#define XL ((bf16*)(ws + WS_XL))
#define GG ((bf16*)(ws + WS_GG))
#define CQ ((bf16*)(ws + WS_CQ))
#define KCS ((bf16*)(ws + WS_KCS))
#define WGT ((bf16*)(ws + WS_WGT))
#define WUVF ((bf16*)(ws + WS_WUVF))
#define WqP ((bf16*)(ws + WS_WQP))
#define Wkv ((bf16*)(ws + WS_WKV))
#define QbP ((bf16*)(ws + WS_QBP))
#define KVH ((bf16*)(ws + WS_KVH))
#define CKVB ((bf16*)(ws + WS_CKVB))
#define SSQM ((float*)(ws + WS_SSQM))
    if (IN(0)) REP(0, p_prologue(p, lds));
    SEAM(0);
    if (IN(1)) { pg8::EpiSwiGLU E{H, nullptr, DFF, 0}; REP(1, GEMM_PHASE(pg8::EpiSwiGLU, R, XN, Wgu1, NGU, DM, E));
        { const int G = (int)gridDim.x, nwg1 = (R / 256) * (NGU / 256), rem = nwg1 % G; int fb = rem, nfree = G - rem; if (rem == 0 || nfree < 32) { fb = 0; nfree = G; }
          __syncthreads();
          if ((int)blockIdx.x >= fb) weight_items<1>(p, lds, ((int)blockIdx.x - fb) * 8 + __builtin_amdgcn_readfirstlane(threadIdx.x >> 6), nfree * 8); } }
    SEAM(1);
    if (IN(2)) {
        if (blockIdx.x & 1) for (int mu = blockIdx.x; mu < (RS / 64) * (DM / 64); mu += gridDim.x) { const int r0 = RP + 64 * (mu >> 4), c0 = 64 * (mu & 15);
            sg::unit64((att::ldsp)lds, H, Wd1, DFF, r0, c0, p.in[1] - (size_t)RP * DM, XN, SSQX, 0.5f); }
        { pg8::EpiRes<true> E{p.in[0], XN, SSQX, 0.5f, 0}; GEMM_PHASE(pg8::EpiRes<true>, RP, H, Wd1, DM, DFF, E); }
        if (!(blockIdx.x & 1)) for (int mu = blockIdx.x; mu < (RS / 64) * (DM / 64); mu += gridDim.x) { const int r0 = RP + 64 * (mu >> 4), c0 = 64 * (mu & 15);
            sg::unit64((att::ldsp)lds, H, Wd1, DFF, r0, c0, p.in[1] - (size_t)RP * DM, XN, SSQX, 0.5f); }
    }
    SEAM(2);
    if (IN(4)) { pg8::EpiZ E{XL, GG, CQ, CKV, SSQ, out, KC, KCS, SSQX, CKVB}; REP(4, GEMM_PHASE(pg8::EpiZ, R, XN, Win, DINP, DM, E));
        { const int G = (int)gridDim.x, nwg4 = (R / 256) * (DINP / 256), rem = nwg4 % G; int fb = rem, nfree = G - rem; if (rem == 0 || nfree < 32) { fb = 0; nfree = G; }
          __syncthreads();
          if ((int)blockIdx.x >= fb) weight_items<2>(p, lds, ((int)blockIdx.x - fb) * 8 + __builtin_amdgcn_readfirstlane(threadIdx.x >> 6), nfree * 8); } }
    SEAM(4);
    lru::State st;
    const bool has_chunk = blockIdx.x < NB * NCHUNK;
    const int cb_ = (int)blockIdx.x / NCHUNK, cc_ = (int)blockIdx.x % NCHUNK;
    const size_t crow0 = (size_t)cb_ * SEQ + (size_t)cc_ * CHUNK;
    if (IN(5)) {
        { pg8::EpiQP E{QbP, SSQ, QSCALE, 0}; GEMM_PHASE_AT(pg8::EpiQP, 0, RP, CQ, WqP, NH * 96, QL, E); }
        { pg8::EpiQ E{Qb + (size_t)RP * NH * QD, SSQ + (size_t)RP * 8, QSCALE, 1}; GEMM_PHASE_AT(pg8::EpiQ, 192, RS, CQ + (size_t)RP * QL, Wq, NQ, QL, E); }
        { pg8::EpiKV E{KVH, SSQ, KC}; GEMM_PHASE_AT(pg8::EpiKV, 64, RP, CKVB, Wkv, NH * 128, KVL, E); }
        REP(51, p_ckv_norm(p));
        REP(52, if (has_chunk) lru::unit_pre<false>((att::ldsp)lds, st, XL, WGT, p.in[13], p.in[14], p.in[16], p.in[18], p.in[19], p.in[5], p.in[4], out, crow0, cb_, cc_ * CHUNK, SUM + ((size_t)blockIdx.x * DLRU) * 2));
    }
    SEAM(5);
    if (IN(6)) {
        if (has_chunk) {
            const int ch = (int)threadIdx.x;
            const float cr = lru::chunk_carry(SUM + (size_t)cb_ * NCHUNK * DLRU * 2, cc_, ch);
            if (cc_ == NCHUNK - 1) { const float2 sv = *(const float2*)(SUM + ((size_t)blockIdx.x * DLRU + ch) * 2); out[O_HP + (size_t)cb_ * DLRU + ch] = sv.y + sv.x * cr; }
            const float c0 = __shfl(cr, (int)threadIdx.x & 31), c1 = __shfl(cr, 32 + ((int)threadIdx.x & 31));
            lru::unit_post((att::ldsp)lds, st, GG, p.in[25], YC, crow0, c0, c1);
        }
        if (threadIdx.x == 0) { *(LAS unsigned*)(lds + att2::L_BAR) = 0u; *(LAS unsigned*)(lds + att2::L_BAR + 64) = 0u; }
        __syncthreads();
        { unsigned bt = 0u;
          if (__builtin_amdgcn_readfirstlane(threadIdx.x >> 6) < 4) {
              _Pragma("unroll 1") for (int bx = (int)blockIdx.x; bx < NB * NH * 16; bx += (int)gridDim.x) { const int x = bx & 7, y = (bx >> 3) & 31, bh = x + 8 * (y & 1), pr = y >> 1;
                  _Pragma("unroll 1") for (int u = 0; u < (PROBE == 61 ? 4 : 2); ++u) att2::prompt_role((att::ldsp)lds, QbP, KVH, SSQM, YC, bh >> 3, bh & 7, (u & 1) ? pr : 31 - pr, bt); }
          } else {
              _Pragma("unroll 1") for (int rep_ = 0; rep_ < (PROBE == 62 ? 2 : 1); ++rep_)
              _Pragma("unroll 1") for (int item = blockIdx.x; item < DB * NSPLIT; item += gridDim.x) { const int db = item / NSPLIT, ch = item % NSPLIT;
                  att2::decode_role((att::ldsp)lds, Qb, p.in[2], p.in[3], (const int*)p.in[6], PART + (size_t)item * 2 * att::PART_FLOATS, db, ch * (NPAGES / NSPLIT), NPAGES / NSPLIT, bt); }
          } }
        __syncthreads();
    }
    SEAM(6);
    if (IN(7)) {
        if (blockIdx.x >= DB + RS / 32) p_mla_norm(p, DB + RS / 32, (int)gridDim.x - (DB + RS / 32));
        if (blockIdx.x >= DB && blockIdx.x < DB + RS / 32) {
            lru::State s2; const int su = (int)blockIdx.x - DB; const size_t r0 = (size_t)RP + 32 * su;
            lru::unit_pre<true, 1>((att::ldsp)lds, s2, XL, WGT, p.in[13], p.in[14], p.in[16], p.in[18], p.in[19], p.in[5], p.in[4], out, r0, 4 * su, 0, nullptr);
            lru::unit_post<1>((att::ldsp)lds, s2, GG, p.in[25], YC, r0, 0.f, 0.f);
        }
        REP(7, for (int db = blockIdx.x; db < DB; db += gridDim.x)
            att::decode_combine((att::ldsp)lds, Qb, out + O_KVS, out + O_KRS, PART + (size_t)db * NSPLIT * 2 * att::PART_FLOATS, NSPLIT, p.in[24], p.in[26], YC, db));
    }
    SEAM(7);
    if (IN(8)) {
        { pg8::EpiRes<false> E{nullptr, XN, SSQX, 1.0f, 0}; REP(80, GEMM_PHASE(pg8::EpiRes<false>, RP, YC, Wout, DM, DMIX, E)); }
        for (int mu = blockIdx.x; mu < (RS / 64) * (DM / 64); mu += gridDim.x) { const int r0 = RP + 64 * (mu >> 4), c0 = 64 * (mu & 15);
            sg::unit64((att::ldsp)lds, YC, Wout, DMIX, r0, c0, nullptr, XN, SSQX, 1.0f); }
    }
    SEAM(8);
    if (IN(10)) { pg8::EpiSwiGLU E{H, SSQX, DFF, 0}; REP(10, GEMM_PHASE(pg8::EpiSwiGLU, R, XN, Wgu2, NGU, DM, E)); }
    SEAM(10);
    if (IN(11)) {
        { pg8::EpiFinal E{(const pg8::bf16_t*)XN, out, p.in[32], (float*)(ws + WS_XCH), (unsigned*)(ws + WS_CTL) + CW_FIN, 0.5f, 0}; GEMM_PHASE(pg8::EpiFinal, RP, H, Wd2, DM, DFF, E); }
        for (int mu = blockIdx.x; mu < (RS / 64) * (DM / 64); mu += gridDim.x) { const int r0 = RP + 64 * (mu >> 4), c0 = 64 * (mu & 15);
            sg::unit64((att::ldsp)lds, H, Wd2, DFF, r0, c0, nullptr, XN, (float*)(ws + WS_XCH), 0.5f, out, p.in[32], (unsigned*)(ws + WS_CTL) + CW_FINS + 64 * (mu >> 4)); }
    }
#undef Wgu1
#undef Wd1
#undef Wgu2
#undef Wd2
#undef Win
#undef Wout
#undef Wq
#undef XN
#undef H
#undef YC
#undef Qb
#undef KC
#undef PART
#undef CKV
#undef SSQ
#undef SUM
#undef SSQX
#undef XL
#undef GG
#undef CQ
#undef KCS
#undef WGT
#undef WUVF
#undef WqP
#undef Wkv
#undef QbP
#undef KVH
#undef CKVB
#undef SSQM
#undef IN
#undef SEAM
}

#ifndef MK_N_LAUNCHES
#define MK_N_LAUNCHES 1
#endif
extern "C" void kernel_launch(void* const* d_in, const int* in_sizes, int n_in, void* d_out, int out_size, void* d_ws, size_t ws_size, hipStream_t stream) {
    static int grid = 0;
    if (grid == 0) {
        if (n_in != 33 || out_size != (int)O_END || ws_size < WS_END) { fprintf(stderr, "kernel_launch: unexpected shapes (n_in %d, out %d, ws %zu)\n", n_in, out_size, ws_size); grid = -1; return; }
        int dev = 0, cus = 0, per_cu = 0;
        if (hipGetDevice(&dev) != hipSuccess || hipDeviceGetAttribute(&cus, hipDeviceAttributeMultiprocessorCount, dev) != hipSuccess) { grid = -1; return; }
        if (hipFuncSetAttribute((const void*)mega, hipFuncAttributeMaxDynamicSharedMemorySize, LDS_BYTES) != hipSuccess) { fprintf(stderr, "kernel_launch: hipFuncSetAttribute failed\n"); grid = -1; return; }
        if (hipOccupancyMaxActiveBlocksPerMultiprocessor(&per_cu, (const void*)mega, 512, LDS_BYTES) != hipSuccess || per_cu < 1) fprintf(stderr, "kernel_launch: occupancy query says %d\n", per_cu);
        (void)hipGetLastError();
        grid = cus;
    }
    if (grid < 0) return;
    (void)hipMemsetAsync((char*)d_ws + WS_CTL, 0, CTL_ZERO_BYTES, stream);
    Params prm; memset(&prm, 0, sizeof(prm));
    for (int i = 0; i < 33; ++i) prm.in[i] = (const float*)d_in[i];
    prm.out = (float*)d_out; prm.ws = (unsigned char*)d_ws;
    if (MK_N_LAUNCHES == 1) { prm.ph_lo = 0; prm.ph_hi = N_PHASES; hipLaunchKernelGGL(mega, dim3(grid), dim3(512), LDS_BYTES, stream, prm); }
    else for (int k = 0; k < N_PHASES; ++k) { prm.ph_lo = k; prm.ph_hi = k + 1; hipLaunchKernelGGL(mega, dim3(grid), dim3(512), LDS_BYTES, stream, prm); }
}
```

```cpp
#include <hip/hip_runtime.h>
#include <cstdio>
#include <cstdint>
#include <cstring>
constexpr int DM = 1024, SEQ = 8192, NB = 2, RP = NB * SEQ, DB = 128, DS = 8, RS = DB * DS, R = RP + RS;
constexpr int PAST = 16384, PAGE = 128, NPAGES = PAST / PAGE;
constexpr int DLRU = 512, NBLK = 8, BLK = 64, CONVW = 4;
constexpr int NH = 8, NOPE = 64, ROPE = 32, VD = 64, QL = 256, KVL = 128, DMLA = 512, DMIX = 1024, DIN = 1440, DINP = 1536;
constexpr int DFF = 2816, NGU = 2 * DFF;
constexpr int NQ = NH * KVL + NH * ROPE;
constexpr int QD = KVL + ROPE;
constexpr float EPS = 1e-6f;
constexpr size_t O_YP = 0, O_YS = O_YP + (size_t)RP * DM, O_KVP = O_YS + (size_t)RS * DM, O_KRP = O_KVP + (size_t)RP * KVL, O_HP = O_KRP + (size_t)RP * ROPE,
                 O_CVP = O_HP + (size_t)NB * DLRU, O_KVS = O_CVP + (size_t)NB * 3 * DLRU, O_KRS = O_KVS + (size_t)RS * KVL, O_HS = O_KRS + (size_t)RS * ROPE,
                 O_CVS = O_HS + (size_t)DB * DLRU, O_END = O_CVS + (size_t)DB * 3 * DLRU;
static_assert(O_END == 20877312, "output size");
__device__ const float ROPE_FREQ[16] = {1.000000000e+00f, 5.623413324e-01f, 3.162277639e-01f, 1.778279394e-01f, 1.000000015e-01f, 5.623413250e-02f, 3.162277490e-02f, 1.778279431e-02f,
                                        9.999999776e-03f, 5.623413250e-03f, 3.162277630e-03f, 1.778279431e-03f, 1.000000047e-03f, 5.623413017e-04f, 3.162277571e-04f, 1.778279402e-04f};
namespace pg8 {
#define PG8_LAS __attribute__((address_space(3)))
typedef unsigned short bf16_t;
typedef short bf16x8 __attribute__((ext_vector_type(8)));
typedef float f32x4 __attribute__((ext_vector_type(4)));
typedef unsigned u32x4 __attribute__((ext_vector_type(4)));
constexpr int BM = 256, BK = 64, HALF = 128, HTB = HALF * BK * 2  , STAGE_BYTES = 8 * HTB, NXCD = 8, WGM = 8;

__host__ __device__ __forceinline__ int lds_byte(int r, int c) { const int st = (r >> 4) * 2 + (c >> 5), rr = r & 15, cc = c & 31, ob = rr * 64 + cc * 2; return st * 1024 + (ob ^ (((ob >> 9) & 1) << 5)); }
__host__ __device__ __forceinline__ void stage_rc(int b, int& R, int& C) { const int st = b / 1024, sb = b % 1024, swz = sb ^ (((sb >> 9) & 1) << 5); R = (st >> 1) * 16 + swz / 64; C = (st & 1) * 32 + (swz % 64) / 2; }
__host__ __device__ __forceinline__ int perm32(int rho) { const int n = rho >> 4, i = rho & 15; return 8 * (i >> 2) + 4 * n + (i & 3); }

struct Unit { int pm, pn; };
struct Gemm { const bf16_t* A; const bf16_t* Bt; int M, N, K; };

struct StaticOrder {
    int nM, nN, nwg, G, c;
    __host__ __device__ void init(int M, int N, int G_, int c_) { nM = M / BM; nN = N / BM; nwg = nM * nN; G = G_; c = c_; }
    __host__ __device__ bool next(int i, Unit& u) const {
        const long L = (long)i * G + c; if (L >= nwg) return false;
        int wgid = (int)L; { const int q = nwg / NXCD, r = nwg % NXCD, xcd = wgid % NXCD, off = wgid / NXCD; wgid = (xcd < r ? xcd * (q + 1) : r * (q + 1) + (xcd - r) * q) + off; }
        const int nig = WGM * nN, gid = wgid / nig, fm = gid * WGM, gsz = (nM - fm) < WGM ? (nM - fm) : WGM;
        u.pm = fm + ((wgid % nig) % gsz); u.pn = (wgid % nig) / gsz; return true;
    }
    __device__ __forceinline__ void a_ready(const Unit&) const {}
    __device__ __forceinline__ void done(const Unit&) const {}
};

__device__ __forceinline__ unsigned cvt_pk_bf16(float lo, float hi) { unsigned r; asm volatile("v_cvt_pk_bf16_f32 %0, %1, %2" : "=v"(r) : "v"(lo), "v"(hi)); return r; }
typedef float f32x2 __attribute__((ext_vector_type(2)));
typedef float f32x2 __attribute__((ext_vector_type(2)));
template <class Epi, class Sched, bool ALIGN_EPI = false, bool SP2 = false>
__device__ __forceinline__ void gemm_phase(PG8_LAS unsigned char* lds, const Gemm g, const Sched& S, const Epi& E) {
    int tid_ = threadIdx.x; asm volatile("" : "+v"(tid_));
    const int tid = tid_, wid = __builtin_amdgcn_readfirstlane(tid >> 6), lane = tid & 63, wr = wid >> 2, wc = wid & 3, fr = lane & 15, fq = lane >> 4;
    const int K = g.K, nt = K / BK;
    unsigned voffA[2], voffB[2];
#pragma unroll
    for (int i = 0; i < 2; ++i) { int R, C; stage_rc(tid * 16 + i * 8192, R, C); const int Rb = Epi::PERM ? ((R & ~31) + perm32(R & 31)) : R;
        voffA[i] = (unsigned)(R * K + C) * 2u; voffB[i] = (unsigned)(Rb * K + C) * 2u; }
    const size_t kstep = (size_t)(BK * 2);
    const size_t hstep = (size_t)HALF * K * 2;
    const size_t tstep = 2 * hstep;
    const unsigned ldsw = (unsigned)wid * 1024u;
    const int aoff = lds_byte(wr * 64 + fr, fq * 8), boff = lds_byte(wc * 32 + fr, fq * 8);
#define PG8_SA(b, h) (((b) * 2 + (h)) * HTB)
#define PG8_SB(b, h) ((4 + (b) * 2 + (h)) * HTB)
#define PG8_STAGE(bufoff, gbase, voff) do { _Pragma("unroll") for (int _i = 0; _i < 2; ++_i) \
        __builtin_amdgcn_global_load_lds((const unsigned*)((const char*)(gbase) + (voff)[_i]), (PG8_LAS unsigned*)(lds + (bufoff) + ldsw + _i * 8192), 16, 0, 0); } while (0)
#define PG8_LDA(dst, b, h) do { _Pragma("unroll") for (int m = 0; m < 4; ++m) _Pragma("unroll") for (int k = 0; k < 2; ++k) dst[m][k] = *(const PG8_LAS bf16x8*)(lds + PG8_SA(b, h) + aoff + m * 2048 + k * 1024); } while (0)
#define PG8_LDB(dst, b, h) do { _Pragma("unroll") for (int n = 0; n < 2; ++n) _Pragma("unroll") for (int k = 0; k < 2; ++k) dst[n][k] = *(const PG8_LAS bf16x8*)(lds + PG8_SB(b, h) + boff + n * 2048 + k * 1024); } while (0)
#define PG8_MMA(ai, bj, At, Bt) do { __builtin_amdgcn_s_setprio(1); _Pragma("unroll") for (int m = 0; m < 4; ++m) _Pragma("unroll") for (int n = 0; n < 2; ++n) _Pragma("unroll") for (int k = 0; k < 2; ++k) \
        acc[ai][bj][m][n] = __builtin_amdgcn_mfma_f32_16x16x32_bf16(Bt[n][k], At[m][k], acc[ai][bj][m][n], 0, 0, 0); __builtin_amdgcn_s_setprio(0); } while (0)
#define PG8_WAIT_V(n) asm volatile("s_waitcnt vmcnt(" #n ")" ::: "memory")
#define PG8_WAIT_L(n) asm volatile("s_waitcnt lgkmcnt(" #n ")" ::: "memory")
#define PG8_BAR __builtin_amdgcn_s_barrier()
#define PG8_SCHED __builtin_amdgcn_sched_barrier(0)
    Unit cur, nxt; int ui = 0;
    if (!S.next(0, cur)) return;
    f32x4 acc[2][2][4][2];
#pragma unroll
    for (int a = 0; a < 2; ++a)
#pragma unroll
        for (int b = 0; b < 2; ++b)
#pragma unroll
            for (int m = 0; m < 4; ++m)
#pragma unroll
                for (int n = 0; n < 2; ++n) acc[a][b][m][n] = (f32x4){0.f, 0.f, 0.f, 0.f};
    bf16x8 At[4][2], B0[2][2], B1[2][2];
    const char* cA = (const char*)g.A + (size_t)cur.pm * tstep; const char* cB = (const char*)g.Bt + (size_t)cur.pn * tstep;
    S.a_ready(cur);
    if constexpr (SP2) {
        PG8_STAGE(PG8_SB(0, 0), cB, voffB); PG8_STAGE(PG8_SB(0, 1), cB + hstep, voffB); PG8_STAGE(PG8_SA(0, 0), cA, voffA); PG8_STAGE(PG8_SA(0, 1), cA + hstep, voffA);
        if (wr == 1) PG8_BAR;
        PG8_WAIT_V(2); PG8_BAR;
        PG8_STAGE(PG8_SB(1, 0), cB + kstep, voffB); PG8_STAGE(PG8_SA(1, 0), cA + kstep, voffA); PG8_STAGE(PG8_SB(1, 1), cB + hstep + kstep, voffB);
        PG8_WAIT_V(6); PG8_BAR;
    } else {
        PG8_STAGE(PG8_SB(0, 0), cB, voffB); PG8_STAGE(PG8_SA(0, 0), cA, voffA); PG8_STAGE(PG8_SB(0, 1), cB + hstep, voffB); PG8_STAGE(PG8_SA(0, 1), cA + hstep, voffA);
        if (wr == 1) PG8_BAR;
        PG8_WAIT_V(4); PG8_BAR;
        PG8_STAGE(PG8_SB(1, 0), cB + kstep, voffB); PG8_STAGE(PG8_SA(1, 0), cA + kstep, voffA); PG8_STAGE(PG8_SB(1, 1), cB + hstep + kstep, voffB);
        PG8_WAIT_V(6); PG8_BAR;
    }
    for (;;) {
        const bool has_next = S.next(ui + 1, nxt);
        const char* nA = has_next ? (const char*)g.A + (size_t)nxt.pm * tstep : cA; const char* nB = has_next ? (const char*)g.Bt + (size_t)nxt.pn * tstep : cB;
        for (int t = 0; t < nt; t += 2) {
            const bool last = (t == nt - 2);
            const char* a1 = cA + (size_t)(t + 1) * kstep;
            const char* a2 = last ? nA : cA + (size_t)(t + 2) * kstep; const char* b2 = last ? nB : cB + (size_t)(t + 2) * kstep;
            const char* a3 = a2 + kstep; const char* b3 = b2 + kstep;
            if (last && has_next) S.a_ready(nxt);
            if constexpr (SP2) {
            PG8_LDB(B0, 0, 0); PG8_LDB(B1, 0, 1); PG8_SCHED; PG8_LDA(At, 0, 0); PG8_STAGE(PG8_SA(1, 1), a1 + hstep, voffA);
            PG8_WAIT_V(8); PG8_WAIT_L(0); PG8_BAR; PG8_MMA(0, 0, At, B0); PG8_MMA(0, 1, At, B1); PG8_BAR; PG8_SCHED;
            PG8_LDA(At, 0, 1); PG8_STAGE(PG8_SB(0, 0), b2, voffB); PG8_STAGE(PG8_SB(0, 1), b2 + hstep, voffB); PG8_STAGE(PG8_SA(0, 0), a2, voffA);
            PG8_WAIT_V(8); PG8_WAIT_L(0); PG8_BAR; PG8_MMA(1, 0, At, B0); PG8_MMA(1, 1, At, B1); PG8_BAR; PG8_SCHED;
            PG8_LDB(B0, 1, 0); PG8_LDB(B1, 1, 1); PG8_SCHED; PG8_LDA(At, 1, 0); PG8_STAGE(PG8_SA(0, 1), a2 + hstep, voffA);
            PG8_WAIT_V(8); PG8_WAIT_L(0); PG8_BAR; PG8_MMA(0, 0, At, B0); PG8_MMA(0, 1, At, B1); PG8_BAR; PG8_SCHED;
            PG8_LDA(At, 1, 1); PG8_STAGE(PG8_SB(1, 0), b3, voffB); PG8_STAGE(PG8_SB(1, 1), b3 + hstep, voffB); PG8_STAGE(PG8_SA(1, 0), a3, voffA);
            PG8_WAIT_V(8); PG8_WAIT_L(0); PG8_BAR; PG8_MMA(1, 0, At, B0); PG8_MMA(1, 1, At, B1); PG8_BAR; PG8_SCHED;
            } else {
            PG8_LDB(B0, 0, 0); PG8_SCHED; PG8_LDA(At, 0, 0); PG8_STAGE(PG8_SA(1, 1), a1 + hstep, voffA);
            PG8_WAIT_L(8); PG8_BAR; PG8_WAIT_L(0); PG8_MMA(0, 0, At, B0); PG8_BAR; PG8_SCHED;
            PG8_LDB(B1, 0, 1); PG8_STAGE(PG8_SB(0, 0), b2, voffB);
            PG8_BAR; PG8_WAIT_L(0); PG8_MMA(0, 1, At, B1); PG8_BAR;
            PG8_LDA(At, 0, 1); PG8_STAGE(PG8_SA(0, 0), a2, voffA);
            PG8_BAR; PG8_WAIT_L(0); PG8_MMA(1, 0, At, B0); PG8_BAR; PG8_SCHED;
            PG8_STAGE(PG8_SB(0, 1), b2 + hstep, voffB);
            PG8_WAIT_V(6); PG8_BAR; PG8_MMA(1, 1, At, B1); PG8_BAR;
            PG8_LDB(B0, 1, 0); PG8_SCHED; PG8_LDA(At, 1, 0); PG8_STAGE(PG8_SA(0, 1), a2 + hstep, voffA);
            PG8_WAIT_L(8); PG8_BAR; PG8_WAIT_L(0); PG8_MMA(0, 0, At, B0); PG8_BAR; PG8_SCHED;
            PG8_LDB(B1, 1, 1); PG8_STAGE(PG8_SB(1, 0), b3, voffB);
            PG8_BAR; PG8_WAIT_L(0); PG8_MMA(0, 1, At, B1); PG8_BAR;
            PG8_LDA(At, 1, 1); PG8_STAGE(PG8_SA(1, 0), a3, voffA);
            PG8_BAR; PG8_WAIT_L(0); PG8_MMA(1, 0, At, B0); PG8_BAR; PG8_SCHED;
            PG8_STAGE(PG8_SB(1, 1), b3 + hstep, voffB);
            PG8_WAIT_V(6); PG8_BAR; PG8_MMA(1, 1, At, B1); PG8_BAR;
            }
        }
        if constexpr (ALIGN_EPI) { if (wr == 0) PG8_BAR; }
        if constexpr (!Epi::AFTER_DRAIN) { E(acc, cur, wr, wc, fr, fq); S.done(cur); }
        if (!has_next) break;
#pragma unroll
        for (int a = 0; a < 2; ++a)
#pragma unroll
            for (int b = 0; b < 2; ++b)
#pragma unroll
                for (int m = 0; m < 4; ++m)
#pragma unroll
                    for (int n = 0; n < 2; ++n) acc[a][b][m][n] = (f32x4){0.f, 0.f, 0.f, 0.f};
        cur = nxt; cA = nA; cB = nB; ++ui;
        if constexpr (ALIGN_EPI) { if (wr == 1) PG8_BAR; }
    }
    PG8_WAIT_V(0);
    if constexpr (!ALIGN_EPI) { if (wr == 0) PG8_BAR; }
    PG8_BAR;
    if constexpr (Epi::AFTER_DRAIN) { E.fused(acc, cur, wr, wc, fr, fq, lds, wid, lane); S.done(cur); }
#undef PG8_SA
#undef PG8_SB
#undef PG8_STAGE
#undef PG8_LDA
#undef PG8_LDB
#undef PG8_MMA
#undef PG8_WAIT_V
#undef PG8_WAIT_L
#undef PG8_BAR
#undef PG8_SCHED
}
}
namespace pg8 {
struct EpiF32 {
    static constexpr bool PERM = false, AFTER_DRAIN = false;
    float* out; const float* base0; const float* base1; int ldc; int split; float alpha; int pad;
    __device__ __forceinline__ void operator()(const f32x4 (&acc)[2][2][4][2], const Unit& u, int wr, int wc, int fr, int fq) const {
        const int col0 = u.pn * BM + wc * 32 + 4 * fq;
        const float* bp = nullptr;
        if (base0) bp = (u.pm < split) ? base0 + (size_t)u.pm * BM * ldc : base1 + (size_t)(u.pm - split) * BM * ldc;
#pragma unroll
        for (int ai = 0; ai < 2; ++ai)
#pragma unroll
            for (int m = 0; m < 4; ++m) { const int rt = ai * HALF + wr * 64 + m * 16 + fr; const size_t off = (size_t)rt * ldc + col0;
                float* orow = out + (size_t)u.pm * BM * ldc + off;
#pragma unroll
                for (int bj = 0; bj < 2; ++bj)
#pragma unroll
                    for (int n = 0; n < 2; ++n) { f32x4 v = acc[ai][bj][m][n] * alpha; if (bp) v = v + *(const f32x4*)(bp + off + bj * HALF + n * 16);
                        *(f32x4*)(orow + bj * HALF + n * 16) = v; } }
    }
};
struct EpiSwiGLU {
    static constexpr bool PERM = true, AFTER_DRAIN = false;
    bf16_t* H; const float* SSQX; int ldh; int pad;
    __device__ __forceinline__ void operator()(const f32x4 (&acc)[2][2][4][2], const Unit& u, int wr, int wc, int fr, int fq) const {
        const int col0 = u.pn * HALF + wc * 32 + 8 * fq;
#pragma unroll
        for (int ai = 0; ai < 2; ++ai)
#pragma unroll
            for (int m = 0; m < 4; ++m) { const int row = u.pm * BM + ai * HALF + wr * 64 + m * 16 + fr; bf16_t* rowp = H + (size_t)row * ldh + col0;
                float rs = 1.0f;
                if (SSQX) { const f32x4* sp = (const f32x4*)(SSQX + (size_t)row * 16); const f32x4 s0 = sp[0], s1 = sp[1], s2 = sp[2], s3 = sp[3]; const f32x4 t = (s0 + s1) + (s2 + s3);
                    rs = __builtin_amdgcn_rsqf(((t[0] + t[1]) + (t[2] + t[3])) * (1.0f / 1024.0f) + 1e-6f); }
                float hv[8];
#pragma unroll
                for (int n = 0; n < 2; ++n)
#pragma unroll
                    for (int i = 0; i < 4; ++i) { const float g = acc[ai][0][m][n][i] * rs, up = acc[ai][1][m][n][i] * rs;
                        hv[4 * n + i] = g * __builtin_amdgcn_rcpf(1.0f + __builtin_amdgcn_exp2f(-1.4426950408889634f * g)) * up; }
                u32x4 w; w.x = cvt_pk_bf16(hv[0], hv[1]); w.y = cvt_pk_bf16(hv[2], hv[3]); w.z = cvt_pk_bf16(hv[4], hv[5]); w.w = cvt_pk_bf16(hv[6], hv[7]);
                *(u32x4*)rowp = w; }
    }
};
template <bool BASE_F32> struct EpiRes {
    static constexpr bool PERM = false, AFTER_DRAIN = false;
    const float* basef; bf16_t* Xb; float* SSQX; float alpha; int pad;
    __device__ __forceinline__ void operator()(const f32x4 (&acc)[2][2][4][2], const Unit& u, int wr, int wc, int fr, int fq) const {
        typedef unsigned u32x2 __attribute__((ext_vector_type(2)));
        constexpr int ldc = 1024;
        const int col0 = u.pn * BM + wc * 32 + 4 * fq;
#pragma unroll
        for (int ai = 0; ai < 2; ++ai)
#pragma unroll
            for (int m = 0; m < 4; ++m) { const size_t row = (size_t)u.pm * BM + ai * HALF + wr * 64 + m * 16 + fr; float ss = 0.f;
#pragma unroll
                for (int bj = 0; bj < 2; ++bj)
#pragma unroll
                    for (int n = 0; n < 2; ++n) { const size_t off = row * ldc + col0 + bj * HALF + n * 16; f32x4 bv;
                        if (BASE_F32) bv = *(const f32x4*)(basef + off);
                        else { const u32x2 bw = *(const u32x2*)(Xb + off); bv[0] = __uint_as_float(bw.x << 16); bv[1] = __uint_as_float(bw.x & 0xffff0000u); bv[2] = __uint_as_float(bw.y << 16); bv[3] = __uint_as_float(bw.y & 0xffff0000u); }
                        const f32x4 v = acc[ai][bj][m][n] * alpha + bv;
                        u32x2 w; w.x = cvt_pk_bf16(v[0], v[1]); w.y = cvt_pk_bf16(v[2], v[3]); *(u32x2*)(Xb + off) = w;
                        ss += (v[0] * v[0] + v[1] * v[1]) + (v[2] * v[2] + v[3] * v[3]); }
                ss += __shfl_xor(ss, 16); ss += __shfl_xor(ss, 32); if (fq == 0) SSQX[row * 16 + u.pn * 4 + wc] = ss; }
    }
};
struct EpiFinal {
    static constexpr bool PERM = false, AFTER_DRAIN = true;
    const bf16_t* Xb; float* out; const float* gain; float* xch; unsigned* cnt; float alpha; int pad;
    __device__ __forceinline__ void fused(f32x4 (&acc)[2][2][4][2], const Unit& u, int wr, int wc, int fr, int fq, PG8_LAS unsigned char* lds, int wid, int lane) const {
        typedef unsigned u32x2 __attribute__((ext_vector_type(2)));
        constexpr int ldc = 1024;
        PG8_LAS float* S = (PG8_LAS float*)(lds + 8192);
        const int col0 = u.pn * BM + wc * 32 + 4 * fq;
        float ssv[2][4];
        {
            u32x2 bw[2][4][2][2];
#pragma unroll
            for (int ai = 0; ai < 2; ++ai)
#pragma unroll
                for (int m = 0; m < 4; ++m) { const size_t row = (size_t)u.pm * BM + ai * HALF + wr * 64 + m * 16 + fr;
#pragma unroll
                    for (int bj = 0; bj < 2; ++bj)
#pragma unroll
                        for (int n = 0; n < 2; ++n) bw[ai][m][bj][n] = *(const u32x2*)(Xb + row * ldc + col0 + bj * HALF + n * 16); }
#pragma unroll
            for (int ai = 0; ai < 2; ++ai)
#pragma unroll
                for (int m = 0; m < 4; ++m) { float ss = 0.f;
#pragma unroll
                    for (int bj = 0; bj < 2; ++bj)
#pragma unroll
                        for (int n = 0; n < 2; ++n) { const u32x2 w_ = bw[ai][m][bj][n]; f32x4 bv;
                            bv[0] = __uint_as_float(w_.x << 16); bv[1] = __uint_as_float(w_.x & 0xffff0000u); bv[2] = __uint_as_float(w_.y << 16); bv[3] = __uint_as_float(w_.y & 0xffff0000u);
                            const f32x4 v = acc[ai][bj][m][n] * alpha + bv; acc[ai][bj][m][n] = v;
                            ss += (v[0] * v[0] + v[1] * v[1]) + (v[2] * v[2] + v[3] * v[3]); }
                    ss += __shfl_xor(ss, 16); ss += __shfl_xor(ss, 32); ssv[ai][m] = ss; } }
        if (fq == 0) {
#pragma unroll
            for (int ai = 0; ai < 2; ++ai)
#pragma unroll
                for (int m = 0; m < 4; ++m) { const size_t row = (size_t)u.pm * BM + ai * HALF + wr * 64 + m * 16 + fr;
                    __hip_atomic_store(xch + row * 16 + u.pn * 4 + wc, ssv[ai][m], __ATOMIC_RELAXED, __HIP_MEMORY_SCOPE_AGENT); } }
        asm volatile("s_waitcnt vmcnt(0)" ::: "memory");
        if (lane == 0) __hip_atomic_fetch_add(cnt + 64 * u.pm, 1u, __ATOMIC_RELAXED, __HIP_MEMORY_SCOPE_AGENT);
        if (wid == 0) { unsigned sp = 0u;
            while ((unsigned)__builtin_amdgcn_readfirstlane(__hip_atomic_load(cnt + 64 * u.pm, __ATOMIC_RELAXED, __HIP_MEMORY_SCOPE_AGENT)) < 32u) { __builtin_amdgcn_s_sleep(2); if (++sp > (1u << 22)) break; }
            __builtin_amdgcn_fence(__ATOMIC_ACQUIRE, "agent"); }
        asm volatile("s_waitcnt vmcnt(0) lgkmcnt(0)" ::: "memory"); __builtin_amdgcn_s_barrier(); asm volatile("" ::: "memory");
        if (lane < 32) { const int r = wid * 32 + lane; const unsigned long long* sl = (const unsigned long long*)(xch + ((size_t)u.pm * BM + r) * 16); float t = 0.f;
#pragma unroll
            for (int j = 0; j < 8; ++j) { const unsigned long long w = __hip_atomic_load(sl + j, __ATOMIC_RELAXED, __HIP_MEMORY_SCOPE_AGENT); t += __uint_as_float((unsigned)w) + __uint_as_float((unsigned)(w >> 32)); }
            S[r] = 1.0f / sqrtf(t * (1.0f / 1024.0f) + 1e-6f); }
        asm volatile("s_waitcnt lgkmcnt(0)" ::: "memory"); __builtin_amdgcn_s_barrier(); asm volatile("" ::: "memory");
        f32x4 gv[2][2];
#pragma unroll
        for (int bj = 0; bj < 2; ++bj)
#pragma unroll
            for (int n = 0; n < 2; ++n) gv[bj][n] = *(const f32x4*)(gain + col0 + bj * HALF + n * 16);
#pragma unroll
        for (int ai = 0; ai < 2; ++ai)
#pragma unroll
            for (int m = 0; m < 4; ++m) { const int r = ai * HALF + wr * 64 + m * 16 + fr; const float rs = S[r]; float* op = out + ((size_t)u.pm * BM + r) * ldc + col0;
#pragma unroll
                for (int bj = 0; bj < 2; ++bj)
#pragma unroll
                    for (int n = 0; n < 2; ++n) *(f32x4*)(op + bj * HALF + n * 16) = acc[ai][bj][m][n] * rs * gv[bj][n]; }
    }
};
}
namespace pg8 {
__device__ __forceinline__ void rope_cs_e(int pos, int i, float& c, float& s) {
    const float ang = (float)pos * ROPE_FREQ[i];
    const double q4 = (double)ang * 0.6366197723675814; const double qr = rint(q4);
    const float r = (float)((q4 - qr) * 1.5707963267948966); const int qi = ((int)qr) & 3; const float r2 = r * r;
    const float sn = r * (1.0f + r2 * (-1.6666667e-1f + r2 * (8.3333333e-3f + r2 * (-1.9841270e-4f + r2 * 2.7557319e-6f))));
    const float cs = 1.0f + r2 * (-0.5f + r2 * (4.1666667e-2f + r2 * (-1.3888889e-3f + r2 * (2.4801587e-5f + r2 * -2.7557319e-7f))));
    c = (qi == 0) ? cs : (qi == 1) ? -sn : (qi == 2) ? -cs : sn;
    s = (qi == 0) ? sn : (qi == 1) ? cs : (qi == 2) ? -sn : -cs;
}
__device__ __forceinline__ float gelu_e(float x) { const float y = 0.7978845608028654f * (x + 0.044715f * x * x * x); return x * __builtin_amdgcn_rcpf(1.0f + __builtin_amdgcn_exp2f(-2.8853900817779268f * y)); }
typedef unsigned u32x2 __attribute__((ext_vector_type(2)));
struct EpiZ {
    static constexpr bool PERM = false, AFTER_DRAIN = false;
    bf16_t* XL; bf16_t* GG; bf16_t* CQ; float* CKV; float* SSQ; float* out; bf16_t* KC; bf16_t* KCS; const float* SSQX; bf16_t* CKVB;
    __device__ __forceinline__ void operator()(const f32x4 (&acc0)[2][2][4][2], const Unit& u, int wr, int wc, int fr, int fq) const {
        const int pn = u.pn;
#pragma unroll
        for (int ai = 0; ai < 2; ++ai)
#pragma unroll
            for (int m = 0; m < 4; ++m) { const int row = u.pm * BM + ai * HALF + wr * 64 + m * 16 + fr;
                f32x4 acc[2][2][4][2];
                { const f32x4* sp = (const f32x4*)(SSQX + (size_t)row * 16); const f32x4 s0 = sp[0], s1 = sp[1], s2 = sp[2], s3 = sp[3]; const f32x4 t = (s0 + s1) + (s2 + s3);
                  const float rs = __builtin_amdgcn_rsqf(((t[0] + t[1]) + (t[2] + t[3])) * (1.0f / 1024.0f) + 1e-6f);
#pragma unroll
                  for (int bj = 0; bj < 2; ++bj)
#pragma unroll
                      for (int n = 0; n < 2; ++n) acc[ai][bj][m][n] = acc0[ai][bj][m][n] * rs; }
                if (pn < 4) { bf16_t* dst = (pn < 2 ? XL : GG) + (size_t)row * 512 + (pn & 1) * 256 + wc * 32 + 4 * fq;
#pragma unroll
                    for (int bj = 0; bj < 2; ++bj)
#pragma unroll
                        for (int n = 0; n < 2; ++n) { f32x4 v = acc[ai][bj][m][n]; if (pn >= 2) { v[0] = gelu_e(v[0]); v[1] = gelu_e(v[1]); v[2] = gelu_e(v[2]); v[3] = gelu_e(v[3]); }
                            u32x2 w; w.x = cvt_pk_bf16(v[0], v[1]); w.y = cvt_pk_bf16(v[2], v[3]); *(u32x2*)(dst + bj * HALF + n * 16) = w; } }
                else if (pn == 4) { bf16_t* dst = CQ + (size_t)row * 256 + wc * 32 + 4 * fq; float ss = 0.f;
#pragma unroll
                    for (int bj = 0; bj < 2; ++bj)
#pragma unroll
                        for (int n = 0; n < 2; ++n) { const f32x4 v = acc[ai][bj][m][n]; ss += (v[0] * v[0] + v[1] * v[1]) + (v[2] * v[2] + v[3] * v[3]);
                            u32x2 w; w.x = cvt_pk_bf16(v[0], v[1]); w.y = cvt_pk_bf16(v[2], v[3]); *(u32x2*)(dst + bj * HALF + n * 16) = w; }
                    ss += __shfl_xor(ss, 16); ss += __shfl_xor(ss, 32);
                    if (fq == 0) SSQ[(size_t)row * 8 + wc] = ss; }
                else { float* dst = CKV + (size_t)row * 128 + wc * 32 + 4 * fq; float ss = 0.f;
#pragma unroll
                    for (int n = 0; n < 2; ++n) { const f32x4 v = acc[ai][0][m][n]; ss += (v[0] * v[0] + v[1] * v[1]) + (v[2] * v[2] + v[3] * v[3]); *(f32x4*)(dst + n * 16) = v;
                        u32x2 w; w.x = cvt_pk_bf16(v[0], v[1]); w.y = cvt_pk_bf16(v[2], v[3]); *(u32x2*)(CKVB + (size_t)row * 128 + wc * 32 + 4 * fq + n * 16) = w; }
                    ss += __shfl_xor(ss, 16); ss += __shfl_xor(ss, 32);
                    if (fq == 0) SSQ[(size_t)row * 8 + 4 + wc] = ss;
                    if (wc == 0) { const bool prompt = row < 16384; const int pos = prompt ? (row & 8191) : 16384 + ((row - 16384) & 7);
                        float* ko = prompt ? out + O_KRP + (size_t)row * 32 : out + O_KRS + (size_t)(row - 16384) * 32;
                        bf16_t* kb = prompt ? KC + (size_t)row * 160 + 128 : KCS + (size_t)(row - 16384) * 160 + 128;
                        const f32x4 x1 = acc[ai][1][m][0], x2 = acc[ai][1][m][1]; f32x4 o1, o2;
#pragma unroll
                        for (int i = 0; i < 4; ++i) { float c, s; rope_cs_e(pos, 4 * fq + i, c, s); o1[i] = x1[i] * c - x2[i] * s; o2[i] = x2[i] * c + x1[i] * s; }
                        *(f32x4*)(ko + 4 * fq) = o1; *(f32x4*)(ko + 16 + 4 * fq) = o2;
                        u32x2 w1, w2; w1.x = cvt_pk_bf16(o1[0], o1[1]); w1.y = cvt_pk_bf16(o1[2], o1[3]); w2.x = cvt_pk_bf16(o2[0], o2[1]); w2.y = cvt_pk_bf16(o2[2], o2[3]);
                        *(u32x2*)(kb + 4 * fq) = w1; *(u32x2*)(kb + 16 + 4 * fq) = w2; } }
            }
    }
};
struct EpiQ {
    static constexpr bool PERM = false, AFTER_DRAIN = false;
    bf16_t* Qb; const float* SSQ; float qscale; int sample;
    __device__ __forceinline__ void operator()(const f32x4 (&acc)[2][2][4][2], const Unit& u, int wr, int wc, int fr, int fq) const {
        const int pn = u.pn;
#pragma unroll
        for (int ai = 0; ai < 2; ++ai)
#pragma unroll
            for (int m = 0; m < 4; ++m) { const int row = u.pm * BM + ai * HALF + wr * 64 + m * 16 + fr;
                const f32x4 sq = *(const f32x4*)(SSQ + (size_t)row * 8);
                const float sc = qscale * __builtin_amdgcn_rsqf(((sq[0] + sq[1]) + (sq[2] + sq[3])) * (1.0f / 256.0f) + 1e-6f);
                if (pn < 4) {
#pragma unroll
                    for (int bj = 0; bj < 2; ++bj) { bf16_t* dst = Qb + ((size_t)row * 8 + 2 * pn + bj) * 160 + wc * 32 + 4 * fq;
#pragma unroll
                        for (int n = 0; n < 2; ++n) { const f32x4 v = acc[ai][bj][m][n] * sc; u32x2 w; w.x = cvt_pk_bf16(v[0], v[1]); w.y = cvt_pk_bf16(v[2], v[3]); *(u32x2*)(dst + n * 16) = w; } } }
                else { const int pos = sample ? 16384 + (row & 7) : (row & 8191);
                    float cs[4], sn[4];
#pragma unroll
                    for (int i = 0; i < 4; ++i) rope_cs_e(pos, 4 * fq + i, cs[i], sn[i]);
#pragma unroll
                    for (int bj = 0; bj < 2; ++bj) { bf16_t* dst = Qb + ((size_t)row * 8 + 4 * bj + wc) * 160 + 128 + 4 * fq;
                        const f32x4 x1 = acc[ai][bj][m][0] * sc, x2 = acc[ai][bj][m][1] * sc; f32x4 o1, o2;
#pragma unroll
                        for (int i = 0; i < 4; ++i) { o1[i] = x1[i] * cs[i] - x2[i] * sn[i]; o2[i] = x2[i] * cs[i] + x1[i] * sn[i]; }
                        u32x2 w1, w2; w1.x = cvt_pk_bf16(o1[0], o1[1]); w1.y = cvt_pk_bf16(o1[2], o1[3]); w2.x = cvt_pk_bf16(o2[0], o2[1]); w2.y = cvt_pk_bf16(o2[2], o2[3]);
                        *(u32x2*)dst = w1; *(u32x2*)(dst + 16) = w2; } }
            }
    }
};
struct EpiQP {
    static constexpr bool PERM = false, AFTER_DRAIN = false;
    bf16_t* Qb; const float* SSQ; float qscale; int pad;
    __device__ __forceinline__ void operator()(const f32x4 (&acc)[2][2][4][2], const Unit& u, int wr, int wc, int fr, int fq) const {
        const int pn = u.pn;
#pragma unroll
        for (int ai = 0; ai < 2; ++ai)
#pragma unroll
            for (int m = 0; m < 4; ++m) { const int row = u.pm * BM + ai * HALF + wr * 64 + m * 16 + fr;
                const f32x4 sq = *(const f32x4*)(SSQ + (size_t)row * 8);
                const float sc = qscale * __builtin_amdgcn_rsqf(((sq[0] + sq[1]) + (sq[2] + sq[3])) * (1.0f / 256.0f) + 1e-6f);
                if (pn < 2) {
#pragma unroll
                    for (int bj = 0; bj < 2; ++bj) { bf16_t* dst = Qb + ((size_t)row * 8 + 4 * pn + 2 * bj + (wc >> 1)) * 96 + 32 * (wc & 1) + 4 * fq;
#pragma unroll
                        for (int n = 0; n < 2; ++n) { const f32x4 v = acc[ai][bj][m][n] * sc; u32x2 w; w.x = cvt_pk_bf16(v[0], v[1]); w.y = cvt_pk_bf16(v[2], v[3]); *(u32x2*)(dst + n * 16) = w; } } }
                else { const int pos = row & 8191;
                    float cs[4], sn[4];
#pragma unroll
                    for (int i = 0; i < 4; ++i) rope_cs_e(pos, 4 * fq + i, cs[i], sn[i]);
#pragma unroll
                    for (int bj = 0; bj < 2; ++bj) { bf16_t* dst = Qb + ((size_t)row * 8 + 4 * bj + wc) * 96 + 64 + 4 * fq;
                        const f32x4 x1 = acc[ai][bj][m][0] * sc, x2 = acc[ai][bj][m][1] * sc; f32x4 o1, o2;
#pragma unroll
                        for (int i = 0; i < 4; ++i) { o1[i] = x1[i] * cs[i] - x2[i] * sn[i]; o2[i] = x2[i] * cs[i] + x1[i] * sn[i]; }
                        u32x2 w1, w2; w1.x = cvt_pk_bf16(o1[0], o1[1]); w1.y = cvt_pk_bf16(o1[2], o1[3]); w2.x = cvt_pk_bf16(o2[0], o2[1]); w2.y = cvt_pk_bf16(o2[2], o2[3]);
                        *(u32x2*)dst = w1; *(u32x2*)(dst + 16) = w2; } }
            }
    }
};
struct EpiKV {
    static constexpr bool PERM = false, AFTER_DRAIN = false;
    bf16_t* KVH; const float* SSQ; const bf16_t* KC;
    __device__ __forceinline__ void operator()(const f32x4 (&acc)[2][2][4][2], const Unit& u, int wr, int wc, int fr, int fq) const {
#pragma unroll
        for (int ai = 0; ai < 2; ++ai)
#pragma unroll
            for (int m = 0; m < 4; ++m) { const int row = u.pm * BM + ai * HALF + wr * 64 + m * 16 + fr; const int b = row >> 13, t = row & 8191;
                const f32x4 sq = *(const f32x4*)(SSQ + (size_t)row * 8 + 4);
                const float sc = __builtin_amdgcn_rsqf(((sq[0] + sq[1]) + (sq[2] + sq[3])) * (1.0f / 128.0f) + 1e-6f);
#pragma unroll
                for (int bj = 0; bj < 2; ++bj) { bf16_t* dst = KVH + (((size_t)b * 8 + 2 * u.pn + bj) * 8192 + t) * 160;
#pragma unroll
                    for (int n = 0; n < 2; ++n) { const f32x4 v = acc[ai][bj][m][n] * sc; u32x2 w; w.x = cvt_pk_bf16(v[0], v[1]); w.y = cvt_pk_bf16(v[2], v[3]); *(u32x2*)(dst + wc * 32 + 4 * fq + n * 16) = w; }
                    if (wc == 0) *(u32x4*)(dst + 128 + 8 * fq) = *(const u32x4*)(KC + (size_t)row * 160 + 128 + 8 * fq); }
            }
    }
};
}
#define GAS __attribute__((address_space(1)))
#define LAS __attribute__((address_space(3)))
typedef unsigned short bf16;
typedef unsigned v4u __attribute__((ext_vector_type(4)));
typedef float f32x4 __attribute__((ext_vector_type(4)));
typedef short bf16x8 __attribute__((ext_vector_type(8)));
typedef GAS unsigned gu32;
typedef GAS unsigned long long gu64;
#define RLX_AGENT __ATOMIC_RELAXED, __HIP_MEMORY_SCOPE_AGENT
#define LDS_WAIT() asm volatile("s_waitcnt lgkmcnt(0)" ::: "memory")
#define VM_WAIT() asm volatile("s_waitcnt vmcnt(0)" ::: "memory")
__device__ __forceinline__ unsigned long long rt() { return __builtin_amdgcn_s_memrealtime(); }
__device__ __forceinline__ unsigned f2bf(float f) { unsigned u = __builtin_bit_cast(unsigned, f); return (u + 0x7fffu + ((u >> 16) & 1u)) >> 16; }
__device__ __forceinline__ unsigned pk2(float lo, float hi) { return f2bf(lo) | (f2bf(hi) << 16); }

#define XB_TMO      128
#define XB_XCNT(j)  (256  + 64 * (j))
#define XB_XSUB(j)  (1280 + 64 * (j))
#define XB_XGEN(j)  (2304 + 64 * (j))
#define XB_TOP      3328
#define XB_TOPGEN   3392
#define XCD_BAR_WORDS 3456
#define XB_SPIN_CAP (1u << 18)

__device__ __forceinline__ unsigned xb_ld(unsigned* p)              { return __hip_atomic_load(p, __ATOMIC_RELAXED, __HIP_MEMORY_SCOPE_AGENT); }
__device__ __forceinline__ unsigned xb_add(unsigned* p, unsigned v) { return __hip_atomic_fetch_add(p, v, __ATOMIC_RELAXED, __HIP_MEMORY_SCOPE_AGENT); }
__device__ __forceinline__ unsigned xb_xcc_id() { return (unsigned)__builtin_amdgcn_s_getreg((3 << 11) | 20) & 0xFu; }
#define XB_SPIN(cond, bar) do { unsigned _sp = 0; while (cond) { __builtin_amdgcn_s_sleep(1); \
    if ((++_sp & 255u) == 0u) { if (xb_ld(&(bar)[XB_TMO])) break; if (_sp > XB_SPIN_CAP) { atomicAdd(&(bar)[XB_TMO], 1u); break; } } } } while (0)

struct XcdBarrier {
    unsigned* bar; unsigned x;
    volatile LAS unsigned* st;
};

__device__ __forceinline__ XcdBarrier xcd_barrier_post(unsigned* bar, volatile LAS unsigned* st) {
    XcdBarrier b; b.bar = bar; b.x = xb_xcc_id(); b.st = st;
    if (threadIdx.x == 0) (void)xb_add(&bar[XB_XCNT(b.x)], 1u);
    return b;
}
__device__ __forceinline__ void xcd_barrier_complete(unsigned* bar, unsigned x, unsigned& nloc, unsigned& nx) {
    const unsigned G = gridDim.x * gridDim.y * gridDim.z;
    unsigned sum, cnt, mine, sp = 0u;
    for (;;) {
        sum = 0u; cnt = 0u; mine = 0u;
#pragma unroll
        for (unsigned j = 0; j < 16; ++j) { const unsigned c = xb_ld(&bar[XB_XCNT(j)]); sum += c; cnt += (c > 0u) ? 1u : 0u; mine = (j == x) ? c : mine; }
        if (sum == G) break;
        __builtin_amdgcn_s_sleep(1);
        if ((++sp & 255u) == 0u) { if (xb_ld(&bar[XB_TMO])) break; if (sp > XB_SPIN_CAP) { atomicAdd(&bar[XB_TMO], 1u); break; } }
    }
    nloc = mine > 0u ? mine : 1u; nx = cnt > 0u ? cnt : 1u;
}

__device__ __forceinline__ void xcd_barrier(const XcdBarrier& b) {
    asm volatile("s_waitcnt vmcnt(0)" ::: "memory");
    __syncthreads();
    if (threadIdx.x == 0) {
        unsigned* bar = b.bar;
        __builtin_amdgcn_s_waitcnt(0);
        unsigned nloc = b.st[0], nx = b.st[1];
        if (nloc == 0u) { xcd_barrier_complete(bar, b.x, nloc, nx); b.st[0] = nloc; b.st[1] = nx; }
        const unsigned old = xb_add(&bar[XB_XSUB(b.x)], 1u);
        const unsigned gen = old / nloc;
        if (old + 1u == (gen + 1u) * nloc) {
            __builtin_amdgcn_fence(__ATOMIC_RELEASE, "agent");
            asm volatile("s_waitcnt vmcnt(0)" ::: "memory");
            const unsigned og = xb_add(&bar[XB_TOP], 1u);
            const unsigned tg = og / nx;
            if (og + 1u == (tg + 1u) * nx) xb_add(&bar[XB_TOPGEN], 1u);
            else XB_SPIN(xb_ld(&bar[XB_TOPGEN]) == tg, bar);
            __builtin_amdgcn_fence(__ATOMIC_ACQUIRE, "agent");
            xb_add(&bar[XB_XGEN(b.x)], 1u);
            asm volatile("s_waitcnt vmcnt(0)" ::: "memory");
        } else {
            XB_SPIN(xb_ld(&bar[XB_XGEN(b.x)]) == gen, bar);
            __builtin_amdgcn_fence(__ATOMIC_ACQUIRE, "agent");
            asm volatile("s_waitcnt vmcnt(0)" ::: "memory");
        }
    }
    __syncthreads();
}
__device__ __forceinline__ float wave_sum(float v) {
#pragma unroll
    for (int o = 1; o < 64; o <<= 1) v += __shfl_xor(v, o);
    return v;
}
__device__ __forceinline__ float sigmoidf_(float x) { return 1.0f / (1.0f + __expf(-x)); }
__device__ __forceinline__ float gelu_tanh(float x) { const float y = 0.7978845608028654f * (x + 0.044715f * x * x * x); return x * sigmoidf_(2.0f * y); }
__device__ __forceinline__ void rope_cs(int pos, int i, float& c, float& s) {
    const float ang = (float)pos * ROPE_FREQ[i];
    const double q4 = (double)ang * 0.6366197723675814;
    const double qr = rint(q4);
    const float r = (float)((q4 - qr) * 1.5707963267948966);
    const int qi = ((int)qr) & 3;
    const float r2 = r * r;
    const float sn = r * (1.0f + r2 * (-1.6666667e-1f + r2 * (8.3333333e-3f + r2 * (-1.9841270e-4f + r2 * 2.7557319e-6f))));
    const float cs = 1.0f + r2 * (-0.5f + r2 * (4.1666667e-2f + r2 * (-1.3888889e-3f + r2 * (2.4801587e-5f + r2 * -2.7557319e-7f))));
    c = (qi == 0) ? cs : (qi == 1) ? -sn : (qi == 2) ? -cs : sn;
    s = (qi == 0) ? sn : (qi == 1) ? cs : (qi == 2) ? -sn : -cs;
}
constexpr float QSCALE = 0.10206207261596577f * 1.4426950408889634f;
namespace att {
#define ATT_LAS __attribute__((address_space(3)))
typedef short bf16x8 __attribute__((ext_vector_type(8)));
typedef float f32x16 __attribute__((ext_vector_type(16)));
typedef short s16x4 __attribute__((ext_vector_type(4)));
typedef short v4i16_t __attribute__((ext_vector_type(4)));
typedef unsigned u32x4 __attribute__((ext_vector_type(4)));
typedef float f32x2_t __attribute__((ext_vector_type(2)));
typedef __bf16 bf16x2_t __attribute__((ext_vector_type(2)));
typedef ATT_LAS unsigned char* ldsp;
#define ATT_MFMA(a, b, c) __builtin_amdgcn_mfma_f32_32x32x16_bf16((a), (b), (c), 0, 0, 0)
__device__ __forceinline__ int crow(int r, int hi) { return (r & 3) + 8 * (r >> 2) + 4 * hi; }
__device__ __forceinline__ unsigned cvtpk(float lo, float hi) { f32x2_t v = {lo, hi}; bf16x2_t b = __builtin_convertvector(v, bf16x2_t); return __builtin_bit_cast(unsigned, b); }
__device__ __forceinline__ unsigned offL(unsigned row, unsigned ch) { return 256u * row + 16u * (ch ^ (((row & 3u) << 2) | ((row >> 2) & 3u))); }
__device__ __forceinline__ unsigned offR(unsigned row, unsigned ch) { return 64u * row + 16u * (ch ^ ((row >> 2) & 3u)); }
__device__ __forceinline__ bf16x8 lds_b128(ldsp p) { return *(const ATT_LAS bf16x8*)p; }
__device__ __forceinline__ s16x4 lds_tr(ldsp p) { return __builtin_bit_cast(s16x4, __builtin_amdgcn_ds_read_tr16_b64_v4i16((ATT_LAS v4i16_t*)p)); }
__device__ __forceinline__ float swapmax(float m) { auto rr = __builtin_amdgcn_permlane32_swap(__float_as_uint(m), __float_as_uint(m), false, false); return fmaxf(__uint_as_float(rr[0]), __uint_as_float(rr[1])); }
__device__ __forceinline__ float swapsum(float m) { auto rr = __builtin_amdgcn_permlane32_swap(__float_as_uint(m), __float_as_uint(m), false, false); return __uint_as_float(rr[0]) + __uint_as_float(rr[1]); }

constexpr int TILE_LAT = 64 * 256, TILE_ROPE = 64 * 64, TILE_BYTES = TILE_LAT + TILE_ROPE;
constexpr float THR = 8.0f;

__device__ __forceinline__ void softmax_step(f32x16& s0, f32x16& s1, float& m, float& l, f32x16 (&o)[4], bool first) {
    float rm = fmaxf(s0[0], s1[0]);
#pragma unroll
    for (int r = 1; r < 16; ++r) rm = fmaxf(rm, fmaxf(s0[r], s1[r]));
    rm = swapmax(rm);
    if (first) m = rm;
    rm -= m;
    if (!first && __any(rm > THR)) {
        const float dl = fmaxf(rm, 0.f);
        m += dl;
        const float f = __builtin_amdgcn_exp2f(-dl); l *= f;
#pragma unroll
        for (int c = 0; c < 4; ++c)
#pragma unroll
            for (int r = 0; r < 16; ++r) o[c][r] *= f;
    }
    float sum = 0.f;
#pragma unroll
    for (int r = 0; r < 16; ++r) { s0[r] = __builtin_amdgcn_exp2f(s0[r] - m); s1[r] = __builtin_amdgcn_exp2f(s1[r] - m); sum += s0[r] + s1[r]; }
    l += sum;
}

__device__ __forceinline__ void stage_load(u32x4 (&st)[3], const bf16* __restrict__ tilep, int tid) {
    const bf16* pl = tilep + (size_t)(tid >> 4) * QD + (tid & 15) * 8;
    st[0] = *(const u32x4*)pl; st[1] = *(const u32x4*)(pl + 32 * QD);
    if (tid < 256) st[2] = *(const u32x4*)(tilep + (size_t)(tid >> 2) * QD + KVL + (tid & 3) * 8);
}
__device__ __forceinline__ void stage_store(const u32x4 (&st)[3], ldsp tile, unsigned dl, unsigned dr, int tid) {
    *(ATT_LAS u32x4*)(tile + dl) = st[0]; *(ATT_LAS u32x4*)(tile + dl + 8192) = st[1];
    if (tid < 256) *(ATT_LAS u32x4*)(tile + TILE_LAT + dr) = st[2];
}
constexpr int PR_Q = 3 * TILE_BYTES, PR_QW = 32 * 256 + 32 * 64;
constexpr int PR_LDS_END = PR_Q + 8 * PR_QW;
__device__ __forceinline__ void softmax_step2(f32x16& s0, f32x16& s1, float& m, float& l, f32x16 (&o)[2], bool first) {
    float rm = fmaxf(s0[0], s1[0]);
#pragma unroll
    for (int r = 1; r < 16; ++r) rm = fmaxf(rm, fmaxf(s0[r], s1[r]));
    rm = swapmax(rm);
    if (first) m = rm;
    rm -= m;
    if (!first && __any(rm > THR)) {
        const float dl = fmaxf(rm, 0.f);
        m += dl;
        const float f = __builtin_amdgcn_exp2f(-dl); l *= f;
#pragma unroll
        for (int c = 0; c < 2; ++c)
#pragma unroll
            for (int r = 0; r < 16; ++r) o[c][r] *= f;
    }
    float sum = 0.f;
#pragma unroll
    for (int r = 0; r < 16; ++r) { s0[r] = __builtin_amdgcn_exp2f(s0[r] - m); s1[r] = __builtin_amdgcn_exp2f(s1[r] - m); sum += s0[r] + s1[r]; }
    l += sum;
}
__device__ __forceinline__ void prompt_unit(ldsp lds, const bf16* __restrict__ QbP, const bf16* __restrict__ KVH, float* __restrict__ SSQM, bf16* __restrict__ YC, int b, int h, int qb) {
    const int tid = threadIdx.x, lane = tid & 63, wid = __builtin_amdgcn_readfirstlane(tid >> 6), r32 = lane & 31, hi = lane >> 5;
    const int tq0 = 256 * qb + 32 * wid; const size_t row0 = (size_t)b * SEQ + tq0;
    const bf16* KVseq = KVH + ((size_t)(b * NH + h) * SEQ) * QD;
    const int ntile_u = 4 * qb + 4, ntile_w = 4 * qb + (wid >> 1) + 1;
    const unsigned lsrc = (unsigned)(4 * wid + (lane >> 4)) * (QD * 2) + 16u * ((unsigned)(lane & 15) ^ ((((unsigned)(lane >> 4) & 3u) << 2) | ((unsigned)wid & 3u)));
    const unsigned rsrc = (unsigned)(16 * wid + (lane >> 2)) * (QD * 2) + 2 * KVL + 16u * ((unsigned)(lane & 3) ^ ((unsigned)(lane >> 4) & 3u));
#define PR_GLDS(gptr, ldsaddr) do { unsigned keep_; asm volatile("s_mov_b32 %0, m0\n\ts_mov_b32 m0, %2\n\ts_nop 0\n\tglobal_load_lds_dwordx4 %1, off\n\ts_mov_b32 m0, %0" : "=&s"(keep_) : "v"(gptr), "s"(ldsaddr) : "memory"); } while (0)
#ifdef PR_SYNC_STAGE
#define PR_DMA(gtile, slot) do { const char* g_ = (const char*)(gtile); ldsp d_ = lds + (slot) + wid * 1024 + 16 * lane; \
        *(ATT_LAS u32x4*)(d_) = *(const u32x4*)(g_ + lsrc); *(ATT_LAS u32x4*)(d_ + 8192) = *(const u32x4*)(g_ + lsrc + 32 * QD * 2); \
        if (wid < 4) *(ATT_LAS u32x4*)(d_ + TILE_LAT) = *(const u32x4*)(g_ + rsrc); } while (0)
#else
#define PR_DMA(gtile, slot) do { const char* g_ = (const char*)(gtile); const unsigned l_ = (unsigned)__builtin_amdgcn_readfirstlane((int)(lds0 + (unsigned)(slot) + (unsigned)wid * 1024u)); \
        PR_GLDS(g_ + lsrc, l_); PR_GLDS(g_ + lsrc + 32 * QD * 2, l_ + 8192u); \
        if (wid < 4) PR_GLDS(g_ + rsrc, l_ + (unsigned)TILE_LAT); } while (0)
#endif
    const unsigned lds0 = (unsigned)(size_t)lds;
    PR_DMA(KVseq, 0);
    ldsp qimg = lds + PR_Q + wid * PR_QW;
    { const bf16* qp = QbP + ((row0 + r32) * NH + h) * 96 + 8 * hi;
#pragma unroll
      for (int s = 0; s < 4; ++s) *(ATT_LAS bf16x8*)(qimg + offL((unsigned)r32, (unsigned)(2 * s + hi))) = *(const bf16x8*)(qp + 16 * s);
#pragma unroll
      for (int s = 0; s < 2; ++s) *(ATT_LAS bf16x8*)(qimg + 32 * 256 + offR((unsigned)r32, (unsigned)(2 * s + hi))) = *(const bf16x8*)(qp + 64 + 16 * s); }
    PR_DMA(KVseq + (size_t)64 * QD, TILE_BYTES);
    asm volatile("s_waitcnt vmcnt(0) lgkmcnt(0)" ::: "memory");
    __syncthreads();
    float m = 0.f, l = 0.f; f32x16 o[2];
#pragma unroll
    for (int r = 0; r < 16; ++r) { o[0][r] = 0.f; o[1][r] = 0.f; }
    const unsigned xk = (unsigned)(((r32 & 3) << 1) | ((r32 >> 3) & 1));
    const unsigned ka = 256u * (unsigned)r32 + 16u * ((unsigned)hi ^ ((unsigned)(r32 >> 2) & 1u));
    const unsigned kr0 = TILE_LAT + offR((unsigned)r32, (unsigned)hi), kr1 = TILE_LAT + offR((unsigned)r32, 2u + (unsigned)hi);
    const unsigned blk = (lane >> 4) & 1, qq = (lane & 15) >> 2, pp = lane & 3;
    const unsigned vb0 = 256u * (unsigned)(4 * hi + qq) + 16u * ((2u * blk + (pp >> 1)) ^ (unsigned)hi) + 8u * (pp & 1u);
    const unsigned vb1 = 256u * (unsigned)(8 + 4 * hi + qq) + 16u * ((2u * blk + (pp >> 1)) ^ (2u + (unsigned)hi)) + 8u * (pp & 1u);
#define PR_QK(S0, S1, tile) do { unsigned xko = xk; asm volatile("" : "+v"(xko)); \
        _Pragma("unroll") for (int r = 0; r < 16; ++r) { S0[r] = 0.f; S1[r] = 0.f; } \
        _Pragma("unroll") for (int k = 0; k < 4; ++k) { const unsigned a_ = ka + 32u * ((unsigned)k ^ xko); const bf16x8 q_ = lds_b128(qimg + a_); \
            S0 = ATT_MFMA(lds_b128((tile) + a_), q_, S0); S1 = ATT_MFMA(lds_b128((tile) + a_ + 8192), q_, S1); } \
        { const bf16x8 q_ = lds_b128(qimg + 32 * 256 + (kr0 - TILE_LAT)); S0 = ATT_MFMA(lds_b128((tile) + kr0), q_, S0); S1 = ATT_MFMA(lds_b128((tile) + kr0 + 2048), q_, S1); } \
        { const bf16x8 q_ = lds_b128(qimg + 32 * 256 + (kr1 - TILE_LAT)); S0 = ATT_MFMA(lds_b128((tile) + kr1), q_, S0); S1 = ATT_MFMA(lds_b128((tile) + kr1 + 2048), q_, S1); } } while (0)
#define PR_STEP(A0, A1, B0, B1, kt) do { \
        ldsp tcur = lds + cur; \
        if ((kt) + 2 < ntile_u) PR_DMA(KVseq + (size_t)((kt) + 2) * 64 * QD, nn); \
        if ((kt) + 1 < ntile_w) PR_QK(B0, B1, lds + nxt); \
        if ((kt) < ntile_w) { \
          if ((kt) == ntile_w - 1) { const int tok = tq0 + r32, kb = (kt) * 64; \
            _Pragma("unroll") for (int r = 0; r < 16; ++r) { const int key = kb + crow(r, hi); if (key > tok) A0[r] = -INFINITY; if (key + 32 > tok) A1[r] = -INFINITY; } } \
          softmax_step2(A0, A1, m, l, o, (kt) == 0); \
          unsigned qqo = qq; asm volatile("" : "+v"(qqo)); \
          _Pragma("unroll") for (int ks = 0; ks < 4; ++ks) { \
            const f32x16& pv = (ks < 2) ? A0 : A1; const int bb = 8 * (ks & 1); \
            u32x4 pw; pw.x = cvtpk(pv[bb + 0], pv[bb + 1]); pw.y = cvtpk(pv[bb + 2], pv[bb + 3]); pw.z = cvtpk(pv[bb + 4], pv[bb + 5]); pw.w = cvtpk(pv[bb + 6], pv[bb + 7]); \
            const bf16x8 pf = __builtin_bit_cast(bf16x8, pw); \
            _Pragma("unroll") for (int c = 2; c < 4; ++c) { const unsigned co = 64u * ((unsigned)c ^ qqo); \
                const s16x4 lo = lds_tr(tcur + vb0 + co + 4096 * ks), hv = lds_tr(tcur + vb1 + co + 4096 * ks); \
                const bf16x8 vf = {lo[0], lo[1], lo[2], lo[3], hv[0], hv[1], hv[2], hv[3]}; \
                o[c - 2] = ATT_MFMA(vf, pf, o[c - 2]); } } } \
        asm volatile("s_waitcnt vmcnt(0)" ::: "memory"); \
        __syncthreads(); \
        { const int t_ = cur; cur = nxt; nxt = nn; nn = t_; } } while (0)
    int cur = 0, nxt = TILE_BYTES, nn = 2 * TILE_BYTES;
    f32x16 sa0, sa1, sb0, sb1;
    PR_QK(sa0, sa1, lds);
    for (int kt = 0; kt < ntile_u; kt += 2) { PR_STEP(sa0, sa1, sb0, sb1, kt); PR_STEP(sb0, sb1, sa0, sa1, kt + 1); }
#undef PR_STEP
#undef PR_QK
#undef PR_DMA
#undef PR_GLDS
    l = swapsum(l);
    const float rl = 1.0f / l;
    float ss = 0.f;
#pragma unroll
    for (int c = 0; c < 2; ++c)
#pragma unroll
        for (int r = 0; r < 16; ++r) { o[c][r] *= rl; ss += o[c][r] * o[c][r]; }
    ss = swapsum(ss);
    if (hi == 0) SSQM[(row0 + r32) * NH + h] = ss;
    bf16* yp = YC + (row0 + r32) * DMIX + DLRU + h * VD + 4 * hi;
#pragma unroll
    for (int c = 0; c < 2; ++c)
#pragma unroll
        for (int g = 0; g < 4; ++g) { typedef unsigned u32x2 __attribute__((ext_vector_type(2)));
            u32x2 w; w.x = cvtpk(o[c][4 * g], o[c][4 * g + 1]); w.y = cvtpk(o[c][4 * g + 2], o[c][4 * g + 3]); *(u32x2*)(yp + 32 * c + 8 * g) = w; }
    __syncthreads();
}
}
namespace att {
constexpr int PG_LAT = 128 * 256, PG_ROPE = 128 * 64, PG_BYTES = PG_LAT + PG_ROPE;
constexpr int PART_ROWS = 66, PART_FLOATS = PART_ROWS * 64;

__device__ __forceinline__ void page_load(f32x4 (&st)[10], const float* __restrict__ ckv, const float* __restrict__ ckr, size_t slot0, int tid) {
    const f32x4* pl = (const f32x4*)(ckv + slot0 * KVL) + tid; const f32x4* pr = (const f32x4*)(ckr + slot0 * ROPE) + tid;
#pragma unroll
    for (int i = 0; i < 8; ++i) st[i] = __builtin_nontemporal_load(pl + 512 * i);
#pragma unroll
    for (int i = 0; i < 2; ++i) st[8 + i] = __builtin_nontemporal_load(pr + 512 * i);
}
__device__ __forceinline__ void page_store(const f32x4 (&st)[10], ldsp pg, unsigned dl, unsigned dr) {
    typedef unsigned u32x2 __attribute__((ext_vector_type(2)));
#pragma unroll
    for (int i = 0; i < 8; ++i) { u32x2 w; w.x = cvtpk(st[i].x, st[i].y); w.y = cvtpk(st[i].z, st[i].w); *(ATT_LAS u32x2*)(pg + dl + 4096 * i) = w; }
#pragma unroll
    for (int i = 0; i < 2; ++i) { u32x2 w; w.x = cvtpk(st[8 + i].x, st[8 + i].y); w.y = cvtpk(st[8 + i].z, st[8 + i].w); *(ATT_LAS u32x2*)(pg + PG_LAT + dr + 4096 * i) = w; }
}
constexpr int Q_OFF = 2 * PG_BYTES;
__device__ __forceinline__ void decode_item(ldsp lds, const bf16* __restrict__ Qb, const float* __restrict__ ckv, const float* __restrict__ ckr, const int* __restrict__ ptab,
                                            float* __restrict__ PART, int db, int pg0, int npg) {
    const int tid = threadIdx.x, lane = tid & 63, wid = __builtin_amdgcn_readfirstlane(tid >> 6), r32 = lane & 31, hi = lane >> 5;
    const int qb = wid & 1, rb = 64 * (wid >> 2) + 32 * ((wid >> 1) & 1), grp = wid >> 1;
    const int* pt = ptab + db * NPAGES + pg0;
    unsigned dl, dr;
    { const unsigned row = (unsigned)tid >> 5, c4 = (unsigned)tid & 31u; dl = offL(row, c4 >> 1) + 8u * (c4 & 1u);
      const unsigned rr = (unsigned)tid >> 3, c4r = (unsigned)tid & 7u; dr = offR(rr, c4r >> 1) + 8u * (c4r & 1u); }
    f32x4 sa[10], sb[10];
    page_load(sa, ckv, ckr, (size_t)pt[0] * PAGE, tid);
    if (npg > 1) page_load(sb, ckv, ckr, (size_t)pt[1] * PAGE, tid);
    {
      const bf16* qsrc = Qb + ((size_t)RP + (size_t)db * DS) * NH * QD;
      const u32x4 q0 = *(const u32x4*)(qsrc + (size_t)(tid >> 4) * QD + (tid & 15) * 8), q1 = *(const u32x4*)(qsrc + (size_t)((tid >> 4) + 32) * QD + (tid & 15) * 8);
      const unsigned dq = offL((unsigned)tid >> 4, (unsigned)tid & 15u);
      *(ATT_LAS u32x4*)(lds + Q_OFF + dq) = q0; *(ATT_LAS u32x4*)(lds + Q_OFF + dq + 8192) = q1;
      if (tid < 256) { const u32x4 q2 = *(const u32x4*)(qsrc + (size_t)(tid >> 2) * QD + KVL + (tid & 3) * 8); *(ATT_LAS u32x4*)(lds + Q_OFF + TILE_LAT + offR((unsigned)tid >> 2, (unsigned)tid & 3u)) = q2; } }
    page_store(sa, lds, dl, dr);
    __syncthreads();
    float m = 0.f, l = 0.f; f32x16 o[4];
#pragma unroll
    for (int r = 0; r < 16; ++r) { o[0][r] = 0.f; o[1][r] = 0.f; o[2][r] = 0.f; o[3][r] = 0.f; }
    const unsigned xk = (unsigned)(((r32 & 3) << 1) | ((r32 >> 3) & 1));
    const unsigned x0 = (unsigned)hi ^ ((unsigned)(r32 >> 2) & 1u);
    const unsigned ka = 256u * (unsigned)(rb + r32) + 16u * x0, qa = Q_OFF + 256u * (unsigned)(32 * qb + r32) + 16u * x0;
    const unsigned kr0 = PG_LAT + offR((unsigned)(rb + r32), (unsigned)hi), kr1 = PG_LAT + offR((unsigned)(rb + r32), 2u + (unsigned)hi);
    const unsigned qr0 = Q_OFF + TILE_LAT + offR((unsigned)(32 * qb + r32), (unsigned)hi), qr1 = Q_OFF + TILE_LAT + offR((unsigned)(32 * qb + r32), 2u + (unsigned)hi);
    const unsigned blk = (lane >> 4) & 1, qq = (lane & 15) >> 2, pp = lane & 3;
    const unsigned vb0 = 256u * (unsigned)(rb + 4 * hi + qq) + 16u * ((2u * blk + (pp >> 1)) ^ (unsigned)hi) + 8u * (pp & 1u);
    const unsigned vb1 = 256u * (unsigned)(rb + 8 + 4 * hi + qq) + 16u * ((2u * blk + (pp >> 1)) ^ (2u + (unsigned)hi)) + 8u * (pp & 1u);
#define DEC_PAGE(pg, first) do { \
        unsigned xko = xk, qqo = qq; asm volatile("" : "+v"(xko), "+v"(qqo)); \
        f32x16 s; \
        _Pragma("unroll") for (int r = 0; r < 16; ++r) s[r] = 0.f; \
        _Pragma("unroll") for (int k = 0; k < 8; ++k) { const unsigned co = 32u * ((unsigned)k ^ xko); s = ATT_MFMA(lds_b128((pg) + ka + co), lds_b128(lds + qa + co), s); } \
        s = ATT_MFMA(lds_b128((pg) + kr0), lds_b128(lds + qr0), s); \
        s = ATT_MFMA(lds_b128((pg) + kr1), lds_b128(lds + qr1), s); \
        float rm = s[0]; \
        _Pragma("unroll") for (int r = 1; r < 16; ++r) rm = fmaxf(rm, s[r]); \
        rm = swapmax(rm); \
        if (first) m = rm; \
        rm -= m; \
        if (!(first) && __any(rm > THR)) { const float dlt = fmaxf(rm, 0.f); m += dlt; const float f = __builtin_amdgcn_exp2f(-dlt); l *= f; \
            _Pragma("unroll") for (int c = 0; c < 4; ++c) _Pragma("unroll") for (int r = 0; r < 16; ++r) o[c][r] *= f; } \
        float sum = 0.f; \
        _Pragma("unroll") for (int r = 0; r < 16; ++r) { s[r] = __builtin_amdgcn_exp2f(s[r] - m); sum += s[r]; } \
        l += sum; \
        _Pragma("unroll") for (int ks = 0; ks < 2; ++ks) { \
            u32x4 pw; pw.x = cvtpk(s[8 * ks + 0], s[8 * ks + 1]); pw.y = cvtpk(s[8 * ks + 2], s[8 * ks + 3]); pw.z = cvtpk(s[8 * ks + 4], s[8 * ks + 5]); pw.w = cvtpk(s[8 * ks + 6], s[8 * ks + 7]); \
            const bf16x8 pf = __builtin_bit_cast(bf16x8, pw); \
            _Pragma("unroll") for (int c = 0; c < 4; ++c) { const unsigned co = 64u * ((unsigned)c ^ qqo); \
                const s16x4 lo = lds_tr((pg) + vb0 + co + 4096 * ks), hv = lds_tr((pg) + vb1 + co + 4096 * ks); \
                const bf16x8 vf = {lo[0], lo[1], lo[2], lo[3], hv[0], hv[1], hv[2], hv[3]}; \
                o[c] = ATT_MFMA(vf, pf, o[c]); } } \
    } while (0)
    for (int pi = 0; pi < npg; pi += 2) {
        if (pi + 2 < npg) page_load(sa, ckv, ckr, (size_t)pt[pi + 2] * PAGE, tid);
        DEC_PAGE(lds, pi == 0);
        page_store(sb, lds + PG_BYTES, dl, dr);
        __syncthreads();
        if (pi + 3 < npg) page_load(sb, ckv, ckr, (size_t)pt[pi + 3] * PAGE, tid);
        DEC_PAGE(lds + PG_BYTES, false);
        if (pi + 2 < npg) page_store(sa, lds, dl, dr);
        __syncthreads();
    }
#undef DEC_PAGE
    ATT_LAS float* reg = (ATT_LAS float*)(lds) + qb * PART_FLOATS;
    for (int g = 0; g < 4; ++g) {
        if (grp == g) {
            if (g > 0) { const float m2 = reg[64 * 64 + lane], l2 = reg[65 * 64 + lane]; const float mn = fmaxf(m, m2); const float a1 = __builtin_amdgcn_exp2f(m - mn), a2 = __builtin_amdgcn_exp2f(m2 - mn);
#pragma unroll
                for (int c = 0; c < 4; ++c)
#pragma unroll
                    for (int r = 0; r < 16; ++r) o[c][r] = o[c][r] * a1 + reg[(c * 16 + r) * 64 + lane] * a2;
                l = l * a1 + l2 * a2; m = mn; }
            if (g < 3) {
#pragma unroll
                for (int c = 0; c < 4; ++c)
#pragma unroll
                    for (int r = 0; r < 16; ++r) reg[(c * 16 + r) * 64 + lane] = o[c][r];
                reg[64 * 64 + lane] = m; reg[65 * 64 + lane] = l; }
            else { float* gp = PART + (size_t)qb * PART_FLOATS;
#pragma unroll
                for (int c = 0; c < 4; ++c)
#pragma unroll
                    for (int r = 0; r < 16; ++r) gp[(c * 16 + r) * 64 + lane] = o[c][r];
                gp[64 * 64 + lane] = m; gp[65 * 64 + lane] = l; }
        }
        __syncthreads();
    }
}
__device__ __forceinline__ void decode_combine(ldsp lds, const bf16* __restrict__ Qb, const float* __restrict__ KN, const float* __restrict__ KR, const float* __restrict__ PARTdb, int ns,
                                               const float* __restrict__ w_uv, const float* __restrict__ gm, bf16* __restrict__ YC, int db) {
    const int tid = threadIdx.x, lane = tid & 63, wid = __builtin_amdgcn_readfirstlane(tid >> 6), qb = wid >> 2, rg = wid & 3, r32 = lane & 31, hi = lane >> 5;
    ATT_LAS float* sc = (ATT_LAS float*)lds;
    ATT_LAS float* ol = (ATT_LAS float*)(lds + 2048);
    ATT_LAS float* red = (ATT_LAS float*)(lds + 2048 + 32768);
    __syncthreads();
    { const int q = tid >> 3, sp = tid & 7;
      const bf16* qp = Qb + (((size_t)RP + (size_t)db * DS) * NH + q) * QD; const float* kn = KN + ((size_t)db * DS + sp) * KVL; const float* kr = KR + ((size_t)db * DS + sp) * ROPE;
      float a = 0.f; const u32x4* qv = (const u32x4*)qp;
#pragma unroll
      for (int part = 0; part < 3; ++part) { const int nq = part < 2 ? 8 : 4; const f32x4* kv = part < 2 ? (const f32x4*)kn + 16 * part : (const f32x4*)kr;
          u32x4 qq[8]; f32x4 kk[16];
#pragma unroll
          for (int j = 0; j < 8; ++j) if (j < nq) qq[j] = qv[8 * part + j];
#pragma unroll
          for (int j = 0; j < 16; ++j) if (j < 2 * nq) kk[j] = kv[j];
#pragma unroll
          for (int j = 0; j < 8; ++j) if (j < nq) { const f32x4 k0 = kk[2 * j], k1 = kk[2 * j + 1];
              a += __uint_as_float(qq[j].x << 16) * k0[0] + __uint_as_float(qq[j].x & 0xffff0000u) * k0[1] + __uint_as_float(qq[j].y << 16) * k0[2] + __uint_as_float(qq[j].y & 0xffff0000u) * k0[3]
                 + __uint_as_float(qq[j].z << 16) * k1[0] + __uint_as_float(qq[j].z & 0xffff0000u) * k1[1] + __uint_as_float(qq[j].w << 16) * k1[2] + __uint_as_float(qq[j].w & 0xffff0000u) * k1[3]; } }
      sc[q * 8 + sp] = a; }
    __syncthreads();
    const int q = 32 * qb + r32, stok = q >> 3, hq = q & 7;
    float M = -INFINITY;
    for (int i = 0; i < ns; ++i) M = fmaxf(M, PARTdb[((size_t)i * 2 + qb) * PART_FLOATS + 64 * 64 + lane]);
    for (int sp = 0; sp <= stok; ++sp) M = fmaxf(M, sc[q * 8 + sp]);
    float acc[16], lsum = 0.f;
#pragma unroll
    for (int r = 0; r < 16; ++r) acc[r] = 0.f;
    for (int i = 0; i < ns; ++i) { const float* pp = PARTdb + ((size_t)i * 2 + qb) * PART_FLOATS; const float f = __builtin_amdgcn_exp2f(pp[64 * 64 + lane] - M);
        lsum += f * pp[65 * 64 + lane];
#pragma unroll
        for (int r = 0; r < 16; ++r) acc[r] += f * pp[(rg * 16 + r) * 64 + lane]; }
    lsum += __shfl_xor(lsum, 32);
    for (int sp = 0; sp <= stok; ++sp) { const float p = __builtin_amdgcn_exp2f(sc[q * 8 + sp] - M); lsum += p; const float* kn = KN + ((size_t)db * DS + sp) * KVL;
#pragma unroll
        for (int r = 0; r < 16; ++r) acc[r] += p * kn[32 * rg + crow(r, hi)]; }
    const float rl = 1.0f / lsum;
#pragma unroll
    for (int r = 0; r < 16; ++r) ol[q * KVL + 32 * rg + crow(r, hi)] = acc[r] * rl;
    __syncthreads();
    float y[8];
#pragma unroll
    for (int s = 0; s < 8; ++s) y[s] = 0.f;
#pragma unroll 1
    for (int c0 = 0; c0 < KVL; c0 += 16) { float w[16];
#pragma unroll
        for (int j = 0; j < 16; ++j) w[j] = w_uv[((size_t)(c0 + j) * NH + wid) * VD + lane];
#pragma unroll
        for (int s = 0; s < 8; ++s) {
#pragma unroll
            for (int j4 = 0; j4 < 4; ++j4) { const f32x4 o4 = *(const ATT_LAS f32x4*)(ol + (s * 8 + wid) * KVL + c0 + 4 * j4);
                y[s] += (o4[0] * w[4 * j4] + o4[1] * w[4 * j4 + 1]) + (o4[2] * w[4 * j4 + 2] + o4[3] * w[4 * j4 + 3]); }
            __builtin_amdgcn_sched_barrier(0); } }
    (void)hq;
#pragma unroll
    for (int s = 0; s < 8; ++s) { float v = y[s] * y[s];
#pragma unroll
        for (int o = 1; o < 64; o <<= 1) v += __shfl_xor(v, o);
        if (lane == 0) red[wid * 8 + s] = v; }
    __syncthreads();
#pragma unroll
    for (int s = 0; s < 8; ++s) { float t = 0.f;
#pragma unroll
        for (int w = 0; w < 8; ++w) t += red[w * 8 + s];
        const float rstd = 1.0f / sqrtf(t * (1.0f / DMLA) + EPS);
        YC[((size_t)RP + (size_t)db * DS + s) * DMIX + DLRU + wid * VD + lane] = (bf16)f2bf(y[s] * rstd * gm[wid * VD + lane]); }
}
}
namespace att2 {
using att::bf16x8; using att::f32x16; using att::s16x4; using att::u32x4; using att::ldsp; using att::cvtpk; using att::crow; using att::offL; using att::offR; using att::lds_b128; using att::lds_tr;
using att::swapmax; using att::swapsum; using att::TILE_LAT; using att::TILE_BYTES; using att::THR; using att::PART_FLOATS;
typedef unsigned u32x2 __attribute__((ext_vector_type(2)));
constexpr int L_PT = 0, L_DT = 3 * TILE_BYTES, L_MG = L_DT + 2 * TILE_BYTES, L_BAR = L_MG + 2 * PART_FLOATS * 4 + 1024;
static_assert(L_BAR + 128 <= 146432, "attention LDS map");

__device__ __forceinline__ void role_bar(ATT_LAS unsigned* cnt, unsigned& target) {
    target += 4u;
    asm volatile("s_waitcnt lgkmcnt(0)" ::: "memory");
    if ((threadIdx.x & 63) == 0) (void)__hip_atomic_fetch_add(cnt, 1u, __ATOMIC_RELAXED, __HIP_MEMORY_SCOPE_WORKGROUP);
    while (__hip_atomic_load(cnt, __ATOMIC_RELAXED, __HIP_MEMORY_SCOPE_WORKGROUP) < target) __builtin_amdgcn_s_sleep(1);
    asm volatile("" ::: "memory");
}

typedef float f32x2 __attribute__((ext_vector_type(2)));
__device__ __forceinline__ float max3(float a, float b, float c) { float d; asm("v_max3_f32 %0, %1, %2, %3" : "=v"(d) : "v"(a), "v"(b), "v"(c)); return d; }
__device__ __forceinline__ void sm_max(const f32x16& s0, const f32x16& s1, float& m, float& l, f32x16 (&o)[2], bool first) {
    float r0 = max3(s0[0], s1[0], s0[1]), r1 = max3(s1[1], s0[2], s1[2]);
#pragma unroll
    for (int r = 3; r < 15; r += 2) { r0 = max3(r0, s0[r], s1[r]); r1 = max3(r1, s0[r + 1], s1[r + 1]); }
    float rm = swapmax(max3(r0, r1, fmaxf(s0[15], s1[15])));
    if (first) m = rm;
    rm -= m;
    if (!first && __any(rm > THR)) { const float dl = fmaxf(rm, 0.f); m += dl; const float f = __builtin_amdgcn_exp2f(-dl); l *= f;
#pragma unroll
        for (int c = 0; c < 2; ++c)
#pragma unroll
            for (int r = 0; r < 16; ++r) o[c][r] *= f; }
}
__device__ __forceinline__ void sm_fin(float rm, float& m, float& l, f32x16 (&o)[2], bool first) {
    rm = swapmax(rm);
    if (first) m = rm;
    rm -= m;
    if (!first && __any(rm > THR)) { const float dl = fmaxf(rm, 0.f); m += dl; const float f = __builtin_amdgcn_exp2f(-dl); l *= f;
#pragma unroll
        for (int c = 0; c < 2; ++c)
#pragma unroll
            for (int r = 0; r < 16; ++r) o[c][r] *= f; }
}
__device__ __forceinline__ void sm_exp(f32x16& s0, f32x16& s1, const float m, float& l) {
    float sum0 = 0.f, sum1 = 0.f;
#pragma unroll
    for (int r = 0; r < 16; ++r) { s0[r] = __builtin_amdgcn_exp2f(s0[r] - m); s1[r] = __builtin_amdgcn_exp2f(s1[r] - m); sum0 += s0[r]; sum1 += s1[r]; }
    l += sum0 + sum1;
}
__device__ __forceinline__ void prompt_role(ldsp lds, const bf16* __restrict__ QbP, const bf16* __restrict__ KVH, float* __restrict__ SSQM, bf16* __restrict__ YC, int b, int h, int qb, unsigned& bt) {
    const int t4 = threadIdx.x & 255, lane = t4 & 63, wid = __builtin_amdgcn_readfirstlane(t4 >> 6), r32 = lane & 31, hi = lane >> 5;
    ATT_LAS unsigned* cnt = (ATT_LAS unsigned*)(lds + L_BAR);
    const int tq0 = 256 * qb + 64 * wid; const size_t row0 = (size_t)b * SEQ + tq0;
    const bf16* KVseq = KVH + ((size_t)(b * NH + h) * SEQ) * QD;
    const int ntile_u = 4 * qb + 4, ntile_w = 4 * qb + wid + 1;
    const unsigned lsrc = (unsigned)(4 * wid + (lane >> 4)) * (QD * 2) + 16u * ((unsigned)(lane & 15) ^ ((((unsigned)(lane >> 4) & 3u) << 2) | ((unsigned)wid & 3u)));
    const unsigned rsrc = (unsigned)(16 * wid + (lane >> 2)) * (QD * 2) + 2 * KVL + 16u * ((unsigned)(lane & 3) ^ ((unsigned)(lane >> 4) & 3u));
    const unsigned lds0 = (unsigned)(size_t)lds + L_PT;
#define R_GLDS(gptr, ldsaddr) do { unsigned keep_; asm volatile("s_mov_b32 %0, m0\n\ts_mov_b32 m0, %2\n\ts_nop 0\n\tglobal_load_lds_dwordx4 %1, off\n\ts_mov_b32 m0, %0" : "=&s"(keep_) : "v"(gptr), "s"(ldsaddr) : "memory"); } while (0)
#define R_DMA(gtile, slot) do { const char* g_ = (const char*)(gtile); const unsigned l_ = (unsigned)__builtin_amdgcn_readfirstlane((int)(lds0 + (unsigned)(slot) + (unsigned)wid * 1024u)); \
        R_GLDS(g_ + lsrc, l_); R_GLDS(g_ + lsrc + 16 * QD * 2, l_ + 4096u); R_GLDS(g_ + lsrc + 32 * QD * 2, l_ + 8192u); R_GLDS(g_ + lsrc + 48 * QD * 2, l_ + 12288u); \
        R_GLDS(g_ + rsrc, l_ + (unsigned)TILE_LAT); } while (0)
    R_DMA(KVseq, 0);
    bf16x8 qa[6], qbf[6];
    { const bf16* qp = QbP + ((row0 + r32) * NH + h) * 96 + 8 * hi;
#pragma unroll
      for (int s = 0; s < 6; ++s) { qa[s] = *(const bf16x8*)(qp + 16 * s); qbf[s] = *(const bf16x8*)(qp + (size_t)32 * NH * 96 + 16 * s); } }
    R_DMA(KVseq + (size_t)64 * QD, TILE_BYTES);
    asm volatile("s_waitcnt vmcnt(0)" ::: "memory");
#pragma unroll
    for (int s = 0; s < 6; ++s) asm volatile("" : "+v"(qa[s]), "+v"(qbf[s]));
    role_bar(cnt, bt);
    float mA = 0.f, lA = 0.f, mB = 0.f, lB = 0.f; f32x16 oA[2], oB[2];
#pragma unroll
    for (int r = 0; r < 16; ++r) { oA[0][r] = 0.f; oA[1][r] = 0.f; oB[0][r] = 0.f; oB[1][r] = 0.f; }
    const unsigned xk = (unsigned)(((r32 & 3) << 1) | ((r32 >> 3) & 1));
    const unsigned ka = 256u * (unsigned)r32 + 16u * ((unsigned)hi ^ ((unsigned)(r32 >> 2) & 1u));
    const unsigned kr0 = TILE_LAT + offR((unsigned)r32, (unsigned)hi), kr1 = TILE_LAT + offR((unsigned)r32, 2u + (unsigned)hi);
    const unsigned blk = (lane >> 4) & 1, qq = (lane & 15) >> 2, pp = lane & 3;
    const unsigned vb0 = 256u * (unsigned)(4 * hi + qq) + 16u * ((2u * blk + (pp >> 1)) ^ (unsigned)hi) + 8u * (pp & 1u);
    const unsigned vb1 = 256u * (unsigned)(8 + 4 * hi + qq) + 16u * ((2u * blk + (pp >> 1)) ^ (2u + (unsigned)hi)) + 8u * (pp & 1u);
    ldsp ring = lds + L_PT;
    int cur = 0, nxt = TILE_BYTES, nn = 2 * TILE_BYTES;
    for (int kt = 0; kt < ntile_u; ++kt) {
        ldsp tile = ring + cur;
        const char* gsrc = (const char*)(KVseq + (size_t)min(kt + 2, ntile_u - 1) * 64 * QD);
        const unsigned ldst = (unsigned)__builtin_amdgcn_readfirstlane((int)(lds0 + (unsigned)nn + (unsigned)wid * 1024u));
#define R_GLDS_S(sbase, voff, ldsaddr) do { unsigned keep_; asm volatile("s_mov_b32 %0, m0\n\ts_mov_b32 m0, %2\n\ts_nop 0\n\tglobal_load_lds_dwordx4 %1, %3\n\ts_mov_b32 m0, %0" : "=&s"(keep_) : "v"(voff), "s"(ldsaddr), "s"(sbase) : "memory"); } while (0)
#define R_PIECE(j) do { if ((j) < 4) R_GLDS_S(gsrc + (j) * 16 * QD * 2, lsrc, ldst + 4096u * (unsigned)(j)); else R_GLDS_S(gsrc, rsrc, ldst + (unsigned)TILE_LAT); } while (0)
        { R_PIECE(0); R_PIECE(1); R_PIECE(2); R_PIECE(3); R_PIECE(4); }
        if (kt < ntile_w) {
            unsigned xko = xk, qqo = qq; asm volatile("" : "+v"(xko), "+v"(qqo));
            const bool lastt = kt == ntile_w - 1; const int kb = kt * 64;
            f32x16 a0, a1, b0, b1;
#define R_QK(s0_, s1_, qf_) do { \
            _Pragma("unroll") for (int r = 0; r < 16; ++r) { s0_[r] = 0.f; s1_[r] = 0.f; } \
            _Pragma("unroll") for (int k = 0; k < 4; ++k) { const unsigned a_ = ka + 32u * ((unsigned)k ^ xko); const bf16x8 k0 = lds_b128(tile + a_), k1 = lds_b128(tile + a_ + 8192); \
                s0_ = ATT_MFMA(k0, qf_[k], s0_); s1_ = ATT_MFMA(k1, qf_[k], s1_); } \
            { const bf16x8 k0 = lds_b128(tile + kr0), k1 = lds_b128(tile + kr0 + 2048); s0_ = ATT_MFMA(k0, qf_[4], s0_); s1_ = ATT_MFMA(k1, qf_[4], s1_); } \
            { const bf16x8 k0 = lds_b128(tile + kr1), k1 = lds_b128(tile + kr1 + 2048); s0_ = ATT_MFMA(k0, qf_[5], s0_); s1_ = ATT_MFMA(k1, qf_[5], s1_); } } while (0)
#define R_MASK(s0_, s1_, tok_) do { int ln_ = lane; asm volatile("" : "+v"(ln_)); int d_ = (tok_) + (ln_ & 31) - kb - 4 * (ln_ >> 5); asm volatile("" : "+v"(d_));   \
            _Pragma("unroll") for (int r = 0; r < 16; ++r) { const int c_ = (r & 3) + 8 * (r >> 2); if (c_ > d_) s0_[r] = -INFINITY; if (c_ + 32 > d_) s1_[r] = -INFINITY; } } while (0)
#define R_PV(s0_, s1_, o_) do { \
            _Pragma("unroll") for (int ks = 0; ks < 4; ++ks) { const int bb = 8 * (ks & 1); const f32x16& pa = (ks < 2) ? s0_ : s1_; \
                u32x4 wa; wa.x = cvtpk(pa[bb + 0], pa[bb + 1]); wa.y = cvtpk(pa[bb + 2], pa[bb + 3]); wa.z = cvtpk(pa[bb + 4], pa[bb + 5]); wa.w = cvtpk(pa[bb + 6], pa[bb + 7]); \
                const bf16x8 pfa = __builtin_bit_cast(bf16x8, wa); \
                _Pragma("unroll") for (int c = 2; c < 4; ++c) { const unsigned co = 64u * ((unsigned)c ^ qqo); \
                    const s16x4 lo = lds_tr(tile + vb0 + co + 4096 * ks), hv = lds_tr(tile + vb1 + co + 4096 * ks); \
                    const bf16x8 vf = {lo[0], lo[1], lo[2], lo[3], hv[0], hv[1], hv[2], hv[3]}; \
                    o_[c - 2] = ATT_MFMA(vf, pfa, o_[c - 2]); } } } while (0)
#define R_K0(i) ((i) < 4 ? ka + 32u * ((unsigned)(i) ^ xko) : ((i) == 4 ? kr0 : kr1))
#define R_K1(i) (R_K0(i) + ((i) < 4 ? 8192u : 2048u))
            { bf16x8 kc0 = lds_b128(tile + R_K0(0)), kc1 = lds_b128(tile + R_K1(0));
#pragma unroll
              for (int r = 0; r < 16; ++r) { a0[r] = 0.f; a1[r] = 0.f; }
#pragma unroll
              for (int i = 0; i < 6; ++i) { bf16x8 kn0 = kc0, kn1 = kc1;
                  if (i < 5) { kn0 = lds_b128(tile + R_K0(i + 1)); kn1 = lds_b128(tile + R_K1(i + 1)); }
                  a0 = ATT_MFMA(kc0, qa[i], a0);
                  __builtin_amdgcn_sched_barrier(0);
                  a1 = ATT_MFMA(kc1, qa[i], a1);
                  __builtin_amdgcn_sched_barrier(0);
                  kc0 = kn0; kc1 = kn1; } }
            if (lastt) R_MASK(a0, a1, tq0);
            sm_max(a0, a1, mA, lA, oA, kt == 0);
#define R_EXPS(v_, s_, n_, m_, acc_) do { \
            _Pragma("unroll") for (int r = 0; r < (n_); ++r) v_[(s_) + r] -= m_; \
            _Pragma("unroll") for (int r = 0; r < (n_); ++r) v_[(s_) + r] = __builtin_amdgcn_exp2f(v_[(s_) + r]); \
            _Pragma("unroll") for (int r = 0; r < (n_); ++r) acc_ += v_[(s_) + r]; } while (0)
            { float sum = 0.f; bf16x8 kc0 = lds_b128(tile + R_K0(0)), kc1 = lds_b128(tile + R_K1(0));
#pragma unroll
              for (int r = 0; r < 16; ++r) { b0[r] = 0.f; b1[r] = 0.f; }
#pragma unroll
              for (int i = 0; i < 6; ++i) { bf16x8 kn0 = kc0, kn1 = kc1;
                  if (i < 5) { kn0 = lds_b128(tile + R_K0(i + 1)); kn1 = lds_b128(tile + R_K1(i + 1)); }
                  const int st_ = i < 4 ? 3 * i : 12 + 2 * (i - 4), n_ = i < 4 ? 3 : 2;
                  b0 = ATT_MFMA(kc0, qbf[i], b0);
                  R_EXPS(a0, st_, n_, mA, sum);
                  __builtin_amdgcn_sched_barrier(0);
                  b1 = ATT_MFMA(kc1, qbf[i], b1);
                  R_EXPS(a1, st_, n_, mA, sum);
                  __builtin_amdgcn_sched_barrier(0);
                  kc0 = kn0; kc1 = kn1; }
              asm volatile("" : "+v"(a0), "+v"(a1), "+v"(sum));
              lA += sum; }
            if (lastt) R_MASK(b0, b1, tq0 + 32);
#define R_VF(g_, dst_) do { const unsigned co_ = 64u * ((unsigned)(2 + ((g_) & 1)) ^ qqo); const s16x4 lo_ = lds_tr(tile + vb0 + co_ + 4096 * ((g_) >> 1)), hv_ = lds_tr(tile + vb1 + co_ + 4096 * ((g_) >> 1)); \
            dst_ = bf16x8{lo_[0], lo_[1], lo_[2], lo_[3], hv_[0], hv_[1], hv_[2], hv_[3]}; } while (0)
#define R_PF(s0_, s1_, ks_, dst_) do { const int bb_ = 8 * ((ks_) & 1); const f32x16& pa_ = ((ks_) < 2) ? s0_ : s1_; u32x4 w_; w_.x = cvtpk(pa_[bb_ + 0], pa_[bb_ + 1]); w_.y = cvtpk(pa_[bb_ + 2], pa_[bb_ + 3]); \
            w_.z = cvtpk(pa_[bb_ + 4], pa_[bb_ + 5]); w_.w = cvtpk(pa_[bb_ + 6], pa_[bb_ + 7]); dst_ = __builtin_bit_cast(bf16x8, w_); } while (0)
            { bf16x8 vc, pf; R_VF(0, vc); R_PF(a0, a1, 0, pf);
              { bf16x8 vn, pn; float r0, r1;
                R_VF(1, vn);
                oA[0] = ATT_MFMA(vc, pf, oA[0]);
                r0 = max3(b0[0], b1[0], b0[1]); r1 = max3(b1[1], b0[2], b1[2]);
#pragma unroll
                for (int r = 3; r < 9; r += 2) { r0 = max3(r0, b0[r], b1[r]); r1 = max3(r1, b0[r + 1], b1[r + 1]); }
                __builtin_amdgcn_sched_barrier(0);
                vc = vn; R_VF(2, vn); R_PF(a0, a1, 1, pn);
                oA[1] = ATT_MFMA(vc, pf, oA[1]);
#pragma unroll
                for (int r = 9; r < 15; r += 2) { r0 = max3(r0, b0[r], b1[r]); r1 = max3(r1, b0[r + 1], b1[r + 1]); }
                r0 = max3(r0, r1, fmaxf(b0[15], b1[15]));
                __builtin_amdgcn_sched_barrier(0);
                vc = vn; pf = pn;
                sm_fin(r0, mB, lB, oB, kt == 0); }
              float sum = 0.f;
#pragma unroll
              for (int g = 2; g < 8; ++g) { bf16x8 vn = vc, pn = pf;
                  if (g < 7) R_VF(g + 1, vn);
                  if ((g & 1) && g < 7) R_PF(a0, a1, (g + 1) >> 1, pn);
                  oA[g & 1] = ATT_MFMA(vc, pf, oA[g & 1]);
                  if (g < 5) R_EXPS(b0, g == 2 ? 0 : 6 + 5 * (g - 3), g == 2 ? 6 : 5, mB, sum); else R_EXPS(b1, g == 5 ? 0 : 6 + 5 * (g - 6), g == 5 ? 6 : 5, mB, sum);
                  __builtin_amdgcn_sched_barrier(0);
                  vc = vn; pf = pn; }
              lB += sum; }
            R_PV(b0, b1, oB);
#undef R_K0
#undef R_K1
#undef R_PIECE
#undef R_GLDS_S
#undef R_EXPS
#undef R_VF
#undef R_PF
#undef R_QK
#undef R_MASK
#undef R_PV
        }
        if (kt + 2 < ntile_u) asm volatile("s_waitcnt vmcnt(5)" ::: "memory");
        else asm volatile("s_waitcnt vmcnt(0)" ::: "memory");
        role_bar(cnt, bt);
        { const int t_ = cur; cur = nxt; nxt = nn; nn = t_; }
    }
#undef R_DMA
#undef R_GLDS
    int lne = lane; asm volatile("" : "+v"(lne));
    const int r32e = lne & 31, hie = lne >> 5;
#pragma unroll
    for (int blkq = 0; blkq < 2; ++blkq) { f32x16 (&o)[2] = blkq ? oB : oA; float l = swapsum(blkq ? lB : lA);
        const float rl = 1.0f / l; float ss = 0.f;
#pragma unroll
        for (int c = 0; c < 2; ++c)
#pragma unroll
            for (int r = 0; r < 16; ++r) { o[c][r] *= rl; ss += o[c][r] * o[c][r]; }
        ss = swapsum(ss);
        const size_t row = row0 + 32 * blkq + r32e;
        if (hie == 0) SSQM[row * NH + h] = ss;
        bf16* yp = YC + row * DMIX + DLRU + h * VD + 4 * hie;
#pragma unroll
        for (int c = 0; c < 2; ++c)
#pragma unroll
            for (int g = 0; g < 4; ++g) { u32x2 w; w.x = cvtpk(o[c][4 * g], o[c][4 * g + 1]); w.y = cvtpk(o[c][4 * g + 2], o[c][4 * g + 3]); *(u32x2*)(yp + 32 * c + 8 * g) = w; } }
    asm volatile("s_waitcnt vmcnt(0)" ::: "memory");
}

__device__ __forceinline__ void dc_load(f32x4 (&st)[10], const float* __restrict__ ckv, const float* __restrict__ ckr, size_t slot0, int t4) {
    const f32x4* pl = (const f32x4*)(ckv + slot0 * KVL) + t4; const f32x4* pr = (const f32x4*)(ckr + slot0 * ROPE) + t4;
#pragma unroll
    for (int i = 0; i < 8; ++i) st[i] = __builtin_nontemporal_load(pl + 256 * i);
#pragma unroll
    for (int i = 0; i < 2; ++i) st[8 + i] = __builtin_nontemporal_load(pr + 256 * i);
}
__device__ __forceinline__ void dc_store(const f32x4 (&st)[10], ldsp img, unsigned dE, unsigned dO, unsigned dr) {
#pragma unroll
    for (int i = 0; i < 8; ++i) { u32x2 wv; wv.x = cvtpk(st[i].x, st[i].y); wv.y = cvtpk(st[i].z, st[i].w); *(ATT_LAS u32x2*)(img + ((i & 1) ? dO : dE) + 2048 * i) = wv; }
#pragma unroll
    for (int i = 0; i < 2; ++i) { u32x2 wv; wv.x = cvtpk(st[8 + i].x, st[8 + i].y); wv.y = cvtpk(st[8 + i].z, st[8 + i].w); *(ATT_LAS u32x2*)(img + TILE_LAT + dr + 2048 * i) = wv; }
}
__device__ __forceinline__ void decode_role(ldsp lds, const bf16* __restrict__ Qb, const float* __restrict__ ckv, const float* __restrict__ ckr, const int* __restrict__ ptab,
                                            float* __restrict__ PART, int db, int pg0, int npg, unsigned& bt) {
    const int t4 = threadIdx.x & 255, lane = t4 & 63, w = __builtin_amdgcn_readfirstlane(t4 >> 6), r32 = lane & 31, hi = lane >> 5;
    const int qb = w & 1, kb = w >> 1, rb = 32 * kb;
    ATT_LAS unsigned* cnt = (ATT_LAS unsigned*)(lds + L_BAR + 64);
    const int mypg = ptab[db * NPAGES + pg0 + (lane < npg ? lane : 0)];
#define DC_PG(i) ((size_t)__builtin_amdgcn_readlane(mypg, (i)))
    unsigned dE, dO, dr;
    { const unsigned r0 = (unsigned)t4 >> 5, c4 = (unsigned)t4 & 31u;
      const unsigned xE = ((r0 & 3u) << 2) | ((r0 >> 2) & 3u), xO = ((r0 & 3u) << 2) | (((r0 >> 2) + 2u) & 3u);
      dE = 256u * r0 + 16u * ((c4 >> 1) ^ xE) + 8u * (c4 & 1u); dO = 256u * r0 + 16u * ((c4 >> 1) ^ xO) + 8u * (c4 & 1u);
      const unsigned rr = (unsigned)t4 >> 3, c4r = (unsigned)t4 & 7u; dr = offR(rr, c4r >> 1) + 8u * (c4r & 1u); }
    f32x4 sa[10], sb[10];
    dc_load(sa, ckv, ckr, DC_PG(0) * PAGE, t4);
    dc_load(sb, ckv, ckr, DC_PG(0) * PAGE + 64, t4);
    {
      const bf16* qsrc = Qb + ((size_t)RP + (size_t)db * DS) * NH * QD; const unsigned dq = offL((unsigned)t4 >> 4, (unsigned)t4 & 15u);
#pragma unroll
      for (int i = 0; i < 4; ++i) *(ATT_LAS u32x4*)(lds + L_MG + dq + 4096 * i) = *(const u32x4*)(qsrc + (size_t)((t4 >> 4) + 16 * i) * QD + (t4 & 15) * 8);
      *(ATT_LAS u32x4*)(lds + L_MG + TILE_LAT + offR((unsigned)t4 >> 2, (unsigned)t4 & 3u)) = *(const u32x4*)(qsrc + (size_t)(t4 >> 2) * QD + KVL + (t4 & 3) * 8); }
    dc_store(sa, lds + L_DT, dE, dO, dr);
    role_bar(cnt, bt);
    const unsigned qa = L_MG + 256u * (unsigned)(32 * qb + r32) + 16u * ((unsigned)hi ^ ((unsigned)(r32 >> 2) & 1u));
    const unsigned qr0 = L_MG + TILE_LAT + offR((unsigned)(32 * qb + r32), (unsigned)hi), qr1 = L_MG + TILE_LAT + offR((unsigned)(32 * qb + r32), 2u + (unsigned)hi);
    float m = 0.f, l = 0.f; f32x16 o[4];
#pragma unroll
    for (int r = 0; r < 16; ++r) { o[0][r] = 0.f; o[1][r] = 0.f; o[2][r] = 0.f; o[3][r] = 0.f; }
    const unsigned xk = (unsigned)(((r32 & 3) << 1) | ((r32 >> 3) & 1));
    const unsigned ka = 256u * (unsigned)(rb + r32) + 16u * ((unsigned)hi ^ ((unsigned)(r32 >> 2) & 1u));
    const unsigned kr0 = TILE_LAT + offR((unsigned)(rb + r32), (unsigned)hi), kr1 = TILE_LAT + offR((unsigned)(rb + r32), 2u + (unsigned)hi);
    const unsigned blk = (lane >> 4) & 1, qq = (lane & 15) >> 2, pp = lane & 3;
    const unsigned vb0 = 256u * (unsigned)(rb + 4 * hi + qq) + 16u * ((2u * blk + (pp >> 1)) ^ (unsigned)hi) + 8u * (pp & 1u);
    const unsigned vb1 = 256u * (unsigned)(rb + 8 + 4 * hi + qq) + 16u * ((2u * blk + (pp >> 1)) ^ (2u + (unsigned)hi)) + 8u * (pp & 1u);
    const int nhp = 2 * npg;
    bf16x8 qf[6];
    { unsigned xq = xk; asm volatile("" : "+v"(xq));
#pragma unroll
      for (int k = 0; k < 6; ++k) qf[k] = lds_b128(lds + qa + 32u * ((unsigned)k ^ xq));
    }
#define DC_HALF(img, first) do { \
        unsigned xko = xk, qqo = qq; asm volatile("" : "+v"(xko), "+v"(qqo)); \
        f32x16 s; \
        _Pragma("unroll") for (int r = 0; r < 16; ++r) s[r] = 0.f; \
        _Pragma("unroll") for (int k = 0; k < 8; ++k) { const unsigned co_ = 32u * ((unsigned)k ^ xko); s = ATT_MFMA(lds_b128((img) + ka + co_), k < 6 ? qf[k < 6 ? k : 0] : lds_b128(lds + qa + co_), s); } \
        s = ATT_MFMA(lds_b128((img) + kr0), lds_b128(lds + qr0), s); \
        s = ATT_MFMA(lds_b128((img) + kr1), lds_b128(lds + qr1), s); \
        float rm = max3(s[0], s[1], s[2]); \
        _Pragma("unroll") for (int r = 3; r < 15; r += 2) rm = max3(rm, s[r], s[r + 1]); \
        rm = max3(rm, s[15], s[15]); \
        rm = swapmax(rm); \
        if (first) m = rm; \
        rm -= m; \
        if (!(first) && __any(rm > THR)) { const float dlt = fmaxf(rm, 0.f); m += dlt; const float f = __builtin_amdgcn_exp2f(-dlt); l *= f; \
            _Pragma("unroll") for (int c = 0; c < 4; ++c) _Pragma("unroll") for (int r = 0; r < 16; ++r) o[c][r] *= f; } \
        { float sum0 = 0.f, sum1 = 0.f;     \
          _Pragma("unroll") for (int r = 0; r < 16; r += 2) { s[r] = __builtin_amdgcn_exp2f(s[r] - m); s[r + 1] = __builtin_amdgcn_exp2f(s[r + 1] - m); sum0 += s[r]; sum1 += s[r + 1]; } \
          l += sum0 + sum1; } \
        _Pragma("unroll") for (int ks = 0; ks < 2; ++ks) { \
            u32x4 pw; pw.x = cvtpk(s[8 * ks + 0], s[8 * ks + 1]); pw.y = cvtpk(s[8 * ks + 2], s[8 * ks + 3]); pw.z = cvtpk(s[8 * ks + 4], s[8 * ks + 5]); pw.w = cvtpk(s[8 * ks + 6], s[8 * ks + 7]); \
            const bf16x8 pf = __builtin_bit_cast(bf16x8, pw); \
            _Pragma("unroll") for (int c = 0; c < 4; ++c) { const unsigned co = 64u * ((unsigned)c ^ qqo); \
                const s16x4 lo = lds_tr((img) + vb0 + co + 4096 * ks), hv = lds_tr((img) + vb1 + co + 4096 * ks); \
                const bf16x8 vf = {lo[0], lo[1], lo[2], lo[3], hv[0], hv[1], hv[2], hv[3]}; \
                o[c] = ATT_MFMA(vf, pf, o[c]); } } \
    } while (0)
    for (int hp = 0; hp < nhp; hp += 2) {
        dc_load(sa, ckv, ckr, DC_PG(min((hp + 2) >> 1, npg - 1)) * PAGE, t4);
        DC_HALF(lds + L_DT, hp == 0);
        dc_store(sb, lds + L_DT + TILE_BYTES, dE, dO, dr);
        role_bar(cnt, bt);
        dc_load(sb, ckv, ckr, DC_PG(min((hp + 3) >> 1, npg - 1)) * PAGE + 64, t4);
        DC_HALF(lds + L_DT + TILE_BYTES, false);
        if (hp + 2 < nhp) dc_store(sa, lds + L_DT, dE, dO, dr);
        role_bar(cnt, bt);
    }
#undef DC_HALF
#undef DC_PG
    ATT_LAS float* reg = (ATT_LAS float*)(lds + L_MG) + qb * PART_FLOATS + lane;
    if (kb == 0) {
#pragma unroll
        for (int c = 0; c < 4; ++c)
#pragma unroll
            for (int r = 0; r < 16; ++r) reg[(c * 16 + r) * 64] = o[c][r];
        reg[64 * 64] = m; reg[65 * 64] = l; }
    role_bar(cnt, bt);
    if (kb == 1) { const float m2 = reg[64 * 64], l2 = reg[65 * 64]; const float mn = fmaxf(m, m2); const float a1 = __builtin_amdgcn_exp2f(m - mn), a2 = __builtin_amdgcn_exp2f(m2 - mn);
        float* gp = PART + (size_t)qb * PART_FLOATS + lane;
#pragma unroll
        for (int c = 0; c < 4; ++c)
#pragma unroll
            for (int r = 0; r < 16; ++r) gp[(c * 16 + r) * 64] = o[c][r] * a1 + reg[(c * 16 + r) * 64] * a2;
        gp[64 * 64] = mn; gp[65 * 64] = l * a1 + l2 * a2; }
    role_bar(cnt, bt);
}
}
namespace lru {
using att::bf16x8; using att::f32x16; using att::u32x4; using att::ldsp; using att::cvtpk; using att::crow;
constexpr int XCT_STRIDE = 72;
constexpr int XCT_WAVE_BYTES = 64 * XCT_STRIDE * 2;
constexpr int LDS_RED = 0;
constexpr int LDS_RS = LDS_RED + 8 * 64 * 32 * 4;
__device__ __forceinline__ float bf2f(unsigned short v) { return __uint_as_float((unsigned)v << 16); }
__device__ __forceinline__ float sigm(float x) { return __builtin_amdgcn_rcpf(1.0f + __builtin_amdgcn_exp2f(-1.4426950408889634f * x)); }

struct State { f32x16 P[2][2]; f32x16 H[2][2]; };

template <bool SAMPLE, int NRB = 2>
__device__ __forceinline__ void unit_pre(ldsp lds, State& st, const bf16* __restrict__ XL, const bf16* __restrict__ WGT, const float* __restrict__ conv_w, const float* __restrict__ conv_b,
                                         const float* __restrict__ b_a, const float* __restrict__ b_i, const float* __restrict__ lam, const float* __restrict__ state_conv, const float* __restrict__ state_h,
                                         float* __restrict__ out, size_t rowbase, int b0, int tpos0, float* __restrict__ SUMp  ) {
    const int tid = threadIdx.x, lane = tid & 63, n = __builtin_amdgcn_readfirstlane(tid >> 6), r32 = lane & 31, hi = lane >> 5;
    ATT_LAS unsigned short* xct = (ATT_LAS unsigned short*)(lds + n * XCT_WAVE_BYTES);
    bf16x8 af[2][4];
#pragma unroll
    for (int s = 0; s < 4; ++s) { const int ch0 = 64 * n + 16 * s + 8 * hi;
        float w[4][8], bb[8];
#pragma unroll
        for (int k = 0; k < 4; ++k) { const f32x4 a = *(const f32x4*)(conv_w + k * DLRU + ch0), c = *(const f32x4*)(conv_w + k * DLRU + ch0 + 4);
            w[k][0] = a[0]; w[k][1] = a[1]; w[k][2] = a[2]; w[k][3] = a[3]; w[k][4] = c[0]; w[k][5] = c[1]; w[k][6] = c[2]; w[k][7] = c[3]; }
        { const f32x4 a = *(const f32x4*)(conv_b + ch0), c = *(const f32x4*)(conv_b + ch0 + 4); bb[0] = a[0]; bb[1] = a[1]; bb[2] = a[2]; bb[3] = a[3]; bb[4] = c[0]; bb[5] = c[1]; bb[6] = c[2]; bb[7] = c[3]; }
#pragma unroll
        for (int rb = 0; rb < NRB; ++rb) { const int tk = 32 * rb + r32;
            const int tseq = SAMPLE ? (tk & 7) : tpos0 + tk;
            float xc[8];
#pragma unroll
            for (int j = 0; j < 8; ++j) xc[j] = bb[j];
#pragma unroll
            for (int k = 0; k < 4; ++k) { const int back = 3 - k;
                float xv[8];
                const bool inseq = tseq - back >= 0;
                { const bf16x8 v = *(const bf16x8*)(XL + (rowbase + tk - (inseq ? back : 0)) * DLRU + ch0);
#pragma unroll
                  for (int j = 0; j < 8; ++j) xv[j] = inseq ? bf2f((unsigned short)v[j]) : 0.f; }
                if (SAMPLE && back > 0) { const int sr = inseq ? 0 : 3 + tseq - back;
                    const float* sp = state_conv + ((size_t)(b0 + (tk >> 3)) * 3 + sr) * DLRU + ch0; const f32x4 a = *(const f32x4*)sp, c = *(const f32x4*)(sp + 4);
                    if (!inseq) { xv[0] = a[0]; xv[1] = a[1]; xv[2] = a[2]; xv[3] = a[3]; xv[4] = c[0]; xv[5] = c[1]; xv[6] = c[2]; xv[7] = c[3]; } }
#pragma unroll
                for (int j = 0; j < 8; ++j) xc[j] += w[k][j] * xv[j]; }
            u32x4 pw; pw.x = cvtpk(xc[0], xc[1]); pw.y = cvtpk(xc[2], xc[3]); pw.z = cvtpk(xc[4], xc[5]); pw.w = cvtpk(xc[6], xc[7]);
            af[rb][s] = __builtin_bit_cast(bf16x8, pw);
            *(ATT_LAS u32x4*)(xct + tk * XCT_STRIDE + 16 * s + 8 * hi) = pw;
        }
    }
    if (SAMPLE || tpos0 + 32 * NRB > SEQ - 3) {
#pragma unroll
        for (int s = 0; s < 4; ++s) { const int ch0 = 64 * n + 16 * s + 8 * hi;
#pragma unroll
            for (int rb = 0; rb < NRB; ++rb) { const int tk = 32 * rb + r32; const int tseq = SAMPLE ? (tk & 7) : tpos0 + tk;
                if (tseq >= (SAMPLE ? DS : SEQ) - 3) { const bf16x8 v = *(const bf16x8*)(XL + (rowbase + tk) * DLRU + ch0);
                    float* o = out + (SAMPLE ? O_CVS : O_CVP) + ((size_t)(SAMPLE ? b0 + (tk >> 3) : b0) * 3 + (tseq - ((SAMPLE ? DS : SEQ) - 3))) * DLRU + ch0;
#pragma unroll
                    for (int j = 0; j < 8; ++j) o[j] = bf2f((unsigned short)v[j]); } } }
    }
#pragma unroll
    for (int g = 0; g < 2; ++g)
#pragma unroll
        for (int cb = 0; cb < 2; ++cb) { f32x16 c0, c1;
#pragma unroll
            for (int r = 0; r < 16; ++r) { c0[r] = 0.f; c1[r] = 0.f; }
#pragma unroll
            for (int s = 0; s < 4; ++s) { const bf16x8 bf = *(const bf16x8*)(WGT + (((size_t)n * 2 + g) * 64 + 32 * cb + r32) * 64 + 16 * s + 8 * hi);
                c0 = ATT_MFMA(af[0][s], bf, c0); if (NRB == 2) c1 = ATT_MFMA(af[1][s], bf, c1); }
            if (g == 0) { st.P[0][cb] = c0; st.P[1][cb] = c1; } else { st.H[0][cb] = c0; st.H[1][cb] = c1; }
            __builtin_amdgcn_sched_barrier(0); }
    asm volatile("s_waitcnt lgkmcnt(0)" ::: "memory");
#pragma unroll
    for (int cb = 0; cb < 2; ++cb) { const int ch = 64 * n + 32 * cb + r32;
        const float ba = b_a[ch], bi = b_i[ch]; const float nl = -lam[ch]; const float sp8 = 8.0f * (fmaxf(nl, 0.f) + log1pf(__expf(-fabsf(nl))));
#pragma unroll
        for (int rb = 0; rb < NRB; ++rb)
#pragma unroll
            for (int r = 0; r < 16; ++r) { const int tk = 32 * rb + crow(r, hi);
                const float xc = bf2f(xct[tk * XCT_STRIDE + 32 * cb + r32]);
                const float rg = sigm(st.P[rb][cb][r] + ba), ig = sigm(st.H[rb][cb][r] + bi);
                const float la = -rg * sp8;
                const float a = __builtin_amdgcn_exp2f(1.4426950408889634f * la);
                const float y = -2.0f * la;
                const float poly = y * (1.0f + y * (-0.5f + y * (1.6666667e-1f + y * (-4.1666667e-2f + y * (8.3333333e-3f + y * -1.3888889e-3f)))));
                const float wgt = __builtin_amdgcn_fmed3f(10.0f * y - 2.0f, 0.0f, 1.0f);
                const float om = poly + wgt * ((1.0f - a * a) - poly);
                st.P[rb][cb][r] = a; st.H[rb][cb][r] = __builtin_amdgcn_sqrtf(om) * (ig * xc); }
        __builtin_amdgcn_sched_barrier(0); }
#pragma unroll
    for (int cb = 0; cb < 2; ++cb) { const int ch = 64 * n + 32 * cb + r32;
        float h = 0.f, pr = 1.f;
#pragma unroll
        for (int k = 0; k < 8 * NRB; ++k) { const int rb = k >> 3, g = (k >> 1) & 3, owner = k & 1;
            if (SAMPLE && (k & 1) == 0) { h = state_h[(size_t)(b0 + (k >> 1)) * DLRU + ch]; pr = 1.f; }
            if (hi == owner) {
#pragma unroll
                for (int i = 0; i < 4; ++i) { const float a = st.P[rb][cb][4 * g + i]; h = a * h + st.H[rb][cb][4 * g + i]; pr *= a; st.H[rb][cb][4 * g + i] = h; st.P[rb][cb][4 * g + i] = pr; } }
            const float ho = __shfl_xor(h, 32), po = __shfl_xor(pr, 32);
            if (hi != owner) { h = ho; pr = po; }
            if (SAMPLE && (k & 1) == 1 && hi == 0) out[O_HS + (size_t)(b0 + (k >> 1)) * DLRU + ch] = h; }
        if (!SAMPLE && hi == 0) { SUMp[2 * ch] = pr; SUMp[2 * ch + 1] = h; } }
}
template <int NRB = 2>
__device__ __forceinline__ void unit_post(ldsp lds, State& st, const bf16* __restrict__ GG, const float* __restrict__ gain, bf16* __restrict__ YC, size_t rowbase, float carry0, float carry1) {
    const int tid = threadIdx.x, lane = tid & 63, n = __builtin_amdgcn_readfirstlane(tid >> 6), r32 = lane & 31, hi = lane >> 5;
    ATT_LAS float* red = (ATT_LAS float*)(lds + LDS_RED); ATT_LAS float* rs = (ATT_LAS float*)(lds + LDS_RS);
    __syncthreads();
#pragma unroll
    for (int rb = 0; rb < NRB; ++rb)
#pragma unroll
        for (int r = 0; r < 16; ++r) { const int tk = 32 * rb + crow(r, hi); float ss = 0.f;
#pragma unroll
            for (int cb = 0; cb < 2; ++cb) { const int ch = 64 * n + 32 * cb + r32; const float cr = cb ? carry1 : carry0;
                const float h = st.H[rb][cb][r] + st.P[rb][cb][r] * cr;
                const float y = bf2f(GG[(rowbase + tk) * DLRU + ch]) * h;
                st.H[rb][cb][r] = y; ss += y * y; }
            red[(n * 64 + tk) * 32 + r32] = ss; }
    __syncthreads();
    { const int tk = tid >> 3, part = tid & 7; float s = 0.f;
#pragma unroll
      for (int j = 0; j < 8; ++j) { const f32x4 v = *(const ATT_LAS f32x4*)(red + (part * 64 + tk) * 32 + 4 * j); s += (v[0] + v[1]) + (v[2] + v[3]); }
      s += __shfl_xor(s, 1); s += __shfl_xor(s, 2); s += __shfl_xor(s, 4);
      if (part == 0 && tk < 32 * NRB) rs[tk] = __builtin_amdgcn_rsqf(s * (1.0f / DLRU) + EPS); }
    __syncthreads();
#pragma unroll
    for (int cb = 0; cb < 2; ++cb) { const int ch = 64 * n + 32 * cb + r32; const float gn = gain[ch];
#pragma unroll
        for (int rb = 0; rb < NRB; ++rb)
#pragma unroll
            for (int r = 0; r < 16; ++r) { const int tk = 32 * rb + crow(r, hi);
                YC[(rowbase + tk) * DMIX + ch] = (bf16)f2bf(st.H[rb][cb][r] * rs[tk] * gn); } }
    __syncthreads();
}
__device__ __forceinline__ float chunk_carry(const float* __restrict__ SUMb, int c, int ch) {
    float h = 0.f;
    int k = 0;
    for (; k + 16 <= c; k += 16) { float2 v[16];
#pragma unroll
        for (int j = 0; j < 16; ++j) v[j] = *(const float2*)(SUMb + ((size_t)(k + j) * DLRU + ch) * 2);
#pragma unroll
        for (int j = 0; j < 16; ++j) h = v[j].x * h + v[j].y; }
#pragma unroll 8
    for (; k < c; ++k) { const float2 v = *(const float2*)(SUMb + ((size_t)k * DLRU + ch) * 2); h = v.x * h + v.y; }
    return h;
}
}
namespace sg {
typedef short bf16x8 __attribute__((ext_vector_type(8)));
typedef unsigned u32x2 __attribute__((ext_vector_type(2)));
using att::u32x4; using att::offL; using att::ldsp;
constexpr int CHK = 256, HALF_B = 64 * 256, TILE_B = 2 * HALF_B  , BUF_B = 2 * TILE_B;
__device__ __forceinline__ void ld_chunk(u32x4 (&st)[8], const bf16* __restrict__ ap, const bf16* __restrict__ bp, int K) {
#pragma unroll
    for (int i = 0; i < 4; ++i) { st[i] = *(const u32x4*)(ap + (size_t)16 * i * K); st[4 + i] = *(const u32x4*)(bp + (size_t)16 * i * K); }
}
__device__ __forceinline__ void st_chunk(const u32x4 (&st)[8], ldsp buf, unsigned d) {
#pragma unroll
    for (int i = 0; i < 4; ++i) { *(ATT_LAS u32x4*)(buf + d + 4096 * i) = st[i]; *(ATT_LAS u32x4*)(buf + TILE_B + d + 4096 * i) = st[4 + i]; }
}
__device__ __forceinline__ void unit64(ldsp lds, const bf16* __restrict__ A, const bf16* __restrict__ Bt, int K, int r0, int c0, const float* __restrict__ basef,
                                       bf16* Xb, float* __restrict__ SSQX, float alpha, float* __restrict__ outf = nullptr, const float* __restrict__ gain = nullptr, unsigned* cnt = nullptr) {
    const int tid = threadIdx.x, lane = tid & 63, w = __builtin_amdgcn_readfirstlane(tid >> 6), nt = w & 1, kq = w >> 1, r32 = lane & 31, hi = lane >> 5;
    const bf16* ap = A + (size_t)(r0 + (tid >> 5)) * K + 8 * (tid & 31); const bf16* bp = Bt + (size_t)(c0 + (tid >> 5)) * K + 8 * (tid & 31);
    const unsigned d = (unsigned)((tid & 31) >> 4) * HALF_B + offL((unsigned)tid >> 5, (unsigned)tid & 15u);
    const unsigned xa = (unsigned)(((r32 & 3) << 2) | ((r32 >> 2) & 3));
    const unsigned ra = (unsigned)(kq >> 1) * HALF_B + 256u * (unsigned)r32, rb = TILE_B + (unsigned)(kq >> 1) * HALF_B + 256u * (unsigned)(32 * nt + r32);
    typedef float f32x16 __attribute__((ext_vector_type(16)));
    f32x16 acc0, acc1;
#pragma unroll
    for (int r = 0; r < 16; ++r) { acc0[r] = 0.f; acc1[r] = 0.f; }
    u32x4 s0[8], s1[8], s2[8];
    const int nch = K / CHK;
    ld_chunk(s0, ap, bp, K);
    { const int c1 = min(1, nch - 1), c2 = min(2, nch - 1); ld_chunk(s1, ap + c1 * CHK, bp + c1 * CHK, K); ld_chunk(s2, ap + c2 * CHK, bp + c2 * CHK, K); }
    __syncthreads();
    st_chunk(s0, lds, d);
    __syncthreads();
#define SG_COMPUTE(buf) do { unsigned xo = xa; asm volatile("" : "+v"(xo)); \
        _Pragma("unroll") for (int j = 0; j < 4; ++j) { const unsigned co = 16u * ((unsigned)(8 * (kq & 1) + 2 * j + hi) ^ xo); \
            const bf16x8 b = *(const ATT_LAS bf16x8*)((buf) + rb + co), a0 = *(const ATT_LAS bf16x8*)((buf) + ra + co), a1 = *(const ATT_LAS bf16x8*)((buf) + ra + 8192 + co); \
            acc0 = __builtin_amdgcn_mfma_f32_32x32x16_bf16(b, a0, acc0, 0, 0, 0); acc1 = __builtin_amdgcn_mfma_f32_32x32x16_bf16(b, a1, acc1, 0, 0, 0); } } while (0)
#define SG_STEP(j, SETL, SETS) { const int cc = c + (j); if (cc >= nch) break; \
        { const int cn = min(cc + 3, nch - 1); ld_chunk(SETL, ap + cn * CHK, bp + cn * CHK, K); } \
        SG_COMPUTE(lds + ((j) & 1) * BUF_B); \
        if (cc + 1 < nch) st_chunk(SETS, lds + (((j) + 1) & 1) * BUF_B, d); \
        __syncthreads(); }
    for (int c = 0; c < nch; c += 6) { SG_STEP(0, s0, s1) SG_STEP(1, s1, s2) SG_STEP(2, s2, s0) SG_STEP(3, s0, s1) SG_STEP(4, s1, s2) SG_STEP(5, s2, s0) }
#undef SG_STEP
#undef SG_COMPUTE
    constexpr int PS = 68;
    ATT_LAS float* P = (ATT_LAS float*)lds;
#pragma unroll
    for (int f = 0; f < 2; ++f)
#pragma unroll
        for (int g = 0; g < 4; ++g) { const f32x16& a = f ? acc1 : acc0; f32x4 q = {a[4 * g], a[4 * g + 1], a[4 * g + 2], a[4 * g + 3]};
            *(ATT_LAS f32x4*)(P + ((size_t)(kq * 64 + 32 * f + r32) * PS + 32 * nt + 8 * g + 4 * hi)) = q; }
    __syncthreads();
    { const int m = tid >> 3, n8 = 8 * (tid & 7); f32x4 v0 = {0.f, 0.f, 0.f, 0.f}, v1 = {0.f, 0.f, 0.f, 0.f};
#pragma unroll
      for (int q = 0; q < 4; ++q) { const ATT_LAS f32x4* pp = (const ATT_LAS f32x4*)(P + ((size_t)(q * 64 + m) * PS + n8)); v0 = v0 + pp[0]; v1 = v1 + pp[1]; }
      const size_t off = ((size_t)r0 + m) * 1024 + c0 + n8; f32x4 b0, b1;
      if (basef) { b0 = *(const f32x4*)(basef + off); b1 = *(const f32x4*)(basef + off + 4); }
      else { const u32x4 bw = *(const u32x4*)(Xb + off);
          b0[0] = __uint_as_float(bw.x << 16); b0[1] = __uint_as_float(bw.x & 0xffff0000u); b0[2] = __uint_as_float(bw.y << 16); b0[3] = __uint_as_float(bw.y & 0xffff0000u);
          b1[0] = __uint_as_float(bw.z << 16); b1[1] = __uint_as_float(bw.z & 0xffff0000u); b1[2] = __uint_as_float(bw.w << 16); b1[3] = __uint_as_float(bw.w & 0xffff0000u); }
      v0 = v0 * alpha + b0; v1 = v1 * alpha + b1;
      float ss = ((v0[0] * v0[0] + v0[1] * v0[1]) + (v0[2] * v0[2] + v0[3] * v0[3])) + ((v1[0] * v1[0] + v1[1] * v1[1]) + (v1[2] * v1[2] + v1[3] * v1[3]));
      ss += __shfl_xor(ss, 1); ss += __shfl_xor(ss, 2); ss += __shfl_xor(ss, 4);
      if (!outf) { u32x4 pw; pw.x = att::cvtpk(v0[0], v0[1]); pw.y = att::cvtpk(v0[2], v0[3]); pw.z = att::cvtpk(v1[0], v1[1]); pw.w = att::cvtpk(v1[2], v1[3]); *(u32x4*)(Xb + off) = pw;
          if ((tid & 7) == 0) SSQX[((size_t)r0 + m) * 16 + (c0 >> 6)] = ss; }
      else {
          if ((tid & 7) == 0) __hip_atomic_store(SSQX + ((size_t)r0 + m) * 16 + (c0 >> 6), ss, __ATOMIC_RELAXED, __HIP_MEMORY_SCOPE_AGENT);
          asm volatile("s_waitcnt vmcnt(0)" ::: "memory");
          __syncthreads();
          if (tid == 0) { __hip_atomic_fetch_add(cnt, 1u, __ATOMIC_RELAXED, __HIP_MEMORY_SCOPE_AGENT); unsigned sp = 0u;
              while (__hip_atomic_load(cnt, __ATOMIC_RELAXED, __HIP_MEMORY_SCOPE_AGENT) < 16u) { __builtin_amdgcn_s_sleep(2); if (++sp > (1u << 22)) break; }
              __builtin_amdgcn_fence(__ATOMIC_ACQUIRE, "agent"); }
          asm volatile("s_waitcnt vmcnt(0)" ::: "memory");
          __syncthreads();
          const unsigned long long* sl = (const unsigned long long*)(SSQX + ((size_t)r0 + m) * 16); float t = 0.f;
#pragma unroll
          for (int j = 0; j < 8; ++j) { const unsigned long long w = __hip_atomic_load(sl + j, __ATOMIC_RELAXED, __HIP_MEMORY_SCOPE_AGENT); t += __uint_as_float((unsigned)w) + __uint_as_float((unsigned)(w >> 32)); }
          const float rs = 1.0f / sqrtf(t * (1.0f / 1024.0f) + 1e-6f);
          const f32x4 g0 = *(const f32x4*)(gain + c0 + n8), g1 = *(const f32x4*)(gain + c0 + n8 + 4);
          *(f32x4*)(outf + off) = v0 * rs * g0; *(f32x4*)(outf + off + 4) = v1 * rs * g1; } }
}
}
constexpr size_t MiB = 1u << 20;
constexpr size_t WS_CTL = 0, CTL_ZERO_BYTES = 64 * 1024;
constexpr size_t WS_WGU1 = 2 * MiB, WS_WD1 = 14 * MiB, WS_WGU2 = 20 * MiB, WS_WD2 = 32 * MiB, WS_WIN = 38 * MiB, WS_WOUT = 42 * MiB, WS_WQ = 44 * MiB, WS_SUM = 46 * MiB, WS_WGT = 48 * MiB, WS_SSQ = 49 * MiB, WS_KCS = 50 * MiB, WS_WUVF = 51 * MiB, WS_CKV = 52 * MiB, WS_SSQX = 61 * MiB, WS_WQP = 45 * MiB, WS_WKV = 45 * MiB + 512 * 1024;
static_assert(WS_SSQX + (size_t)R * 64 <= 64 * MiB && WS_WQ + (size_t)NQ * QL * 2 <= WS_WQP && WS_WQP + (size_t)NH * 96 * QL * 2 <= WS_WKV && WS_WKV + (size_t)NH * 128 * KVL * 2 <= WS_SUM, "workspace map");
constexpr size_t WS_XN = 64 * MiB, WS_H = 100 * MiB, WS_X1 = 200 * MiB, WS_X2 = 270 * MiB, WS_Z = 340 * MiB, WS_QALL = 444 * MiB, WS_CQN = 530 * MiB;
constexpr size_t WS_A = 540 * MiB, WS_U = 576 * MiB, WS_YL = 612 * MiB, WS_OLAT = 648 * MiB, WS_YC = 720 * MiB, WS_QB = 760 * MiB, WS_KC = 820 * MiB, WS_PART = 830 * MiB, WS_XL = 900 * MiB, WS_GG = 920 * MiB, WS_CQ = 940 * MiB, WS_QBP = 950 * MiB, WS_KVH = 980 * MiB, WS_CKVB = 1024 * MiB, WS_SSQM = 1030 * MiB, WS_XCH = 1032 * MiB  , WS_END = 1034 * MiB;
constexpr int CW_QUE = 256;
constexpr int CW_BAR = 1024;
constexpr int CW_FIN = 8192, CW_FINS = 12288;
static_assert((CW_BAR + XCD_BAR_WORDS) <= CW_FIN && (CW_FINS + 64 * (RS / 64)) * 4 <= (int)CTL_ZERO_BYTES && CW_FIN + 64 * (RP / 256) <= CW_FINS, "CTL");
constexpr int RING_BYTES = 131072, LDS_BYTES = 147456, LDSCTL_OFF = LDS_BYTES - 1024, MISC_OFF = LDSCTL_OFF + 320;
static_assert(att::PR_LDS_END <= LDSCTL_OFF, "prompt attention LDS map");
constexpr int NSPLIT = 2;
constexpr int CHUNK = 64, NCHUNK = SEQ / CHUNK;

struct Params { const float* in[33]; float* out; unsigned char* ws; int ph_lo, ph_hi; };
static_assert(sizeof(Params) == 33 * 8 + 8 + 8 + 8, "Params has no padding");

template <bool NT_STORE>
__device__ __forceinline__ void transpose_tile(const float* __restrict__ src, int ldw, bf16* __restrict__ dst, int ldt, LAS float* scr, int lane, const float* __restrict__ gain) {
    {
        const float* wp = src + (size_t)(lane >> 5) * ldw + (lane & 31); float v[32];
#pragma unroll
        for (int i = 0; i < 32; ++i) v[i] = __builtin_nontemporal_load(wp + (size_t)(2 * i) * ldw);
        if (gain) { float g[32];
#pragma unroll
            for (int i = 0; i < 32; ++i) g[i] = gain[2 * i + (lane >> 5)];
#pragma unroll
            for (int i = 0; i < 32; ++i) v[i] *= g[i]; }
#pragma unroll
        for (int i = 0; i < 32; ++i) scr[(2 * i + (lane >> 5)) * 33 + (lane & 31)] = v[i]; }
    LDS_WAIT(); asm volatile("" ::: "memory");
    const int c = lane & 7;
#pragma unroll
    for (int j = 0; j < 4; ++j) { const int n = (lane >> 3) + 8 * j; const LAS float* sp = scr + (8 * c) * 33 + n;
        v4u o; o.x = pk2(sp[0 * 33], sp[1 * 33]); o.y = pk2(sp[2 * 33], sp[3 * 33]); o.z = pk2(sp[4 * 33], sp[5 * 33]); o.w = pk2(sp[6 * 33], sp[7 * 33]);
        if (NT_STORE) __builtin_nontemporal_store(o, (v4u*)(dst + (size_t)n * ldt + 8 * c)); else *(v4u*)(dst + (size_t)n * ldt + 8 * c) = o; }
    LDS_WAIT(); asm volatile("" ::: "memory");
}
template <bool OUT_BF16>
__device__ __forceinline__ void rmsnorm_rows(const float* __restrict__ x0, const float* __restrict__ x1, int split, const float* __restrict__ gain, void* __restrict__ outp) {
    const int lane = threadIdx.x & 63, gw = blockIdx.x * 8 + __builtin_amdgcn_readfirstlane(threadIdx.x >> 6), NGW = gridDim.x * 8;
    for (int row = gw; row < R; row += NGW) {
        const float* xr = (row < split) ? x0 + (size_t)row * DM : x1 + (size_t)(row - split) * DM;
        f32x4 v[4]; float s = 0.f;
#pragma unroll
        for (int j = 0; j < 4; ++j) { v[j] = ((const f32x4*)xr)[lane + 64 * j]; s += (v[j].x * v[j].x + v[j].y * v[j].y) + (v[j].z * v[j].z + v[j].w * v[j].w); }
        const float rstd = 1.0f / sqrtf(wave_sum(s) * (1.0f / DM) + EPS);
#pragma unroll
        for (int j = 0; j < 4; ++j) { const f32x4 g = ((const f32x4*)gain)[lane + 64 * j]; const f32x4 o = v[j] * rstd * g;
            if (OUT_BF16) { unsigned long long w = (unsigned long long)pk2(o.x, o.y) | ((unsigned long long)pk2(o.z, o.w) << 32); ((unsigned long long*)((bf16*)outp + (size_t)row * DM))[lane + 64 * j] = w; }
            else ((f32x4*)((float*)outp + (size_t)row * DM))[lane + 64 * j] = o; }
    }
}
__device__ __forceinline__ void final_norm_rows(const bf16* __restrict__ XB, const float* __restrict__ SSQX, const float* __restrict__ gain, float* __restrict__ outp) {
    const int lane = threadIdx.x & 63, gw = blockIdx.x * 8 + __builtin_amdgcn_readfirstlane(threadIdx.x >> 6), NGW = gridDim.x * 8;
    const f32x4 g00 = ((const f32x4*)gain)[2 * lane], g01 = ((const f32x4*)gain)[2 * lane + 1], g10 = ((const f32x4*)gain)[2 * (lane + 64)], g11 = ((const f32x4*)gain)[2 * (lane + 64) + 1];
    for (int row = gw; row < R; row += 2 * NGW) {
        const int row2 = row + NGW; const bool two = row2 < R; const int rb_ = two ? row2 : row;
        const v4u wa0 = ((const v4u*)(XB + (size_t)row * DM))[lane], wa1 = ((const v4u*)(XB + (size_t)row * DM))[lane + 64];
        const v4u wb0 = ((const v4u*)(XB + (size_t)rb_ * DM))[lane], wb1 = ((const v4u*)(XB + (size_t)rb_ * DM))[lane + 64];
        const f32x4* spa = (const f32x4*)(SSQX + (size_t)row * 16); const f32x4* spb = (const f32x4*)(SSQX + (size_t)rb_ * 16);
        const f32x4 ta = (spa[0] + spa[1]) + (spa[2] + spa[3]), tb = (spb[0] + spb[1]) + (spb[2] + spb[3]);
        const float ra = 1.0f / sqrtf(((ta[0] + ta[1]) + (ta[2] + ta[3])) * (1.0f / DM) + EPS), rbs = 1.0f / sqrtf(((tb[0] + tb[1]) + (tb[2] + tb[3])) * (1.0f / DM) + EPS);
#define FN_OUT(W_, RS_, GA_, GB_, DST_) do { f32x4 o0, o1; \
            o0[0] = __uint_as_float((W_).x << 16) * (RS_) * (GA_)[0]; o0[1] = __uint_as_float((W_).x & 0xffff0000u) * (RS_) * (GA_)[1]; o0[2] = __uint_as_float((W_).y << 16) * (RS_) * (GA_)[2]; o0[3] = __uint_as_float((W_).y & 0xffff0000u) * (RS_) * (GA_)[3]; \
            o1[0] = __uint_as_float((W_).z << 16) * (RS_) * (GB_)[0]; o1[1] = __uint_as_float((W_).z & 0xffff0000u) * (RS_) * (GB_)[1]; o1[2] = __uint_as_float((W_).w << 16) * (RS_) * (GB_)[2]; o1[3] = __uint_as_float((W_).w & 0xffff0000u) * (RS_) * (GB_)[3]; \
            (DST_)[0] = o0; (DST_)[1] = o1; } while (0)
        FN_OUT(wa0, ra, g00, g01, (f32x4*)(outp + (size_t)row * DM) + 2 * lane);
        FN_OUT(wa1, ra, g10, g11, (f32x4*)(outp + (size_t)row * DM) + 2 * (lane + 64));
        if (two) { FN_OUT(wb0, rbs, g00, g01, (f32x4*)(outp + (size_t)row2 * DM) + 2 * lane); FN_OUT(wb1, rbs, g10, g11, (f32x4*)(outp + (size_t)row2 * DM) + 2 * (lane + 64)); }
#undef FN_OUT
    }
}
template <int MODE>
__device__ __forceinline__ void weight_items(const Params& p, LAS unsigned char* lds, int gw, int NGW) {
    const int tid = threadIdx.x, lane = tid & 63, wave = __builtin_amdgcn_readfirstlane(tid >> 6);
    unsigned char* ws = p.ws;
    LAS float* scr = (LAS float*)(lds + wave * 16384);
    constexpr int I_F = (DM / 64) * (DFF / 32), I_IN = (DM / 64) * (DIN / 32), I_OUT = (DMIX / 64) * (DM / 32);
    constexpr int I_WQ = NH * (QL / 64) * (KVL / 8), I_QP = (QL / 64) * (NH * 96 / 32), I_QR = (QL / 64) * NH, I_KV = (KVL / 64) * NH * 4, I_GT = NBLK * 2 * 2;
    constexpr int NITEMS = I_WQ + 6 * I_F + I_IN + I_OUT + I_QP + I_QR + I_KV + I_GT;
    static_assert((DFF / 64) * (DM / 32) == I_F, "down items");
    const float* wq = p.in[21]; const float* wuk = p.in[23]; const float* qn = p.in[20]; bf16* WqT = (bf16*)(ws + WS_WQ);
    constexpr bool LATE = MODE == 2;
    constexpr int NE = 2 * I_F, NM = I_F + I_IN, NL = NITEMS - I_WQ - NE - NM;
    for (int it = gw; it < (MODE == 2 ? I_WQ + NL : MODE == 1 ? NM : NE); it += NGW) {
        int r;
        if (MODE == 2) { r = it; if (it >= I_WQ) { const int l = it - I_WQ; r = I_WQ + (l < 3 * I_F ? l + 3 * I_F : l + 3 * I_F + I_IN); } }
        else if (MODE == 1) r = I_WQ + (it < I_F ? it + 2 * I_F : it + 5 * I_F);
        else r = I_WQ + it;
        if (r < I_WQ) {
            const int h = r / ((QL / 64) * (KVL / 8)), kt = (r / (KVL / 8)) % (QL / 64), cg = r % (KVL / 8), k = 64 * kt + lane;
            f32x4 a[16];
#pragma unroll
            for (int j = 0; j < 16; ++j) a[j] = *(const f32x4*)(wq + (size_t)k * (NH * 96) + h * 96 + 4 * j);
            const float gk = qn[k];
#pragma unroll 1
            for (int c = 8 * cg; c < 8 * cg + 8; c += 2) { const f32x4* b0 = (const f32x4*)(wuk + ((size_t)c * NH + h) * NOPE); const f32x4* b1 = (const f32x4*)(wuk + ((size_t)(c + 1) * NH + h) * NOPE);
                f32x4 u[16], w[16];
#pragma unroll
                for (int j = 0; j < 16; ++j) { u[j] = b0[j]; w[j] = b1[j]; }
                f32x4 s4 = {0.f, 0.f, 0.f, 0.f}, t4 = {0.f, 0.f, 0.f, 0.f};
#pragma unroll
                for (int j = 0; j < 16; ++j) { s4 = s4 + a[j] * u[j]; t4 = t4 + a[j] * w[j]; }
                WqT[(size_t)(h * KVL + c) * QL + k] = (bf16)f2bf(((s4[0] + s4[1]) + (s4[2] + s4[3])) * gk);
                WqT[(size_t)(h * KVL + c + 1) * QL + k] = (bf16)f2bf(((t4[0] + t4[1]) + (t4[2] + t4[3])) * gk); }
            continue; }
        r -= I_WQ;
        const float* src; bf16* dst; const float* gain = nullptr; int ldw, ldt;
        if (r < 6 * I_F) { const int which = r / I_F, q = r % I_F;
            const bool down = which == 2 || which == 5; const int K = down ? DFF : DM, N = down ? DM : DFF, nblk = N / 32, k0 = 64 * (q / nblk), n0 = 32 * (q % nblk);
            const int inp = which == 0 ? 8 : which == 1 ? 9 : which == 2 ? 10 : which == 3 ? 29 : which == 4 ? 30 : 31;
            const size_t wsoff = which < 2 ? WS_WGU1 : which == 2 ? WS_WD1 : which < 5 ? WS_WGU2 : WS_WD2;
            const int drow0 = down ? n0 : 256 * (n0 / 128) + (n0 % 128) + ((which == 1 || which == 4) ? 128 : 0);
            src = p.in[inp] + (size_t)k0 * N + n0; ldw = N; dst = (bf16*)(ws + wsoff) + (size_t)drow0 * K + k0; ldt = K; if (which == 3 || which == 4) gain = p.in[28] + k0; }
        else if ((r -= 6 * I_F) < I_IN) { const int nblk = DIN / 32, k0 = 64 * (r / nblk), n0 = 32 * (r % nblk);
            src = p.in[12] + (size_t)k0 * DIN + n0; ldw = DIN; dst = (bf16*)(ws + WS_WIN) + (size_t)n0 * DM + k0; ldt = DM; gain = p.in[11] + k0; }
        else if ((r -= I_IN) < I_OUT) { const int nblk = DM / 32, k0 = 64 * (r / nblk), n0 = 32 * (r % nblk);
            src = p.in[27] + (size_t)k0 * DM + n0; ldw = DM; dst = (bf16*)(ws + WS_WOUT) + (size_t)n0 * DMIX + k0; ldt = DMIX; }
        else if ((r -= I_OUT) < I_QP) { const int nblk = NH * 96 / 32, k0 = 64 * (r / nblk), n0 = 32 * (r % nblk);
            const int col = (n0 < NH * NOPE) ? (n0 / NOPE) * 96 + (n0 % NOPE) : ((n0 - NH * NOPE) / ROPE) * 96 + NOPE;
            src = wq + (size_t)k0 * (NH * 96) + col; ldw = NH * 96; dst = (bf16*)(ws + WS_WQP) + (size_t)n0 * QL + k0; ldt = QL; gain = qn + k0; }
        else if ((r -= I_QP) < I_QR) { const int k0 = 64 * (r / NH), h = r % NH;
            src = wq + (size_t)k0 * (NH * 96) + h * 96 + NOPE; ldw = NH * 96; dst = WqT + (size_t)(NH * KVL + ROPE * h) * QL + k0; ldt = QL; gain = qn + k0; }
        else if ((r -= I_QR) < I_KV) { const int c0 = 64 * (r / (NH * 4)), h = (r >> 2) % NH, jb = r & 3;
            src = (jb < 2 ? wuk : p.in[24]) + (size_t)c0 * (NH * NOPE) + h * NOPE + 32 * (jb & 1); ldw = NH * NOPE; dst = (bf16*)(ws + WS_WKV) + (size_t)(h * 128 + 32 * jb) * KVL + c0; ldt = KVL; gain = p.in[22] + c0; }
        else { r -= I_KV; const int n = r >> 2, g = (r >> 1) & 1, eb = r & 1;
            src = (g ? p.in[17] : p.in[15]) + (size_t)n * BLK * BLK + 32 * eb; ldw = BLK; dst = (bf16*)(ws + WS_WGT) + (size_t)((n * 2 + g) * BLK + 32 * eb) * BLK; ldt = BLK; }
        transpose_tile<MODE != 0>(src, ldw, dst, ldt, scr, lane, gain);
    }
}
__device__ __forceinline__ void p_prologue(const Params& p, LAS unsigned char* lds) {
    const int tid = threadIdx.x, lane = tid & 63, wave = __builtin_amdgcn_readfirstlane(tid >> 6), gw = blockIdx.x * 8 + wave, NGW = gridDim.x * 8;
    unsigned char* ws = p.ws;
    LAS float* scr = (LAS float*)(lds + wave * 16384);
    weight_items<0>(p, lds, gw, NGW);
    const int gt = blockIdx.x * 512 + tid, NGT = gridDim.x * 512;
    { unsigned* z = (unsigned*)((bf16*)(ws + WS_WIN) + (size_t)DIN * DM); for (int i = gt; i < (DINP - DIN) * DM / 2; i += NGT) z[i] = 0u; }
    { const int xcd = (int)(blockIdx.x & 7), jb = (int)(blockIdx.x >> 3), nb = (int)(gridDim.x >> 3); const float* gain = p.in[7]; bf16* XNp = (bf16*)(ws + WS_XN);
      if ((gridDim.x & 7) == 0) {
          const int rows_x = R / 8, r_lo = xcd * rows_x + (jb * rows_x) / nb, r_hi = xcd * rows_x + ((jb + 1) * rows_x) / nb;
          for (int row = r_lo + 2 * wave; row < r_hi; row += 16) {
              const bool two = row + 1 < r_hi;
              const float* xa = (row < RP) ? p.in[0] + (size_t)row * DM : p.in[1] + (size_t)(row - RP) * DM;
              const float* xb = (row + 1 < RP) ? p.in[0] + (size_t)(row + 1) * DM : p.in[1] + (size_t)(row + 1 - RP) * DM;
              f32x4 va[4], vb[4]; float sa = 0.f, sb = 0.f;
#pragma unroll
              for (int j = 0; j < 4; ++j) { va[j] = ((const f32x4*)xa)[lane + 64 * j]; vb[j] = two ? ((const f32x4*)xb)[lane + 64 * j] : va[j]; }
#pragma unroll
              for (int j = 0; j < 4; ++j) { sa += (va[j].x * va[j].x + va[j].y * va[j].y) + (va[j].z * va[j].z + va[j].w * va[j].w); sb += (vb[j].x * vb[j].x + vb[j].y * vb[j].y) + (vb[j].z * vb[j].z + vb[j].w * vb[j].w); }
              const float ra = 1.0f / sqrtf(wave_sum(sa) * (1.0f / DM) + EPS), rb = 1.0f / sqrtf(wave_sum(sb) * (1.0f / DM) + EPS);
#pragma unroll
              for (int j = 0; j < 4; ++j) { const f32x4 g = ((const f32x4*)gain)[lane + 64 * j]; const f32x4 oa = va[j] * ra * g, ob = vb[j] * rb * g;
                  ((unsigned long long*)(XNp + (size_t)row * DM))[lane + 64 * j] = (unsigned long long)pk2(oa.x, oa.y) | ((unsigned long long)pk2(oa.z, oa.w) << 32);
                  if (two) ((unsigned long long*)(XNp + (size_t)(row + 1) * DM))[lane + 64 * j] = (unsigned long long)pk2(ob.x, ob.y) | ((unsigned long long)pk2(ob.z, ob.w) << 32); }
          }
      } else rmsnorm_rows<true>(p.in[0], p.in[1], RP, p.in[7], ws + WS_XN);
    }
}

__device__ __forceinline__ float half_sum(float v, LAS float* red4) {
    v = wave_sum(v);
    __syncthreads();
    if ((threadIdx.x & 63) == 0) red4[(threadIdx.x >> 6) & 3] = v;
    __syncthreads();
    return (red4[0] + red4[1]) + (red4[2] + red4[3]);
}
__device__ __forceinline__ void p_ckv_norm(const Params& p) {
    const int lane = threadIdx.x & 63, gw = blockIdx.x * 8 + __builtin_amdgcn_readfirstlane(threadIdx.x >> 6), NGW = gridDim.x * 8;
    const float* CKV = (const float*)(p.ws + WS_CKV); const float* SSQ = (const float*)(p.ws + WS_SSQ); bf16* KC = (bf16*)(p.ws + WS_KC); bf16* KCS = (bf16*)(p.ws + WS_KCS);
    const float2 g2 = ((const float2*)p.in[22])[lane];
    for (int row = gw; row < R; row += NGW) {
        const float2 v = ((const float2*)(CKV + (size_t)row * KVL))[lane]; const f32x4 sq = *(const f32x4*)(SSQ + (size_t)row * 8 + 4);
        const float rstd = 1.0f / sqrtf(((sq[0] + sq[1]) + (sq[2] + sq[3])) * (1.0f / KVL) + EPS);
        float2 o; o.x = v.x * rstd * g2.x; o.y = v.y * rstd * g2.y;
        if (row < RP) { ((float2*)(p.out + O_KVP + (size_t)row * KVL))[lane] = o; }
        else { ((float2*)(p.out + O_KVS + (size_t)(row - RP) * KVL))[lane] = o; ((unsigned*)(KCS + (size_t)(row - RP) * QD))[lane] = pk2(o.x, o.y); }
    }
}

__device__ __forceinline__ void p_mla_norm(const Params& p, int first_block, int nblocks) {
    const int lane = threadIdx.x & 63, gw = ((int)blockIdx.x - first_block) * 8 + __builtin_amdgcn_readfirstlane(threadIdx.x >> 6), NGW = nblocks * 8;
    bf16* YCp = (bf16*)(p.ws + WS_YC); const float* SSQM = (const float*)(p.ws + WS_SSQM); const float* gm = p.in[26];
    const f32x4 g0 = ((const f32x4*)gm)[2 * lane], g1 = ((const f32x4*)gm)[2 * lane + 1];
    for (int row0 = gw; row0 < RP; row0 += 4 * NGW) {
        v4u w[4]; f32x4 t[4];
#pragma unroll
        for (int i = 0; i < 4; ++i) { const int row = row0 + i * NGW < RP ? row0 + i * NGW : row0;
            w[i] = *((const v4u*)(YCp + (size_t)row * DMIX + DLRU) + lane); const f32x4* sp = (const f32x4*)(SSQM + (size_t)row * NH); t[i] = sp[0] + sp[1]; }
#pragma unroll
        for (int i = 0; i < 4; ++i) { const int row = row0 + i * NGW; if (row < RP) {
            const float rstd = 1.0f / sqrtf(((t[i][0] + t[i][1]) + (t[i][2] + t[i][3])) * (1.0f / DMLA) + EPS); v4u o;
            o.x = pk2(__uint_as_float(w[i].x << 16) * rstd * g0[0], __uint_as_float(w[i].x & 0xffff0000u) * rstd * g0[1]); o.y = pk2(__uint_as_float(w[i].y << 16) * rstd * g0[2], __uint_as_float(w[i].y & 0xffff0000u) * rstd * g0[3]);
            o.z = pk2(__uint_as_float(w[i].z << 16) * rstd * g1[0], __uint_as_float(w[i].z & 0xffff0000u) * rstd * g1[1]); o.w = pk2(__uint_as_float(w[i].w << 16) * rstd * g1[2], __uint_as_float(w[i].w & 0xffff0000u) * rstd * g1[3]);
            *((v4u*)(YCp + (size_t)row * DMIX + DLRU) + lane) = o; } }
    }
}

#define GEMM_PHASE_AT(Epi, shift, Mm, Aptr, Bptr, Nn, Kk, Eobj) do { pg8::Gemm g_{(const pg8::bf16_t*)(Aptr), (const pg8::bf16_t*)(Bptr), (Mm), (Nn), (Kk)}; pg8::StaticOrder S_; S_.init((Mm), (Nn), (int)gridDim.x, (int)((blockIdx.x + gridDim.x - (shift)) % gridDim.x)); \
    pg8::gemm_phase<Epi, pg8::StaticOrder, true, true>((PG8_LAS unsigned char*)lds, g_, S_, (Eobj)); } while (0)
#define GEMM_PHASE(Epi, Mm, Aptr, Bptr, Nn, Kk, Eobj) do { pg8::Gemm g_{(const pg8::bf16_t*)(Aptr), (const pg8::bf16_t*)(Bptr), (Mm), (Nn), (Kk)}; pg8::StaticOrder S_; S_.init((Mm), (Nn), (int)gridDim.x, (int)blockIdx.x); \
    pg8::gemm_phase<Epi, pg8::StaticOrder, true, true>((PG8_LAS unsigned char*)lds, g_, S_, (Eobj)); } while (0)
constexpr int N_PHASES = 13;
__global__ void __launch_bounds__(512, 2) mega(Params p) {
    extern __shared__ __attribute__((aligned(16))) unsigned char lds_raw[];
    LAS unsigned char* lds = (LAS unsigned char*)lds_raw;
    volatile LAS unsigned* MISC = (volatile LAS unsigned*)(lds + MISC_OFF);
    for (int u = threadIdx.x; u < (LDS_BYTES - LDSCTL_OFF) / 4; u += 512) ((LAS unsigned*)(lds + LDSCTL_OFF))[u] = 0u;
    __syncthreads();
    unsigned char* ws = p.ws; float* out = p.out;
    XcdBarrier bar = xcd_barrier_post((unsigned*)(ws + WS_CTL) + CW_BAR, MISC + 8);
    const int lo = p.ph_lo, hi = p.ph_hi;
#ifdef ONLY_PHASE
#define IN(k) ((k) == ONLY_PHASE && lo <= (k) && (k) < hi)
#else
#define IN(k) (lo <= (k) && (k) < hi)
#endif
#ifndef PROBE
#define PROBE -1
#endif
#define SEAM(k) do { if (IN(k) && IN((k) + 1)) { xcd_barrier(bar); if (PROBE == 99) xcd_barrier(bar); } } while (0)
#define REP(id, ...) do { __VA_ARGS__; if (PROBE == (id)) { __syncthreads(); __VA_ARGS__; } } while (0)
#define Wgu1 ((bf16*)(ws + WS_WGU1))
#define Wd1 ((bf16*)(ws + WS_WD1))
#define Wgu2 ((bf16*)(ws + WS_WGU2))
#define Wd2 ((bf16*)(ws + WS_WD2))
#define Win ((bf16*)(ws + WS_WIN))
#define Wout ((bf16*)(ws + WS_WOUT))
#define Wq ((bf16*)(ws + WS_WQ))
#define XN ((bf16*)(ws + WS_XN))
#define H ((bf16*)(ws + WS_H))
#define YC ((bf16*)(ws + WS_YC))
#define Qb ((bf16*)(ws + WS_QB))
#define KC ((bf16*)(ws + WS_KC))
#define PART ((float*)(ws + WS_PART))
#define CKV ((float*)(ws + WS_CKV))
#define SSQ ((float*)(ws + WS_SSQ))
#define SUM ((float*)(ws + WS_SUM))
#define SSQX ((float*)(ws + WS_SSQX))
#define XL ((bf16*)(ws + WS_XL))
#define GG ((bf16*)(ws + WS_GG))
#define CQ ((bf16*)(ws + WS_CQ))
#define KCS ((bf16*)(ws + WS_KCS))
#define WGT ((bf16*)(ws + WS_WGT))
#define WUVF ((bf16*)(ws + WS_WUVF))
#define WqP ((bf16*)(ws + WS_WQP))
#define Wkv ((bf16*)(ws + WS_WKV))
#define QbP ((bf16*)(ws + WS_QBP))
#define KVH ((bf16*)(ws + WS_KVH))
#define CKVB ((bf16*)(ws + WS_CKVB))
#define SSQM ((float*)(ws + WS_SSQM))
    if (IN(0)) REP(0, p_prologue(p, lds));
    SEAM(0);
    if (IN(1)) { pg8::EpiSwiGLU E{H, nullptr, DFF, 0}; REP(1, GEMM_PHASE(pg8::EpiSwiGLU, R, XN, Wgu1, NGU, DM, E));
        { const int G = (int)gridDim.x, nwg1 = (R / 256) * (NGU / 256), rem = nwg1 % G; int fb = rem, nfree = G - rem; if (rem == 0 || nfree < 32) { fb = 0; nfree = G; }
          __syncthreads();
          if ((int)blockIdx.x >= fb) weight_items<1>(p, lds, ((int)blockIdx.x - fb) * 8 + __builtin_amdgcn_readfirstlane(threadIdx.x >> 6), nfree * 8); } }
    SEAM(1);
    if (IN(2)) {
        if (blockIdx.x & 1) for (int mu = blockIdx.x; mu < (RS / 64) * (DM / 64); mu += gridDim.x) { const int r0 = RP + 64 * (mu >> 4), c0 = 64 * (mu & 15);
            sg::unit64((att::ldsp)lds, H, Wd1, DFF, r0, c0, p.in[1] - (size_t)RP * DM, XN, SSQX, 0.5f); }
        { pg8::EpiRes<true> E{p.in[0], XN, SSQX, 0.5f, 0}; GEMM_PHASE(pg8::EpiRes<true>, RP, H, Wd1, DM, DFF, E); }
        if (!(blockIdx.x & 1)) for (int mu = blockIdx.x; mu < (RS / 64) * (DM / 64); mu += gridDim.x) { const int r0 = RP + 64 * (mu >> 4), c0 = 64 * (mu & 15);
            sg::unit64((att::ldsp)lds, H, Wd1, DFF, r0, c0, p.in[1] - (size_t)RP * DM, XN, SSQX, 0.5f); }
    }
    SEAM(2);
    if (IN(4)) { pg8::EpiZ E{XL, GG, CQ, CKV, SSQ, out, KC, KCS, SSQX, CKVB}; REP(4, GEMM_PHASE(pg8::EpiZ, R, XN, Win, DINP, DM, E));
        { const int G = (int)gridDim.x, nwg4 = (R / 256) * (DINP / 256), rem = nwg4 % G; int fb = rem, nfree = G - rem; if (rem == 0 || nfree < 32) { fb = 0; nfree = G; }
          __syncthreads();
          if ((int)blockIdx.x >= fb) weight_items<2>(p, lds, ((int)blockIdx.x - fb) * 8 + __builtin_amdgcn_readfirstlane(threadIdx.x >> 6), nfree * 8); } }
    SEAM(4);
    lru::State st;
    const bool has_chunk = blockIdx.x < NB * NCHUNK;
    const int cb_ = (int)blockIdx.x / NCHUNK, cc_ = (int)blockIdx.x % NCHUNK;
    const size_t crow0 = (size_t)cb_ * SEQ + (size_t)cc_ * CHUNK;
    if (IN(5)) {
        { pg8::EpiQP E{QbP, SSQ, QSCALE, 0}; GEMM_PHASE_AT(pg8::EpiQP, 0, RP, CQ, WqP, NH * 96, QL, E); }
        { pg8::EpiQ E{Qb + (size_t)RP * NH * QD, SSQ + (size_t)RP * 8, QSCALE, 1}; GEMM_PHASE_AT(pg8::EpiQ, 192, RS, CQ + (size_t)RP * QL, Wq, NQ, QL, E); }
        { pg8::EpiKV E{KVH, SSQ, KC}; GEMM_PHASE_AT(pg8::EpiKV, 64, RP, CKVB, Wkv, NH * 128, KVL, E); }
        REP(51, p_ckv_norm(p));
        REP(52, if (has_chunk) lru::unit_pre<false>((att::ldsp)lds, st, XL, WGT, p.in[13], p.in[14], p.in[16], p.in[18], p.in[19], p.in[5], p.in[4], out, crow0, cb_, cc_ * CHUNK, SUM + ((size_t)blockIdx.x * DLRU) * 2));
    }
    SEAM(5);
    if (IN(6)) {
        if (has_chunk) {
            const int ch = (int)threadIdx.x;
            const float cr = lru::chunk_carry(SUM + (size_t)cb_ * NCHUNK * DLRU * 2, cc_, ch);
            if (cc_ == NCHUNK - 1) { const float2 sv = *(const float2*)(SUM + ((size_t)blockIdx.x * DLRU + ch) * 2); out[O_HP + (size_t)cb_ * DLRU + ch] = sv.y + sv.x * cr; }
            const float c0 = __shfl(cr, (int)threadIdx.x & 31), c1 = __shfl(cr, 32 + ((int)threadIdx.x & 31));
            lru::unit_post((att::ldsp)lds, st, GG, p.in[25], YC, crow0, c0, c1);
        }
        if (threadIdx.x == 0) { *(LAS unsigned*)(lds + att2::L_BAR) = 0u; *(LAS unsigned*)(lds + att2::L_BAR + 64) = 0u; }
        __syncthreads();
        { unsigned bt = 0u;
          if (__builtin_amdgcn_readfirstlane(threadIdx.x >> 6) < 4) {
              _Pragma("unroll 1") for (int bx = (int)blockIdx.x; bx < NB * NH * 16; bx += (int)gridDim.x) { const int x = bx & 7, y = (bx >> 3) & 31, bh = x + 8 * (y & 1), pr = y >> 1;
                  _Pragma("unroll 1") for (int u = 0; u < (PROBE == 61 ? 4 : 2); ++u) att2::prompt_role((att::ldsp)lds, QbP, KVH, SSQM, YC, bh >> 3, bh & 7, (u & 1) ? pr : 31 - pr, bt); }
          } else {
              _Pragma("unroll 1") for (int rep_ = 0; rep_ < (PROBE == 62 ? 2 : 1); ++rep_)
              _Pragma("unroll 1") for (int item = blockIdx.x; item < DB * NSPLIT; item += gridDim.x) { const int db = item / NSPLIT, ch = item % NSPLIT;
                  att2::decode_role((att::ldsp)lds, Qb, p.in[2], p.in[3], (const int*)p.in[6], PART + (size_t)item * 2 * att::PART_FLOATS, db, ch * (NPAGES / NSPLIT), NPAGES / NSPLIT, bt); }
          } }
        __syncthreads();
    }
    SEAM(6);
    if (IN(7)) {
        if (blockIdx.x >= DB + RS / 32) p_mla_norm(p, DB + RS / 32, (int)gridDim.x - (DB + RS / 32));
        if (blockIdx.x >= DB && blockIdx.x < DB + RS / 32) {
            lru::State s2; const int su = (int)blockIdx.x - DB; const size_t r0 = (size_t)RP + 32 * su;
            lru::unit_pre<true, 1>((att::ldsp)lds, s2, XL, WGT, p.in[13], p.in[14], p.in[16], p.in[18], p.in[19], p.in[5], p.in[4], out, r0, 4 * su, 0, nullptr);
            lru::unit_post<1>((att::ldsp)lds, s2, GG, p.in[25], YC, r0, 0.f, 0.f);
        }
        REP(7, for (int db = blockIdx.x; db < DB; db += gridDim.x)
            att::decode_combine((att::ldsp)lds, Qb, out + O_KVS, out + O_KRS, PART + (size_t)db * NSPLIT * 2 * att::PART_FLOATS, NSPLIT, p.in[24], p.in[26], YC, db));
    }
    SEAM(7);
    if (IN(8)) {
        { pg8::EpiRes<false> E{nullptr, XN, SSQX, 1.0f, 0}; REP(80, GEMM_PHASE(pg8::EpiRes<false>, RP, YC, Wout, DM, DMIX, E)); }
        for (int mu = blockIdx.x; mu < (RS / 64) * (DM / 64); mu += gridDim.x) { const int r0 = RP + 64 * (mu >> 4), c0 = 64 * (mu & 15);
            sg::unit64((att::ldsp)lds, YC, Wout, DMIX, r0, c0, nullptr, XN, SSQX, 1.0f); }
    }
    SEAM(8);
    if (IN(10)) { pg8::EpiSwiGLU E{H, SSQX, DFF, 0}; REP(10, GEMM_PHASE(pg8::EpiSwiGLU, R, XN, Wgu2, NGU, DM, E)); }
    SEAM(10);
    if (IN(11)) {
        { pg8::EpiFinal E{(const pg8::bf16_t*)XN, out, p.in[32], (float*)(ws + WS_XCH), (unsigned*)(ws + WS_CTL) + CW_FIN, 0.5f, 0}; GEMM_PHASE(pg8::EpiFinal, RP, H, Wd2, DM, DFF, E); }
        for (int mu = blockIdx.x; mu < (RS / 64) * (DM / 64); mu += gridDim.x) { const int r0 = RP + 64 * (mu >> 4), c0 = 64 * (mu & 15);
            sg::unit64((att::ldsp)lds, H, Wd2, DFF, r0, c0, nullptr, XN, (float*)(ws + WS_XCH), 0.5f, out, p.in[32], (unsigned*)(ws + WS_CTL) + CW_FINS + 64 * (mu >> 4)); }
    }
#undef Wgu1
#undef Wd1
#undef Wgu2
#undef Wd2
#undef Win
#undef Wout
#undef Wq
#undef XN
#undef H
#undef YC
#undef Qb
#undef KC
#undef PART
#undef CKV
#undef SSQ
#undef SUM
#undef SSQX
#undef XL
#undef GG
#undef CQ
#undef KCS
#undef WGT
#undef WUVF
#undef WqP
#undef Wkv
#undef QbP
#undef KVH
#undef CKVB
#undef SSQM
#undef IN
#undef SEAM
}

#ifndef MK_N_LAUNCHES
#define MK_N_LAUNCHES 1
#endif
extern "C" void kernel_launch(void* const* d_in, const int* in_sizes, int n_in, void* d_out, int out_size, void* d_ws, size_t ws_size, hipStream_t stream) {
    static int grid = 0;
    if (grid == 0) {
        if (n_in != 33 || out_size != (int)O_END || ws_size < WS_END) { fprintf(stderr, "kernel_launch: unexpected shapes (n_in %d, out %d, ws %zu)\n", n_in, out_size, ws_size); grid = -1; return; }
        int dev = 0, cus = 0, per_cu = 0;
        if (hipGetDevice(&dev) != hipSuccess || hipDeviceGetAttribute(&cus, hipDeviceAttributeMultiprocessorCount, dev) != hipSuccess) { grid = -1; return; }
        if (hipFuncSetAttribute((const void*)mega, hipFuncAttributeMaxDynamicSharedMemorySize, LDS_BYTES) != hipSuccess) { fprintf(stderr, "kernel_launch: hipFuncSetAttribute failed\n"); grid = -1; return; }
        if (hipOccupancyMaxActiveBlocksPerMultiprocessor(&per_cu, (const void*)mega, 512, LDS_BYTES) != hipSuccess || per_cu < 1) fprintf(stderr, "kernel_launch: occupancy query says %d\n", per_cu);
        (void)hipGetLastError();
        grid = cus;
    }
    if (grid < 0) return;
    (void)hipMemsetAsync((char*)d_ws + WS_CTL, 0, CTL_ZERO_BYTES, stream);
    Params prm; memset(&prm, 0, sizeof(prm));
    for (int i = 0; i < 33; ++i) prm.in[i] = (const float*)d_in[i];
    prm.out = (float*)d_out; prm.ws = (unsigned char*)d_ws;
    if (MK_N_LAUNCHES == 1) { prm.ph_lo = 0; prm.ph_hi = N_PHASES; hipLaunchKernelGGL(mega, dim3(grid), dim3(512), LDS_BYTES, stream, prm); }
    else for (int k = 0; k < N_PHASES; ++k) { prm.ph_lo = k; prm.ph_hi = k + 1; hipLaunchKernelGGL(mega, dim3(grid), dim3(512), LDS_BYTES, stream, prm); }
}
```

```cpp
#include <hip/hip_runtime.h>
#include <cstdio>
#include <cstdint>
#include <cstring>
constexpr int DM = 1024, SEQ = 8192, NB = 2, RP = NB * SEQ, DB = 128, DS = 8, RS = DB * DS, R = RP + RS;
constexpr int PAST = 16384, PAGE = 128, NPAGES = PAST / PAGE;
constexpr int DLRU = 512, NBLK = 8, BLK = 64, CONVW = 4;
constexpr int NH = 8, NOPE = 64, ROPE = 32, VD = 64, QL = 256, KVL = 128, DMLA = 512, DMIX = 1024, DIN = 1440, DINP = 1536;
constexpr int DFF = 2816, NGU = 2 * DFF;
constexpr int NQ = NH * KVL + NH * ROPE;
constexpr int QD = KVL + ROPE;
constexpr float EPS = 1e-6f;
constexpr size_t O_YP = 0, O_YS = O_YP + (size_t)RP * DM, O_KVP = O_YS + (size_t)RS * DM, O_KRP = O_KVP + (size_t)RP * KVL, O_HP = O_KRP + (size_t)RP * ROPE,
                 O_CVP = O_HP + (size_t)NB * DLRU, O_KVS = O_CVP + (size_t)NB * 3 * DLRU, O_KRS = O_KVS + (size_t)RS * KVL, O_HS = O_KRS + (size_t)RS * ROPE,
                 O_CVS = O_HS + (size_t)DB * DLRU, O_END = O_CVS + (size_t)DB * 3 * DLRU;
static_assert(O_END == 20877312, "output size");
__device__ const float ROPE_FREQ[16] = {1.000000000e+00f, 5.623413324e-01f, 3.162277639e-01f, 1.778279394e-01f, 1.000000015e-01f, 5.623413250e-02f, 3.162277490e-02f, 1.778279431e-02f,
                                        9.999999776e-03f, 5.623413250e-03f, 3.162277630e-03f, 1.778279431e-03f, 1.000000047e-03f, 5.623413017e-04f, 3.162277571e-04f, 1.778279402e-04f};
namespace pg8 {
#define PG8_LAS __attribute__((address_space(3)))
typedef unsigned short bf16_t;
typedef short bf16x8 __attribute__((ext_vector_type(8)));
typedef float f32x4 __attribute__((ext_vector_type(4)));
typedef unsigned u32x4 __attribute__((ext_vector_type(4)));
constexpr int BM = 256, BK = 64, HALF = 128, HTB = HALF * BK * 2  , STAGE_BYTES = 8 * HTB, NXCD = 8, WGM = 8;

__host__ __device__ __forceinline__ int lds_byte(int r, int c) { const int st = (r >> 4) * 2 + (c >> 5), rr = r & 15, cc = c & 31, ob = rr * 64 + cc * 2; return st * 1024 + (ob ^ (((ob >> 9) & 1) << 5)); }
__host__ __device__ __forceinline__ void stage_rc(int b, int& R, int& C) { const int st = b / 1024, sb = b % 1024, swz = sb ^ (((sb >> 9) & 1) << 5); R = (st >> 1) * 16 + swz / 64; C = (st & 1) * 32 + (swz % 64) / 2; }
__host__ __device__ __forceinline__ int perm32(int rho) { const int n = rho >> 4, i = rho & 15; return 8 * (i >> 2) + 4 * n + (i & 3); }

struct Unit { int pm, pn; };
struct Gemm { const bf16_t* A; const bf16_t* Bt; int M, N, K; };

struct StaticOrder {
    int nM, nN, nwg, G, c;
    __host__ __device__ void init(int M, int N, int G_, int c_) { nM = M / BM; nN = N / BM; nwg = nM * nN; G = G_; c = c_; }
    __host__ __device__ bool next(int i, Unit& u) const {
        const long L = (long)i * G + c; if (L >= nwg) return false;
        int wgid = (int)L; { const int q = nwg / NXCD, r = nwg % NXCD, xcd = wgid % NXCD, off = wgid / NXCD; wgid = (xcd < r ? xcd * (q + 1) : r * (q + 1) + (xcd - r) * q) + off; }
        const int nig = WGM * nN, gid = wgid / nig, fm = gid * WGM, gsz = (nM - fm) < WGM ? (nM - fm) : WGM;
        u.pm = fm + ((wgid % nig) % gsz); u.pn = (wgid % nig) / gsz; return true;
    }
    __device__ __forceinline__ void a_ready(const Unit&) const {}
    __device__ __forceinline__ void done(const Unit&) const {}
};

__device__ __forceinline__ unsigned cvt_pk_bf16(float lo, float hi) { unsigned r; asm volatile("v_cvt_pk_bf16_f32 %0, %1, %2" : "=v"(r) : "v"(lo), "v"(hi)); return r; }
typedef float f32x2 __attribute__((ext_vector_type(2)));
typedef float f32x2 __attribute__((ext_vector_type(2)));
template <class Epi, class Sched, bool ALIGN_EPI = false, bool SP2 = false>
__device__ __forceinline__ void gemm_phase(PG8_LAS unsigned char* lds, const Gemm g, const Sched& S, const Epi& E) {
    int tid_ = threadIdx.x; asm volatile("" : "+v"(tid_));
    const int tid = tid_, wid = __builtin_amdgcn_readfirstlane(tid >> 6), lane = tid & 63, wr = wid >> 2, wc = wid & 3, fr = lane & 15, fq = lane >> 4;
    const int K = g.K, nt = K / BK;
    unsigned voffA[2], voffB[2];
#pragma unroll
    for (int i = 0; i < 2; ++i) { int R, C; stage_rc(tid * 16 + i * 8192, R, C); const int Rb = Epi::PERM ? ((R & ~31) + perm32(R & 31)) : R;
        voffA[i] = (unsigned)(R * K + C) * 2u; voffB[i] = (unsigned)(Rb * K + C) * 2u; }
    const size_t kstep = (size_t)(BK * 2);
    const size_t hstep = (size_t)HALF * K * 2;
    const size_t tstep = 2 * hstep;
    const unsigned ldsw = (unsigned)wid * 1024u;
    const int aoff = lds_byte(wr * 64 + fr, fq * 8), boff = lds_byte(wc * 32 + fr, fq * 8);
#define PG8_SA(b, h) (((b) * 2 + (h)) * HTB)
#define PG8_SB(b, h) ((4 + (b) * 2 + (h)) * HTB)
#define PG8_STAGE(bufoff, gbase, voff) do { _Pragma("unroll") for (int _i = 0; _i < 2; ++_i) \
        __builtin_amdgcn_global_load_lds((const unsigned*)((const char*)(gbase) + (voff)[_i]), (PG8_LAS unsigned*)(lds + (bufoff) + ldsw + _i * 8192), 16, 0, 0); } while (0)
#define PG8_LDA(dst, b, h) do { _Pragma("unroll") for (int m = 0; m < 4; ++m) _Pragma("unroll") for (int k = 0; k < 2; ++k) dst[m][k] = *(const PG8_LAS bf16x8*)(lds + PG8_SA(b, h) + aoff + m * 2048 + k * 1024); } while (0)
#define PG8_LDB(dst, b, h) do { _Pragma("unroll") for (int n = 0; n < 2; ++n) _Pragma("unroll") for (int k = 0; k < 2; ++k) dst[n][k] = *(const PG8_LAS bf16x8*)(lds + PG8_SB(b, h) + boff + n * 2048 + k * 1024); } while (0)
#define PG8_MMA(ai, bj, At, Bt) do { __builtin_amdgcn_s_setprio(1); _Pragma("unroll") for (int m = 0; m < 4; ++m) _Pragma("unroll") for (int n = 0; n < 2; ++n) _Pragma("unroll") for (int k = 0; k < 2; ++k) \
        acc[ai][bj][m][n] = __builtin_amdgcn_mfma_f32_16x16x32_bf16(Bt[n][k], At[m][k], acc[ai][bj][m][n], 0, 0, 0); __builtin_amdgcn_s_setprio(0); } while (0)
#define PG8_WAIT_V(n) asm volatile("s_waitcnt vmcnt(" #n ")" ::: "memory")
#define PG8_WAIT_L(n) asm volatile("s_waitcnt lgkmcnt(" #n ")" ::: "memory")
#define PG8_BAR __builtin_amdgcn_s_barrier()
#define PG8_SCHED __builtin_amdgcn_sched_barrier(0)
    Unit cur, nxt; int ui = 0;
    if (!S.next(0, cur)) return;
    f32x4 acc[2][2][4][2];
#pragma unroll
    for (int a = 0; a < 2; ++a)
#pragma unroll
        for (int b = 0; b < 2; ++b)
#pragma unroll
            for (int m = 0; m < 4; ++m)
#pragma unroll
                for (int n = 0; n < 2; ++n) acc[a][b][m][n] = (f32x4){0.f, 0.f, 0.f, 0.f};
    bf16x8 At[4][2], B0[2][2], B1[2][2];
    const char* cA = (const char*)g.A + (size_t)cur.pm * tstep; const char* cB = (const char*)g.Bt + (size_t)cur.pn * tstep;
    S.a_ready(cur);
    if constexpr (SP2) {
        PG8_STAGE(PG8_SB(0, 0), cB, voffB); PG8_STAGE(PG8_SB(0, 1), cB + hstep, voffB); PG8_STAGE(PG8_SA(0, 0), cA, voffA); PG8_STAGE(PG8_SA(0, 1), cA + hstep, voffA);
        if (wr == 1) PG8_BAR;
        PG8_WAIT_V(2); PG8_BAR;
        PG8_STAGE(PG8_SB(1, 0), cB + kstep, voffB); PG8_STAGE(PG8_SA(1, 0), cA + kstep, voffA); PG8_STAGE(PG8_SB(1, 1), cB + hstep + kstep, voffB);
        PG8_WAIT_V(6); PG8_BAR;
    } else {
        PG8_STAGE(PG8_SB(0, 0), cB, voffB); PG8_STAGE(PG8_SA(0, 0), cA, voffA); PG8_STAGE(PG8_SB(0, 1), cB + hstep, voffB); PG8_STAGE(PG8_SA(0, 1), cA + hstep, voffA);
        if (wr == 1) PG8_BAR;
        PG8_WAIT_V(4); PG8_BAR;
        PG8_STAGE(PG8_SB(1, 0), cB + kstep, voffB); PG8_STAGE(PG8_SA(1, 0), cA + kstep, voffA); PG8_STAGE(PG8_SB(1, 1), cB + hstep + kstep, voffB);
        PG8_WAIT_V(6); PG8_BAR;
    }
    for (;;) {
        const bool has_next = S.next(ui + 1, nxt);
        const char* nA = has_next ? (const char*)g.A + (size_t)nxt.pm * tstep : cA; const char* nB = has_next ? (const char*)g.Bt + (size_t)nxt.pn * tstep : cB;
        for (int t = 0; t < nt; t += 2) {
            const bool last = (t == nt - 2);
            const char* a1 = cA + (size_t)(t + 1) * kstep;
            const char* a2 = last ? nA : cA + (size_t)(t + 2) * kstep; const char* b2 = last ? nB : cB + (size_t)(t + 2) * kstep;
            const char* a3 = a2 + kstep; const char* b3 = b2 + kstep;
            if (last && has_next) S.a_ready(nxt);
            if constexpr (SP2) {
            PG8_LDB(B0, 0, 0); PG8_LDB(B1, 0, 1); PG8_SCHED; PG8_LDA(At, 0, 0); PG8_STAGE(PG8_SA(1, 1), a1 + hstep, voffA);
            PG8_WAIT_V(8); PG8_WAIT_L(0); PG8_BAR; PG8_MMA(0, 0, At, B0); PG8_MMA(0, 1, At, B1); PG8_BAR; PG8_SCHED;
            PG8_LDA(At, 0, 1); PG8_STAGE(PG8_SB(0, 0), b2, voffB); PG8_STAGE(PG8_SB(0, 1), b2 + hstep, voffB); PG8_STAGE(PG8_SA(0, 0), a2, voffA);
            PG8_WAIT_V(8); PG8_WAIT_L(0); PG8_BAR; PG8_MMA(1, 0, At, B0); PG8_MMA(1, 1, At, B1); PG8_BAR; PG8_SCHED;
            PG8_LDB(B0, 1, 0); PG8_LDB(B1, 1, 1); PG8_SCHED; PG8_LDA(At, 1, 0); PG8_STAGE(PG8_SA(0, 1), a2 + hstep, voffA);
            PG8_WAIT_V(8); PG8_WAIT_L(0); PG8_BAR; PG8_MMA(0, 0, At, B0); PG8_MMA(0, 1, At, B1); PG8_BAR; PG8_SCHED;
            PG8_LDA(At, 1, 1); PG8_STAGE(PG8_SB(1, 0), b3, voffB); PG8_STAGE(PG8_SB(1, 1), b3 + hstep, voffB); PG8_STAGE(PG8_SA(1, 0), a3, voffA);
            PG8_WAIT_V(8); PG8_WAIT_L(0); PG8_BAR; PG8_MMA(1, 0, At, B0); PG8_MMA(1, 1, At, B1); PG8_BAR; PG8_SCHED;
            } else {
            PG8_LDB(B0, 0, 0); PG8_SCHED; PG8_LDA(At, 0, 0); PG8_STAGE(PG8_SA(1, 1), a1 + hstep, voffA);
            PG8_WAIT_L(8); PG8_BAR; PG8_WAIT_L(0); PG8_MMA(0, 0, At, B0); PG8_BAR; PG8_SCHED;
            PG8_LDB(B1, 0, 1); PG8_STAGE(PG8_SB(0, 0), b2, voffB);
            PG8_BAR; PG8_WAIT_L(0); PG8_MMA(0, 1, At, B1); PG8_BAR;
            PG8_LDA(At, 0, 1); PG8_STAGE(PG8_SA(0, 0), a2, voffA);
            PG8_BAR; PG8_WAIT_L(0); PG8_MMA(1, 0, At, B0); PG8_BAR; PG8_SCHED;
            PG8_STAGE(PG8_SB(0, 1), b2 + hstep, voffB);
            PG8_WAIT_V(6); PG8_BAR; PG8_MMA(1, 1, At, B1); PG8_BAR;
            PG8_LDB(B0, 1, 0); PG8_SCHED; PG8_LDA(At, 1, 0); PG8_STAGE(PG8_SA(0, 1), a2 + hstep, voffA);
            PG8_WAIT_L(8); PG8_BAR; PG8_WAIT_L(0); PG8_MMA(0, 0, At, B0); PG8_BAR; PG8_SCHED;
            PG8_LDB(B1, 1, 1); PG8_STAGE(PG8_SB(1, 0), b3, voffB);
            PG8_BAR; PG8_WAIT_L(0); PG8_MMA(0, 1, At, B1); PG8_BAR;
            PG8_LDA(At, 1, 1); PG8_STAGE(PG8_SA(1, 0), a3, voffA);
            PG8_BAR; PG8_WAIT_L(0); PG8_MMA(1, 0, At, B0); PG8_BAR; PG8_SCHED;
            PG8_STAGE(PG8_SB(1, 1), b3 + hstep, voffB);
            PG8_WAIT_V(6); PG8_BAR; PG8_MMA(1, 1, At, B1); PG8_BAR;
            }
        }
        if constexpr (ALIGN_EPI) { if (wr == 0) PG8_BAR; }
        if constexpr (!Epi::AFTER_DRAIN) { E(acc, cur, wr, wc, fr, fq); S.done(cur); }
        if (!has_next) break;
#pragma unroll
        for (int a = 0; a < 2; ++a)
#pragma unroll
            for (int b = 0; b < 2; ++b)
#pragma unroll
                for (int m = 0; m < 4; ++m)
#pragma unroll
                    for (int n = 0; n < 2; ++n) acc[a][b][m][n] = (f32x4){0.f, 0.f, 0.f, 0.f};
        cur = nxt; cA = nA; cB = nB; ++ui;
        if constexpr (ALIGN_EPI) { if (wr == 1) PG8_BAR; }
    }
    PG8_WAIT_V(0);
    if constexpr (!ALIGN_EPI) { if (wr == 0) PG8_BAR; }
    PG8_BAR;
    if constexpr (Epi::AFTER_DRAIN) { E.fused(acc, cur, wr, wc, fr, fq, lds, wid, lane); S.done(cur); }
#undef PG8_SA
#undef PG8_SB
#undef PG8_STAGE
#undef PG8_LDA
#undef PG8_LDB
#undef PG8_MMA
#undef PG8_WAIT_V
#undef PG8_WAIT_L
#undef PG8_BAR
#undef PG8_SCHED
}
}
namespace pg8 {
struct EpiF32 {
    static constexpr bool PERM = false, AFTER_DRAIN = false;
    float* out; const float* base0; const float* base1; int ldc; int split; float alpha; int pad;
    __device__ __forceinline__ void operator()(const f32x4 (&acc)[2][2][4][2], const Unit& u, int wr, int wc, int fr, int fq) const {
        const int col0 = u.pn * BM + wc * 32 + 4 * fq;
        const float* bp = nullptr;
        if (base0) bp = (u.pm < split) ? base0 + (size_t)u.pm * BM * ldc : base1 + (size_t)(u.pm - split) * BM * ldc;
#pragma unroll
        for (int ai = 0; ai < 2; ++ai)
#pragma unroll
            for (int m = 0; m < 4; ++m) { const int rt = ai * HALF + wr * 64 + m * 16 + fr; const size_t off = (size_t)rt * ldc + col0;
                float* orow = out + (size_t)u.pm * BM * ldc + off;
#pragma unroll
                for (int bj = 0; bj < 2; ++bj)
#pragma unroll
                    for (int n = 0; n < 2; ++n) { f32x4 v = acc[ai][bj][m][n] * alpha; if (bp) v = v + *(const f32x4*)(bp + off + bj * HALF + n * 16);
                        *(f32x4*)(orow + bj * HALF + n * 16) = v; } }
    }
};
struct EpiSwiGLU {
    static constexpr bool PERM = true, AFTER_DRAIN = false;
    bf16_t* H; const float* SSQX; int ldh; int pad;
    __device__ __forceinline__ void operator()(const f32x4 (&acc)[2][2][4][2], const Unit& u, int wr, int wc, int fr, int fq) const {
        const int col0 = u.pn * HALF + wc * 32 + 8 * fq;
#pragma unroll
        for (int ai = 0; ai < 2; ++ai)
#pragma unroll
            for (int m = 0; m < 4; ++m) { const int row = u.pm * BM + ai * HALF + wr * 64 + m * 16 + fr; bf16_t* rowp = H + (size_t)row * ldh + col0;
                float rs = 1.0f;
                if (SSQX) { const f32x4* sp = (const f32x4*)(SSQX + (size_t)row * 16); const f32x4 s0 = sp[0], s1 = sp[1], s2 = sp[2], s3 = sp[3]; const f32x4 t = (s0 + s1) + (s2 + s3);
                    rs = __builtin_amdgcn_rsqf(((t[0] + t[1]) + (t[2] + t[3])) * (1.0f / 1024.0f) + 1e-6f); }
                float hv[8];
#pragma unroll
                for (int n = 0; n < 2; ++n)
#pragma unroll
                    for (int i = 0; i < 4; ++i) { const float g = acc[ai][0][m][n][i] * rs, up = acc[ai][1][m][n][i] * rs;
                        hv[4 * n + i] = g * __builtin_amdgcn_rcpf(1.0f + __builtin_amdgcn_exp2f(-1.4426950408889634f * g)) * up; }
                u32x4 w; w.x = cvt_pk_bf16(hv[0], hv[1]); w.y = cvt_pk_bf16(hv[2], hv[3]); w.z = cvt_pk_bf16(hv[4], hv[5]); w.w = cvt_pk_bf16(hv[6], hv[7]);
                *(u32x4*)rowp = w; }
    }
};
template <bool BASE_F32> struct EpiRes {
    static constexpr bool PERM = false, AFTER_DRAIN = false;
    const float* basef; bf16_t* Xb; float* SSQX; float alpha; int pad;
    __device__ __forceinline__ void operator()(const f32x4 (&acc)[2][2][4][2], const Unit& u, int wr, int wc, int fr, int fq) const {
        typedef unsigned u32x2 __attribute__((ext_vector_type(2)));
        constexpr int ldc = 1024;
        const int col0 = u.pn * BM + wc * 32 + 4 * fq;
#pragma unroll
        for (int ai = 0; ai < 2; ++ai)
#pragma unroll
            for (int m = 0; m < 4; ++m) { const size_t row = (size_t)u.pm * BM + ai * HALF + wr * 64 + m * 16 + fr; float ss = 0.f;
#pragma unroll
                for (int bj = 0; bj < 2; ++bj)
#pragma unroll
                    for (int n = 0; n < 2; ++n) { const size_t off = row * ldc + col0 + bj * HALF + n * 16; f32x4 bv;
                        if (BASE_F32) bv = *(const f32x4*)(basef + off);
                        else { const u32x2 bw = *(const u32x2*)(Xb + off); bv[0] = __uint_as_float(bw.x << 16); bv[1] = __uint_as_float(bw.x & 0xffff0000u); bv[2] = __uint_as_float(bw.y << 16); bv[3] = __uint_as_float(bw.y & 0xffff0000u); }
                        const f32x4 v = acc[ai][bj][m][n] * alpha + bv;
                        u32x2 w; w.x = cvt_pk_bf16(v[0], v[1]); w.y = cvt_pk_bf16(v[2], v[3]); *(u32x2*)(Xb + off) = w;
                        ss += (v[0] * v[0] + v[1] * v[1]) + (v[2] * v[2] + v[3] * v[3]); }
                ss += __shfl_xor(ss, 16); ss += __shfl_xor(ss, 32); if (fq == 0) SSQX[row * 16 + u.pn * 4 + wc] = ss; }
    }
};
struct EpiFinal {
    static constexpr bool PERM = false, AFTER_DRAIN = true;
    const bf16_t* Xb; float* out; const float* gain; float* xch; unsigned* cnt; float alpha; int pad;
    __device__ __forceinline__ void fused(f32x4 (&acc)[2][2][4][2], const Unit& u, int wr, int wc, int fr, int fq, PG8_LAS unsigned char* lds, int wid, int lane) const {
        typedef unsigned u32x2 __attribute__((ext_vector_type(2)));
        constexpr int ldc = 1024;
        PG8_LAS float* S = (PG8_LAS float*)(lds + 8192);
        const int col0 = u.pn * BM + wc * 32 + 4 * fq;
        float ssv[2][4];
        {
            u32x2 bw[2][4][2][2];
#pragma unroll
            for (int ai = 0; ai < 2; ++ai)
#pragma unroll
                for (int m = 0; m < 4; ++m) { const size_t row = (size_t)u.pm * BM + ai * HALF + wr * 64 + m * 16 + fr;
#pragma unroll
                    for (int bj = 0; bj < 2; ++bj)
#pragma unroll
                        for (int n = 0; n < 2; ++n) bw[ai][m][bj][n] = *(const u32x2*)(Xb + row * ldc + col0 + bj * HALF + n * 16); }
#pragma unroll
            for (int ai = 0; ai < 2; ++ai)
#pragma unroll
                for (int m = 0; m < 4; ++m) { float ss = 0.f;
#pragma unroll
                    for (int bj = 0; bj < 2; ++bj)
#pragma unroll
                        for (int n = 0; n < 2; ++n) { const u32x2 w_ = bw[ai][m][bj][n]; f32x4 bv;
                            bv[0] = __uint_as_float(w_.x << 16); bv[1] = __uint_as_float(w_.x & 0xffff0000u); bv[2] = __uint_as_float(w_.y << 16); bv[3] = __uint_as_float(w_.y & 0xffff0000u);
                            const f32x4 v = acc[ai][bj][m][n] * alpha + bv; acc[ai][bj][m][n] = v;
                            ss += (v[0] * v[0] + v[1] * v[1]) + (v[2] * v[2] + v[3] * v[3]); }
                    ss += __shfl_xor(ss, 16); ss += __shfl_xor(ss, 32); ssv[ai][m] = ss; } }
        if (fq == 0) {
#pragma unroll
            for (int ai = 0; ai < 2; ++ai)
#pragma unroll
                for (int m = 0; m < 4; ++m) { const size_t row = (size_t)u.pm * BM + ai * HALF + wr * 64 + m * 16 + fr;
                    __hip_atomic_store(xch + row * 16 + u.pn * 4 + wc, ssv[ai][m], __ATOMIC_RELAXED, __HIP_MEMORY_SCOPE_AGENT); } }
        asm volatile("s_waitcnt vmcnt(0)" ::: "memory");
        if (lane == 0) __hip_atomic_fetch_add(cnt + 64 * u.pm, 1u, __ATOMIC_RELAXED, __HIP_MEMORY_SCOPE_AGENT);
        if (wid == 0) { unsigned sp = 0u;
            while ((unsigned)__builtin_amdgcn_readfirstlane(__hip_atomic_load(cnt + 64 * u.pm, __ATOMIC_RELAXED, __HIP_MEMORY_SCOPE_AGENT)) < 32u) { __builtin_amdgcn_s_sleep(2); if (++sp > (1u << 22)) break; }
            __builtin_amdgcn_fence(__ATOMIC_ACQUIRE, "agent"); }
        asm volatile("s_waitcnt vmcnt(0) lgkmcnt(0)" ::: "memory"); __builtin_amdgcn_s_barrier(); asm volatile("" ::: "memory");
        if (lane < 32) { const int r = wid * 32 + lane; const unsigned long long* sl = (const unsigned long long*)(xch + ((size_t)u.pm * BM + r) * 16); float t = 0.f;
#pragma unroll
            for (int j = 0; j < 8; ++j) { const unsigned long long w = __hip_atomic_load(sl + j, __ATOMIC_RELAXED, __HIP_MEMORY_SCOPE_AGENT); t += __uint_as_float((unsigned)w) + __uint_as_float((unsigned)(w >> 32)); }
            S[r] = 1.0f / sqrtf(t * (1.0f / 1024.0f) + 1e-6f); }
        asm volatile("s_waitcnt lgkmcnt(0)" ::: "memory"); __builtin_amdgcn_s_barrier(); asm volatile("" ::: "memory");
        f32x4 gv[2][2];
#pragma unroll
        for (int bj = 0; bj < 2; ++bj)
#pragma unroll
            for (int n = 0; n < 2; ++n) gv[bj][n] = *(const f32x4*)(gain + col0 + bj * HALF + n * 16);
#pragma unroll
        for (int ai = 0; ai < 2; ++ai)
#pragma unroll
            for (int m = 0; m < 4; ++m) { const int r = ai * HALF + wr * 64 + m * 16 + fr; const float rs = S[r]; float* op = out + ((size_t)u.pm * BM + r) * ldc + col0;
#pragma unroll
                for (int bj = 0; bj < 2; ++bj)
#pragma unroll
                    for (int n = 0; n < 2; ++n) *(f32x4*)(op + bj * HALF + n * 16) = acc[ai][bj][m][n] * rs * gv[bj][n]; }
    }
};
}
namespace pg8 {
__device__ __forceinline__ void rope_cs_e(int pos, int i, float& c, float& s) {
    const float ang = (float)pos * ROPE_FREQ[i];
    const double q4 = (double)ang * 0.6366197723675814; const double qr = rint(q4);
    const float r = (float)((q4 - qr) * 1.5707963267948966); const int qi = ((int)qr) & 3; const float r2 = r * r;
    const float sn = r * (1.0f + r2 * (-1.6666667e-1f + r2 * (8.3333333e-3f + r2 * (-1.9841270e-4f + r2 * 2.7557319e-6f))));
    const float cs = 1.0f + r2 * (-0.5f + r2 * (4.1666667e-2f + r2 * (-1.3888889e-3f + r2 * (2.4801587e-5f + r2 * -2.7557319e-7f))));
    c = (qi == 0) ? cs : (qi == 1) ? -sn : (qi == 2) ? -cs : sn;
    s = (qi == 0) ? sn : (qi == 1) ? cs : (qi == 2) ? -sn : -cs;
}
__device__ __forceinline__ float gelu_e(float x) { const float y = 0.7978845608028654f * (x + 0.044715f * x * x * x); return x * __builtin_amdgcn_rcpf(1.0f + __builtin_amdgcn_exp2f(-2.8853900817779268f * y)); }
typedef unsigned u32x2 __attribute__((ext_vector_type(2)));
struct EpiZ {
    static constexpr bool PERM = false, AFTER_DRAIN = false;
    bf16_t* XL; bf16_t* GG; bf16_t* CQ; float* CKV; float* SSQ; float* out; bf16_t* KC; bf16_t* KCS; const float* SSQX; bf16_t* CKVB;
    __device__ __forceinline__ void operator()(const f32x4 (&acc0)[2][2][4][2], const Unit& u, int wr, int wc, int fr, int fq) const {
        const int pn = u.pn;
#pragma unroll
        for (int ai = 0; ai < 2; ++ai)
#pragma unroll
            for (int m = 0; m < 4; ++m) { const int row = u.pm * BM + ai * HALF + wr * 64 + m * 16 + fr;
                f32x4 acc[2][2][4][2];
                { const f32x4* sp = (const f32x4*)(SSQX + (size_t)row * 16); const f32x4 s0 = sp[0], s1 = sp[1], s2 = sp[2], s3 = sp[3]; const f32x4 t = (s0 + s1) + (s2 + s3);
                  const float rs = __builtin_amdgcn_rsqf(((t[0] + t[1]) + (t[2] + t[3])) * (1.0f / 1024.0f) + 1e-6f);
#pragma unroll
                  for (int bj = 0; bj < 2; ++bj)
#pragma unroll
                      for (int n = 0; n < 2; ++n) acc[ai][bj][m][n] = acc0[ai][bj][m][n] * rs; }
                if (pn < 4) { bf16_t* dst = (pn < 2 ? XL : GG) + (size_t)row * 512 + (pn & 1) * 256 + wc * 32 + 4 * fq;
#pragma unroll
                    for (int bj = 0; bj < 2; ++bj)
#pragma unroll
                        for (int n = 0; n < 2; ++n) { f32x4 v = acc[ai][bj][m][n]; if (pn >= 2) { v[0] = gelu_e(v[0]); v[1] = gelu_e(v[1]); v[2] = gelu_e(v[2]); v[3] = gelu_e(v[3]); }
                            u32x2 w; w.x = cvt_pk_bf16(v[0], v[1]); w.y = cvt_pk_bf16(v[2], v[3]); *(u32x2*)(dst + bj * HALF + n * 16) = w; } }
                else if (pn == 4) { bf16_t* dst = CQ + (size_t)row * 256 + wc * 32 + 4 * fq; float ss = 0.f;
#pragma unroll
                    for (int bj = 0; bj < 2; ++bj)
#pragma unroll
                        for (int n = 0; n < 2; ++n) { const f32x4 v = acc[ai][bj][m][n]; ss += (v[0] * v[0] + v[1] * v[1]) + (v[2] * v[2] + v[3] * v[3]);
                            u32x2 w; w.x = cvt_pk_bf16(v[0], v[1]); w.y = cvt_pk_bf16(v[2], v[3]); *(u32x2*)(dst + bj * HALF + n * 16) = w; }
                    ss += __shfl_xor(ss, 16); ss += __shfl_xor(ss, 32);
                    if (fq == 0) SSQ[(size_t)row * 8 + wc] = ss; }
                else { float* dst = CKV + (size_t)row * 128 + wc * 32 + 4 * fq; float ss = 0.f;
#pragma unroll
                    for (int n = 0; n < 2; ++n) { const f32x4 v = acc[ai][0][m][n]; ss += (v[0] * v[0] + v[1] * v[1]) + (v[2] * v[2] + v[3] * v[3]); *(f32x4*)(dst + n * 16) = v;
                        u32x2 w; w.x = cvt_pk_bf16(v[0], v[1]); w.y = cvt_pk_bf16(v[2], v[3]); *(u32x2*)(CKVB + (size_t)row * 128 + wc * 32 + 4 * fq + n * 16) = w; }
                    ss += __shfl_xor(ss, 16); ss += __shfl_xor(ss, 32);
                    if (fq == 0) SSQ[(size_t)row * 8 + 4 + wc] = ss;
                    if (wc == 0) { const bool prompt = row < 16384; const int pos = prompt ? (row & 8191) : 16384 + ((row - 16384) & 7);
                        float* ko = prompt ? out + O_KRP + (size_t)row * 32 : out + O_KRS + (size_t)(row - 16384) * 32;
                        bf16_t* kb = prompt ? KC + (size_t)row * 160 + 128 : KCS + (size_t)(row - 16384) * 160 + 128;
                        const f32x4 x1 = acc[ai][1][m][0], x2 = acc[ai][1][m][1]; f32x4 o1, o2;
#pragma unroll
                        for (int i = 0; i < 4; ++i) { float c, s; rope_cs_e(pos, 4 * fq + i, c, s); o1[i] = x1[i] * c - x2[i] * s; o2[i] = x2[i] * c + x1[i] * s; }
                        *(f32x4*)(ko + 4 * fq) = o1; *(f32x4*)(ko + 16 + 4 * fq) = o2;
                        u32x2 w1, w2; w1.x = cvt_pk_bf16(o1[0], o1[1]); w1.y = cvt_pk_bf16(o1[2], o1[3]); w2.x = cvt_pk_bf16(o2[0], o2[1]); w2.y = cvt_pk_bf16(o2[2], o2[3]);
                        *(u32x2*)(kb + 4 * fq) = w1; *(u32x2*)(kb + 16 + 4 * fq) = w2; } }
            }
    }
};
struct EpiQ {
    static constexpr bool PERM = false, AFTER_DRAIN = false;
    bf16_t* Qb; const float* SSQ; float qscale; int sample;
    __device__ __forceinline__ void operator()(const f32x4 (&acc)[2][2][4][2], const Unit& u, int wr, int wc, int fr, int fq) const {
        const int pn = u.pn;
#pragma unroll
        for (int ai = 0; ai < 2; ++ai)
#pragma unroll
            for (int m = 0; m < 4; ++m) { const int row = u.pm * BM + ai * HALF + wr * 64 + m * 16 + fr;
                const f32x4 sq = *(const f32x4*)(SSQ + (size_t)row * 8);
                const float sc = qscale * __builtin_amdgcn_rsqf(((sq[0] + sq[1]) + (sq[2] + sq[3])) * (1.0f / 256.0f) + 1e-6f);
                if (pn < 4) {
#pragma unroll
                    for (int bj = 0; bj < 2; ++bj) { bf16_t* dst = Qb + ((size_t)row * 8 + 2 * pn + bj) * 160 + wc * 32 + 4 * fq;
#pragma unroll
                        for (int n = 0; n < 2; ++n) { const f32x4 v = acc[ai][bj][m][n] * sc; u32x2 w; w.x = cvt_pk_bf16(v[0], v[1]); w.y = cvt_pk_bf16(v[2], v[3]); *(u32x2*)(dst + n * 16) = w; } } }
                else { const int pos = sample ? 16384 + (row & 7) : (row & 8191);
                    float cs[4], sn[4];
#pragma unroll
                    for (int i = 0; i < 4; ++i) rope_cs_e(pos, 4 * fq + i, cs[i], sn[i]);
#pragma unroll
                    for (int bj = 0; bj < 2; ++bj) { bf16_t* dst = Qb + ((size_t)row * 8 + 4 * bj + wc) * 160 + 128 + 4 * fq;
                        const f32x4 x1 = acc[ai][bj][m][0] * sc, x2 = acc[ai][bj][m][1] * sc; f32x4 o1, o2;
#pragma unroll
                        for (int i = 0; i < 4; ++i) { o1[i] = x1[i] * cs[i] - x2[i] * sn[i]; o2[i] = x2[i] * cs[i] + x1[i] * sn[i]; }
                        u32x2 w1, w2; w1.x = cvt_pk_bf16(o1[0], o1[1]); w1.y = cvt_pk_bf16(o1[2], o1[3]); w2.x = cvt_pk_bf16(o2[0], o2[1]); w2.y = cvt_pk_bf16(o2[2], o2[3]);
                        *(u32x2*)dst = w1; *(u32x2*)(dst + 16) = w2; } }
            }
    }
};
struct EpiQP {
    static constexpr bool PERM = false, AFTER_DRAIN = false;
    bf16_t* Qb; const float* SSQ; float qscale; int pad;
    __device__ __forceinline__ void operator()(const f32x4 (&acc)[2][2][4][2], const Unit& u, int wr, int wc, int fr, int fq) const {
        const int pn = u.pn;
#pragma unroll
        for (int ai = 0; ai < 2; ++ai)
#pragma unroll
            for (int m = 0; m < 4; ++m) { const int row = u.pm * BM + ai * HALF + wr * 64 + m * 16 + fr;
                const f32x4 sq = *(const f32x4*)(SSQ + (size_t)row * 8);
                const float sc = qscale * __builtin_amdgcn_rsqf(((sq[0] + sq[1]) + (sq[2] + sq[3])) * (1.0f / 256.0f) + 1e-6f);
                if (pn < 2) {
#pragma unroll
                    for (int bj = 0; bj < 2; ++bj) { bf16_t* dst = Qb + ((size_t)row * 8 + 4 * pn + 2 * bj + (wc >> 1)) * 96 + 32 * (wc & 1) + 4 * fq;
#pragma unroll
                        for (int n = 0; n < 2; ++n) { const f32x4 v = acc[ai][bj][m][n] * sc; u32x2 w; w.x = cvt_pk_bf16(v[0], v[1]); w.y = cvt_pk_bf16(v[2], v[3]); *(u32x2*)(dst + n * 16) = w; } } }
                else { const int pos = row & 8191;
                    float cs[4], sn[4];
#pragma unroll
                    for (int i = 0; i < 4; ++i) rope_cs_e(pos, 4 * fq + i, cs[i], sn[i]);
#pragma unroll
                    for (int bj = 0; bj < 2; ++bj) { bf16_t* dst = Qb + ((size_t)row * 8 + 4 * bj + wc) * 96 + 64 + 4 * fq;
                        const f32x4 x1 = acc[ai][bj][m][0] * sc, x2 = acc[ai][bj][m][1] * sc; f32x4 o1, o2;
#pragma unroll
                        for (int i = 0; i < 4; ++i) { o1[i] = x1[i] * cs[i] - x2[i] * sn[i]; o2[i] = x2[i] * cs[i] + x1[i] * sn[i]; }
                        u32x2 w1, w2; w1.x = cvt_pk_bf16(o1[0], o1[1]); w1.y = cvt_pk_bf16(o1[2], o1[3]); w2.x = cvt_pk_bf16(o2[0], o2[1]); w2.y = cvt_pk_bf16(o2[2], o2[3]);
                        *(u32x2*)dst = w1; *(u32x2*)(dst + 16) = w2; } }
            }
    }
};
struct EpiKV {
    static constexpr bool PERM = false, AFTER_DRAIN = false;
    bf16_t* KVH; const float* SSQ; const bf16_t* KC;
    __device__ __forceinline__ void operator()(const f32x4 (&acc)[2][2][4][2], const Unit& u, int wr, int wc, int fr, int fq) const {
#pragma unroll
        for (int ai = 0; ai < 2; ++ai)
#pragma unroll
            for (int m = 0; m < 4; ++m) { const int row = u.pm * BM + ai * HALF + wr * 64 + m * 16 + fr; const int b = row >> 13, t = row & 8191;
                const f32x4 sq = *(const f32x4*)(SSQ + (size_t)row * 8 + 4);
                const float sc = __builtin_amdgcn_rsqf(((sq[0] + sq[1]) + (sq[2] + sq[3])) * (1.0f / 128.0f) + 1e-6f);
#pragma unroll
                for (int bj = 0; bj < 2; ++bj) { bf16_t* dst = KVH + (((size_t)b * 8 + 2 * u.pn + bj) * 8192 + t) * 160;
#pragma unroll
                    for (int n = 0; n < 2; ++n) { const f32x4 v = acc[ai][bj][m][n] * sc; u32x2 w; w.x = cvt_pk_bf16(v[0], v[1]); w.y = cvt_pk_bf16(v[2], v[3]); *(u32x2*)(dst + wc * 32 + 4 * fq + n * 16) = w; }
                    if (wc == 0) *(u32x4*)(dst + 128 + 8 * fq) = *(const u32x4*)(KC + (size_t)row * 160 + 128 + 8 * fq); }
            }
    }
};
}
#define GAS __attribute__((address_space(1)))
#define LAS __attribute__((address_space(3)))
typedef unsigned short bf16;
typedef unsigned v4u __attribute__((ext_vector_type(4)));
typedef float f32x4 __attribute__((ext_vector_type(4)));
typedef short bf16x8 __attribute__((ext_vector_type(8)));
typedef GAS unsigned gu32;
typedef GAS unsigned long long gu64;
#define RLX_AGENT __ATOMIC_RELAXED, __HIP_MEMORY_SCOPE_AGENT
#define LDS_WAIT() asm volatile("s_waitcnt lgkmcnt(0)" ::: "memory")
#define VM_WAIT() asm volatile("s_waitcnt vmcnt(0)" ::: "memory")
__device__ __forceinline__ unsigned long long rt() { return __builtin_amdgcn_s_memrealtime(); }
__device__ __forceinline__ unsigned f2bf(float f) { unsigned u = __builtin_bit_cast(unsigned, f); return (u + 0x7fffu + ((u >> 16) & 1u)) >> 16; }
__device__ __forceinline__ unsigned pk2(float lo, float hi) { return f2bf(lo) | (f2bf(hi) << 16); }

#define XB_TMO      128
#define XB_XCNT(j)  (256  + 64 * (j))
#define XB_XSUB(j)  (1280 + 64 * (j))
#define XB_XGEN(j)  (2304 + 64 * (j))
#define XB_TOP      3328
#define XB_TOPGEN   3392
#define XCD_BAR_WORDS 3456
#define XB_SPIN_CAP (1u << 18)

__device__ __forceinline__ unsigned xb_ld(unsigned* p)              { return __hip_atomic_load(p, __ATOMIC_RELAXED, __HIP_MEMORY_SCOPE_AGENT); }
__device__ __forceinline__ unsigned xb_add(unsigned* p, unsigned v) { return __hip_atomic_fetch_add(p, v, __ATOMIC_RELAXED, __HIP_MEMORY_SCOPE_AGENT); }
__device__ __forceinline__ unsigned xb_xcc_id() { return (unsigned)__builtin_amdgcn_s_getreg((3 << 11) | 20) & 0xFu; }
#define XB_SPIN(cond, bar) do { unsigned _sp = 0; while (cond) { __builtin_amdgcn_s_sleep(1); \
    if ((++_sp & 255u) == 0u) { if (xb_ld(&(bar)[XB_TMO])) break; if (_sp > XB_SPIN_CAP) { atomicAdd(&(bar)[XB_TMO], 1u); break; } } } } while (0)

struct XcdBarrier {
    unsigned* bar; unsigned x;
    volatile LAS unsigned* st;
};

__device__ __forceinline__ XcdBarrier xcd_barrier_post(unsigned* bar, volatile LAS unsigned* st) {
    XcdBarrier b; b.bar = bar; b.x = xb_xcc_id(); b.st = st;
    if (threadIdx.x == 0) (void)xb_add(&bar[XB_XCNT(b.x)], 1u);
    return b;
}
__device__ __forceinline__ void xcd_barrier_complete(unsigned* bar, unsigned x, unsigned& nloc, unsigned& nx) {
    const unsigned G = gridDim.x * gridDim.y * gridDim.z;
    unsigned sum, cnt, mine, sp = 0u;
    for (;;) {
        sum = 0u; cnt = 0u; mine = 0u;
#pragma unroll
        for (unsigned j = 0; j < 16; ++j) { const unsigned c = xb_ld(&bar[XB_XCNT(j)]); sum += c; cnt += (c > 0u) ? 1u : 0u; mine = (j == x) ? c : mine; }
        if (sum == G) break;
        __builtin_amdgcn_s_sleep(1);
        if ((++sp & 255u) == 0u) { if (xb_ld(&bar[XB_TMO])) break; if (sp > XB_SPIN_CAP) { atomicAdd(&bar[XB_TMO], 1u); break; } }
    }
    nloc = mine > 0u ? mine : 1u; nx = cnt > 0u ? cnt : 1u;
}

__device__ __forceinline__ void xcd_barrier(const XcdBarrier& b) {
    asm volatile("s_waitcnt vmcnt(0)" ::: "memory");
    __syncthreads();
    if (threadIdx.x == 0) {
        unsigned* bar = b.bar;
        __builtin_amdgcn_s_waitcnt(0);
        unsigned nloc = b.st[0], nx = b.st[1];
        if (nloc == 0u) { xcd_barrier_complete(bar, b.x, nloc, nx); b.st[0] = nloc; b.st[1] = nx; }
        const unsigned old = xb_add(&bar[XB_XSUB(b.x)], 1u);
        const unsigned gen = old / nloc;
        if (old + 1u == (gen + 1u) * nloc) {
            __builtin_amdgcn_fence(__ATOMIC_RELEASE, "agent");
            asm volatile("s_waitcnt vmcnt(0)" ::: "memory");
            const unsigned og = xb_add(&bar[XB_TOP], 1u);
            const unsigned tg = og / nx;
            if (og + 1u == (tg + 1u) * nx) xb_add(&bar[XB_TOPGEN], 1u);
            else XB_SPIN(xb_ld(&bar[XB_TOPGEN]) == tg, bar);
            __builtin_amdgcn_fence(__ATOMIC_ACQUIRE, "agent");
            xb_add(&bar[XB_XGEN(b.x)], 1u);
            asm volatile("s_waitcnt vmcnt(0)" ::: "memory");
        } else {
            XB_SPIN(xb_ld(&bar[XB_XGEN(b.x)]) == gen, bar);
            __builtin_amdgcn_fence(__ATOMIC_ACQUIRE, "agent");
            asm volatile("s_waitcnt vmcnt(0)" ::: "memory");
        }
    }
    __syncthreads();
}
__device__ __forceinline__ float wave_sum(float v) {
#pragma unroll
    for (int o = 1; o < 64; o <<= 1) v += __shfl_xor(v, o);
    return v;
}
__device__ __forceinline__ float sigmoidf_(float x) { return 1.0f / (1.0f + __expf(-x)); }
__device__ __forceinline__ float gelu_tanh(float x) { const float y = 0.7978845608028654f * (x + 0.044715f * x * x * x); return x * sigmoidf_(2.0f * y); }
__device__ __forceinline__ void rope_cs(int pos, int i, float& c, float& s) {
    const float ang = (float)pos * ROPE_FREQ[i];
    const double q4 = (double)ang * 0.6366197723675814;
    const double qr = rint(q4);
    const float r = (float)((q4 - qr) * 1.5707963267948966);
    const int qi = ((int)qr) & 3;
    const float r2 = r * r;
    const float sn = r * (1.0f + r2 * (-1.6666667e-1f + r2 * (8.3333333e-3f + r2 * (-1.9841270e-4f + r2 * 2.7557319e-6f))));
    const float cs = 1.0f + r2 * (-0.5f + r2 * (4.1666667e-2f + r2 * (-1.3888889e-3f + r2 * (2.4801587e-5f + r2 * -2.7557319e-7f))));
    c = (qi == 0) ? cs : (qi == 1) ? -sn : (qi == 2) ? -cs : sn;
    s = (qi == 0) ? sn : (qi == 1) ? cs : (qi == 2) ? -sn : -cs;
}
constexpr float QSCALE = 0.10206207261596577f * 1.4426950408889634f;
namespace att {
#define ATT_LAS __attribute__((address_space(3)))
typedef short bf16x8 __attribute__((ext_vector_type(8)));
typedef float f32x16 __attribute__((ext_vector_type(16)));
typedef short s16x4 __attribute__((ext_vector_type(4)));
typedef short v4i16_t __attribute__((ext_vector_type(4)));
typedef unsigned u32x4 __attribute__((ext_vector_type(4)));
typedef float f32x2_t __attribute__((ext_vector_type(2)));
typedef __bf16 bf16x2_t __attribute__((ext_vector_type(2)));
typedef ATT_LAS unsigned char* ldsp;
#define ATT_MFMA(a, b, c) __builtin_amdgcn_mfma_f32_32x32x16_bf16((a), (b), (c), 0, 0, 0)
__device__ __forceinline__ int crow(int r, int hi) { return (r & 3) + 8 * (r >> 2) + 4 * hi; }
__device__ __forceinline__ unsigned cvtpk(float lo, float hi) { f32x2_t v = {lo, hi}; bf16x2_t b = __builtin_convertvector(v, bf16x2_t); return __builtin_bit_cast(unsigned, b); }
__device__ __forceinline__ unsigned offL(unsigned row, unsigned ch) { return 256u * row + 16u * (ch ^ (((row & 3u) << 2) | ((row >> 2) & 3u))); }
__device__ __forceinline__ unsigned offR(unsigned row, unsigned ch) { return 64u * row + 16u * (ch ^ ((row >> 2) & 3u)); }
__device__ __forceinline__ bf16x8 lds_b128(ldsp p) { return *(const ATT_LAS bf16x8*)p; }
__device__ __forceinline__ s16x4 lds_tr(ldsp p) { return __builtin_bit_cast(s16x4, __builtin_amdgcn_ds_read_tr16_b64_v4i16((ATT_LAS v4i16_t*)p)); }
__device__ __forceinline__ float swapmax(float m) { auto rr = __builtin_amdgcn_permlane32_swap(__float_as_uint(m), __float_as_uint(m), false, false); return fmaxf(__uint_as_float(rr[0]), __uint_as_float(rr[1])); }
__device__ __forceinline__ float swapsum(float m) { auto rr = __builtin_amdgcn_permlane32_swap(__float_as_uint(m), __float_as_uint(m), false, false); return __uint_as_float(rr[0]) + __uint_as_float(rr[1]); }

constexpr int TILE_LAT = 64 * 256, TILE_ROPE = 64 * 64, TILE_BYTES = TILE_LAT + TILE_ROPE;
constexpr float THR = 8.0f;

__device__ __forceinline__ void softmax_step(f32x16& s0, f32x16& s1, float& m, float& l, f32x16 (&o)[4], bool first) {
    float rm = fmaxf(s0[0], s1[0]);
#pragma unroll
    for (int r = 1; r < 16; ++r) rm = fmaxf(rm, fmaxf(s0[r], s1[r]));
    rm = swapmax(rm);
    if (first) m = rm;
    rm -= m;
    if (!first && __any(rm > THR)) {
        const float dl = fmaxf(rm, 0.f);
        m += dl;
        const float f = __builtin_amdgcn_exp2f(-dl); l *= f;
#pragma unroll
        for (int c = 0; c < 4; ++c)
#pragma unroll
            for (int r = 0; r < 16; ++r) o[c][r] *= f;
    }
    float sum = 0.f;
#pragma unroll
    for (int r = 0; r < 16; ++r) { s0[r] = __builtin_amdgcn_exp2f(s0[r] - m); s1[r] = __builtin_amdgcn_exp2f(s1[r] - m); sum += s0[r] + s1[r]; }
    l += sum;
}

__device__ __forceinline__ void stage_load(u32x4 (&st)[3], const bf16* __restrict__ tilep, int tid) {
    const bf16* pl = tilep + (size_t)(tid >> 4) * QD + (tid & 15) * 8;
    st[0] = *(const u32x4*)pl; st[1] = *(const u32x4*)(pl + 32 * QD);
    if (tid < 256) st[2] = *(const u32x4*)(tilep + (size_t)(tid >> 2) * QD + KVL + (tid & 3) * 8);
}
__device__ __forceinline__ void stage_store(const u32x4 (&st)[3], ldsp tile, unsigned dl, unsigned dr, int tid) {
    *(ATT_LAS u32x4*)(tile + dl) = st[0]; *(ATT_LAS u32x4*)(tile + dl + 8192) = st[1];
    if (tid < 256) *(ATT_LAS u32x4*)(tile + TILE_LAT + dr) = st[2];
}
constexpr int PR_Q = 3 * TILE_BYTES, PR_QW = 32 * 256 + 32 * 64;
constexpr int PR_LDS_END = PR_Q + 8 * PR_QW;
__device__ __forceinline__ void softmax_step2(f32x16& s0, f32x16& s1, float& m, float& l, f32x16 (&o)[2], bool first) {
    float rm = fmaxf(s0[0], s1[0]);
#pragma unroll
    for (int r = 1; r < 16; ++r) rm = fmaxf(rm, fmaxf(s0[r], s1[r]));
    rm = swapmax(rm);
    if (first) m = rm;
    rm -= m;
    if (!first && __any(rm > THR)) {
        const float dl = fmaxf(rm, 0.f);
        m += dl;
        const float f = __builtin_amdgcn_exp2f(-dl); l *= f;
#pragma unroll
        for (int c = 0; c < 2; ++c)
#pragma unroll
            for (int r = 0; r < 16; ++r) o[c][r] *= f;
    }
    float sum = 0.f;
#pragma unroll
    for (int r = 0; r < 16; ++r) { s0[r] = __builtin_amdgcn_exp2f(s0[r] - m); s1[r] = __builtin_amdgcn_exp2f(s1[r] - m); sum += s0[r] + s1[r]; }
    l += sum;
}
__device__ __forceinline__ void prompt_unit(ldsp lds, const bf16* __restrict__ QbP, const bf16* __restrict__ KVH, float* __restrict__ SSQM, bf16* __restrict__ YC, int b, int h, int qb) {
    const int tid = threadIdx.x, lane = tid & 63, wid = __builtin_amdgcn_readfirstlane(tid >> 6), r32 = lane & 31, hi = lane >> 5;
    const int tq0 = 256 * qb + 32 * wid; const size_t row0 = (size_t)b * SEQ + tq0;
    const bf16* KVseq = KVH + ((size_t)(b * NH + h) * SEQ) * QD;
    const int ntile_u = 4 * qb + 4, ntile_w = 4 * qb + (wid >> 1) + 1;
    const unsigned lsrc = (unsigned)(4 * wid + (lane >> 4)) * (QD * 2) + 16u * ((unsigned)(lane & 15) ^ ((((unsigned)(lane >> 4) & 3u) << 2) | ((unsigned)wid & 3u)));
    const unsigned rsrc = (unsigned)(16 * wid + (lane >> 2)) * (QD * 2) + 2 * KVL + 16u * ((unsigned)(lane & 3) ^ ((unsigned)(lane >> 4) & 3u));
#define PR_GLDS(gptr, ldsaddr) do { unsigned keep_; asm volatile("s_mov_b32 %0, m0\n\ts_mov_b32 m0, %2\n\ts_nop 0\n\tglobal_load_lds_dwordx4 %1, off\n\ts_mov_b32 m0, %0" : "=&s"(keep_) : "v"(gptr), "s"(ldsaddr) : "memory"); } while (0)
#ifdef PR_SYNC_STAGE
#define PR_DMA(gtile, slot) do { const char* g_ = (const char*)(gtile); ldsp d_ = lds + (slot) + wid * 1024 + 16 * lane; \
        *(ATT_LAS u32x4*)(d_) = *(const u32x4*)(g_ + lsrc); *(ATT_LAS u32x4*)(d_ + 8192) = *(const u32x4*)(g_ + lsrc + 32 * QD * 2); \
        if (wid < 4) *(ATT_LAS u32x4*)(d_ + TILE_LAT) = *(const u32x4*)(g_ + rsrc); } while (0)
#else
#define PR_DMA(gtile, slot) do { const char* g_ = (const char*)(gtile); const unsigned l_ = (unsigned)__builtin_amdgcn_readfirstlane((int)(lds0 + (unsigned)(slot) + (unsigned)wid * 1024u)); \
        PR_GLDS(g_ + lsrc, l_); PR_GLDS(g_ + lsrc + 32 * QD * 2, l_ + 8192u); \
        if (wid < 4) PR_GLDS(g_ + rsrc, l_ + (unsigned)TILE_LAT); } while (0)
#endif
    const unsigned lds0 = (unsigned)(size_t)lds;
    PR_DMA(KVseq, 0);
    ldsp qimg = lds + PR_Q + wid * PR_QW;
    { const bf16* qp = QbP + ((row0 + r32) * NH + h) * 96 + 8 * hi;
#pragma unroll
      for (int s = 0; s < 4; ++s) *(ATT_LAS bf16x8*)(qimg + offL((unsigned)r32, (unsigned)(2 * s + hi))) = *(const bf16x8*)(qp + 16 * s);
#pragma unroll
      for (int s = 0; s < 2; ++s) *(ATT_LAS bf16x8*)(qimg + 32 * 256 + offR((unsigned)r32, (unsigned)(2 * s + hi))) = *(const bf16x8*)(qp + 64 + 16 * s); }
    PR_DMA(KVseq + (size_t)64 * QD, TILE_BYTES);
    asm volatile("s_waitcnt vmcnt(0) lgkmcnt(0)" ::: "memory");
    __syncthreads();
    float m = 0.f, l = 0.f; f32x16 o[2];
#pragma unroll
    for (int r = 0; r < 16; ++r) { o[0][r] = 0.f; o[1][r] = 0.f; }
    const unsigned xk = (unsigned)(((r32 & 3) << 1) | ((r32 >> 3) & 1));
    const unsigned ka = 256u * (unsigned)r32 + 16u * ((unsigned)hi ^ ((unsigned)(r32 >> 2) & 1u));
    const unsigned kr0 = TILE_LAT + offR((unsigned)r32, (unsigned)hi), kr1 = TILE_LAT + offR((unsigned)r32, 2u + (unsigned)hi);
    const unsigned blk = (lane >> 4) & 1, qq = (lane & 15) >> 2, pp = lane & 3;
    const unsigned vb0 = 256u * (unsigned)(4 * hi + qq) + 16u * ((2u * blk + (pp >> 1)) ^ (unsigned)hi) + 8u * (pp & 1u);
    const unsigned vb1 = 256u * (unsigned)(8 + 4 * hi + qq) + 16u * ((2u * blk + (pp >> 1)) ^ (2u + (unsigned)hi)) + 8u * (pp & 1u);
#define PR_QK(S0, S1, tile) do { unsigned xko = xk; asm volatile("" : "+v"(xko)); \
        _Pragma("unroll") for (int r = 0; r < 16; ++r) { S0[r] = 0.f; S1[r] = 0.f; } \
        _Pragma("unroll") for (int k = 0; k < 4; ++k) { const unsigned a_ = ka + 32u * ((unsigned)k ^ xko); const bf16x8 q_ = lds_b128(qimg + a_); \
            S0 = ATT_MFMA(lds_b128((tile) + a_), q_, S0); S1 = ATT_MFMA(lds_b128((tile) + a_ + 8192), q_, S1); } \
        { const bf16x8 q_ = lds_b128(qimg + 32 * 256 + (kr0 - TILE_LAT)); S0 = ATT_MFMA(lds_b128((tile) + kr0), q_, S0); S1 = ATT_MFMA(lds_b128((tile) + kr0 + 2048), q_, S1); } \
        { const bf16x8 q_ = lds_b128(qimg + 32 * 256 + (kr1 - TILE_LAT)); S0 = ATT_MFMA(lds_b128((tile) + kr1), q_, S0); S1 = ATT_MFMA(lds_b128((tile) + kr1 + 2048), q_, S1); } } while (0)
#define PR_STEP(A0, A1, B0, B1, kt) do { \
        ldsp tcur = lds + cur; \
        if ((kt) + 2 < ntile_u) PR_DMA(KVseq + (size_t)((kt) + 2) * 64 * QD, nn); \
        if ((kt) + 1 < ntile_w) PR_QK(B0, B1, lds + nxt); \
        if ((kt) < ntile_w) { \
          if ((kt) == ntile_w - 1) { const int tok = tq0 + r32, kb = (kt) * 64; \
            _Pragma("unroll") for (int r = 0; r < 16; ++r) { const int key = kb + crow(r, hi); if (key > tok) A0[r] = -INFINITY; if (key + 32 > tok) A1[r] = -INFINITY; } } \
          softmax_step2(A0, A1, m, l, o, (kt) == 0); \
          unsigned qqo = qq; asm volatile("" : "+v"(qqo)); \
          _Pragma("unroll") for (int ks = 0; ks < 4; ++ks) { \
            const f32x16& pv = (ks < 2) ? A0 : A1; const int bb = 8 * (ks & 1); \
            u32x4 pw; pw.x = cvtpk(pv[bb + 0], pv[bb + 1]); pw.y = cvtpk(pv[bb + 2], pv[bb + 3]); pw.z = cvtpk(pv[bb + 4], pv[bb + 5]); pw.w = cvtpk(pv[bb + 6], pv[bb + 7]); \
            const bf16x8 pf = __builtin_bit_cast(bf16x8, pw); \
            _Pragma("unroll") for (int c = 2; c < 4; ++c) { const unsigned co = 64u * ((unsigned)c ^ qqo); \
                const s16x4 lo = lds_tr(tcur + vb0 + co + 4096 * ks), hv = lds_tr(tcur + vb1 + co + 4096 * ks); \
                const bf16x8 vf = {lo[0], lo[1], lo[2], lo[3], hv[0], hv[1], hv[2], hv[3]}; \
                o[c - 2] = ATT_MFMA(vf, pf, o[c - 2]); } } } \
        asm volatile("s_waitcnt vmcnt(0)" ::: "memory"); \
        __syncthreads(); \
        { const int t_ = cur; cur = nxt; nxt = nn; nn = t_; } } while (0)
    int cur = 0, nxt = TILE_BYTES, nn = 2 * TILE_BYTES;
    f32x16 sa0, sa1, sb0, sb1;
    PR_QK(sa0, sa1, lds);
    for (int kt = 0; kt < ntile_u; kt += 2) { PR_STEP(sa0, sa1, sb0, sb1, kt); PR_STEP(sb0, sb1, sa0, sa1, kt + 1); }
#undef PR_STEP
#undef PR_QK
#undef PR_DMA
#undef PR_GLDS
    l = swapsum(l);
    const float rl = 1.0f / l;
    float ss = 0.f;
#pragma unroll
    for (int c = 0; c < 2; ++c)
#pragma unroll
        for (int r = 0; r < 16; ++r) { o[c][r] *= rl; ss += o[c][r] * o[c][r]; }
    ss = swapsum(ss);
    if (hi == 0) SSQM[(row0 + r32) * NH + h] = ss;
    bf16* yp = YC + (row0 + r32) * DMIX + DLRU + h * VD + 4 * hi;
#pragma unroll
    for (int c = 0; c < 2; ++c)
#pragma unroll
        for (int g = 0; g < 4; ++g) { typedef unsigned u32x2 __attribute__((ext_vector_type(2)));
            u32x2 w; w.x = cvtpk(o[c][4 * g], o[c][4 * g + 1]); w.y = cvtpk(o[c][4 * g + 2], o[c][4 * g + 3]); *(u32x2*)(yp + 32 * c + 8 * g) = w; }
    __syncthreads();
}
}
namespace att {
constexpr int PG_LAT = 128 * 256, PG_ROPE = 128 * 64, PG_BYTES = PG_LAT + PG_ROPE;
constexpr int PART_ROWS = 66, PART_FLOATS = PART_ROWS * 64;

__device__ __forceinline__ void page_load(f32x4 (&st)[10], const float* __restrict__ ckv, const float* __restrict__ ckr, size_t slot0, int tid) {
    const f32x4* pl = (const f32x4*)(ckv + slot0 * KVL) + tid; const f32x4* pr = (const f32x4*)(ckr + slot0 * ROPE) + tid;
#pragma unroll
    for (int i = 0; i < 8; ++i) st[i] = __builtin_nontemporal_load(pl + 512 * i);
#pragma unroll
    for (int i = 0; i < 2; ++i) st[8 + i] = __builtin_nontemporal_load(pr + 512 * i);
}
__device__ __forceinline__ void page_store(const f32x4 (&st)[10], ldsp pg, unsigned dl, unsigned dr) {
    typedef unsigned u32x2 __attribute__((ext_vector_type(2)));
#pragma unroll
    for (int i = 0; i < 8; ++i) { u32x2 w; w.x = cvtpk(st[i].x, st[i].y); w.y = cvtpk(st[i].z, st[i].w); *(ATT_LAS u32x2*)(pg + dl + 4096 * i) = w; }
#pragma unroll
    for (int i = 0; i < 2; ++i) { u32x2 w; w.x = cvtpk(st[8 + i].x, st[8 + i].y); w.y = cvtpk(st[8 + i].z, st[8 + i].w); *(ATT_LAS u32x2*)(pg + PG_LAT + dr + 4096 * i) = w; }
}
constexpr int Q_OFF = 2 * PG_BYTES;
__device__ __forceinline__ void decode_item(ldsp lds, const bf16* __restrict__ Qb, const float* __restrict__ ckv, const float* __restrict__ ckr, const int* __restrict__ ptab,
                                            float* __restrict__ PART, int db, int pg0, int npg) {
    const int tid = threadIdx.x, lane = tid & 63, wid = __builtin_amdgcn_readfirstlane(tid >> 6), r32 = lane & 31, hi = lane >> 5;
    const int qb = wid & 1, rb = 64 * (wid >> 2) + 32 * ((wid >> 1) & 1), grp = wid >> 1;
    const int* pt = ptab + db * NPAGES + pg0;
    unsigned dl, dr;
    { const unsigned row = (unsigned)tid >> 5, c4 = (unsigned)tid & 31u; dl = offL(row, c4 >> 1) + 8u * (c4 & 1u);
      const unsigned rr = (unsigned)tid >> 3, c4r = (unsigned)tid & 7u; dr = offR(rr, c4r >> 1) + 8u * (c4r & 1u); }
    f32x4 sa[10], sb[10];
    page_load(sa, ckv, ckr, (size_t)pt[0] * PAGE, tid);
    if (npg > 1) page_load(sb, ckv, ckr, (size_t)pt[1] * PAGE, tid);
    {
      const bf16* qsrc = Qb + ((size_t)RP + (size_t)db * DS) * NH * QD;
      const u32x4 q0 = *(const u32x4*)(qsrc + (size_t)(tid >> 4) * QD + (tid & 15) * 8), q1 = *(const u32x4*)(qsrc + (size_t)((tid >> 4) + 32) * QD + (tid & 15) * 8);
      const unsigned dq = offL((unsigned)tid >> 4, (unsigned)tid & 15u);
      *(ATT_LAS u32x4*)(lds + Q_OFF + dq) = q0; *(ATT_LAS u32x4*)(lds + Q_OFF + dq + 8192) = q1;
      if (tid < 256) { const u32x4 q2 = *(const u32x4*)(qsrc + (size_t)(tid >> 2) * QD + KVL + (tid & 3) * 8); *(ATT_LAS u32x4*)(lds + Q_OFF + TILE_LAT + offR((unsigned)tid >> 2, (unsigned)tid & 3u)) = q2; } }
    page_store(sa, lds, dl, dr);
    __syncthreads();
    float m = 0.f, l = 0.f; f32x16 o[4];
#pragma unroll
    for (int r = 0; r < 16; ++r) { o[0][r] = 0.f; o[1][r] = 0.f; o[2][r] = 0.f; o[3][r] = 0.f; }
    const unsigned xk = (unsigned)(((r32 & 3) << 1) | ((r32 >> 3) & 1));
    const unsigned x0 = (unsigned)hi ^ ((unsigned)(r32 >> 2) & 1u);
    const unsigned ka = 256u * (unsigned)(rb + r32) + 16u * x0, qa = Q_OFF + 256u * (unsigned)(32 * qb + r32) + 16u * x0;
    const unsigned kr0 = PG_LAT + offR((unsigned)(rb + r32), (unsigned)hi), kr1 = PG_LAT + offR((unsigned)(rb + r32), 2u + (unsigned)hi);
    const unsigned qr0 = Q_OFF + TILE_LAT + offR((unsigned)(32 * qb + r32), (unsigned)hi), qr1 = Q_OFF + TILE_LAT + offR((unsigned)(32 * qb + r32), 2u + (unsigned)hi);
    const unsigned blk = (lane >> 4) & 1, qq = (lane & 15) >> 2, pp = lane & 3;
    const unsigned vb0 = 256u * (unsigned)(rb + 4 * hi + qq) + 16u * ((2u * blk + (pp >> 1)) ^ (unsigned)hi) + 8u * (pp & 1u);
    const unsigned vb1 = 256u * (unsigned)(rb + 8 + 4 * hi + qq) + 16u * ((2u * blk + (pp >> 1)) ^ (2u + (unsigned)hi)) + 8u * (pp & 1u);
#define DEC_PAGE(pg, first) do { \
        unsigned xko = xk, qqo = qq; asm volatile("" : "+v"(xko), "+v"(qqo)); \
        f32x16 s; \
        _Pragma("unroll") for (int r = 0; r < 16; ++r) s[r] = 0.f; \
        _Pragma("unroll") for (int k = 0; k < 8; ++k) { const unsigned co = 32u * ((unsigned)k ^ xko); s = ATT_MFMA(lds_b128((pg) + ka + co), lds_b128(lds + qa + co), s); } \
        s = ATT_MFMA(lds_b128((pg) + kr0), lds_b128(lds + qr0), s); \
        s = ATT_MFMA(lds_b128((pg) + kr1), lds_b128(lds + qr1), s); \
        float rm = s[0]; \
        _Pragma("unroll") for (int r = 1; r < 16; ++r) rm = fmaxf(rm, s[r]); \
        rm = swapmax(rm); \
        if (first) m = rm; \
        rm -= m; \
        if (!(first) && __any(rm > THR)) { const float dlt = fmaxf(rm, 0.f); m += dlt; const float f = __builtin_amdgcn_exp2f(-dlt); l *= f; \
            _Pragma("unroll") for (int c = 0; c < 4; ++c) _Pragma("unroll") for (int r = 0; r < 16; ++r) o[c][r] *= f; } \
        float sum = 0.f; \
        _Pragma("unroll") for (int r = 0; r < 16; ++r) { s[r] = __builtin_amdgcn_exp2f(s[r] - m); sum += s[r]; } \
        l += sum; \
        _Pragma("unroll") for (int ks = 0; ks < 2; ++ks) { \
            u32x4 pw; pw.x = cvtpk(s[8 * ks + 0], s[8 * ks + 1]); pw.y = cvtpk(s[8 * ks + 2], s[8 * ks + 3]); pw.z = cvtpk(s[8 * ks + 4], s[8 * ks + 5]); pw.w = cvtpk(s[8 * ks + 6], s[8 * ks + 7]); \
            const bf16x8 pf = __builtin_bit_cast(bf16x8, pw); \
            _Pragma("unroll") for (int c = 0; c < 4; ++c) { const unsigned co = 64u * ((unsigned)c ^ qqo); \
                const s16x4 lo = lds_tr((pg) + vb0 + co + 4096 * ks), hv = lds_tr((pg) + vb1 + co + 4096 * ks); \
                const bf16x8 vf = {lo[0], lo[1], lo[2], lo[3], hv[0], hv[1], hv[2], hv[3]}; \
                o[c] = ATT_MFMA(vf, pf, o[c]); } } \
    } while (0)
    for (int pi = 0; pi < npg; pi += 2) {
        if (pi + 2 < npg) page_load(sa, ckv, ckr, (size_t)pt[pi + 2] * PAGE, tid);
        DEC_PAGE(lds, pi == 0);
        page_store(sb, lds + PG_BYTES, dl, dr);
        __syncthreads();
        if (pi + 3 < npg) page_load(sb, ckv, ckr, (size_t)pt[pi + 3] * PAGE, tid);
        DEC_PAGE(lds + PG_BYTES, false);
        if (pi + 2 < npg) page_store(sa, lds, dl, dr);
        __syncthreads();
    }
#undef DEC_PAGE
    ATT_LAS float* reg = (ATT_LAS float*)(lds) + qb * PART_FLOATS;
    for (int g = 0; g < 4; ++g) {
        if (grp == g) {
            if (g > 0) { const float m2 = reg[64 * 64 + lane], l2 = reg[65 * 64 + lane]; const float mn = fmaxf(m, m2); const float a1 = __builtin_amdgcn_exp2f(m - mn), a2 = __builtin_amdgcn_exp2f(m2 - mn);
#pragma unroll
                for (int c = 0; c < 4; ++c)
#pragma unroll
                    for (int r = 0; r < 16; ++r) o[c][r] = o[c][r] * a1 + reg[(c * 16 + r) * 64 + lane] * a2;
                l = l * a1 + l2 * a2; m = mn; }
            if (g < 3) {
#pragma unroll
                for (int c = 0; c < 4; ++c)
#pragma unroll
                    for (int r = 0; r < 16; ++r) reg[(c * 16 + r) * 64 + lane] = o[c][r];
                reg[64 * 64 + lane] = m; reg[65 * 64 + lane] = l; }
            else { float* gp = PART + (size_t)qb * PART_FLOATS;
#pragma unroll
                for (int c = 0; c < 4; ++c)
#pragma unroll
                    for (int r = 0; r < 16; ++r) gp[(c * 16 + r) * 64 + lane] = o[c][r];
                gp[64 * 64 + lane] = m; gp[65 * 64 + lane] = l; }
        }
        __syncthreads();
    }
}
__device__ __forceinline__ void decode_combine(ldsp lds, const bf16* __restrict__ Qb, const float* __restrict__ KN, const float* __restrict__ KR, const float* __restrict__ PARTdb, int ns,
                                               const float* __restrict__ w_uv, const float* __restrict__ gm, bf16* __restrict__ YC, int db) {
    const int tid = threadIdx.x, lane = tid & 63, wid = __builtin_amdgcn_readfirstlane(tid >> 6), qb = wid >> 2, rg = wid & 3, r32 = lane & 31, hi = lane >> 5;
    ATT_LAS float* sc = (ATT_LAS float*)lds;
    ATT_LAS float* ol = (ATT_LAS float*)(lds + 2048);
    ATT_LAS float* red = (ATT_LAS float*)(lds + 2048 + 32768);
    __syncthreads();
    { const int q = tid >> 3, sp = tid & 7;
      const bf16* qp = Qb + (((size_t)RP + (size_t)db * DS) * NH + q) * QD; const float* kn = KN + ((size_t)db * DS + sp) * KVL; const float* kr = KR + ((size_t)db * DS + sp) * ROPE;
      float a = 0.f; const u32x4* qv = (const u32x4*)qp;
#pragma unroll
      for (int part = 0; part < 3; ++part) { const int nq = part < 2 ? 8 : 4; const f32x4* kv = part < 2 ? (const f32x4*)kn + 16 * part : (const f32x4*)kr;
          u32x4 qq[8]; f32x4 kk[16];
#pragma unroll
          for (int j = 0; j < 8; ++j) if (j < nq) qq[j] = qv[8 * part + j];
#pragma unroll
          for (int j = 0; j < 16; ++j) if (j < 2 * nq) kk[j] = kv[j];
#pragma unroll
          for (int j = 0; j < 8; ++j) if (j < nq) { const f32x4 k0 = kk[2 * j], k1 = kk[2 * j + 1];
              a += __uint_as_float(qq[j].x << 16) * k0[0] + __uint_as_float(qq[j].x & 0xffff0000u) * k0[1] + __uint_as_float(qq[j].y << 16) * k0[2] + __uint_as_float(qq[j].y & 0xffff0000u) * k0[3]
                 + __uint_as_float(qq[j].z << 16) * k1[0] + __uint_as_float(qq[j].z & 0xffff0000u) * k1[1] + __uint_as_float(qq[j].w << 16) * k1[2] + __uint_as_float(qq[j].w & 0xffff0000u) * k1[3]; } }
      sc[q * 8 + sp] = a; }
    __syncthreads();
    const int q = 32 * qb + r32, stok = q >> 3, hq = q & 7;
    float M = -INFINITY;
    for (int i = 0; i < ns; ++i) M = fmaxf(M, PARTdb[((size_t)i * 2 + qb) * PART_FLOATS + 64 * 64 + lane]);
    for (int sp = 0; sp <= stok; ++sp) M = fmaxf(M, sc[q * 8 + sp]);
    float acc[16], lsum = 0.f;
#pragma unroll
    for (int r = 0; r < 16; ++r) acc[r] = 0.f;
    for (int i = 0; i < ns; ++i) { const float* pp = PARTdb + ((size_t)i * 2 + qb) * PART_FLOATS; const float f = __builtin_amdgcn_exp2f(pp[64 * 64 + lane] - M);
        lsum += f * pp[65 * 64 + lane];
#pragma unroll
        for (int r = 0; r < 16; ++r) acc[r] += f * pp[(rg * 16 + r) * 64 + lane]; }
    lsum += __shfl_xor(lsum, 32);
    for (int sp = 0; sp <= stok; ++sp) { const float p = __builtin_amdgcn_exp2f(sc[q * 8 + sp] - M); lsum += p; const float* kn = KN + ((size_t)db * DS + sp) * KVL;
#pragma unroll
        for (int r = 0; r < 16; ++r) acc[r] += p * kn[32 * rg + crow(r, hi)]; }
    const float rl = 1.0f / lsum;
#pragma unroll
    for (int r = 0; r < 16; ++r) ol[q * KVL + 32 * rg + crow(r, hi)] = acc[r] * rl;
    __syncthreads();
    float y[8];
#pragma unroll
    for (int s = 0; s < 8; ++s) y[s] = 0.f;
#pragma unroll 1
    for (int c0 = 0; c0 < KVL; c0 += 16) { float w[16];
#pragma unroll
        for (int j = 0; j < 16; ++j) w[j] = w_uv[((size_t)(c0 + j) * NH + wid) * VD + lane];
#pragma unroll
        for (int s = 0; s < 8; ++s) {
#pragma unroll
            for (int j4 = 0; j4 < 4; ++j4) { const f32x4 o4 = *(const ATT_LAS f32x4*)(ol + (s * 8 + wid) * KVL + c0 + 4 * j4);
                y[s] += (o4[0] * w[4 * j4] + o4[1] * w[4 * j4 + 1]) + (o4[2] * w[4 * j4 + 2] + o4[3] * w[4 * j4 + 3]); }
            __builtin_amdgcn_sched_barrier(0); } }
    (void)hq;
#pragma unroll
    for (int s = 0; s < 8; ++s) { float v = y[s] * y[s];
#pragma unroll
        for (int o = 1; o < 64; o <<= 1) v += __shfl_xor(v, o);
        if (lane == 0) red[wid * 8 + s] = v; }
    __syncthreads();
#pragma unroll
    for (int s = 0; s < 8; ++s) { float t = 0.f;
#pragma unroll
        for (int w = 0; w < 8; ++w) t += red[w * 8 + s];
        const float rstd = 1.0f / sqrtf(t * (1.0f / DMLA) + EPS);
        YC[((size_t)RP + (size_t)db * DS + s) * DMIX + DLRU + wid * VD + lane] = (bf16)f2bf(y[s] * rstd * gm[wid * VD + lane]); }
}
}
namespace att2 {
using att::bf16x8; using att::f32x16; using att::s16x4; using att::u32x4; using att::ldsp; using att::cvtpk; using att::crow; using att::offL; using att::offR; using att::lds_b128; using att::lds_tr;
using att::swapmax; using att::swapsum; using att::TILE_LAT; using att::TILE_BYTES; using att::THR; using att::PART_FLOATS;
typedef unsigned u32x2 __attribute__((ext_vector_type(2)));
constexpr int L_PT = 0, L_DT = 3 * TILE_BYTES, L_MG = L_DT + 2 * TILE_BYTES, L_BAR = L_MG + 2 * PART_FLOATS * 4 + 1024;
static_assert(L_BAR + 128 <= 146432, "attention LDS map");

__device__ __forceinline__ void role_bar(ATT_LAS unsigned* cnt, unsigned& target) {
    target += 4u;
    asm volatile("s_waitcnt lgkmcnt(0)" ::: "memory");
    if ((threadIdx.x & 63) == 0) (void)__hip_atomic_fetch_add(cnt, 1u, __ATOMIC_RELAXED, __HIP_MEMORY_SCOPE_WORKGROUP);
    while (__hip_atomic_load(cnt, __ATOMIC_RELAXED, __HIP_MEMORY_SCOPE_WORKGROUP) < target) __builtin_amdgcn_s_sleep(1);
    asm volatile("" ::: "memory");
}

typedef float f32x2 __attribute__((ext_vector_type(2)));
__device__ __forceinline__ float max3(float a, float b, float c) { float d; asm("v_max3_f32 %0, %1, %2, %3" : "=v"(d) : "v"(a), "v"(b), "v"(c)); return d; }
__device__ __forceinline__ void sm_max(const f32x16& s0, const f32x16& s1, float& m, float& l, f32x16 (&o)[2], bool first) {
    float r0 = max3(s0[0], s1[0], s0[1]), r1 = max3(s1[1], s0[2], s1[2]);
#pragma unroll
    for (int r = 3; r < 15; r += 2) { r0 = max3(r0, s0[r], s1[r]); r1 = max3(r1, s0[r + 1], s1[r + 1]); }
    float rm = swapmax(max3(r0, r1, fmaxf(s0[15], s1[15])));
    if (first) m = rm;
    rm -= m;
    if (!first && __any(rm > THR)) { const float dl = fmaxf(rm, 0.f); m += dl; const float f = __builtin_amdgcn_exp2f(-dl); l *= f;
#pragma unroll
        for (int c = 0; c < 2; ++c)
#pragma unroll
            for (int r = 0; r < 16; ++r) o[c][r] *= f; }
}
__device__ __forceinline__ void sm_fin(float rm, float& m, float& l, f32x16 (&o)[2], bool first) {
    rm = swapmax(rm);
    if (first) m = rm;
    rm -= m;
    if (!first && __any(rm > THR)) { const float dl = fmaxf(rm, 0.f); m += dl; const float f = __builtin_amdgcn_exp2f(-dl); l *= f;
#pragma unroll
        for (int c = 0; c < 2; ++c)
#pragma unroll
            for (int r = 0; r < 16; ++r) o[c][r] *= f; }
}
__device__ __forceinline__ void sm_exp(f32x16& s0, f32x16& s1, const float m, float& l) {
    float sum0 = 0.f, sum1 = 0.f;
#pragma unroll
    for (int r = 0; r < 16; ++r) { s0[r] = __builtin_amdgcn_exp2f(s0[r] - m); s1[r] = __builtin_amdgcn_exp2f(s1[r] - m); sum0 += s0[r]; sum1 += s1[r]; }
    l += sum0 + sum1;
}
__device__ __forceinline__ void prompt_role(ldsp lds, const bf16* __restrict__ QbP, const bf16* __restrict__ KVH, float* __restrict__ SSQM, bf16* __restrict__ YC, int b, int h, int qb, unsigned& bt) {
    const int t4 = threadIdx.x & 255, lane = t4 & 63, wid = __builtin_amdgcn_readfirstlane(t4 >> 6), r32 = lane & 31, hi = lane >> 5;
    ATT_LAS unsigned* cnt = (ATT_LAS unsigned*)(lds + L_BAR);
    const int tq0 = 256 * qb + 64 * wid; const size_t row0 = (size_t)b * SEQ + tq0;
    const bf16* KVseq = KVH + ((size_t)(b * NH + h) * SEQ) * QD;
    const int ntile_u = 4 * qb + 4, ntile_w = 4 * qb + wid + 1;
    const unsigned lsrc = (unsigned)(4 * wid + (lane >> 4)) * (QD * 2) + 16u * ((unsigned)(lane & 15) ^ ((((unsigned)(lane >> 4) & 3u) << 2) | ((unsigned)wid & 3u)));
    const unsigned rsrc = (unsigned)(16 * wid + (lane >> 2)) * (QD * 2) + 2 * KVL + 16u * ((unsigned)(lane & 3) ^ ((unsigned)(lane >> 4) & 3u));
    const unsigned lds0 = (unsigned)(size_t)lds + L_PT;
#define R_GLDS(gptr, ldsaddr) do { unsigned keep_; asm volatile("s_mov_b32 %0, m0\n\ts_mov_b32 m0, %2\n\ts_nop 0\n\tglobal_load_lds_dwordx4 %1, off\n\ts_mov_b32 m0, %0" : "=&s"(keep_) : "v"(gptr), "s"(ldsaddr) : "memory"); } while (0)
#define R_DMA(gtile, slot) do { const char* g_ = (const char*)(gtile); const unsigned l_ = (unsigned)__builtin_amdgcn_readfirstlane((int)(lds0 + (unsigned)(slot) + (unsigned)wid * 1024u)); \
        R_GLDS(g_ + lsrc, l_); R_GLDS(g_ + lsrc + 16 * QD * 2, l_ + 4096u); R_GLDS(g_ + lsrc + 32 * QD * 2, l_ + 8192u); R_GLDS(g_ + lsrc + 48 * QD * 2, l_ + 12288u); \
        R_GLDS(g_ + rsrc, l_ + (unsigned)TILE_LAT); } while (0)
    R_DMA(KVseq, 0);
    bf16x8 qa[6], qbf[6];
    { const bf16* qp = QbP + ((row0 + r32) * NH + h) * 96 + 8 * hi;
#pragma unroll
      for (int s = 0; s < 6; ++s) { qa[s] = *(const bf16x8*)(qp + 16 * s); qbf[s] = *(const bf16x8*)(qp + (size_t)32 * NH * 96 + 16 * s); } }
    R_DMA(KVseq + (size_t)64 * QD, TILE_BYTES);
    asm volatile("s_waitcnt vmcnt(0)" ::: "memory");
#pragma unroll
    for (int s = 0; s < 6; ++s) asm volatile("" : "+v"(qa[s]), "+v"(qbf[s]));
    role_bar(cnt, bt);
    float mA = 0.f, lA = 0.f, mB = 0.f, lB = 0.f; f32x16 oA[2], oB[2];
#pragma unroll
    for (int r = 0; r < 16; ++r) { oA[0][r] = 0.f; oA[1][r] = 0.f; oB[0][r] = 0.f; oB[1][r] = 0.f; }
    const unsigned xk = (unsigned)(((r32 & 3) << 1) | ((r32 >> 3) & 1));
    const unsigned ka = 256u * (unsigned)r32 + 16u * ((unsigned)hi ^ ((unsigned)(r32 >> 2) & 1u));
    const unsigned kr0 = TILE_LAT + offR((unsigned)r32, (unsigned)hi), kr1 = TILE_LAT + offR((unsigned)r32, 2u + (unsigned)hi);
    const unsigned blk = (lane >> 4) & 1, qq = (lane & 15) >> 2, pp = lane & 3;
    const unsigned vb0 = 256u * (unsigned)(4 * hi + qq) + 16u * ((2u * blk + (pp >> 1)) ^ (unsigned)hi) + 8u * (pp & 1u);
    const unsigned vb1 = 256u * (unsigned)(8 + 4 * hi + qq) + 16u * ((2u * blk + (pp >> 1)) ^ (2u + (unsigned)hi)) + 8u * (pp & 1u);
    ldsp ring = lds + L_PT;
    int cur = 0, nxt = TILE_BYTES, nn = 2 * TILE_BYTES;
    for (int kt = 0; kt < ntile_u; ++kt) {
        ldsp tile = ring + cur;
        const char* gsrc = (const char*)(KVseq + (size_t)min(kt + 2, ntile_u - 1) * 64 * QD);
        const unsigned ldst = (unsigned)__builtin_amdgcn_readfirstlane((int)(lds0 + (unsigned)nn + (unsigned)wid * 1024u));
#define R_GLDS_S(sbase, voff, ldsaddr) do { unsigned keep_; asm volatile("s_mov_b32 %0, m0\n\ts_mov_b32 m0, %2\n\ts_nop 0\n\tglobal_load_lds_dwordx4 %1, %3\n\ts_mov_b32 m0, %0" : "=&s"(keep_) : "v"(voff), "s"(ldsaddr), "s"(sbase) : "memory"); } while (0)
#define R_PIECE(j) do { if ((j) < 4) R_GLDS_S(gsrc + (j) * 16 * QD * 2, lsrc, ldst + 4096u * (unsigned)(j)); else R_GLDS_S(gsrc, rsrc, ldst + (unsigned)TILE_LAT); } while (0)
        { R_PIECE(0); R_PIECE(1); R_PIECE(2); R_PIECE(3); R_PIECE(4); }
        if (kt < ntile_w) {
            unsigned xko = xk, qqo = qq; asm volatile("" : "+v"(xko), "+v"(qqo));
            const bool lastt = kt == ntile_w - 1; const int kb = kt * 64;
            f32x16 a0, a1, b0, b1;
#define R_QK(s0_, s1_, qf_) do { \
            _Pragma("unroll") for (int r = 0; r < 16; ++r) { s0_[r] = 0.f; s1_[r] = 0.f; } \
            _Pragma("unroll") for (int k = 0; k < 4; ++k) { const unsigned a_ = ka + 32u * ((unsigned)k ^ xko); const bf16x8 k0 = lds_b128(tile + a_), k1 = lds_b128(tile + a_ + 8192); \
                s0_ = ATT_MFMA(k0, qf_[k], s0_); s1_ = ATT_MFMA(k1, qf_[k], s1_); } \
            { const bf16x8 k0 = lds_b128(tile + kr0), k1 = lds_b128(tile + kr0 + 2048); s0_ = ATT_MFMA(k0, qf_[4], s0_); s1_ = ATT_MFMA(k1, qf_[4], s1_); } \
            { const bf16x8 k0 = lds_b128(tile + kr1), k1 = lds_b128(tile + kr1 + 2048); s0_ = ATT_MFMA(k0, qf_[5], s0_); s1_ = ATT_MFMA(k1, qf_[5], s1_); } } while (0)
#define R_MASK(s0_, s1_, tok_) do { int ln_ = lane; asm volatile("" : "+v"(ln_)); int d_ = (tok_) + (ln_ & 31) - kb - 4 * (ln_ >> 5); asm volatile("" : "+v"(d_));   \
            _Pragma("unroll") for (int r = 0; r < 16; ++r) { const int c_ = (r & 3) + 8 * (r >> 2); if (c_ > d_) s0_[r] = -INFINITY; if (c_ + 32 > d_) s1_[r] = -INFINITY; } } while (0)
#define R_PV(s0_, s1_, o_) do { \
            _Pragma("unroll") for (int ks = 0; ks < 4; ++ks) { const int bb = 8 * (ks & 1); const f32x16& pa = (ks < 2) ? s0_ : s1_; \
                u32x4 wa; wa.x = cvtpk(pa[bb + 0], pa[bb + 1]); wa.y = cvtpk(pa[bb + 2], pa[bb + 3]); wa.z = cvtpk(pa[bb + 4], pa[bb + 5]); wa.w = cvtpk(pa[bb + 6], pa[bb + 7]); \
                const bf16x8 pfa = __builtin_bit_cast(bf16x8, wa); \
                _Pragma("unroll") for (int c = 2; c < 4; ++c) { const unsigned co = 64u * ((unsigned)c ^ qqo); \
                    const s16x4 lo = lds_tr(tile + vb0 + co + 4096 * ks), hv = lds_tr(tile + vb1 + co + 4096 * ks); \
                    const bf16x8 vf = {lo[0], lo[1], lo[2], lo[3], hv[0], hv[1], hv[2], hv[3]}; \
                    o_[c - 2] = ATT_MFMA(vf, pfa, o_[c - 2]); } } } while (0)
#define R_K0(i) ((i) < 4 ? ka + 32u * ((unsigned)(i) ^ xko) : ((i) == 4 ? kr0 : kr1))
#define R_K1(i) (R_K0(i) + ((i) < 4 ? 8192u : 2048u))
            { bf16x8 kc0 = lds_b128(tile + R_K0(0)), kc1 = lds_b128(tile + R_K1(0));
#pragma unroll
              for (int r = 0; r < 16; ++r) { a0[r] = 0.f; a1[r] = 0.f; }
#pragma unroll
              for (int i = 0; i < 6; ++i) { bf16x8 kn0 = kc0, kn1 = kc1;
                  if (i < 5) { kn0 = lds_b128(tile + R_K0(i + 1)); kn1 = lds_b128(tile + R_K1(i + 1)); }
                  a0 = ATT_MFMA(kc0, qa[i], a0);
                  __builtin_amdgcn_sched_barrier(0);
                  a1 = ATT_MFMA(kc1, qa[i], a1);
                  __builtin_amdgcn_sched_barrier(0);
                  kc0 = kn0; kc1 = kn1; } }
            if (lastt) R_MASK(a0, a1, tq0);
            sm_max(a0, a1, mA, lA, oA, kt == 0);
#define R_EXPS(v_, s_, n_, m_, acc_) do { \
            _Pragma("unroll") for (int r = 0; r < (n_); ++r) v_[(s_) + r] -= m_; \
            _Pragma("unroll") for (int r = 0; r < (n_); ++r) v_[(s_) + r] = __builtin_amdgcn_exp2f(v_[(s_) + r]); \
            _Pragma("unroll") for (int r = 0; r < (n_); ++r) acc_ += v_[(s_) + r]; } while (0)
            { float sum = 0.f; bf16x8 kc0 = lds_b128(tile + R_K0(0)), kc1 = lds_b128(tile + R_K1(0));
#pragma unroll
              for (int r = 0; r < 16; ++r) { b0[r] = 0.f; b1[r] = 0.f; }
#pragma unroll
              for (int i = 0; i < 6; ++i) { bf16x8 kn0 = kc0, kn1 = kc1;
                  if (i < 5) { kn0 = lds_b128(tile + R_K0(i + 1)); kn1 = lds_b128(tile + R_K1(i + 1)); }
                  const int st_ = i < 4 ? 3 * i : 12 + 2 * (i - 4), n_ = i < 4 ? 3 : 2;
                  b0 = ATT_MFMA(kc0, qbf[i], b0);
                  R_EXPS(a0, st_, n_, mA, sum);
                  __builtin_amdgcn_sched_barrier(0);
                  b1 = ATT_MFMA(kc1, qbf[i], b1);
                  R_EXPS(a1, st_, n_, mA, sum);
                  __builtin_amdgcn_sched_barrier(0);
                  kc0 = kn0; kc1 = kn1; }
              asm volatile("" : "+v"(a0), "+v"(a1), "+v"(sum));
              lA += sum; }
            if (lastt) R_MASK(b0, b1, tq0 + 32);
#define R_VF(g_, dst_) do { const unsigned co_ = 64u * ((unsigned)(2 + ((g_) & 1)) ^ qqo); const s16x4 lo_ = lds_tr(tile + vb0 + co_ + 4096 * ((g_) >> 1)), hv_ = lds_tr(tile + vb1 + co_ + 4096 * ((g_) >> 1)); \
            dst_ = bf16x8{lo_[0], lo_[1], lo_[2], lo_[3], hv_[0], hv_[1], hv_[2], hv_[3]}; } while (0)
#define R_PF(s0_, s1_, ks_, dst_) do { const int bb_ = 8 * ((ks_) & 1); const f32x16& pa_ = ((ks_) < 2) ? s0_ : s1_; u32x4 w_; w_.x = cvtpk(pa_[bb_ + 0], pa_[bb_ + 1]); w_.y = cvtpk(pa_[bb_ + 2], pa_[bb_ + 3]); \
            w_.z = cvtpk(pa_[bb_ + 4], pa_[bb_ + 5]); w_.w = cvtpk(pa_[bb_ + 6], pa_[bb_ + 7]); dst_ = __builtin_bit_cast(bf16x8, w_); } while (0)
            { bf16x8 vc, pf; R_VF(0, vc); R_PF(a0, a1, 0, pf);
              { bf16x8 vn, pn; float r0, r1;
                R_VF(1, vn);
                oA[0] = ATT_MFMA(vc, pf, oA[0]);
                r0 = max3(b0[0], b1[0], b0[1]); r1 = max3(b1[1], b0[2], b1[2]);
#pragma unroll
                for (int r = 3; r < 9; r += 2) { r0 = max3(r0, b0[r], b1[r]); r1 = max3(r1, b0[r + 1], b1[r + 1]); }
                __builtin_amdgcn_sched_barrier(0);
                vc = vn; R_VF(2, vn); R_PF(a0, a1, 1, pn);
                oA[1] = ATT_MFMA(vc, pf, oA[1]);
#pragma unroll
                for (int r = 9; r < 15; r += 2) { r0 = max3(r0, b0[r], b1[r]); r1 = max3(r1, b0[r + 1], b1[r + 1]); }
                r0 = max3(r0, r1, fmaxf(b0[15], b1[15]));
                __builtin_amdgcn_sched_barrier(0);
                vc = vn; pf = pn;
                sm_fin(r0, mB, lB, oB, kt == 0); }
              float sum = 0.f;
#pragma unroll
              for (int g = 2; g < 8; ++g) { bf16x8 vn = vc, pn = pf;
                  if (g < 7) R_VF(g + 1, vn);
                  if ((g & 1) && g < 7) R_PF(a0, a1, (g + 1) >> 1, pn);
                  oA[g & 1] = ATT_MFMA(vc, pf, oA[g & 1]);
                  if (g < 5) R_EXPS(b0, g == 2 ? 0 : 6 + 5 * (g - 3), g == 2 ? 6 : 5, mB, sum); else R_EXPS(b1, g == 5 ? 0 : 6 + 5 * (g - 6), g == 5 ? 6 : 5, mB, sum);
                  __builtin_amdgcn_sched_barrier(0);
                  vc = vn; pf = pn; }
              lB += sum; }
            R_PV(b0, b1, oB);
#undef R_K0
#undef R_K1
#undef R_PIECE
#undef R_GLDS_S
#undef R_EXPS
#undef R_VF
#undef R_PF
#undef R_QK
#undef R_MASK
#undef R_PV
        }
        if (kt + 2 < ntile_u) asm volatile("s_waitcnt vmcnt(5)" ::: "memory");
        else asm volatile("s_waitcnt vmcnt(0)" ::: "memory");
        role_bar(cnt, bt);
        { const int t_ = cur; cur = nxt; nxt = nn; nn = t_; }
    }
#undef R_DMA
#undef R_GLDS
    int lne = lane; asm volatile("" : "+v"(lne));
    const int r32e = lne & 31, hie = lne >> 5;
#pragma unroll
    for (int blkq = 0; blkq < 2; ++blkq) { f32x16 (&o)[2] = blkq ? oB : oA; float l = swapsum(blkq ? lB : lA);
        const float rl = 1.0f / l; float ss = 0.f;
#pragma unroll
        for (int c = 0; c < 2; ++c)
#pragma unroll
            for (int r = 0; r < 16; ++r) { o[c][r] *= rl; ss += o[c][r] * o[c][r]; }
        ss = swapsum(ss);
        const size_t row = row0 + 32 * blkq + r32e;
        if (hie == 0) SSQM[row * NH + h] = ss;
        bf16* yp = YC + row * DMIX + DLRU + h * VD + 4 * hie;
#pragma unroll
        for (int c = 0; c < 2; ++c)
#pragma unroll
            for (int g = 0; g < 4; ++g) { u32x2 w; w.x = cvtpk(o[c][4 * g], o[c][4 * g + 1]); w.y = cvtpk(o[c][4 * g + 2], o[c][4 * g + 3]); *(u32x2*)(yp + 32 * c + 8 * g) = w; } }
    asm volatile("s_waitcnt vmcnt(0)" ::: "memory");
}

__device__ __forceinline__ void dc_load(f32x4 (&st)[10], const float* __restrict__ ckv, const float* __restrict__ ckr, size_t slot0, int t4) {
    const f32x4* pl = (const f32x4*)(ckv + slot0 * KVL) + t4; const f32x4* pr = (const f32x4*)(ckr + slot0 * ROPE) + t4;
#pragma unroll
    for (int i = 0; i < 8; ++i) st[i] = __builtin_nontemporal_load(pl + 256 * i);
#pragma unroll
    for (int i = 0; i < 2; ++i) st[8 + i] = __builtin_nontemporal_load(pr + 256 * i);
}
__device__ __forceinline__ void dc_store(const f32x4 (&st)[10], ldsp img, unsigned dE, unsigned dO, unsigned dr) {
#pragma unroll
    for (int i = 0; i < 8; ++i) { u32x2 wv; wv.x = cvtpk(st[i].x, st[i].y); wv.y = cvtpk(st[i].z, st[i].w); *(ATT_LAS u32x2*)(img + ((i & 1) ? dO : dE) + 2048 * i) = wv; }
#pragma unroll
    for (int i = 0; i < 2; ++i) { u32x2 wv; wv.x = cvtpk(st[8 + i].x, st[8 + i].y); wv.y = cvtpk(st[8 + i].z, st[8 + i].w); *(ATT_LAS u32x2*)(img + TILE_LAT + dr + 2048 * i) = wv; }
}
__device__ __forceinline__ void decode_role(ldsp lds, const bf16* __restrict__ Qb, const float* __restrict__ ckv, const float* __restrict__ ckr, const int* __restrict__ ptab,
                                            float* __restrict__ PART, int db, int pg0, int npg, unsigned& bt) {
    const int t4 = threadIdx.x & 255, lane = t4 & 63, w = __builtin_amdgcn_readfirstlane(t4 >> 6), r32 = lane & 31, hi = lane >> 5;
    const int qb = w & 1, kb = w >> 1, rb = 32 * kb;
    ATT_LAS unsigned* cnt = (ATT_LAS unsigned*)(lds + L_BAR + 64);
    const int mypg = ptab[db * NPAGES + pg0 + (lane < npg ? lane : 0)];
#define DC_PG(i) ((size_t)__builtin_amdgcn_readlane(mypg, (i)))
    unsigned dE, dO, dr;
    { const unsigned r0 = (unsigned)t4 >> 5, c4 = (unsigned)t4 & 31u;
      const unsigned xE = ((r0 & 3u) << 2) | ((r0 >> 2) & 3u), xO = ((r0 & 3u) << 2) | (((r0 >> 2) + 2u) & 3u);
      dE = 256u * r0 + 16u * ((c4 >> 1) ^ xE) + 8u * (c4 & 1u); dO = 256u * r0 + 16u * ((c4 >> 1) ^ xO) + 8u * (c4 & 1u);
      const unsigned rr = (unsigned)t4 >> 3, c4r = (unsigned)t4 & 7u; dr = offR(rr, c4r >> 1) + 8u * (c4r & 1u); }
    f32x4 sa[10], sb[10];
    dc_load(sa, ckv, ckr, DC_PG(0) * PAGE, t4);
    dc_load(sb, ckv, ckr, DC_PG(0) * PAGE + 64, t4);
    {
      const bf16* qsrc = Qb + ((size_t)RP + (size_t)db * DS) * NH * QD; const unsigned dq = offL((unsigned)t4 >> 4, (unsigned)t4 & 15u);
#pragma unroll
      for (int i = 0; i < 4; ++i) *(ATT_LAS u32x4*)(lds + L_MG + dq + 4096 * i) = *(const u32x4*)(qsrc + (size_t)((t4 >> 4) + 16 * i) * QD + (t4 & 15) * 8);
      *(ATT_LAS u32x4*)(lds + L_MG + TILE_LAT + offR((unsigned)t4 >> 2, (unsigned)t4 & 3u)) = *(const u32x4*)(qsrc + (size_t)(t4 >> 2) * QD + KVL + (t4 & 3) * 8); }
    dc_store(sa, lds + L_DT, dE, dO, dr);
    role_bar(cnt, bt);
    const unsigned qa = L_MG + 256u * (unsigned)(32 * qb + r32) + 16u * ((unsigned)hi ^ ((unsigned)(r32 >> 2) & 1u));
    const unsigned qr0 = L_MG + TILE_LAT + offR((unsigned)(32 * qb + r32), (unsigned)hi), qr1 = L_MG + TILE_LAT + offR((unsigned)(32 * qb + r32), 2u + (unsigned)hi);
    float m = 0.f, l = 0.f; f32x16 o[4];
#pragma unroll
    for (int r = 0; r < 16; ++r) { o[0][r] = 0.f; o[1][r] = 0.f; o[2][r] = 0.f; o[3][r] = 0.f; }
    const unsigned xk = (unsigned)(((r32 & 3) << 1) | ((r32 >> 3) & 1));
    const unsigned ka = 256u * (unsigned)(rb + r32) + 16u * ((unsigned)hi ^ ((unsigned)(r32 >> 2) & 1u));
    const unsigned kr0 = TILE_LAT + offR((unsigned)(rb + r32), (unsigned)hi), kr1 = TILE_LAT + offR((unsigned)(rb + r32), 2u + (unsigned)hi);
    const unsigned blk = (lane >> 4) & 1, qq = (lane & 15) >> 2, pp = lane & 3;
    const unsigned vb0 = 256u * (unsigned)(rb + 4 * hi + qq) + 16u * ((2u * blk + (pp >> 1)) ^ (unsigned)hi) + 8u * (pp & 1u);
    const unsigned vb1 = 256u * (unsigned)(rb + 8 + 4 * hi + qq) + 16u * ((2u * blk + (pp >> 1)) ^ (2u + (unsigned)hi)) + 8u * (pp & 1u);
    const int nhp = 2 * npg;
    bf16x8 qf[6];
    { unsigned xq = xk; asm volatile("" : "+v"(xq));
#pragma unroll
      for (int k = 0; k < 6; ++k) qf[k] = lds_b128(lds + qa + 32u * ((unsigned)k ^ xq));
    }
#define DC_HALF(img, first) do { \
        unsigned xko = xk, qqo = qq; asm volatile("" : "+v"(xko), "+v"(qqo)); \
        f32x16 s; \
        _Pragma("unroll") for (int r = 0; r < 16; ++r) s[r] = 0.f; \
        _Pragma("unroll") for (int k = 0; k < 8; ++k) { const unsigned co_ = 32u * ((unsigned)k ^ xko); s = ATT_MFMA(lds_b128((img) + ka + co_), k < 6 ? qf[k < 6 ? k : 0] : lds_b128(lds + qa + co_), s); } \
        s = ATT_MFMA(lds_b128((img) + kr0), lds_b128(lds + qr0), s); \
        s = ATT_MFMA(lds_b128((img) + kr1), lds_b128(lds + qr1), s); \
        float rm = max3(s[0], s[1], s[2]); \
        _Pragma("unroll") for (int r = 3; r < 15; r += 2) rm = max3(rm, s[r], s[r + 1]); \
        rm = max3(rm, s[15], s[15]); \
        rm = swapmax(rm); \
        if (first) m = rm; \
        rm -= m; \
        if (!(first) && __any(rm > THR)) { const float dlt = fmaxf(rm, 0.f); m += dlt; const float f = __builtin_amdgcn_exp2f(-dlt); l *= f; \
            _Pragma("unroll") for (int c = 0; c < 4; ++c) _Pragma("unroll") for (int r = 0; r < 16; ++r) o[c][r] *= f; } \
        { float sum0 = 0.f, sum1 = 0.f;     \
          _Pragma("unroll") for (int r = 0; r < 16; r += 2) { s[r] = __builtin_amdgcn_exp2f(s[r] - m); s[r + 1] = __builtin_amdgcn_exp2f(s[r + 1] - m); sum0 += s[r]; sum1 += s[r + 1]; } \
          l += sum0 + sum1; } \
        _Pragma("unroll") for (int ks = 0; ks < 2; ++ks) { \
            u32x4 pw; pw.x = cvtpk(s[8 * ks + 0], s[8 * ks + 1]); pw.y = cvtpk(s[8 * ks + 2], s[8 * ks + 3]); pw.z = cvtpk(s[8 * ks + 4], s[8 * ks + 5]); pw.w = cvtpk(s[8 * ks + 6], s[8 * ks + 7]); \
            const bf16x8 pf = __builtin_bit_cast(bf16x8, pw); \
            _Pragma("unroll") for (int c = 0; c < 4; ++c) { const unsigned co = 64u * ((unsigned)c ^ qqo); \
                const s16x4 lo = lds_tr((img) + vb0 + co + 4096 * ks), hv = lds_tr((img) + vb1 + co + 4096 * ks); \
                const bf16x8 vf = {lo[0], lo[1], lo[2], lo[3], hv[0], hv[1], hv[2], hv[3]}; \
                o[c] = ATT_MFMA(vf, pf, o[c]); } } \
    } while (0)
    for (int hp = 0; hp < nhp; hp += 2) {
        dc_load(sa, ckv, ckr, DC_PG(min((hp + 2) >> 1, npg - 1)) * PAGE, t4);
        DC_HALF(lds + L_DT, hp == 0);
        dc_store(sb, lds + L_DT + TILE_BYTES, dE, dO, dr);
        role_bar(cnt, bt);
        dc_load(sb, ckv, ckr, DC_PG(min((hp + 3) >> 1, npg - 1)) * PAGE + 64, t4);
        DC_HALF(lds + L_DT + TILE_BYTES, false);
        if (hp + 2 < nhp) dc_store(sa, lds + L_DT, dE, dO, dr);
        role_bar(cnt, bt);
    }
#undef DC_HALF
#undef DC_PG
    ATT_LAS float* reg = (ATT_LAS float*)(lds + L_MG) + qb * PART_FLOATS + lane;
    if (kb == 0) {
#pragma unroll
        for (int c = 0; c < 4; ++c)
#pragma unroll
            for (int r = 0; r < 16; ++r) reg[(c * 16 + r) * 64] = o[c][r];
        reg[64 * 64] = m; reg[65 * 64] = l; }
    role_bar(cnt, bt);
    if (kb == 1) { const float m2 = reg[64 * 64], l2 = reg[65 * 64]; const float mn = fmaxf(m, m2); const float a1 = __builtin_amdgcn_exp2f(m - mn), a2 = __builtin_amdgcn_exp2f(m2 - mn);
        float* gp = PART + (size_t)qb * PART_FLOATS + lane;
#pragma unroll
        for (int c = 0; c < 4; ++c)
#pragma unroll
            for (int r = 0; r < 16; ++r) gp[(c * 16 + r) * 64] = o[c][r] * a1 + reg[(c * 16 + r) * 64] * a2;
        gp[64 * 64] = mn; gp[65 * 64] = l * a1 + l2 * a2; }
    role_bar(cnt, bt);
}
}
namespace lru {
using att::bf16x8; using att::f32x16; using att::u32x4; using att::ldsp; using att::cvtpk; using att::crow;
constexpr int XCT_STRIDE = 72;
constexpr int XCT_WAVE_BYTES = 64 * XCT_STRIDE * 2;
constexpr int LDS_RED = 0;
constexpr int LDS_RS = LDS_RED + 8 * 64 * 32 * 4;
__device__ __forceinline__ float bf2f(unsigned short v) { return __uint_as_float((unsigned)v << 16); }
__device__ __forceinline__ float sigm(float x) { return __builtin_amdgcn_rcpf(1.0f + __builtin_amdgcn_exp2f(-1.4426950408889634f * x)); }

struct State { f32x16 P[2][2]; f32x16 H[2][2]; };

template <bool SAMPLE, int NRB = 2>
__device__ __forceinline__ void unit_pre(ldsp lds, State& st, const bf16* __restrict__ XL, const bf16* __restrict__ WGT, const float* __restrict__ conv_w, const float* __restrict__ conv_b,
                                         const float* __restrict__ b_a, const float* __restrict__ b_i, const float* __restrict__ lam, const float* __restrict__ state_conv, const float* __restrict__ state_h,
                                         float* __restrict__ out, size_t rowbase, int b0, int tpos0, float* __restrict__ SUMp  ) {
    const int tid = threadIdx.x, lane = tid & 63, n = __builtin_amdgcn_readfirstlane(tid >> 6), r32 = lane & 31, hi = lane >> 5;
    ATT_LAS unsigned short* xct = (ATT_LAS unsigned short*)(lds + n * XCT_WAVE_BYTES);
    bf16x8 af[2][4];
#pragma unroll
    for (int s = 0; s < 4; ++s) { const int ch0 = 64 * n + 16 * s + 8 * hi;
        float w[4][8], bb[8];
#pragma unroll
        for (int k = 0; k < 4; ++k) { const f32x4 a = *(const f32x4*)(conv_w + k * DLRU + ch0), c = *(const f32x4*)(conv_w + k * DLRU + ch0 + 4);
            w[k][0] = a[0]; w[k][1] = a[1]; w[k][2] = a[2]; w[k][3] = a[3]; w[k][4] = c[0]; w[k][5] = c[1]; w[k][6] = c[2]; w[k][7] = c[3]; }
        { const f32x4 a = *(const f32x4*)(conv_b + ch0), c = *(const f32x4*)(conv_b + ch0 + 4); bb[0] = a[0]; bb[1] = a[1]; bb[2] = a[2]; bb[3] = a[3]; bb[4] = c[0]; bb[5] = c[1]; bb[6] = c[2]; bb[7] = c[3]; }
#pragma unroll
        for (int rb = 0; rb < NRB; ++rb) { const int tk = 32 * rb + r32;
            const int tseq = SAMPLE ? (tk & 7) : tpos0 + tk;
            float xc[8];
#pragma unroll
            for (int j = 0; j < 8; ++j) xc[j] = bb[j];
#pragma unroll
            for (int k = 0; k < 4; ++k) { const int back = 3 - k;
                float xv[8];
                const bool inseq = tseq - back >= 0;
                { const bf16x8 v = *(const bf16x8*)(XL + (rowbase + tk - (inseq ? back : 0)) * DLRU + ch0);
#pragma unroll
                  for (int j = 0; j < 8; ++j) xv[j] = inseq ? bf2f((unsigned short)v[j]) : 0.f; }
                if (SAMPLE && back > 0) { const int sr = inseq ? 0 : 3 + tseq - back;
                    const float* sp = state_conv + ((size_t)(b0 + (tk >> 3)) * 3 + sr) * DLRU + ch0; const f32x4 a = *(const f32x4*)sp, c = *(const f32x4*)(sp + 4);
                    if (!inseq) { xv[0] = a[0]; xv[1] = a[1]; xv[2] = a[2]; xv[3] = a[3]; xv[4] = c[0]; xv[5] = c[1]; xv[6] = c[2]; xv[7] = c[3]; } }
#pragma unroll
                for (int j = 0; j < 8; ++j) xc[j] += w[k][j] * xv[j]; }
            u32x4 pw; pw.x = cvtpk(xc[0], xc[1]); pw.y = cvtpk(xc[2], xc[3]); pw.z = cvtpk(xc[4], xc[5]); pw.w = cvtpk(xc[6], xc[7]);
            af[rb][s] = __builtin_bit_cast(bf16x8, pw);
            *(ATT_LAS u32x4*)(xct + tk * XCT_STRIDE + 16 * s + 8 * hi) = pw;
        }
    }
    if (SAMPLE || tpos0 + 32 * NRB > SEQ - 3) {
#pragma unroll
        for (int s = 0; s < 4; ++s) { const int ch0 = 64 * n + 16 * s + 8 * hi;
#pragma unroll
            for (int rb = 0; rb < NRB; ++rb) { const int tk = 32 * rb + r32; const int tseq = SAMPLE ? (tk & 7) : tpos0 + tk;
                if (tseq >= (SAMPLE ? DS : SEQ) - 3) { const bf16x8 v = *(const bf16x8*)(XL + (rowbase + tk) * DLRU + ch0);
                    float* o = out + (SAMPLE ? O_CVS : O_CVP) + ((size_t)(SAMPLE ? b0 + (tk >> 3) : b0) * 3 + (tseq - ((SAMPLE ? DS : SEQ) - 3))) * DLRU + ch0;
#pragma unroll
                    for (int j = 0; j < 8; ++j) o[j] = bf2f((unsigned short)v[j]); } } }
    }
#pragma unroll
    for (int g = 0; g < 2; ++g)
#pragma unroll
        for (int cb = 0; cb < 2; ++cb) { f32x16 c0, c1;
#pragma unroll
            for (int r = 0; r < 16; ++r) { c0[r] = 0.f; c1[r] = 0.f; }
#pragma unroll
            for (int s = 0; s < 4; ++s) { const bf16x8 bf = *(const bf16x8*)(WGT + (((size_t)n * 2 + g) * 64 + 32 * cb + r32) * 64 + 16 * s + 8 * hi);
                c0 = ATT_MFMA(af[0][s], bf, c0); if (NRB == 2) c1 = ATT_MFMA(af[1][s], bf, c1); }
            if (g == 0) { st.P[0][cb] = c0; st.P[1][cb] = c1; } else { st.H[0][cb] = c0; st.H[1][cb] = c1; }
            __builtin_amdgcn_sched_barrier(0); }
    asm volatile("s_waitcnt lgkmcnt(0)" ::: "memory");
#pragma unroll
    for (int cb = 0; cb < 2; ++cb) { const int ch = 64 * n + 32 * cb + r32;
        const float ba = b_a[ch], bi = b_i[ch]; const float nl = -lam[ch]; const float sp8 = 8.0f * (fmaxf(nl, 0.f) + log1pf(__expf(-fabsf(nl))));
#pragma unroll
        for (int rb = 0; rb < NRB; ++rb)
#pragma unroll
            for (int r = 0; r < 16; ++r) { const int tk = 32 * rb + crow(r, hi);
                const float xc = bf2f(xct[tk * XCT_STRIDE + 32 * cb + r32]);
                const float rg = sigm(st.P[rb][cb][r] + ba), ig = sigm(st.H[rb][cb][r] + bi);
                const float la = -rg * sp8;
                const float a = __builtin_amdgcn_exp2f(1.4426950408889634f * la);
                const float y = -2.0f * la;
                const float poly = y * (1.0f + y * (-0.5f + y * (1.6666667e-1f + y * (-4.1666667e-2f + y * (8.3333333e-3f + y * -1.3888889e-3f)))));
                const float wgt = __builtin_amdgcn_fmed3f(10.0f * y - 2.0f, 0.0f, 1.0f);
                const float om = poly + wgt * ((1.0f - a * a) - poly);
                st.P[rb][cb][r] = a; st.H[rb][cb][r] = __builtin_amdgcn_sqrtf(om) * (ig * xc); }
        __builtin_amdgcn_sched_barrier(0); }
#pragma unroll
    for (int cb = 0; cb < 2; ++cb) { const int ch = 64 * n + 32 * cb + r32;
        float h = 0.f, pr = 1.f;
#pragma unroll
        for (int k = 0; k < 8 * NRB; ++k) { const int rb = k >> 3, g = (k >> 1) & 3, owner = k & 1;
            if (SAMPLE && (k & 1) == 0) { h = state_h[(size_t)(b0 + (k >> 1)) * DLRU + ch]; pr = 1.f; }
            if (hi == owner) {
#pragma unroll
                for (int i = 0; i < 4; ++i) { const float a = st.P[rb][cb][4 * g + i]; h = a * h + st.H[rb][cb][4 * g + i]; pr *= a; st.H[rb][cb][4 * g + i] = h; st.P[rb][cb][4 * g + i] = pr; } }
            const float ho = __shfl_xor(h, 32), po = __shfl_xor(pr, 32);
            if (hi != owner) { h = ho; pr = po; }
            if (SAMPLE && (k & 1) == 1 && hi == 0) out[O_HS + (size_t)(b0 + (k >> 1)) * DLRU + ch] = h; }
        if (!SAMPLE && hi == 0) { SUMp[2 * ch] = pr; SUMp[2 * ch + 1] = h; } }
}
template <int NRB = 2>
__device__ __forceinline__ void unit_post(ldsp lds, State& st, const bf16* __restrict__ GG, const float* __restrict__ gain, bf16* __restrict__ YC, size_t rowbase, float carry0, float carry1) {
    const int tid = threadIdx.x, lane = tid & 63, n = __builtin_amdgcn_readfirstlane(tid >> 6), r32 = lane & 31, hi = lane >> 5;
    ATT_LAS float* red = (ATT_LAS float*)(lds + LDS_RED); ATT_LAS float* rs = (ATT_LAS float*)(lds + LDS_RS);
    __syncthreads();
#pragma unroll
    for (int rb = 0; rb < NRB; ++rb)
#pragma unroll
        for (int r = 0; r < 16; ++r) { const int tk = 32 * rb + crow(r, hi); float ss = 0.f;
#pragma unroll
            for (int cb = 0; cb < 2; ++cb) { const int ch = 64 * n + 32 * cb + r32; const float cr = cb ? carry1 : carry0;
                const float h = st.H[rb][cb][r] + st.P[rb][cb][r] * cr;
                const float y = bf2f(GG[(rowbase + tk) * DLRU + ch]) * h;
                st.H[rb][cb][r] = y; ss += y * y; }
            red[(n * 64 + tk) * 32 + r32] = ss; }
    __syncthreads();
    { const int tk = tid >> 3, part = tid & 7; float s = 0.f;
#pragma unroll
      for (int j = 0; j < 8; ++j) { const f32x4 v = *(const ATT_LAS f32x4*)(red + (part * 64 + tk) * 32 + 4 * j); s += (v[0] + v[1]) + (v[2] + v[3]); }
      s += __shfl_xor(s, 1); s += __shfl_xor(s, 2); s += __shfl_xor(s, 4);
      if (part == 0 && tk < 32 * NRB) rs[tk] = __builtin_amdgcn_rsqf(s * (1.0f / DLRU) + EPS); }
    __syncthreads();
#pragma unroll
    for (int cb = 0; cb < 2; ++cb) { const int ch = 64 * n + 32 * cb + r32; const float gn = gain[ch];
#pragma unroll
        for (int rb = 0; rb < NRB; ++rb)
#pragma unroll
            for (int r = 0; r < 16; ++r) { const int tk = 32 * rb + crow(r, hi);
                YC[(rowbase + tk) * DMIX + ch] = (bf16)f2bf(st.H[rb][cb][r] * rs[tk] * gn); } }
    __syncthreads();
}
__device__ __forceinline__ float chunk_carry(const float* __restrict__ SUMb, int c, int ch) {
    float h = 0.f;
    int k = 0;
    for (; k + 16 <= c; k += 16) { float2 v[16];
#pragma unroll
        for (int j = 0; j < 16; ++j) v[j] = *(const float2*)(SUMb + ((size_t)(k + j) * DLRU + ch) * 2);
#pragma unroll
        for (int j = 0; j < 16; ++j) h = v[j].x * h + v[j].y; }
#pragma unroll 8
    for (; k < c; ++k) { const float2 v = *(const float2*)(SUMb + ((size_t)k * DLRU + ch) * 2); h = v.x * h + v.y; }
    return h;
}
}
namespace sg {
typedef short bf16x8 __attribute__((ext_vector_type(8)));
typedef unsigned u32x2 __attribute__((ext_vector_type(2)));
using att::u32x4; using att::offL; using att::ldsp;
constexpr int CHK = 256, HALF_B = 64 * 256, TILE_B = 2 * HALF_B  , BUF_B = 2 * TILE_B;
__device__ __forceinline__ void ld_chunk(u32x4 (&st)[8], const bf16* __restrict__ ap, const bf16* __restrict__ bp, int K) {
#pragma unroll
    for (int i = 0; i < 4; ++i) { st[i] = *(const u32x4*)(ap + (size_t)16 * i * K); st[4 + i] = *(const u32x4*)(bp + (size_t)16 * i * K); }
}
__device__ __forceinline__ void st_chunk(const u32x4 (&st)[8], ldsp buf, unsigned d) {
#pragma unroll
    for (int i = 0; i < 4; ++i) { *(ATT_LAS u32x4*)(buf + d + 4096 * i) = st[i]; *(ATT_LAS u32x4*)(buf + TILE_B + d + 4096 * i) = st[4 + i]; }
}
__device__ __forceinline__ void unit64(ldsp lds, const bf16* __restrict__ A, const bf16* __restrict__ Bt, int K, int r0, int c0, const float* __restrict__ basef,
                                       bf16* Xb, float* __restrict__ SSQX, float alpha, float* __restrict__ outf = nullptr, const float* __restrict__ gain = nullptr, unsigned* cnt = nullptr) {
    const int tid = threadIdx.x, lane = tid & 63, w = __builtin_amdgcn_readfirstlane(tid >> 6), nt = w & 1, kq = w >> 1, r32 = lane & 31, hi = lane >> 5;
    const bf16* ap = A + (size_t)(r0 + (tid >> 5)) * K + 8 * (tid & 31); const bf16* bp = Bt + (size_t)(c0 + (tid >> 5)) * K + 8 * (tid & 31);
    const unsigned d = (unsigned)((tid & 31) >> 4) * HALF_B + offL((unsigned)tid >> 5, (unsigned)tid & 15u);
    const unsigned xa = (unsigned)(((r32 & 3) << 2) | ((r32 >> 2) & 3));
    const unsigned ra = (unsigned)(kq >> 1) * HALF_B + 256u * (unsigned)r32, rb = TILE_B + (unsigned)(kq >> 1) * HALF_B + 256u * (unsigned)(32 * nt + r32);
    typedef float f32x16 __attribute__((ext_vector_type(16)));
    f32x16 acc0, acc1;
#pragma unroll
    for (int r = 0; r < 16; ++r) { acc0[r] = 0.f; acc1[r] = 0.f; }
    u32x4 s0[8], s1[8], s2[8];
    const int nch = K / CHK;
    ld_chunk(s0, ap, bp, K);
    { const int c1 = min(1, nch - 1), c2 = min(2, nch - 1); ld_chunk(s1, ap + c1 * CHK, bp + c1 * CHK, K); ld_chunk(s2, ap + c2 * CHK, bp + c2 * CHK, K); }
    __syncthreads();
    st_chunk(s0, lds, d);
    __syncthreads();
#define SG_COMPUTE(buf) do { unsigned xo = xa; asm volatile("" : "+v"(xo)); \
        _Pragma("unroll") for (int j = 0; j < 4; ++j) { const unsigned co = 16u * ((unsigned)(8 * (kq & 1) + 2 * j + hi) ^ xo); \
            const bf16x8 b = *(const ATT_LAS bf16x8*)((buf) + rb + co), a0 = *(const ATT_LAS bf16x8*)((buf) + ra + co), a1 = *(const ATT_LAS bf16x8*)((buf) + ra + 8192 + co); \
            acc0 = __builtin_amdgcn_mfma_f32_32x32x16_bf16(b, a0, acc0, 0, 0, 0); acc1 = __builtin_amdgcn_mfma_f32_32x32x16_bf16(b, a1, acc1, 0, 0, 0); } } while (0)
#define SG_STEP(j, SETL, SETS) { const int cc = c + (j); if (cc >= nch) break; \
        { const int cn = min(cc + 3, nch - 1); ld_chunk(SETL, ap + cn * CHK, bp + cn * CHK, K); } \
        SG_COMPUTE(lds + ((j) & 1) * BUF_B); \
        if (cc + 1 < nch) st_chunk(SETS, lds + (((j) + 1) & 1) * BUF_B, d); \
        __syncthreads(); }
    for (int c = 0; c < nch; c += 6) { SG_STEP(0, s0, s1) SG_STEP(1, s1, s2) SG_STEP(2, s2, s0) SG_STEP(3, s0, s1) SG_STEP(4, s1, s2) SG_STEP(5, s2, s0) }
#undef SG_STEP
#undef SG_COMPUTE
    constexpr int PS = 68;
    ATT_LAS float* P = (ATT_LAS float*)lds;
#pragma unroll
    for (int f = 0; f < 2; ++f)
#pragma unroll
        for (int g = 0; g < 4; ++g) { const f32x16& a = f ? acc1 : acc0; f32x4 q = {a[4 * g], a[4 * g + 1], a[4 * g + 2], a[4 * g + 3]};
            *(ATT_LAS f32x4*)(P + ((size_t)(kq * 64 + 32 * f + r32) * PS + 32 * nt + 8 * g + 4 * hi)) = q; }
    __syncthreads();
    { const int m = tid >> 3, n8 = 8 * (tid & 7); f32x4 v0 = {0.f, 0.f, 0.f, 0.f}, v1 = {0.f, 0.f, 0.f, 0.f};
#pragma unroll
      for (int q = 0; q < 4; ++q) { const ATT_LAS f32x4* pp = (const ATT_LAS f32x4*)(P + ((size_t)(q * 64 + m) * PS + n8)); v0 = v0 + pp[0]; v1 = v1 + pp[1]; }
      const size_t off = ((size_t)r0 + m) * 1024 + c0 + n8; f32x4 b0, b1;
      if (basef) { b0 = *(const f32x4*)(basef + off); b1 = *(const f32x4*)(basef + off + 4); }
      else { const u32x4 bw = *(const u32x4*)(Xb + off);
          b0[0] = __uint_as_float(bw.x << 16); b0[1] = __uint_as_float(bw.x & 0xffff0000u); b0[2] = __uint_as_float(bw.y << 16); b0[3] = __uint_as_float(bw.y & 0xffff0000u);
          b1[0] = __uint_as_float(bw.z << 16); b1[1] = __uint_as_float(bw.z & 0xffff0000u); b1[2] = __uint_as_float(bw.w << 16); b1[3] = __uint_as_float(bw.w & 0xffff0000u); }
      v0 = v0 * alpha + b0; v1 = v1 * alpha + b1;
      float ss = ((v0[0] * v0[0] + v0[1] * v0[1]) + (v0[2] * v0[2] + v0[3] * v0[3])) + ((v1[0] * v1[0] + v1[1] * v1[1]) + (v1[2] * v1[2] + v1[3] * v1[3]));
      ss += __shfl_xor(ss, 1); ss += __shfl_xor(ss, 2); ss += __shfl_xor(ss, 4);
      if (!outf) { u32x4 pw; pw.x = att::cvtpk(v0[0], v0[1]); pw.y = att::cvtpk(v0[2], v0[3]); pw.z = att::cvtpk(v1[0], v1[1]); pw.w = att::cvtpk(v1[2], v1[3]); *(u32x4*)(Xb + off) = pw;
          if ((tid & 7) == 0) SSQX[((size_t)r0 + m) * 16 + (c0 >> 6)] = ss; }
      else {
          if ((tid & 7) == 0) __hip_atomic_store(SSQX + ((size_t)r0 + m) * 16 + (c0 >> 6), ss, __ATOMIC_RELAXED, __HIP_MEMORY_SCOPE_AGENT);
          asm volatile("s_waitcnt vmcnt(0)" ::: "memory");
          __syncthreads();
          if (tid == 0) { __hip_atomic_fetch_add(cnt, 1u, __ATOMIC_RELAXED, __HIP_MEMORY_SCOPE_AGENT); unsigned sp = 0u;
              while (__hip_atomic_load(cnt, __ATOMIC_RELAXED, __HIP_MEMORY_SCOPE_AGENT) < 16u) { __builtin_amdgcn_s_sleep(2); if (++sp > (1u << 22)) break; }
              __builtin_amdgcn_fence(__ATOMIC_ACQUIRE, "agent"); }
          asm volatile("s_waitcnt vmcnt(0)" ::: "memory");
          __syncthreads();
          const unsigned long long* sl = (const unsigned long long*)(SSQX + ((size_t)r0 + m) * 16); float t = 0.f;
#pragma unroll
          for (int j = 0; j < 8; ++j) { const unsigned long long w = __hip_atomic_load(sl + j, __ATOMIC_RELAXED, __HIP_MEMORY_SCOPE_AGENT); t += __uint_as_float((unsigned)w) + __uint_as_float((unsigned)(w >> 32)); }
          const float rs = 1.0f / sqrtf(t * (1.0f / 1024.0f) + 1e-6f);
          const f32x4 g0 = *(const f32x4*)(gain + c0 + n8), g1 = *(const f32x4*)(gain + c0 + n8 + 4);
          *(f32x4*)(outf + off) = v0 * rs * g0; *(f32x4*)(outf + off + 4) = v1 * rs * g1; } }
}
}
constexpr size_t MiB = 1u << 20;
constexpr size_t WS_CTL = 0, CTL_ZERO_BYTES = 64 * 1024;
constexpr size_t WS_WGU1 = 2 * MiB, WS_WD1 = 14 * MiB, WS_WGU2 = 20 * MiB, WS_WD2 = 32 * MiB, WS_WIN = 38 * MiB, WS_WOUT = 42 * MiB, WS_WQ = 44 * MiB, WS_SUM = 46 * MiB, WS_WGT = 48 * MiB, WS_SSQ = 49 * MiB, WS_KCS = 50 * MiB, WS_WUVF = 51 * MiB, WS_CKV = 52 * MiB, WS_SSQX = 61 * MiB, WS_WQP = 45 * MiB, WS_WKV = 45 * MiB + 512 * 1024;
static_assert(WS_SSQX + (size_t)R * 64 <= 64 * MiB && WS_WQ + (size_t)NQ * QL * 2 <= WS_WQP && WS_WQP + (size_t)NH * 96 * QL * 2 <= WS_WKV && WS_WKV + (size_t)NH * 128 * KVL * 2 <= WS_SUM, "workspace map");
constexpr size_t WS_XN = 64 * MiB, WS_H = 100 * MiB, WS_X1 = 200 * MiB, WS_X2 = 270 * MiB, WS_Z = 340 * MiB, WS_QALL = 444 * MiB, WS_CQN = 530 * MiB;
constexpr size_t WS_A = 540 * MiB, WS_U = 576 * MiB, WS_YL = 612 * MiB, WS_OLAT = 648 * MiB, WS_YC = 720 * MiB, WS_QB = 760 * MiB, WS_KC = 820 * MiB, WS_PART = 830 * MiB, WS_XL = 900 * MiB, WS_GG = 920 * MiB, WS_CQ = 940 * MiB, WS_QBP = 950 * MiB, WS_KVH = 980 * MiB, WS_CKVB = 1024 * MiB, WS_SSQM = 1030 * MiB, WS_XCH = 1032 * MiB  , WS_END = 1034 * MiB;
constexpr int CW_QUE = 256;
constexpr int CW_BAR = 1024;
constexpr int CW_FIN = 8192, CW_FINS = 12288;
static_assert((CW_BAR + XCD_BAR_WORDS) <= CW_FIN && (CW_FINS + 64 * (RS / 64)) * 4 <= (int)CTL_ZERO_BYTES && CW_FIN + 64 * (RP / 256) <= CW_FINS, "CTL");
constexpr int RING_BYTES = 131072, LDS_BYTES = 147456, LDSCTL_OFF = LDS_BYTES - 1024, MISC_OFF = LDSCTL_OFF + 320;
static_assert(att::PR_LDS_END <= LDSCTL_OFF, "prompt attention LDS map");
constexpr int NSPLIT = 2;
constexpr int CHUNK = 64, NCHUNK = SEQ / CHUNK;

struct Params { const float* in[33]; float* out; unsigned char* ws; int ph_lo, ph_hi; };
static_assert(sizeof(Params) == 33 * 8 + 8 + 8 + 8, "Params has no padding");

__device__ __forceinline__ void transpose_tile(const float* __restrict__ src, int ldw, bf16* __restrict__ dst, int ldt, LAS float* scr, int lane, const float* __restrict__ gain) {
    {
        const float* wp = src + (size_t)(lane >> 5) * ldw + (lane & 31); float v[32];
#pragma unroll
        for (int i = 0; i < 32; ++i) v[i] = __builtin_nontemporal_load(wp + (size_t)(2 * i) * ldw);
        if (gain) { float g[32];
#pragma unroll
            for (int i = 0; i < 32; ++i) g[i] = gain[2 * i + (lane >> 5)];
#pragma unroll
            for (int i = 0; i < 32; ++i) v[i] *= g[i]; }
#pragma unroll
        for (int i = 0; i < 32; ++i) scr[(2 * i + (lane >> 5)) * 33 + (lane & 31)] = v[i]; }
    LDS_WAIT(); asm volatile("" ::: "memory");
    const int c = lane & 7;
#pragma unroll
    for (int j = 0; j < 4; ++j) { const int n = (lane >> 3) + 8 * j; const LAS float* sp = scr + (8 * c) * 33 + n;
        v4u o; o.x = pk2(sp[0 * 33], sp[1 * 33]); o.y = pk2(sp[2 * 33], sp[3 * 33]); o.z = pk2(sp[4 * 33], sp[5 * 33]); o.w = pk2(sp[6 * 33], sp[7 * 33]);
        *(v4u*)(dst + (size_t)n * ldt + 8 * c) = o; }
    LDS_WAIT(); asm volatile("" ::: "memory");
}
template <bool OUT_BF16>
__device__ __forceinline__ void rmsnorm_rows(const float* __restrict__ x0, const float* __restrict__ x1, int split, const float* __restrict__ gain, void* __restrict__ outp) {
    const int lane = threadIdx.x & 63, gw = blockIdx.x * 8 + __builtin_amdgcn_readfirstlane(threadIdx.x >> 6), NGW = gridDim.x * 8;
    for (int row = gw; row < R; row += NGW) {
        const float* xr = (row < split) ? x0 + (size_t)row * DM : x1 + (size_t)(row - split) * DM;
        f32x4 v[4]; float s = 0.f;
#pragma unroll
        for (int j = 0; j < 4; ++j) { v[j] = ((const f32x4*)xr)[lane + 64 * j]; s += (v[j].x * v[j].x + v[j].y * v[j].y) + (v[j].z * v[j].z + v[j].w * v[j].w); }
        const float rstd = 1.0f / sqrtf(wave_sum(s) * (1.0f / DM) + EPS);
#pragma unroll
        for (int j = 0; j < 4; ++j) { const f32x4 g = ((const f32x4*)gain)[lane + 64 * j]; const f32x4 o = v[j] * rstd * g;
            if (OUT_BF16) { unsigned long long w = (unsigned long long)pk2(o.x, o.y) | ((unsigned long long)pk2(o.z, o.w) << 32); ((unsigned long long*)((bf16*)outp + (size_t)row * DM))[lane + 64 * j] = w; }
            else ((f32x4*)((float*)outp + (size_t)row * DM))[lane + 64 * j] = o; }
    }
}
__device__ __forceinline__ void final_norm_rows(const bf16* __restrict__ XB, const float* __restrict__ SSQX, const float* __restrict__ gain, float* __restrict__ outp) {
    const int lane = threadIdx.x & 63, gw = blockIdx.x * 8 + __builtin_amdgcn_readfirstlane(threadIdx.x >> 6), NGW = gridDim.x * 8;
    const f32x4 g00 = ((const f32x4*)gain)[2 * lane], g01 = ((const f32x4*)gain)[2 * lane + 1], g10 = ((const f32x4*)gain)[2 * (lane + 64)], g11 = ((const f32x4*)gain)[2 * (lane + 64) + 1];
    for (int row = gw; row < R; row += 2 * NGW) {
        const int row2 = row + NGW; const bool two = row2 < R; const int rb_ = two ? row2 : row;
        const v4u wa0 = ((const v4u*)(XB + (size_t)row * DM))[lane], wa1 = ((const v4u*)(XB + (size_t)row * DM))[lane + 64];
        const v4u wb0 = ((const v4u*)(XB + (size_t)rb_ * DM))[lane], wb1 = ((const v4u*)(XB + (size_t)rb_ * DM))[lane + 64];
        const f32x4* spa = (const f32x4*)(SSQX + (size_t)row * 16); const f32x4* spb = (const f32x4*)(SSQX + (size_t)rb_ * 16);
        const f32x4 ta = (spa[0] + spa[1]) + (spa[2] + spa[3]), tb = (spb[0] + spb[1]) + (spb[2] + spb[3]);
        const float ra = 1.0f / sqrtf(((ta[0] + ta[1]) + (ta[2] + ta[3])) * (1.0f / DM) + EPS), rbs = 1.0f / sqrtf(((tb[0] + tb[1]) + (tb[2] + tb[3])) * (1.0f / DM) + EPS);
#define FN_OUT(W_, RS_, GA_, GB_, DST_) do { f32x4 o0, o1; \
            o0[0] = __uint_as_float((W_).x << 16) * (RS_) * (GA_)[0]; o0[1] = __uint_as_float((W_).x & 0xffff0000u) * (RS_) * (GA_)[1]; o0[2] = __uint_as_float((W_).y << 16) * (RS_) * (GA_)[2]; o0[3] = __uint_as_float((W_).y & 0xffff0000u) * (RS_) * (GA_)[3]; \
            o1[0] = __uint_as_float((W_).z << 16) * (RS_) * (GB_)[0]; o1[1] = __uint_as_float((W_).z & 0xffff0000u) * (RS_) * (GB_)[1]; o1[2] = __uint_as_float((W_).w << 16) * (RS_) * (GB_)[2]; o1[3] = __uint_as_float((W_).w & 0xffff0000u) * (RS_) * (GB_)[3]; \
            (DST_)[0] = o0; (DST_)[1] = o1; } while (0)
        FN_OUT(wa0, ra, g00, g01, (f32x4*)(outp + (size_t)row * DM) + 2 * lane);
        FN_OUT(wa1, ra, g10, g11, (f32x4*)(outp + (size_t)row * DM) + 2 * (lane + 64));
        if (two) { FN_OUT(wb0, rbs, g00, g01, (f32x4*)(outp + (size_t)row2 * DM) + 2 * lane); FN_OUT(wb1, rbs, g10, g11, (f32x4*)(outp + (size_t)row2 * DM) + 2 * (lane + 64)); }
#undef FN_OUT
    }
}
template <int MODE>
__device__ __forceinline__ void weight_items(const Params& p, LAS unsigned char* lds, int gw, int NGW) {
    const int tid = threadIdx.x, lane = tid & 63, wave = __builtin_amdgcn_readfirstlane(tid >> 6);
    unsigned char* ws = p.ws;
    LAS float* scr = (LAS float*)(lds + wave * 16384);
    constexpr int I_F = (DM / 64) * (DFF / 32), I_IN = (DM / 64) * (DIN / 32), I_OUT = (DMIX / 64) * (DM / 32);
    constexpr int I_WQ = NH * (QL / 64) * (KVL / 8), I_QP = (QL / 64) * (NH * 96 / 32), I_QR = (QL / 64) * NH, I_KV = (KVL / 64) * NH * 4, I_GT = NBLK * 2 * 2;
    constexpr int NITEMS = I_WQ + 6 * I_F + I_IN + I_OUT + I_QP + I_QR + I_KV + I_GT;
    static_assert((DFF / 64) * (DM / 32) == I_F, "down items");
    const float* wq = p.in[21]; const float* wuk = p.in[23]; const float* qn = p.in[20]; bf16* WqT = (bf16*)(ws + WS_WQ);
    constexpr bool LATE = MODE == 2;
    constexpr int NE = 2 * I_F + I_IN, NM = I_F, NL = NITEMS - I_WQ - NE - NM;
    for (int it = gw; it < (MODE == 2 ? I_WQ + NL : MODE == 1 ? NM : NE); it += NGW) {
        int r;
        if (MODE == 2) { r = it; if (it >= I_WQ) { const int l = it - I_WQ; r = I_WQ + (l < 3 * I_F ? l + 3 * I_F : l + 3 * I_F + I_IN); } }
        else if (MODE == 1) r = I_WQ + it + 2 * I_F;
        else r = I_WQ + (it < 2 * I_F ? it : it + 4 * I_F);
        if (r < I_WQ) {
            const int h = r / ((QL / 64) * (KVL / 8)), kt = (r / (KVL / 8)) % (QL / 64), cg = r % (KVL / 8), k = 64 * kt + lane;
            f32x4 a[16];
#pragma unroll
            for (int j = 0; j < 16; ++j) a[j] = *(const f32x4*)(wq + (size_t)k * (NH * 96) + h * 96 + 4 * j);
            const float gk = qn[k];
#pragma unroll 1
            for (int c = 8 * cg; c < 8 * cg + 8; c += 2) { const f32x4* b0 = (const f32x4*)(wuk + ((size_t)c * NH + h) * NOPE); const f32x4* b1 = (const f32x4*)(wuk + ((size_t)(c + 1) * NH + h) * NOPE);
                f32x4 u[16], w[16];
#pragma unroll
                for (int j = 0; j < 16; ++j) { u[j] = b0[j]; w[j] = b1[j]; }
                f32x4 s4 = {0.f, 0.f, 0.f, 0.f}, t4 = {0.f, 0.f, 0.f, 0.f};
#pragma unroll
                for (int j = 0; j < 16; ++j) { s4 = s4 + a[j] * u[j]; t4 = t4 + a[j] * w[j]; }
                WqT[(size_t)(h * KVL + c) * QL + k] = (bf16)f2bf(((s4[0] + s4[1]) + (s4[2] + s4[3])) * gk);
                WqT[(size_t)(h * KVL + c + 1) * QL + k] = (bf16)f2bf(((t4[0] + t4[1]) + (t4[2] + t4[3])) * gk); }
            continue; }
        r -= I_WQ;
        const float* src; bf16* dst; const float* gain = nullptr; int ldw, ldt;
        if (r < 6 * I_F) { const int which = r / I_F, q = r % I_F;
            const bool down = which == 2 || which == 5; const int K = down ? DFF : DM, N = down ? DM : DFF, nblk = N / 32, k0 = 64 * (q / nblk), n0 = 32 * (q % nblk);
            const int inp = which == 0 ? 8 : which == 1 ? 9 : which == 2 ? 10 : which == 3 ? 29 : which == 4 ? 30 : 31;
            const size_t wsoff = which < 2 ? WS_WGU1 : which == 2 ? WS_WD1 : which < 5 ? WS_WGU2 : WS_WD2;
            const int drow0 = down ? n0 : 256 * (n0 / 128) + (n0 % 128) + ((which == 1 || which == 4) ? 128 : 0);
            src = p.in[inp] + (size_t)k0 * N + n0; ldw = N; dst = (bf16*)(ws + wsoff) + (size_t)drow0 * K + k0; ldt = K; if (which == 3 || which == 4) gain = p.in[28] + k0; }
        else if ((r -= 6 * I_F) < I_IN) { const int nblk = DIN / 32, k0 = 64 * (r / nblk), n0 = 32 * (r % nblk);
            src = p.in[12] + (size_t)k0 * DIN + n0; ldw = DIN; dst = (bf16*)(ws + WS_WIN) + (size_t)n0 * DM + k0; ldt = DM; gain = p.in[11] + k0; }
        else if ((r -= I_IN) < I_OUT) { const int nblk = DM / 32, k0 = 64 * (r / nblk), n0 = 32 * (r % nblk);
            src = p.in[27] + (size_t)k0 * DM + n0; ldw = DM; dst = (bf16*)(ws + WS_WOUT) + (size_t)n0 * DMIX + k0; ldt = DMIX; }
        else if ((r -= I_OUT) < I_QP) { const int nblk = NH * 96 / 32, k0 = 64 * (r / nblk), n0 = 32 * (r % nblk);
            const int col = (n0 < NH * NOPE) ? (n0 / NOPE) * 96 + (n0 % NOPE) : ((n0 - NH * NOPE) / ROPE) * 96 + NOPE;
            src = wq + (size_t)k0 * (NH * 96) + col; ldw = NH * 96; dst = (bf16*)(ws + WS_WQP) + (size_t)n0 * QL + k0; ldt = QL; gain = qn + k0; }
        else if ((r -= I_QP) < I_QR) { const int k0 = 64 * (r / NH), h = r % NH;
            src = wq + (size_t)k0 * (NH * 96) + h * 96 + NOPE; ldw = NH * 96; dst = WqT + (size_t)(NH * KVL + ROPE * h) * QL + k0; ldt = QL; gain = qn + k0; }
        else if ((r -= I_QR) < I_KV) { const int c0 = 64 * (r / (NH * 4)), h = (r >> 2) % NH, jb = r & 3;
            src = (jb < 2 ? wuk : p.in[24]) + (size_t)c0 * (NH * NOPE) + h * NOPE + 32 * (jb & 1); ldw = NH * NOPE; dst = (bf16*)(ws + WS_WKV) + (size_t)(h * 128 + 32 * jb) * KVL + c0; ldt = KVL; gain = p.in[22] + c0; }
        else { r -= I_KV; const int n = r >> 2, g = (r >> 1) & 1, eb = r & 1;
            src = (g ? p.in[17] : p.in[15]) + (size_t)n * BLK * BLK + 32 * eb; ldw = BLK; dst = (bf16*)(ws + WS_WGT) + (size_t)((n * 2 + g) * BLK + 32 * eb) * BLK; ldt = BLK; }
        transpose_tile(src, ldw, dst, ldt, scr, lane, gain);
    }
}
__device__ __forceinline__ void p_prologue(const Params& p, LAS unsigned char* lds) {
    const int tid = threadIdx.x, lane = tid & 63, wave = __builtin_amdgcn_readfirstlane(tid >> 6), gw = blockIdx.x * 8 + wave, NGW = gridDim.x * 8;
    unsigned char* ws = p.ws;
    LAS float* scr = (LAS float*)(lds + wave * 16384);
    weight_items<0>(p, lds, gw, NGW);
    const int gt = blockIdx.x * 512 + tid, NGT = gridDim.x * 512;
    { unsigned* z = (unsigned*)((bf16*)(ws + WS_WIN) + (size_t)DIN * DM); for (int i = gt; i < (DINP - DIN) * DM / 2; i += NGT) z[i] = 0u; }
    { const int xcd = (int)(blockIdx.x & 7), jb = (int)(blockIdx.x >> 3), nb = (int)(gridDim.x >> 3); const float* gain = p.in[7]; bf16* XNp = (bf16*)(ws + WS_XN);
      if ((gridDim.x & 7) == 0) {
          const int rows_x = R / 8, r_lo = xcd * rows_x + (jb * rows_x) / nb, r_hi = xcd * rows_x + ((jb + 1) * rows_x) / nb;
          for (int row = r_lo + 2 * wave; row < r_hi; row += 16) {
              const bool two = row + 1 < r_hi;
              const float* xa = (row < RP) ? p.in[0] + (size_t)row * DM : p.in[1] + (size_t)(row - RP) * DM;
              const float* xb = (row + 1 < RP) ? p.in[0] + (size_t)(row + 1) * DM : p.in[1] + (size_t)(row + 1 - RP) * DM;
              f32x4 va[4], vb[4]; float sa = 0.f, sb = 0.f;
#pragma unroll
              for (int j = 0; j < 4; ++j) { va[j] = ((const f32x4*)xa)[lane + 64 * j]; vb[j] = two ? ((const f32x4*)xb)[lane + 64 * j] : va[j]; }
#pragma unroll
              for (int j = 0; j < 4; ++j) { sa += (va[j].x * va[j].x + va[j].y * va[j].y) + (va[j].z * va[j].z + va[j].w * va[j].w); sb += (vb[j].x * vb[j].x + vb[j].y * vb[j].y) + (vb[j].z * vb[j].z + vb[j].w * vb[j].w); }
              const float ra = 1.0f / sqrtf(wave_sum(sa) * (1.0f / DM) + EPS), rb = 1.0f / sqrtf(wave_sum(sb) * (1.0f / DM) + EPS);
#pragma unroll
              for (int j = 0; j < 4; ++j) { const f32x4 g = ((const f32x4*)gain)[lane + 64 * j]; const f32x4 oa = va[j] * ra * g, ob = vb[j] * rb * g;
                  ((unsigned long long*)(XNp + (size_t)row * DM))[lane + 64 * j] = (unsigned long long)pk2(oa.x, oa.y) | ((unsigned long long)pk2(oa.z, oa.w) << 32);
                  if (two) ((unsigned long long*)(XNp + (size_t)(row + 1) * DM))[lane + 64 * j] = (unsigned long long)pk2(ob.x, ob.y) | ((unsigned long long)pk2(ob.z, ob.w) << 32); }
          }
      } else rmsnorm_rows<true>(p.in[0], p.in[1], RP, p.in[7], ws + WS_XN);
    }
}

__device__ __forceinline__ float half_sum(float v, LAS float* red4) {
    v = wave_sum(v);
    __syncthreads();
    if ((threadIdx.x & 63) == 0) red4[(threadIdx.x >> 6) & 3] = v;
    __syncthreads();
    return (red4[0] + red4[1]) + (red4[2] + red4[3]);
}
__device__ __forceinline__ void p_ckv_norm(const Params& p) {
    const int lane = threadIdx.x & 63, gw = blockIdx.x * 8 + __builtin_amdgcn_readfirstlane(threadIdx.x >> 6), NGW = gridDim.x * 8;
    const float* CKV = (const float*)(p.ws + WS_CKV); const float* SSQ = (const float*)(p.ws + WS_SSQ); bf16* KC = (bf16*)(p.ws + WS_KC); bf16* KCS = (bf16*)(p.ws + WS_KCS);
    const float2 g2 = ((const float2*)p.in[22])[lane];
    for (int row = gw; row < R; row += NGW) {
        const float2 v = ((const float2*)(CKV + (size_t)row * KVL))[lane]; const f32x4 sq = *(const f32x4*)(SSQ + (size_t)row * 8 + 4);
        const float rstd = 1.0f / sqrtf(((sq[0] + sq[1]) + (sq[2] + sq[3])) * (1.0f / KVL) + EPS);
        float2 o; o.x = v.x * rstd * g2.x; o.y = v.y * rstd * g2.y;
        if (row < RP) { ((float2*)(p.out + O_KVP + (size_t)row * KVL))[lane] = o; }
        else { ((float2*)(p.out + O_KVS + (size_t)(row - RP) * KVL))[lane] = o; ((unsigned*)(KCS + (size_t)(row - RP) * QD))[lane] = pk2(o.x, o.y); }
    }
}

__device__ __forceinline__ void p_mla_norm(const Params& p, int first_block, int nblocks) {
    const int lane = threadIdx.x & 63, gw = ((int)blockIdx.x - first_block) * 8 + __builtin_amdgcn_readfirstlane(threadIdx.x >> 6), NGW = nblocks * 8;
    bf16* YCp = (bf16*)(p.ws + WS_YC); const float* SSQM = (const float*)(p.ws + WS_SSQM); const float* gm = p.in[26];
    const f32x4 g0 = ((const f32x4*)gm)[2 * lane], g1 = ((const f32x4*)gm)[2 * lane + 1];
    for (int row0 = gw; row0 < RP; row0 += 4 * NGW) {
        v4u w[4]; f32x4 t[4];
#pragma unroll
        for (int i = 0; i < 4; ++i) { const int row = row0 + i * NGW < RP ? row0 + i * NGW : row0;
            w[i] = *((const v4u*)(YCp + (size_t)row * DMIX + DLRU) + lane); const f32x4* sp = (const f32x4*)(SSQM + (size_t)row * NH); t[i] = sp[0] + sp[1]; }
#pragma unroll
        for (int i = 0; i < 4; ++i) { const int row = row0 + i * NGW; if (row < RP) {
            const float rstd = 1.0f / sqrtf(((t[i][0] + t[i][1]) + (t[i][2] + t[i][3])) * (1.0f / DMLA) + EPS); v4u o;
            o.x = pk2(__uint_as_float(w[i].x << 16) * rstd * g0[0], __uint_as_float(w[i].x & 0xffff0000u) * rstd * g0[1]); o.y = pk2(__uint_as_float(w[i].y << 16) * rstd * g0[2], __uint_as_float(w[i].y & 0xffff0000u) * rstd * g0[3]);
            o.z = pk2(__uint_as_float(w[i].z << 16) * rstd * g1[0], __uint_as_float(w[i].z & 0xffff0000u) * rstd * g1[1]); o.w = pk2(__uint_as_float(w[i].w << 16) * rstd * g1[2], __uint_as_float(w[i].w & 0xffff0000u) * rstd * g1[3]);
            *((v4u*)(YCp + (size_t)row * DMIX + DLRU) + lane) = o; } }
    }
}

#define GEMM_PHASE_AT(Epi, shift, Mm, Aptr, Bptr, Nn, Kk, Eobj) do { pg8::Gemm g_{(const pg8::bf16_t*)(Aptr), (const pg8::bf16_t*)(Bptr), (Mm), (Nn), (Kk)}; pg8::StaticOrder S_; S_.init((Mm), (Nn), (int)gridDim.x, (int)((blockIdx.x + gridDim.x - (shift)) % gridDim.x)); \
    pg8::gemm_phase<Epi, pg8::StaticOrder, true, true>((PG8_LAS unsigned char*)lds, g_, S_, (Eobj)); } while (0)
#define GEMM_PHASE(Epi, Mm, Aptr, Bptr, Nn, Kk, Eobj) do { pg8::Gemm g_{(const pg8::bf16_t*)(Aptr), (const pg8::bf16_t*)(Bptr), (Mm), (Nn), (Kk)}; pg8::StaticOrder S_; S_.init((Mm), (Nn), (int)gridDim.x, (int)blockIdx.x); \
    pg8::gemm_phase<Epi, pg8::StaticOrder, true, true>((PG8_LAS unsigned char*)lds, g_, S_, (Eobj)); } while (0)
constexpr int N_PHASES = 13;
__global__ void __launch_bounds__(512, 2) mega(Params p) {
    extern __shared__ __attribute__((aligned(16))) unsigned char lds_raw[];
    LAS unsigned char* lds = (LAS unsigned char*)lds_raw;
    volatile LAS unsigned* MISC = (volatile LAS unsigned*)(lds + MISC_OFF);
    for (int u = threadIdx.x; u < (LDS_BYTES - LDSCTL_OFF) / 4; u += 512) ((LAS unsigned*)(lds + LDSCTL_OFF))[u] = 0u;
    __syncthreads();
    unsigned char* ws = p.ws; float* out = p.out;
    XcdBarrier bar = xcd_barrier_post((unsigned*)(ws + WS_CTL) + CW_BAR, MISC + 8);
    const int lo = p.ph_lo, hi = p.ph_hi;
#ifdef ONLY_PHASE
#define IN(k) ((k) == ONLY_PHASE && lo <= (k) && (k) < hi)
#else
#define IN(k) (lo <= (k) && (k) < hi)
#endif
#ifndef PROBE
#define PROBE -1
#endif
#define SEAM(k) do { if (IN(k) && IN((k) + 1)) { xcd_barrier(bar); if (PROBE == 99) xcd_barrier(bar); } } while (0)
#define REP(id, ...) do { __VA_ARGS__; if (PROBE == (id)) { __syncthreads(); __VA_ARGS__; } } while (0)
#define Wgu1 ((bf16*)(ws + WS_WGU1))
#define Wd1 ((bf16*)(ws + WS_WD1))
#define Wgu2 ((bf16*)(ws + WS_WGU2))
#define Wd2 ((bf16*)(ws + WS_WD2))
#define Win ((bf16*)(ws + WS_WIN))
#define Wout ((bf16*)(ws + WS_WOUT))
#define Wq ((bf16*)(ws + WS_WQ))
#define XN ((bf16*)(ws + WS_XN))
#define H ((bf16*)(ws + WS_H))
#define YC ((bf16*)(ws + WS_YC))
#define Qb ((bf16*)(ws + WS_QB))
#define KC ((bf16*)(ws + WS_KC))
#define PART ((float*)(ws + WS_PART))
#define CKV ((float*)(ws + WS_CKV))
#define SSQ ((float*)(ws + WS_SSQ))
#define SUM ((float*)(ws + WS_SUM))
#define SSQX ((float*)(ws + WS_SSQX))
#define XL ((bf16*)(ws + WS_XL))
#define GG ((bf16*)(ws + WS_GG))
#define CQ ((bf16*)(ws + WS_CQ))
#define KCS ((bf16*)(ws + WS_KCS))
#define WGT ((bf16*)(ws + WS_WGT))
#define WUVF ((bf16*)(ws + WS_WUVF))
#define WqP ((bf16*)(ws + WS_WQP))
#define Wkv ((bf16*)(ws + WS_WKV))
#define QbP ((bf16*)(ws + WS_QBP))
#define KVH ((bf16*)(ws + WS_KVH))
#define CKVB ((bf16*)(ws + WS_CKVB))
#define SSQM ((float*)(ws + WS_SSQM))
    if (IN(0)) REP(0, p_prologue(p, lds));
    SEAM(0);
    if (IN(1)) { pg8::EpiSwiGLU E{H, nullptr, DFF, 0}; REP(1, GEMM_PHASE(pg8::EpiSwiGLU, R, XN, Wgu1, NGU, DM, E));
        { const int G = (int)gridDim.x, nwg1 = (R / 256) * (NGU / 256), rem = nwg1 % G; int fb = rem, nfree = G - rem; if (rem == 0 || nfree < 32) { fb = 0; nfree = G; }
          __syncthreads();
          if ((int)blockIdx.x >= fb) weight_items<1>(p, lds, ((int)blockIdx.x - fb) * 8 + __builtin_amdgcn_readfirstlane(threadIdx.x >> 6), nfree * 8); } }
    SEAM(1);
    if (IN(2)) {
        if (blockIdx.x & 1) for (int mu = blockIdx.x; mu < (RS / 64) * (DM / 64); mu += gridDim.x) { const int r0 = RP + 64 * (mu >> 4), c0 = 64 * (mu & 15);
            sg::unit64((att::ldsp)lds, H, Wd1, DFF, r0, c0, p.in[1] - (size_t)RP * DM, XN, SSQX, 0.5f); }
        { pg8::EpiRes<true> E{p.in[0], XN, SSQX, 0.5f, 0}; GEMM_PHASE(pg8::EpiRes<true>, RP, H, Wd1, DM, DFF, E); }
        if (!(blockIdx.x & 1)) for (int mu = blockIdx.x; mu < (RS / 64) * (DM / 64); mu += gridDim.x) { const int r0 = RP + 64 * (mu >> 4), c0 = 64 * (mu & 15);
            sg::unit64((att::ldsp)lds, H, Wd1, DFF, r0, c0, p.in[1] - (size_t)RP * DM, XN, SSQX, 0.5f); }
    }
    SEAM(2);
    if (IN(4)) { pg8::EpiZ E{XL, GG, CQ, CKV, SSQ, out, KC, KCS, SSQX, CKVB}; REP(4, GEMM_PHASE(pg8::EpiZ, R, XN, Win, DINP, DM, E));
        { const int G = (int)gridDim.x, nwg4 = (R / 256) * (DINP / 256), rem = nwg4 % G; int fb = rem, nfree = G - rem; if (rem == 0 || nfree < 32) { fb = 0; nfree = G; }
          __syncthreads();
          if ((int)blockIdx.x >= fb) weight_items<2>(p, lds, ((int)blockIdx.x - fb) * 8 + __builtin_amdgcn_readfirstlane(threadIdx.x >> 6), nfree * 8); } }
    SEAM(4);
    lru::State st;
    const bool has_chunk = blockIdx.x < NB * NCHUNK;
    const int cb_ = (int)blockIdx.x / NCHUNK, cc_ = (int)blockIdx.x % NCHUNK;
    const size_t crow0 = (size_t)cb_ * SEQ + (size_t)cc_ * CHUNK;
    if (IN(5)) {
        { pg8::EpiQP E{QbP, SSQ, QSCALE, 0}; GEMM_PHASE_AT(pg8::EpiQP, 0, RP, CQ, WqP, NH * 96, QL, E); }
        { pg8::EpiQ E{Qb + (size_t)RP * NH * QD, SSQ + (size_t)RP * 8, QSCALE, 1}; GEMM_PHASE_AT(pg8::EpiQ, 192, RS, CQ + (size_t)RP * QL, Wq, NQ, QL, E); }
        { pg8::EpiKV E{KVH, SSQ, KC}; GEMM_PHASE_AT(pg8::EpiKV, 64, RP, CKVB, Wkv, NH * 128, KVL, E); }
        REP(51, p_ckv_norm(p));
        REP(52, if (has_chunk) lru::unit_pre<false>((att::ldsp)lds, st, XL, WGT, p.in[13], p.in[14], p.in[16], p.in[18], p.in[19], p.in[5], p.in[4], out, crow0, cb_, cc_ * CHUNK, SUM + ((size_t)blockIdx.x * DLRU) * 2));
    }
    SEAM(5);
    if (IN(6)) {
        if (has_chunk) {
            const int ch = (int)threadIdx.x;
            const float cr = lru::chunk_carry(SUM + (size_t)cb_ * NCHUNK * DLRU * 2, cc_, ch);
            if (cc_ == NCHUNK - 1) { const float2 sv = *(const float2*)(SUM + ((size_t)blockIdx.x * DLRU + ch) * 2); out[O_HP + (size_t)cb_ * DLRU + ch] = sv.y + sv.x * cr; }
            const float c0 = __shfl(cr, (int)threadIdx.x & 31), c1 = __shfl(cr, 32 + ((int)threadIdx.x & 31));
            lru::unit_post((att::ldsp)lds, st, GG, p.in[25], YC, crow0, c0, c1);
        }
        if (threadIdx.x == 0) { *(LAS unsigned*)(lds + att2::L_BAR) = 0u; *(LAS unsigned*)(lds + att2::L_BAR + 64) = 0u; }
        __syncthreads();
        { unsigned bt = 0u;
          if (__builtin_amdgcn_readfirstlane(threadIdx.x >> 6) < 4) {
              _Pragma("unroll 1") for (int bx = (int)blockIdx.x; bx < NB * NH * 16; bx += (int)gridDim.x) { const int x = bx & 7, y = (bx >> 3) & 31, bh = x + 8 * (y & 1), pr = y >> 1;
                  _Pragma("unroll 1") for (int u = 0; u < (PROBE == 61 ? 4 : 2); ++u) att2::prompt_role((att::ldsp)lds, QbP, KVH, SSQM, YC, bh >> 3, bh & 7, (u & 1) ? pr : 31 - pr, bt); }
          } else {
              _Pragma("unroll 1") for (int rep_ = 0; rep_ < (PROBE == 62 ? 2 : 1); ++rep_)
              _Pragma("unroll 1") for (int item = blockIdx.x; item < DB * NSPLIT; item += gridDim.x) { const int db = item / NSPLIT, ch = item % NSPLIT;
                  att2::decode_role((att::ldsp)lds, Qb, p.in[2], p.in[3], (const int*)p.in[6], PART + (size_t)item * 2 * att::PART_FLOATS, db, ch * (NPAGES / NSPLIT), NPAGES / NSPLIT, bt); }
          } }
        __syncthreads();
    }
    SEAM(6);
    if (IN(7)) {
        if (blockIdx.x >= DB + RS / 32) p_mla_norm(p, DB + RS / 32, (int)gridDim.x - (DB + RS / 32));
        if (blockIdx.x >= DB && blockIdx.x < DB + RS / 32) {
            lru::State s2; const int su = (int)blockIdx.x - DB; const size_t r0 = (size_t)RP + 32 * su;
            lru::unit_pre<true, 1>((att::ldsp)lds, s2, XL, WGT, p.in[13], p.in[14], p.in[16], p.in[18], p.in[19], p.in[5], p.in[4], out, r0, 4 * su, 0, nullptr);
            lru::unit_post<1>((att::ldsp)lds, s2, GG, p.in[25], YC, r0, 0.f, 0.f);
        }
        REP(7, for (int db = blockIdx.x; db < DB; db += gridDim.x)
            att::decode_combine((att::ldsp)lds, Qb, out + O_KVS, out + O_KRS, PART + (size_t)db * NSPLIT * 2 * att::PART_FLOATS, NSPLIT, p.in[24], p.in[26], YC, db));
    }
    SEAM(7);
    if (IN(8)) {
        { pg8::EpiRes<false> E{nullptr, XN, SSQX, 1.0f, 0}; REP(80, GEMM_PHASE(pg8::EpiRes<false>, RP, YC, Wout, DM, DMIX, E)); }
        for (int mu = blockIdx.x; mu < (RS / 64) * (DM / 64); mu += gridDim.x) { const int r0 = RP + 64 * (mu >> 4), c0 = 64 * (mu & 15);
            sg::unit64((att::ldsp)lds, YC, Wout, DMIX, r0, c0, nullptr, XN, SSQX, 1.0f); }
    }
    SEAM(8);
    if (IN(10)) { pg8::EpiSwiGLU E{H, SSQX, DFF, 0}; REP(10, GEMM_PHASE(pg8::EpiSwiGLU, R, XN, Wgu2, NGU, DM, E)); }
    SEAM(10);
    if (IN(11)) {
        { pg8::EpiFinal E{(const pg8::bf16_t*)XN, out, p.in[32], (float*)(ws + WS_XCH), (unsigned*)(ws + WS_CTL) + CW_FIN, 0.5f, 0}; GEMM_PHASE(pg8::EpiFinal, RP, H, Wd2, DM, DFF, E); }
        for (int mu = blockIdx.x; mu < (RS / 64) * (DM / 64); mu += gridDim.x) { const int r0 = RP + 64 * (mu >> 4), c0 = 64 * (mu & 15);
            sg::unit64((att::ldsp)lds, H, Wd2, DFF, r0, c0, nullptr, XN, (float*)(ws + WS_XCH), 0.5f, out, p.in[32], (unsigned*)(ws + WS_CTL) + CW_FINS + 64 * (mu >> 4)); }
    }
#undef Wgu1
#undef Wd1
#undef Wgu2
#undef Wd2
#undef Win
#undef Wout
#undef Wq
#undef XN
#undef H
#undef YC
#undef Qb
#undef KC
#undef PART
#undef CKV
#undef SSQ
#undef SUM
#undef SSQX
#undef XL
#undef GG
#undef CQ
#undef KCS
#undef WGT
#undef WUVF
#undef WqP
#undef Wkv
#undef QbP
#undef KVH
#undef CKVB
#undef SSQM
#undef IN
#undef SEAM
}

#ifndef MK_N_LAUNCHES
#define MK_N_LAUNCHES 1
#endif
extern "C" void kernel_launch(void* const* d_in, const int* in_sizes, int n_in, void* d_out, int out_size, void* d_ws, size_t ws_size, hipStream_t stream) {
    static int grid = 0;
    if (grid == 0) {
        if (n_in != 33 || out_size != (int)O_END || ws_size < WS_END) { fprintf(stderr, "kernel_launch: unexpected shapes (n_in %d, out %d, ws %zu)\n", n_in, out_size, ws_size); grid = -1; return; }
        int dev = 0, cus = 0, per_cu = 0;
        if (hipGetDevice(&dev) != hipSuccess || hipDeviceGetAttribute(&cus, hipDeviceAttributeMultiprocessorCount, dev) != hipSuccess) { grid = -1; return; }
        if (hipFuncSetAttribute((const void*)mega, hipFuncAttributeMaxDynamicSharedMemorySize, LDS_BYTES) != hipSuccess) { fprintf(stderr, "kernel_launch: hipFuncSetAttribute failed\n"); grid = -1; return; }
        if (hipOccupancyMaxActiveBlocksPerMultiprocessor(&per_cu, (const void*)mega, 512, LDS_BYTES) != hipSuccess || per_cu < 1) fprintf(stderr, "kernel_launch: occupancy query says %d\n", per_cu);
        (void)hipGetLastError();
        grid = cus;
    }
    if (grid < 0) return;
    (void)hipMemsetAsync((char*)d_ws + WS_CTL, 0, CTL_ZERO_BYTES, stream);
    Params prm; memset(&prm, 0, sizeof(prm));
    for (int i = 0; i < 33; ++i) prm.in[i] = (const float*)d_in[i];
    prm.out = (float*)d_out; prm.ws = (unsigned char*)d_ws;
    if (MK_N_LAUNCHES == 1) { prm.ph_lo = 0; prm.ph_hi = N_PHASES; hipLaunchKernelGGL(mega, dim3(grid), dim3(512), LDS_BYTES, stream, prm); }
    else for (int k = 0; k < N_PHASES; ++k) { prm.ph_lo = k; prm.ph_hi = k + 1; hipLaunchKernelGGL(mega, dim3(grid), dim3(512), LDS_BYTES, stream, prm); }
}
```

```cpp
#include <hip/hip_runtime.h>
#include <cstdio>
#include <cstdint>
#include <cstring>
constexpr int DM = 1024, SEQ = 8192, NB = 2, RP = NB * SEQ, DB = 128, DS = 8, RS = DB * DS, R = RP + RS;
constexpr int PAST = 16384, PAGE = 128, NPAGES = PAST / PAGE;
constexpr int DLRU = 512, NBLK = 8, BLK = 64, CONVW = 4;
constexpr int NH = 8, NOPE = 64, ROPE = 32, VD = 64, QL = 256, KVL = 128, DMLA = 512, DMIX = 1024, DIN = 1440, DINP = 1536;
constexpr int DFF = 2816, NGU = 2 * DFF;
constexpr int NQ = NH * KVL + NH * ROPE;
constexpr int QD = KVL + ROPE;
constexpr float EPS = 1e-6f;
constexpr size_t O_YP = 0, O_YS = O_YP + (size_t)RP * DM, O_KVP = O_YS + (size_t)RS * DM, O_KRP = O_KVP + (size_t)RP * KVL, O_HP = O_KRP + (size_t)RP * ROPE,
                 O_CVP = O_HP + (size_t)NB * DLRU, O_KVS = O_CVP + (size_t)NB * 3 * DLRU, O_KRS = O_KVS + (size_t)RS * KVL, O_HS = O_KRS + (size_t)RS * ROPE,
                 O_CVS = O_HS + (size_t)DB * DLRU, O_END = O_CVS + (size_t)DB * 3 * DLRU;
static_assert(O_END == 20877312, "output size");
__device__ const float ROPE_FREQ[16] = {1.000000000e+00f, 5.623413324e-01f, 3.162277639e-01f, 1.778279394e-01f, 1.000000015e-01f, 5.623413250e-02f, 3.162277490e-02f, 1.778279431e-02f,
                                        9.999999776e-03f, 5.623413250e-03f, 3.162277630e-03f, 1.778279431e-03f, 1.000000047e-03f, 5.623413017e-04f, 3.162277571e-04f, 1.778279402e-04f};
namespace pg8 {
#define PG8_LAS __attribute__((address_space(3)))
typedef unsigned short bf16_t;
typedef short bf16x8 __attribute__((ext_vector_type(8)));
typedef float f32x4 __attribute__((ext_vector_type(4)));
typedef unsigned u32x4 __attribute__((ext_vector_type(4)));
constexpr int BM = 256, BK = 64, HALF = 128, HTB = HALF * BK * 2  , STAGE_BYTES = 8 * HTB, NXCD = 8, WGM = 8;

__host__ __device__ __forceinline__ int lds_byte(int r, int c) { const int st = (r >> 4) * 2 + (c >> 5), rr = r & 15, cc = c & 31, ob = rr * 64 + cc * 2; return st * 1024 + (ob ^ (((ob >> 9) & 1) << 5)); }
__host__ __device__ __forceinline__ void stage_rc(int b, int& R, int& C) { const int st = b / 1024, sb = b % 1024, swz = sb ^ (((sb >> 9) & 1) << 5); R = (st >> 1) * 16 + swz / 64; C = (st & 1) * 32 + (swz % 64) / 2; }
__host__ __device__ __forceinline__ int perm32(int rho) { const int n = rho >> 4, i = rho & 15; return 8 * (i >> 2) + 4 * n + (i & 3); }

struct Unit { int pm, pn; };
struct Gemm { const bf16_t* A; const bf16_t* Bt; int M, N, K; };

struct StaticOrder {
    int nM, nN, nwg, G, c;
    __host__ __device__ void init(int M, int N, int G_, int c_) { nM = M / BM; nN = N / BM; nwg = nM * nN; G = G_; c = c_; }
    __host__ __device__ bool next(int i, Unit& u) const {
        const long L = (long)i * G + c; if (L >= nwg) return false;
        int wgid = (int)L; { const int q = nwg / NXCD, r = nwg % NXCD, xcd = wgid % NXCD, off = wgid / NXCD; wgid = (xcd < r ? xcd * (q + 1) : r * (q + 1) + (xcd - r) * q) + off; }
        const int nig = WGM * nN, gid = wgid / nig, fm = gid * WGM, gsz = (nM - fm) < WGM ? (nM - fm) : WGM;
        u.pm = fm + ((wgid % nig) % gsz); u.pn = (wgid % nig) / gsz; return true;
    }
    __device__ __forceinline__ void a_ready(const Unit&) const {}
    __device__ __forceinline__ void done(const Unit&) const {}
};

__device__ __forceinline__ unsigned cvt_pk_bf16(float lo, float hi) { unsigned r; asm volatile("v_cvt_pk_bf16_f32 %0, %1, %2" : "=v"(r) : "v"(lo), "v"(hi)); return r; }
typedef float f32x2 __attribute__((ext_vector_type(2)));
typedef float f32x2 __attribute__((ext_vector_type(2)));
template <class Epi, class Sched, bool ALIGN_EPI = false, bool SP2 = false>
__device__ __forceinline__ void gemm_phase(PG8_LAS unsigned char* lds, const Gemm g, const Sched& S, const Epi& E) {
    int tid_ = threadIdx.x; asm volatile("" : "+v"(tid_));
    const int tid = tid_, wid = __builtin_amdgcn_readfirstlane(tid >> 6), lane = tid & 63, wr = wid >> 2, wc = wid & 3, fr = lane & 15, fq = lane >> 4;
    const int K = g.K, nt = K / BK;
    unsigned voffA[2], voffB[2];
#pragma unroll
    for (int i = 0; i < 2; ++i) { int R, C; stage_rc(tid * 16 + i * 8192, R, C); const int Rb = Epi::PERM ? ((R & ~31) + perm32(R & 31)) : R;
        voffA[i] = (unsigned)(R * K + C) * 2u; voffB[i] = (unsigned)(Rb * K + C) * 2u; }
    const size_t kstep = (size_t)(BK * 2);
    const size_t hstep = (size_t)HALF * K * 2;
    const size_t tstep = 2 * hstep;
    const unsigned ldsw = (unsigned)wid * 1024u;
    const int aoff = lds_byte(wr * 64 + fr, fq * 8), boff = lds_byte(wc * 32 + fr, fq * 8);
#define PG8_SA(b, h) (((b) * 2 + (h)) * HTB)
#define PG8_SB(b, h) ((4 + (b) * 2 + (h)) * HTB)
#define PG8_STAGE(bufoff, gbase, voff) do { _Pragma("unroll") for (int _i = 0; _i < 2; ++_i) \
        __builtin_amdgcn_global_load_lds((const unsigned*)((const char*)(gbase) + (voff)[_i]), (PG8_LAS unsigned*)(lds + (bufoff) + ldsw + _i * 8192), 16, 0, 0); } while (0)
#define PG8_LDA(dst, b, h) do { _Pragma("unroll") for (int m = 0; m < 4; ++m) _Pragma("unroll") for (int k = 0; k < 2; ++k) dst[m][k] = *(const PG8_LAS bf16x8*)(lds + PG8_SA(b, h) + aoff + m * 2048 + k * 1024); } while (0)
#define PG8_LDB(dst, b, h) do { _Pragma("unroll") for (int n = 0; n < 2; ++n) _Pragma("unroll") for (int k = 0; k < 2; ++k) dst[n][k] = *(const PG8_LAS bf16x8*)(lds + PG8_SB(b, h) + boff + n * 2048 + k * 1024); } while (0)
#define PG8_MMA(ai, bj, At, Bt) do { __builtin_amdgcn_s_setprio(1); _Pragma("unroll") for (int m = 0; m < 4; ++m) _Pragma("unroll") for (int n = 0; n < 2; ++n) _Pragma("unroll") for (int k = 0; k < 2; ++k) \
        acc[ai][bj][m][n] = __builtin_amdgcn_mfma_f32_16x16x32_bf16(Bt[n][k], At[m][k], acc[ai][bj][m][n], 0, 0, 0); __builtin_amdgcn_s_setprio(0); } while (0)
#define PG8_WAIT_V(n) asm volatile("s_waitcnt vmcnt(" #n ")" ::: "memory")
#define PG8_WAIT_L(n) asm volatile("s_waitcnt lgkmcnt(" #n ")" ::: "memory")
#define PG8_BAR __builtin_amdgcn_s_barrier()
#define PG8_SCHED __builtin_amdgcn_sched_barrier(0)
    Unit cur, nxt; int ui = 0;
    if (!S.next(0, cur)) return;
    f32x4 acc[2][2][4][2];
#pragma unroll
    for (int a = 0; a < 2; ++a)
#pragma unroll
        for (int b = 0; b < 2; ++b)
#pragma unroll
            for (int m = 0; m < 4; ++m)
#pragma unroll
                for (int n = 0; n < 2; ++n) acc[a][b][m][n] = (f32x4){0.f, 0.f, 0.f, 0.f};
    bf16x8 At[4][2], B0[2][2], B1[2][2];
    const char* cA = (const char*)g.A + (size_t)cur.pm * tstep; const char* cB = (const char*)g.Bt + (size_t)cur.pn * tstep;
    S.a_ready(cur);
    if constexpr (SP2) {
        PG8_STAGE(PG8_SB(0, 0), cB, voffB); PG8_STAGE(PG8_SB(0, 1), cB + hstep, voffB); PG8_STAGE(PG8_SA(0, 0), cA, voffA); PG8_STAGE(PG8_SA(0, 1), cA + hstep, voffA);
        if (wr == 1) PG8_BAR;
        PG8_WAIT_V(2); PG8_BAR;
        PG8_STAGE(PG8_SB(1, 0), cB + kstep, voffB); PG8_STAGE(PG8_SA(1, 0), cA + kstep, voffA); PG8_STAGE(PG8_SB(1, 1), cB + hstep + kstep, voffB);
        PG8_WAIT_V(6); PG8_BAR;
    } else {
        PG8_STAGE(PG8_SB(0, 0), cB, voffB); PG8_STAGE(PG8_SA(0, 0), cA, voffA); PG8_STAGE(PG8_SB(0, 1), cB + hstep, voffB); PG8_STAGE(PG8_SA(0, 1), cA + hstep, voffA);
        if (wr == 1) PG8_BAR;
        PG8_WAIT_V(4); PG8_BAR;
        PG8_STAGE(PG8_SB(1, 0), cB + kstep, voffB); PG8_STAGE(PG8_SA(1, 0), cA + kstep, voffA); PG8_STAGE(PG8_SB(1, 1), cB + hstep + kstep, voffB);
        PG8_WAIT_V(6); PG8_BAR;
    }
    for (;;) {
        const bool has_next = S.next(ui + 1, nxt);
        const char* nA = has_next ? (const char*)g.A + (size_t)nxt.pm * tstep : cA; const char* nB = has_next ? (const char*)g.Bt + (size_t)nxt.pn * tstep : cB;
        for (int t = 0; t < nt; t += 2) {
            const bool last = (t == nt - 2);
            const char* a1 = cA + (size_t)(t + 1) * kstep;
            const char* a2 = last ? nA : cA + (size_t)(t + 2) * kstep; const char* b2 = last ? nB : cB + (size_t)(t + 2) * kstep;
            const char* a3 = a2 + kstep; const char* b3 = b2 + kstep;
            if (last && has_next) S.a_ready(nxt);
            if constexpr (SP2) {
            PG8_LDB(B0, 0, 0); PG8_LDB(B1, 0, 1); PG8_SCHED; PG8_LDA(At, 0, 0); PG8_STAGE(PG8_SA(1, 1), a1 + hstep, voffA);
            PG8_WAIT_V(8); PG8_WAIT_L(0); PG8_BAR; PG8_MMA(0, 0, At, B0); PG8_MMA(0, 1, At, B1); PG8_BAR; PG8_SCHED;
            PG8_LDA(At, 0, 1); PG8_STAGE(PG8_SB(0, 0), b2, voffB); PG8_STAGE(PG8_SB(0, 1), b2 + hstep, voffB); PG8_STAGE(PG8_SA(0, 0), a2, voffA);
            PG8_WAIT_V(8); PG8_WAIT_L(0); PG8_BAR; PG8_MMA(1, 0, At, B0); PG8_MMA(1, 1, At, B1); PG8_BAR; PG8_SCHED;
            PG8_LDB(B0, 1, 0); PG8_LDB(B1, 1, 1); PG8_SCHED; PG8_LDA(At, 1, 0); PG8_STAGE(PG8_SA(0, 1), a2 + hstep, voffA);
            PG8_WAIT_V(8); PG8_WAIT_L(0); PG8_BAR; PG8_MMA(0, 0, At, B0); PG8_MMA(0, 1, At, B1); PG8_BAR; PG8_SCHED;
            PG8_LDA(At, 1, 1); PG8_STAGE(PG8_SB(1, 0), b3, voffB); PG8_STAGE(PG8_SB(1, 1), b3 + hstep, voffB); PG8_STAGE(PG8_SA(1, 0), a3, voffA);
            PG8_WAIT_V(8); PG8_WAIT_L(0); PG8_BAR; PG8_MMA(1, 0, At, B0); PG8_MMA(1, 1, At, B1); PG8_BAR; PG8_SCHED;
            } else {
            PG8_LDB(B0, 0, 0); PG8_SCHED; PG8_LDA(At, 0, 0); PG8_STAGE(PG8_SA(1, 1), a1 + hstep, voffA);
            PG8_WAIT_L(8); PG8_BAR; PG8_WAIT_L(0); PG8_MMA(0, 0, At, B0); PG8_BAR; PG8_SCHED;
            PG8_LDB(B1, 0, 1); PG8_STAGE(PG8_SB(0, 0), b2, voffB);
            PG8_BAR; PG8_WAIT_L(0); PG8_MMA(0, 1, At, B1); PG8_BAR;
            PG8_LDA(At, 0, 1); PG8_STAGE(PG8_SA(0, 0), a2, voffA);
            PG8_BAR; PG8_WAIT_L(0); PG8_MMA(1, 0, At, B0); PG8_BAR; PG8_SCHED;
            PG8_STAGE(PG8_SB(0, 1), b2 + hstep, voffB);
            PG8_WAIT_V(6); PG8_BAR; PG8_MMA(1, 1, At, B1); PG8_BAR;
            PG8_LDB(B0, 1, 0); PG8_SCHED; PG8_LDA(At, 1, 0); PG8_STAGE(PG8_SA(0, 1), a2 + hstep, voffA);
            PG8_WAIT_L(8); PG8_BAR; PG8_WAIT_L(0); PG8_MMA(0, 0, At, B0); PG8_BAR; PG8_SCHED;
            PG8_LDB(B1, 1, 1); PG8_STAGE(PG8_SB(1, 0), b3, voffB);
            PG8_BAR; PG8_WAIT_L(0); PG8_MMA(0, 1, At, B1); PG8_BAR;
            PG8_LDA(At, 1, 1); PG8_STAGE(PG8_SA(1, 0), a3, voffA);
            PG8_BAR; PG8_WAIT_L(0); PG8_MMA(1, 0, At, B0); PG8_BAR; PG8_SCHED;
            PG8_STAGE(PG8_SB(1, 1), b3 + hstep, voffB);
            PG8_WAIT_V(6); PG8_BAR; PG8_MMA(1, 1, At, B1); PG8_BAR;
            }
        }
        if constexpr (ALIGN_EPI) { if (wr == 0) PG8_BAR; }
        if constexpr (!Epi::AFTER_DRAIN) { E(acc, cur, wr, wc, fr, fq); S.done(cur); }
        if (!has_next) break;
#pragma unroll
        for (int a = 0; a < 2; ++a)
#pragma unroll
            for (int b = 0; b < 2; ++b)
#pragma unroll
                for (int m = 0; m < 4; ++m)
#pragma unroll
                    for (int n = 0; n < 2; ++n) acc[a][b][m][n] = (f32x4){0.f, 0.f, 0.f, 0.f};
        cur = nxt; cA = nA; cB = nB; ++ui;
        if constexpr (ALIGN_EPI) { if (wr == 1) PG8_BAR; }
    }
    PG8_WAIT_V(0);
    if constexpr (!ALIGN_EPI) { if (wr == 0) PG8_BAR; }
    PG8_BAR;
    if constexpr (Epi::AFTER_DRAIN) { E.fused(acc, cur, wr, wc, fr, fq, lds, wid, lane); S.done(cur); }
#undef PG8_SA
#undef PG8_SB
#undef PG8_STAGE
#undef PG8_LDA
#undef PG8_LDB
#undef PG8_MMA
#undef PG8_WAIT_V
#undef PG8_WAIT_L
#undef PG8_BAR
#undef PG8_SCHED
}
}
namespace pg8 {
struct EpiF32 {
    static constexpr bool PERM = false, AFTER_DRAIN = false;
    float* out; const float* base0; const float* base1; int ldc; int split; float alpha; int pad;
    __device__ __forceinline__ void operator()(const f32x4 (&acc)[2][2][4][2], const Unit& u, int wr, int wc, int fr, int fq) const {
        const int col0 = u.pn * BM + wc * 32 + 4 * fq;
        const float* bp = nullptr;
        if (base0) bp = (u.pm < split) ? base0 + (size_t)u.pm * BM * ldc : base1 + (size_t)(u.pm - split) * BM * ldc;
#pragma unroll
        for (int ai = 0; ai < 2; ++ai)
#pragma unroll
            for (int m = 0; m < 4; ++m) { const int rt = ai * HALF + wr * 64 + m * 16 + fr; const size_t off = (size_t)rt * ldc + col0;
                float* orow = out + (size_t)u.pm * BM * ldc + off;
#pragma unroll
                for (int bj = 0; bj < 2; ++bj)
#pragma unroll
                    for (int n = 0; n < 2; ++n) { f32x4 v = acc[ai][bj][m][n] * alpha; if (bp) v = v + *(const f32x4*)(bp + off + bj * HALF + n * 16);
                        *(f32x4*)(orow + bj * HALF + n * 16) = v; } }
    }
};
struct EpiSwiGLU {
    static constexpr bool PERM = true, AFTER_DRAIN = false;
    bf16_t* H; const float* SSQX; int ldh; int pad;
    __device__ __forceinline__ void operator()(const f32x4 (&acc)[2][2][4][2], const Unit& u, int wr, int wc, int fr, int fq) const {
        const int col0 = u.pn * HALF + wc * 32 + 8 * fq;
#pragma unroll
        for (int ai = 0; ai < 2; ++ai)
#pragma unroll
            for (int m = 0; m < 4; ++m) { const int row = u.pm * BM + ai * HALF + wr * 64 + m * 16 + fr; bf16_t* rowp = H + (size_t)row * ldh + col0;
                float rs = 1.0f;
                if (SSQX) { const f32x4* sp = (const f32x4*)(SSQX + (size_t)row * 16); const f32x4 s0 = sp[0], s1 = sp[1], s2 = sp[2], s3 = sp[3]; const f32x4 t = (s0 + s1) + (s2 + s3);
                    rs = __builtin_amdgcn_rsqf(((t[0] + t[1]) + (t[2] + t[3])) * (1.0f / 1024.0f) + 1e-6f); }
                float hv[8];
#pragma unroll
                for (int n = 0; n < 2; ++n)
#pragma unroll
                    for (int i = 0; i < 4; ++i) { const float g = acc[ai][0][m][n][i] * rs, up = acc[ai][1][m][n][i] * rs;
                        hv[4 * n + i] = g * __builtin_amdgcn_rcpf(1.0f + __builtin_amdgcn_exp2f(-1.4426950408889634f * g)) * up; }
                u32x4 w; w.x = cvt_pk_bf16(hv[0], hv[1]); w.y = cvt_pk_bf16(hv[2], hv[3]); w.z = cvt_pk_bf16(hv[4], hv[5]); w.w = cvt_pk_bf16(hv[6], hv[7]);
                *(u32x4*)rowp = w; }
    }
};
template <bool BASE_F32> struct EpiRes {
    static constexpr bool PERM = false, AFTER_DRAIN = false;
    const float* basef; bf16_t* Xb; float* SSQX; float alpha; int pad;
    __device__ __forceinline__ void operator()(const f32x4 (&acc)[2][2][4][2], const Unit& u, int wr, int wc, int fr, int fq) const {
        typedef unsigned u32x2 __attribute__((ext_vector_type(2)));
        constexpr int ldc = 1024;
        const int col0 = u.pn * BM + wc * 32 + 4 * fq;
#pragma unroll
        for (int ai = 0; ai < 2; ++ai)
#pragma unroll
            for (int m = 0; m < 4; ++m) { const size_t row = (size_t)u.pm * BM + ai * HALF + wr * 64 + m * 16 + fr; float ss = 0.f;
#pragma unroll
                for (int bj = 0; bj < 2; ++bj)
#pragma unroll
                    for (int n = 0; n < 2; ++n) { const size_t off = row * ldc + col0 + bj * HALF + n * 16; f32x4 bv;
                        if (BASE_F32) bv = *(const f32x4*)(basef + off);
                        else { const u32x2 bw = *(const u32x2*)(Xb + off); bv[0] = __uint_as_float(bw.x << 16); bv[1] = __uint_as_float(bw.x & 0xffff0000u); bv[2] = __uint_as_float(bw.y << 16); bv[3] = __uint_as_float(bw.y & 0xffff0000u); }
                        const f32x4 v = acc[ai][bj][m][n] * alpha + bv;
                        u32x2 w; w.x = cvt_pk_bf16(v[0], v[1]); w.y = cvt_pk_bf16(v[2], v[3]); *(u32x2*)(Xb + off) = w;
                        ss += (v[0] * v[0] + v[1] * v[1]) + (v[2] * v[2] + v[3] * v[3]); }
                ss += __shfl_xor(ss, 16); ss += __shfl_xor(ss, 32); if (fq == 0) SSQX[row * 16 + u.pn * 4 + wc] = ss; }
    }
};
struct EpiFinal {
    static constexpr bool PERM = false, AFTER_DRAIN = true;
    const bf16_t* Xb; float* out; const float* gain; float* xch; unsigned* cnt; float alpha; int pad;
    __device__ __forceinline__ void fused(f32x4 (&acc)[2][2][4][2], const Unit& u, int wr, int wc, int fr, int fq, PG8_LAS unsigned char* lds, int wid, int lane) const {
        typedef unsigned u32x2 __attribute__((ext_vector_type(2)));
        constexpr int ldc = 1024;
        PG8_LAS float* S = (PG8_LAS float*)(lds + 8192);
        const int col0 = u.pn * BM + wc * 32 + 4 * fq;
        float ssv[2][4];
        {
            u32x2 bw[2][4][2][2];
#pragma unroll
            for (int ai = 0; ai < 2; ++ai)
#pragma unroll
                for (int m = 0; m < 4; ++m) { const size_t row = (size_t)u.pm * BM + ai * HALF + wr * 64 + m * 16 + fr;
#pragma unroll
                    for (int bj = 0; bj < 2; ++bj)
#pragma unroll
                        for (int n = 0; n < 2; ++n) bw[ai][m][bj][n] = *(const u32x2*)(Xb + row * ldc + col0 + bj * HALF + n * 16); }
#pragma unroll
            for (int ai = 0; ai < 2; ++ai)
#pragma unroll
                for (int m = 0; m < 4; ++m) { float ss = 0.f;
#pragma unroll
                    for (int bj = 0; bj < 2; ++bj)
#pragma unroll
                        for (int n = 0; n < 2; ++n) { const u32x2 w_ = bw[ai][m][bj][n]; f32x4 bv;
                            bv[0] = __uint_as_float(w_.x << 16); bv[1] = __uint_as_float(w_.x & 0xffff0000u); bv[2] = __uint_as_float(w_.y << 16); bv[3] = __uint_as_float(w_.y & 0xffff0000u);
                            const f32x4 v = acc[ai][bj][m][n] * alpha + bv; acc[ai][bj][m][n] = v;
                            ss += (v[0] * v[0] + v[1] * v[1]) + (v[2] * v[2] + v[3] * v[3]); }
                    ss += __shfl_xor(ss, 16); ss += __shfl_xor(ss, 32); ssv[ai][m] = ss; } }
        if (fq == 0) {
#pragma unroll
            for (int ai = 0; ai < 2; ++ai)
#pragma unroll
                for (int m = 0; m < 4; ++m) { const size_t row = (size_t)u.pm * BM + ai * HALF + wr * 64 + m * 16 + fr;
                    __hip_atomic_store(xch + row * 16 + u.pn * 4 + wc, ssv[ai][m], __ATOMIC_RELAXED, __HIP_MEMORY_SCOPE_AGENT); } }
        asm volatile("s_waitcnt vmcnt(0)" ::: "memory");
        if (lane == 0) __hip_atomic_fetch_add(cnt + 64 * u.pm, 1u, __ATOMIC_RELAXED, __HIP_MEMORY_SCOPE_AGENT);
        if (wid == 0) { unsigned sp = 0u;
            while ((unsigned)__builtin_amdgcn_readfirstlane(__hip_atomic_load(cnt + 64 * u.pm, __ATOMIC_RELAXED, __HIP_MEMORY_SCOPE_AGENT)) < 32u) { __builtin_amdgcn_s_sleep(2); if (++sp > (1u << 22)) break; }
            __builtin_amdgcn_fence(__ATOMIC_ACQUIRE, "agent"); }
        asm volatile("s_waitcnt vmcnt(0) lgkmcnt(0)" ::: "memory"); __builtin_amdgcn_s_barrier(); asm volatile("" ::: "memory");
        if (lane < 32) { const int r = wid * 32 + lane; const unsigned long long* sl = (const unsigned long long*)(xch + ((size_t)u.pm * BM + r) * 16); float t = 0.f;
#pragma unroll
            for (int j = 0; j < 8; ++j) { const unsigned long long w = __hip_atomic_load(sl + j, __ATOMIC_RELAXED, __HIP_MEMORY_SCOPE_AGENT); t += __uint_as_float((unsigned)w) + __uint_as_float((unsigned)(w >> 32)); }
            S[r] = 1.0f / sqrtf(t * (1.0f / 1024.0f) + 1e-6f); }
        asm volatile("s_waitcnt lgkmcnt(0)" ::: "memory"); __builtin_amdgcn_s_barrier(); asm volatile("" ::: "memory");
        f32x4 gv[2][2];
#pragma unroll
        for (int bj = 0; bj < 2; ++bj)
#pragma unroll
            for (int n = 0; n < 2; ++n) gv[bj][n] = *(const f32x4*)(gain + col0 + bj * HALF + n * 16);
#pragma unroll
        for (int ai = 0; ai < 2; ++ai)
#pragma unroll
            for (int m = 0; m < 4; ++m) { const int r = ai * HALF + wr * 64 + m * 16 + fr; const float rs = S[r]; float* op = out + ((size_t)u.pm * BM + r) * ldc + col0;
#pragma unroll
                for (int bj = 0; bj < 2; ++bj)
#pragma unroll
                    for (int n = 0; n < 2; ++n) *(f32x4*)(op + bj * HALF + n * 16) = acc[ai][bj][m][n] * rs * gv[bj][n]; }
    }
};
}
namespace pg8 {
__device__ __forceinline__ void rope_cs_e(int pos, int i, float& c, float& s) {
    const float ang = (float)pos * ROPE_FREQ[i];
    const double q4 = (double)ang * 0.6366197723675814; const double qr = rint(q4);
    const float r = (float)((q4 - qr) * 1.5707963267948966); const int qi = ((int)qr) & 3; const float r2 = r * r;
    const float sn = r * (1.0f + r2 * (-1.6666667e-1f + r2 * (8.3333333e-3f + r2 * (-1.9841270e-4f + r2 * 2.7557319e-6f))));
    const float cs = 1.0f + r2 * (-0.5f + r2 * (4.1666667e-2f + r2 * (-1.3888889e-3f + r2 * (2.4801587e-5f + r2 * -2.7557319e-7f))));
    c = (qi == 0) ? cs : (qi == 1) ? -sn : (qi == 2) ? -cs : sn;
    s = (qi == 0) ? sn : (qi == 1) ? cs : (qi == 2) ? -sn : -cs;
}
__device__ __forceinline__ float gelu_e(float x) { const float y = 0.7978845608028654f * (x + 0.044715f * x * x * x); return x * __builtin_amdgcn_rcpf(1.0f + __builtin_amdgcn_exp2f(-2.8853900817779268f * y)); }
typedef unsigned u32x2 __attribute__((ext_vector_type(2)));
struct EpiZ {
    static constexpr bool PERM = false, AFTER_DRAIN = false;
    bf16_t* XL; bf16_t* GG; bf16_t* CQ; float* CKV; float* SSQ; float* out; bf16_t* KC; bf16_t* KCS; const float* SSQX; bf16_t* CKVB;
    __device__ __forceinline__ void operator()(const f32x4 (&acc0)[2][2][4][2], const Unit& u, int wr, int wc, int fr, int fq) const {
        const int pn = u.pn;
#pragma unroll
        for (int ai = 0; ai < 2; ++ai)
#pragma unroll
            for (int m = 0; m < 4; ++m) { const int row = u.pm * BM + ai * HALF + wr * 64 + m * 16 + fr;
                f32x4 acc[2][2][4][2];
                { const f32x4* sp = (const f32x4*)(SSQX + (size_t)row * 16); const f32x4 s0 = sp[0], s1 = sp[1], s2 = sp[2], s3 = sp[3]; const f32x4 t = (s0 + s1) + (s2 + s3);
                  const float rs = __builtin_amdgcn_rsqf(((t[0] + t[1]) + (t[2] + t[3])) * (1.0f / 1024.0f) + 1e-6f);
#pragma unroll
                  for (int bj = 0; bj < 2; ++bj)
#pragma unroll
                      for (int n = 0; n < 2; ++n) acc[ai][bj][m][n] = acc0[ai][bj][m][n] * rs; }
                if (pn < 4) { bf16_t* dst = (pn < 2 ? XL : GG) + (size_t)row * 512 + (pn & 1) * 256 + wc * 32 + 4 * fq;
#pragma unroll
                    for (int bj = 0; bj < 2; ++bj)
#pragma unroll
                        for (int n = 0; n < 2; ++n) { f32x4 v = acc[ai][bj][m][n]; if (pn >= 2) { v[0] = gelu_e(v[0]); v[1] = gelu_e(v[1]); v[2] = gelu_e(v[2]); v[3] = gelu_e(v[3]); }
                            u32x2 w; w.x = cvt_pk_bf16(v[0], v[1]); w.y = cvt_pk_bf16(v[2], v[3]); *(u32x2*)(dst + bj * HALF + n * 16) = w; } }
                else if (pn == 4) { bf16_t* dst = CQ + (size_t)row * 256 + wc * 32 + 4 * fq; float ss = 0.f;
#pragma unroll
                    for (int bj = 0; bj < 2; ++bj)
#pragma unroll
                        for (int n = 0; n < 2; ++n) { const f32x4 v = acc[ai][bj][m][n]; ss += (v[0] * v[0] + v[1] * v[1]) + (v[2] * v[2] + v[3] * v[3]);
                            u32x2 w; w.x = cvt_pk_bf16(v[0], v[1]); w.y = cvt_pk_bf16(v[2], v[3]); *(u32x2*)(dst + bj * HALF + n * 16) = w; }
                    ss += __shfl_xor(ss, 16); ss += __shfl_xor(ss, 32);
                    if (fq == 0) SSQ[(size_t)row * 8 + wc] = ss; }
                else { float* dst = CKV + (size_t)row * 128 + wc * 32 + 4 * fq; float ss = 0.f;
#pragma unroll
                    for (int n = 0; n < 2; ++n) { const f32x4 v = acc[ai][0][m][n]; ss += (v[0] * v[0] + v[1] * v[1]) + (v[2] * v[2] + v[3] * v[3]); *(f32x4*)(dst + n * 16) = v;
                        u32x2 w; w.x = cvt_pk_bf16(v[0], v[1]); w.y = cvt_pk_bf16(v[2], v[3]); *(u32x2*)(CKVB + (size_t)row * 128 + wc * 32 + 4 * fq + n * 16) = w; }
                    ss += __shfl_xor(ss, 16); ss += __shfl_xor(ss, 32);
                    if (fq == 0) SSQ[(size_t)row * 8 + 4 + wc] = ss;
                    if (wc == 0) { const bool prompt = row < 16384; const int pos = prompt ? (row & 8191) : 16384 + ((row - 16384) & 7);
                        float* ko = prompt ? out + O_KRP + (size_t)row * 32 : out + O_KRS + (size_t)(row - 16384) * 32;
                        bf16_t* kb = prompt ? KC + (size_t)row * 160 + 128 : KCS + (size_t)(row - 16384) * 160 + 128;
                        const f32x4 x1 = acc[ai][1][m][0], x2 = acc[ai][1][m][1]; f32x4 o1, o2;
#pragma unroll
                        for (int i = 0; i < 4; ++i) { float c, s; rope_cs_e(pos, 4 * fq + i, c, s); o1[i] = x1[i] * c - x2[i] * s; o2[i] = x2[i] * c + x1[i] * s; }
                        *(f32x4*)(ko + 4 * fq) = o1; *(f32x4*)(ko + 16 + 4 * fq) = o2;
                        u32x2 w1, w2; w1.x = cvt_pk_bf16(o1[0], o1[1]); w1.y = cvt_pk_bf16(o1[2], o1[3]); w2.x = cvt_pk_bf16(o2[0], o2[1]); w2.y = cvt_pk_bf16(o2[2], o2[3]);
                        *(u32x2*)(kb + 4 * fq) = w1; *(u32x2*)(kb + 16 + 4 * fq) = w2; } }
            }
    }
};
struct EpiQ {
    static constexpr bool PERM = false, AFTER_DRAIN = false;
    bf16_t* Qb; const float* SSQ; float qscale; int sample;
    __device__ __forceinline__ void operator()(const f32x4 (&acc)[2][2][4][2], const Unit& u, int wr, int wc, int fr, int fq) const {
        const int pn = u.pn;
#pragma unroll
        for (int ai = 0; ai < 2; ++ai)
#pragma unroll
            for (int m = 0; m < 4; ++m) { const int row = u.pm * BM + ai * HALF + wr * 64 + m * 16 + fr;
                const f32x4 sq = *(const f32x4*)(SSQ + (size_t)row * 8);
                const float sc = qscale * __builtin_amdgcn_rsqf(((sq[0] + sq[1]) + (sq[2] + sq[3])) * (1.0f / 256.0f) + 1e-6f);
                if (pn < 4) {
#pragma unroll
                    for (int bj = 0; bj < 2; ++bj) { bf16_t* dst = Qb + ((size_t)row * 8 + 2 * pn + bj) * 160 + wc * 32 + 4 * fq;
#pragma unroll
                        for (int n = 0; n < 2; ++n) { const f32x4 v = acc[ai][bj][m][n] * sc; u32x2 w; w.x = cvt_pk_bf16(v[0], v[1]); w.y = cvt_pk_bf16(v[2], v[3]); *(u32x2*)(dst + n * 16) = w; } } }
                else { const int pos = sample ? 16384 + (row & 7) : (row & 8191);
                    float cs[4], sn[4];
#pragma unroll
                    for (int i = 0; i < 4; ++i) rope_cs_e(pos, 4 * fq + i, cs[i], sn[i]);
#pragma unroll
                    for (int bj = 0; bj < 2; ++bj) { bf16_t* dst = Qb + ((size_t)row * 8 + 4 * bj + wc) * 160 + 128 + 4 * fq;
                        const f32x4 x1 = acc[ai][bj][m][0] * sc, x2 = acc[ai][bj][m][1] * sc; f32x4 o1, o2;
#pragma unroll
                        for (int i = 0; i < 4; ++i) { o1[i] = x1[i] * cs[i] - x2[i] * sn[i]; o2[i] = x2[i] * cs[i] + x1[i] * sn[i]; }
                        u32x2 w1, w2; w1.x = cvt_pk_bf16(o1[0], o1[1]); w1.y = cvt_pk_bf16(o1[2], o1[3]); w2.x = cvt_pk_bf16(o2[0], o2[1]); w2.y = cvt_pk_bf16(o2[2], o2[3]);
                        *(u32x2*)dst = w1; *(u32x2*)(dst + 16) = w2; } }
            }
    }
};
struct EpiQP {
    static constexpr bool PERM = false, AFTER_DRAIN = false;
    bf16_t* Qb; const float* SSQ; float qscale; int pad;
    __device__ __forceinline__ void operator()(const f32x4 (&acc)[2][2][4][2], const Unit& u, int wr, int wc, int fr, int fq) const {
        const int pn = u.pn;
#pragma unroll
        for (int ai = 0; ai < 2; ++ai)
#pragma unroll
            for (int m = 0; m < 4; ++m) { const int row = u.pm * BM + ai * HALF + wr * 64 + m * 16 + fr;
                const f32x4 sq = *(const f32x4*)(SSQ + (size_t)row * 8);
                const float sc = qscale * __builtin_amdgcn_rsqf(((sq[0] + sq[1]) + (sq[2] + sq[3])) * (1.0f / 256.0f) + 1e-6f);
                if (pn < 2) {
#pragma unroll
                    for (int bj = 0; bj < 2; ++bj) { bf16_t* dst = Qb + ((size_t)row * 8 + 4 * pn + 2 * bj + (wc >> 1)) * 96 + 32 * (wc & 1) + 4 * fq;
#pragma unroll
                        for (int n = 0; n < 2; ++n) { const f32x4 v = acc[ai][bj][m][n] * sc; u32x2 w; w.x = cvt_pk_bf16(v[0], v[1]); w.y = cvt_pk_bf16(v[2], v[3]); *(u32x2*)(dst + n * 16) = w; } } }
                else { const int pos = row & 8191;
                    float cs[4], sn[4];
#pragma unroll
                    for (int i = 0; i < 4; ++i) rope_cs_e(pos, 4 * fq + i, cs[i], sn[i]);
#pragma unroll
                    for (int bj = 0; bj < 2; ++bj) { bf16_t* dst = Qb + ((size_t)row * 8 + 4 * bj + wc) * 96 + 64 + 4 * fq;
                        const f32x4 x1 = acc[ai][bj][m][0] * sc, x2 = acc[ai][bj][m][1] * sc; f32x4 o1, o2;
#pragma unroll
                        for (int i = 0; i < 4; ++i) { o1[i] = x1[i] * cs[i] - x2[i] * sn[i]; o2[i] = x2[i] * cs[i] + x1[i] * sn[i]; }
                        u32x2 w1, w2; w1.x = cvt_pk_bf16(o1[0], o1[1]); w1.y = cvt_pk_bf16(o1[2], o1[3]); w2.x = cvt_pk_bf16(o2[0], o2[1]); w2.y = cvt_pk_bf16(o2[2], o2[3]);
                        *(u32x2*)dst = w1; *(u32x2*)(dst + 16) = w2; } }
            }
    }
};
struct EpiKV {
    static constexpr bool PERM = false, AFTER_DRAIN = false;
    bf16_t* KVH; const float* SSQ; const bf16_t* KC;
    __device__ __forceinline__ void operator()(const f32x4 (&acc)[2][2][4][2], const Unit& u, int wr, int wc, int fr, int fq) const {
#pragma unroll
        for (int ai = 0; ai < 2; ++ai)
#pragma unroll
            for (int m = 0; m < 4; ++m) { const int row = u.pm * BM + ai * HALF + wr * 64 + m * 16 + fr; const int b = row >> 13, t = row & 8191;
                const f32x4 sq = *(const f32x4*)(SSQ + (size_t)row * 8 + 4);
                const float sc = __builtin_amdgcn_rsqf(((sq[0] + sq[1]) + (sq[2] + sq[3])) * (1.0f / 128.0f) + 1e-6f);
#pragma unroll
                for (int bj = 0; bj < 2; ++bj) { bf16_t* dst = KVH + (((size_t)b * 8 + 2 * u.pn + bj) * 8192 + t) * 160;
#pragma unroll
                    for (int n = 0; n < 2; ++n) { const f32x4 v = acc[ai][bj][m][n] * sc; u32x2 w; w.x = cvt_pk_bf16(v[0], v[1]); w.y = cvt_pk_bf16(v[2], v[3]); *(u32x2*)(dst + wc * 32 + 4 * fq + n * 16) = w; }
                    if (wc == 0) *(u32x4*)(dst + 128 + 8 * fq) = *(const u32x4*)(KC + (size_t)row * 160 + 128 + 8 * fq); }
            }
    }
};
}
#define GAS __attribute__((address_space(1)))
#define LAS __attribute__((address_space(3)))
typedef unsigned short bf16;
typedef unsigned v4u __attribute__((ext_vector_type(4)));
typedef float f32x4 __attribute__((ext_vector_type(4)));
typedef short bf16x8 __attribute__((ext_vector_type(8)));
typedef GAS unsigned gu32;
typedef GAS unsigned long long gu64;
#define RLX_AGENT __ATOMIC_RELAXED, __HIP_MEMORY_SCOPE_AGENT
#define LDS_WAIT() asm volatile("s_waitcnt lgkmcnt(0)" ::: "memory")
#define VM_WAIT() asm volatile("s_waitcnt vmcnt(0)" ::: "memory")
__device__ __forceinline__ unsigned long long rt() { return __builtin_amdgcn_s_memrealtime(); }
__device__ __forceinline__ unsigned f2bf(float f) { unsigned u = __builtin_bit_cast(unsigned, f); return (u + 0x7fffu + ((u >> 16) & 1u)) >> 16; }
__device__ __forceinline__ unsigned pk2(float lo, float hi) { return f2bf(lo) | (f2bf(hi) << 16); }

#define XB_TMO      128
#define XB_XCNT(j)  (256  + 64 * (j))
#define XB_XSUB(j)  (1280 + 64 * (j))
#define XB_XGEN(j)  (2304 + 64 * (j))
#define XB_TOP      3328
#define XB_TOPGEN   3392
#define XCD_BAR_WORDS 3456
#define XB_SPIN_CAP (1u << 18)

__device__ __forceinline__ unsigned xb_ld(unsigned* p)              { return __hip_atomic_load(p, __ATOMIC_RELAXED, __HIP_MEMORY_SCOPE_AGENT); }
__device__ __forceinline__ unsigned xb_add(unsigned* p, unsigned v) { return __hip_atomic_fetch_add(p, v, __ATOMIC_RELAXED, __HIP_MEMORY_SCOPE_AGENT); }
__device__ __forceinline__ unsigned xb_xcc_id() { return (unsigned)__builtin_amdgcn_s_getreg((3 << 11) | 20) & 0xFu; }
#define XB_SPIN(cond, bar) do { unsigned _sp = 0; while (cond) { __builtin_amdgcn_s_sleep(1); \
    if ((++_sp & 255u) == 0u) { if (xb_ld(&(bar)[XB_TMO])) break; if (_sp > XB_SPIN_CAP) { atomicAdd(&(bar)[XB_TMO], 1u); break; } } } } while (0)

struct XcdBarrier {
    unsigned* bar; unsigned x;
    volatile LAS unsigned* st;
};

__device__ __forceinline__ XcdBarrier xcd_barrier_post(unsigned* bar, volatile LAS unsigned* st) {
    XcdBarrier b; b.bar = bar; b.x = xb_xcc_id(); b.st = st;
    if (threadIdx.x == 0) (void)xb_add(&bar[XB_XCNT(b.x)], 1u);
    return b;
}
__device__ __forceinline__ void xcd_barrier_complete(unsigned* bar, unsigned x, unsigned& nloc, unsigned& nx) {
    const unsigned G = gridDim.x * gridDim.y * gridDim.z;
    unsigned sum, cnt, mine, sp = 0u;
    for (;;) {
        sum = 0u; cnt = 0u; mine = 0u;
#pragma unroll
        for (unsigned j = 0; j < 16; ++j) { const unsigned c = xb_ld(&bar[XB_XCNT(j)]); sum += c; cnt += (c > 0u) ? 1u : 0u; mine = (j == x) ? c : mine; }
        if (sum == G) break;
        __builtin_amdgcn_s_sleep(1);
        if ((++sp & 255u) == 0u) { if (xb_ld(&bar[XB_TMO])) break; if (sp > XB_SPIN_CAP) { atomicAdd(&bar[XB_TMO], 1u); break; } }
    }
    nloc = mine > 0u ? mine : 1u; nx = cnt > 0u ? cnt : 1u;
}

__device__ __forceinline__ void xcd_barrier(const XcdBarrier& b) {
    asm volatile("s_waitcnt vmcnt(0)" ::: "memory");
    __syncthreads();
    if (threadIdx.x == 0) {
        unsigned* bar = b.bar;
        __builtin_amdgcn_s_waitcnt(0);
        unsigned nloc = b.st[0], nx = b.st[1];
        if (nloc == 0u) { xcd_barrier_complete(bar, b.x, nloc, nx); b.st[0] = nloc; b.st[1] = nx; }
        const unsigned old = xb_add(&bar[XB_XSUB(b.x)], 1u);
        const unsigned gen = old / nloc;
        if (old + 1u == (gen + 1u) * nloc) {
            __builtin_amdgcn_fence(__ATOMIC_RELEASE, "agent");
            asm volatile("s_waitcnt vmcnt(0)" ::: "memory");
            const unsigned og = xb_add(&bar[XB_TOP], 1u);
            const unsigned tg = og / nx;
            if (og + 1u == (tg + 1u) * nx) xb_add(&bar[XB_TOPGEN], 1u);
            else XB_SPIN(xb_ld(&bar[XB_TOPGEN]) == tg, bar);
            __builtin_amdgcn_fence(__ATOMIC_ACQUIRE, "agent");
            xb_add(&bar[XB_XGEN(b.x)], 1u);
            asm volatile("s_waitcnt vmcnt(0)" ::: "memory");
        } else {
            XB_SPIN(xb_ld(&bar[XB_XGEN(b.x)]) == gen, bar);
            __builtin_amdgcn_fence(__ATOMIC_ACQUIRE, "agent");
            asm volatile("s_waitcnt vmcnt(0)" ::: "memory");
        }
    }
    __syncthreads();
}
__device__ __forceinline__ float wave_sum(float v) {
#pragma unroll
    for (int o = 1; o < 64; o <<= 1) v += __shfl_xor(v, o);
    return v;
}
__device__ __forceinline__ float sigmoidf_(float x) { return 1.0f / (1.0f + __expf(-x)); }
__device__ __forceinline__ float gelu_tanh(float x) { const float y = 0.7978845608028654f * (x + 0.044715f * x * x * x); return x * sigmoidf_(2.0f * y); }
__device__ __forceinline__ void rope_cs(int pos, int i, float& c, float& s) {
    const float ang = (float)pos * ROPE_FREQ[i];
    const double q4 = (double)ang * 0.6366197723675814;
    const double qr = rint(q4);
    const float r = (float)((q4 - qr) * 1.5707963267948966);
    const int qi = ((int)qr) & 3;
    const float r2 = r * r;
    const float sn = r * (1.0f + r2 * (-1.6666667e-1f + r2 * (8.3333333e-3f + r2 * (-1.9841270e-4f + r2 * 2.7557319e-6f))));
    const float cs = 1.0f + r2 * (-0.5f + r2 * (4.1666667e-2f + r2 * (-1.3888889e-3f + r2 * (2.4801587e-5f + r2 * -2.7557319e-7f))));
    c = (qi == 0) ? cs : (qi == 1) ? -sn : (qi == 2) ? -cs : sn;
    s = (qi == 0) ? sn : (qi == 1) ? cs : (qi == 2) ? -sn : -cs;
}
constexpr float QSCALE = 0.10206207261596577f * 1.4426950408889634f;
namespace att {
#define ATT_LAS __attribute__((address_space(3)))
typedef short bf16x8 __attribute__((ext_vector_type(8)));
typedef float f32x16 __attribute__((ext_vector_type(16)));
typedef short s16x4 __attribute__((ext_vector_type(4)));
typedef short v4i16_t __attribute__((ext_vector_type(4)));
typedef unsigned u32x4 __attribute__((ext_vector_type(4)));
typedef float f32x2_t __attribute__((ext_vector_type(2)));
typedef __bf16 bf16x2_t __attribute__((ext_vector_type(2)));
typedef ATT_LAS unsigned char* ldsp;
#define ATT_MFMA(a, b, c) __builtin_amdgcn_mfma_f32_32x32x16_bf16((a), (b), (c), 0, 0, 0)
__device__ __forceinline__ int crow(int r, int hi) { return (r & 3) + 8 * (r >> 2) + 4 * hi; }
__device__ __forceinline__ unsigned cvtpk(float lo, float hi) { f32x2_t v = {lo, hi}; bf16x2_t b = __builtin_convertvector(v, bf16x2_t); return __builtin_bit_cast(unsigned, b); }
__device__ __forceinline__ unsigned offL(unsigned row, unsigned ch) { return 256u * row + 16u * (ch ^ (((row & 3u) << 2) | ((row >> 2) & 3u))); }
__device__ __forceinline__ unsigned offR(unsigned row, unsigned ch) { return 64u * row + 16u * (ch ^ ((row >> 2) & 3u)); }
__device__ __forceinline__ bf16x8 lds_b128(ldsp p) { return *(const ATT_LAS bf16x8*)p; }
__device__ __forceinline__ s16x4 lds_tr(ldsp p) { return __builtin_bit_cast(s16x4, __builtin_amdgcn_ds_read_tr16_b64_v4i16((ATT_LAS v4i16_t*)p)); }
__device__ __forceinline__ float swapmax(float m) { auto rr = __builtin_amdgcn_permlane32_swap(__float_as_uint(m), __float_as_uint(m), false, false); return fmaxf(__uint_as_float(rr[0]), __uint_as_float(rr[1])); }
__device__ __forceinline__ float swapsum(float m) { auto rr = __builtin_amdgcn_permlane32_swap(__float_as_uint(m), __float_as_uint(m), false, false); return __uint_as_float(rr[0]) + __uint_as_float(rr[1]); }

constexpr int TILE_LAT = 64 * 256, TILE_ROPE = 64 * 64, TILE_BYTES = TILE_LAT + TILE_ROPE;
constexpr float THR = 8.0f;

__device__ __forceinline__ void softmax_step(f32x16& s0, f32x16& s1, float& m, float& l, f32x16 (&o)[4], bool first) {
    float rm = fmaxf(s0[0], s1[0]);
#pragma unroll
    for (int r = 1; r < 16; ++r) rm = fmaxf(rm, fmaxf(s0[r], s1[r]));
    rm = swapmax(rm);
    if (first) m = rm;
    rm -= m;
    if (!first && __any(rm > THR)) {
        const float dl = fmaxf(rm, 0.f);
        m += dl;
        const float f = __builtin_amdgcn_exp2f(-dl); l *= f;
#pragma unroll
        for (int c = 0; c < 4; ++c)
#pragma unroll
            for (int r = 0; r < 16; ++r) o[c][r] *= f;
    }
    float sum = 0.f;
#pragma unroll
    for (int r = 0; r < 16; ++r) { s0[r] = __builtin_amdgcn_exp2f(s0[r] - m); s1[r] = __builtin_amdgcn_exp2f(s1[r] - m); sum += s0[r] + s1[r]; }
    l += sum;
}

__device__ __forceinline__ void stage_load(u32x4 (&st)[3], const bf16* __restrict__ tilep, int tid) {
    const bf16* pl = tilep + (size_t)(tid >> 4) * QD + (tid & 15) * 8;
    st[0] = *(const u32x4*)pl; st[1] = *(const u32x4*)(pl + 32 * QD);
    if (tid < 256) st[2] = *(const u32x4*)(tilep + (size_t)(tid >> 2) * QD + KVL + (tid & 3) * 8);
}
__device__ __forceinline__ void stage_store(const u32x4 (&st)[3], ldsp tile, unsigned dl, unsigned dr, int tid) {
    *(ATT_LAS u32x4*)(tile + dl) = st[0]; *(ATT_LAS u32x4*)(tile + dl + 8192) = st[1];
    if (tid < 256) *(ATT_LAS u32x4*)(tile + TILE_LAT + dr) = st[2];
}
constexpr int PR_Q = 3 * TILE_BYTES, PR_QW = 32 * 256 + 32 * 64;
constexpr int PR_LDS_END = PR_Q + 8 * PR_QW;
__device__ __forceinline__ void softmax_step2(f32x16& s0, f32x16& s1, float& m, float& l, f32x16 (&o)[2], bool first) {
    float rm = fmaxf(s0[0], s1[0]);
#pragma unroll
    for (int r = 1; r < 16; ++r) rm = fmaxf(rm, fmaxf(s0[r], s1[r]));
    rm = swapmax(rm);
    if (first) m = rm;
    rm -= m;
    if (!first && __any(rm > THR)) {
        const float dl = fmaxf(rm, 0.f);
        m += dl;
        const float f = __builtin_amdgcn_exp2f(-dl); l *= f;
#pragma unroll
        for (int c = 0; c < 2; ++c)
#pragma unroll
            for (int r = 0; r < 16; ++r) o[c][r] *= f;
    }
    float sum = 0.f;
#pragma unroll
    for (int r = 0; r < 16; ++r) { s0[r] = __builtin_amdgcn_exp2f(s0[r] - m); s1[r] = __builtin_amdgcn_exp2f(s1[r] - m); sum += s0[r] + s1[r]; }
    l += sum;
}
__device__ __forceinline__ void prompt_unit(ldsp lds, const bf16* __restrict__ QbP, const bf16* __restrict__ KVH, float* __restrict__ SSQM, bf16* __restrict__ YC, int b, int h, int qb) {
    const int tid = threadIdx.x, lane = tid & 63, wid = __builtin_amdgcn_readfirstlane(tid >> 6), r32 = lane & 31, hi = lane >> 5;
    const int tq0 = 256 * qb + 32 * wid; const size_t row0 = (size_t)b * SEQ + tq0;
    const bf16* KVseq = KVH + ((size_t)(b * NH + h) * SEQ) * QD;
    const int ntile_u = 4 * qb + 4, ntile_w = 4 * qb + (wid >> 1) + 1;
    const unsigned lsrc = (unsigned)(4 * wid + (lane >> 4)) * (QD * 2) + 16u * ((unsigned)(lane & 15) ^ ((((unsigned)(lane >> 4) & 3u) << 2) | ((unsigned)wid & 3u)));
    const unsigned rsrc = (unsigned)(16 * wid + (lane >> 2)) * (QD * 2) + 2 * KVL + 16u * ((unsigned)(lane & 3) ^ ((unsigned)(lane >> 4) & 3u));
#define PR_GLDS(gptr, ldsaddr) do { unsigned keep_; asm volatile("s_mov_b32 %0, m0\n\ts_mov_b32 m0, %2\n\ts_nop 0\n\tglobal_load_lds_dwordx4 %1, off\n\ts_mov_b32 m0, %0" : "=&s"(keep_) : "v"(gptr), "s"(ldsaddr) : "memory"); } while (0)
#ifdef PR_SYNC_STAGE
#define PR_DMA(gtile, slot) do { const char* g_ = (const char*)(gtile); ldsp d_ = lds + (slot) + wid * 1024 + 16 * lane; \
        *(ATT_LAS u32x4*)(d_) = *(const u32x4*)(g_ + lsrc); *(ATT_LAS u32x4*)(d_ + 8192) = *(const u32x4*)(g_ + lsrc + 32 * QD * 2); \
        if (wid < 4) *(ATT_LAS u32x4*)(d_ + TILE_LAT) = *(const u32x4*)(g_ + rsrc); } while (0)
#else
#define PR_DMA(gtile, slot) do { const char* g_ = (const char*)(gtile); const unsigned l_ = (unsigned)__builtin_amdgcn_readfirstlane((int)(lds0 + (unsigned)(slot) + (unsigned)wid * 1024u)); \
        PR_GLDS(g_ + lsrc, l_); PR_GLDS(g_ + lsrc + 32 * QD * 2, l_ + 8192u); \
        if (wid < 4) PR_GLDS(g_ + rsrc, l_ + (unsigned)TILE_LAT); } while (0)
#endif
    const unsigned lds0 = (unsigned)(size_t)lds;
    PR_DMA(KVseq, 0);
    ldsp qimg = lds + PR_Q + wid * PR_QW;
    { const bf16* qp = QbP + ((row0 + r32) * NH + h) * 96 + 8 * hi;
#pragma unroll
      for (int s = 0; s < 4; ++s) *(ATT_LAS bf16x8*)(qimg + offL((unsigned)r32, (unsigned)(2 * s + hi))) = *(const bf16x8*)(qp + 16 * s);
#pragma unroll
      for (int s = 0; s < 2; ++s) *(ATT_LAS bf16x8*)(qimg + 32 * 256 + offR((unsigned)r32, (unsigned)(2 * s + hi))) = *(const bf16x8*)(qp + 64 + 16 * s); }
    PR_DMA(KVseq + (size_t)64 * QD, TILE_BYTES);
    asm volatile("s_waitcnt vmcnt(0) lgkmcnt(0)" ::: "memory");
    __syncthreads();
    float m = 0.f, l = 0.f; f32x16 o[2];
#pragma unroll
    for (int r = 0; r < 16; ++r) { o[0][r] = 0.f; o[1][r] = 0.f; }
    const unsigned xk = (unsigned)(((r32 & 3) << 1) | ((r32 >> 3) & 1));
    const unsigned ka = 256u * (unsigned)r32 + 16u * ((unsigned)hi ^ ((unsigned)(r32 >> 2) & 1u));
    const unsigned kr0 = TILE_LAT + offR((unsigned)r32, (unsigned)hi), kr1 = TILE_LAT + offR((unsigned)r32, 2u + (unsigned)hi);
    const unsigned blk = (lane >> 4) & 1, qq = (lane & 15) >> 2, pp = lane & 3;
    const unsigned vb0 = 256u * (unsigned)(4 * hi + qq) + 16u * ((2u * blk + (pp >> 1)) ^ (unsigned)hi) + 8u * (pp & 1u);
    const unsigned vb1 = 256u * (unsigned)(8 + 4 * hi + qq) + 16u * ((2u * blk + (pp >> 1)) ^ (2u + (unsigned)hi)) + 8u * (pp & 1u);
#define PR_QK(S0, S1, tile) do { unsigned xko = xk; asm volatile("" : "+v"(xko)); \
        _Pragma("unroll") for (int r = 0; r < 16; ++r) { S0[r] = 0.f; S1[r] = 0.f; } \
        _Pragma("unroll") for (int k = 0; k < 4; ++k) { const unsigned a_ = ka + 32u * ((unsigned)k ^ xko); const bf16x8 q_ = lds_b128(qimg + a_); \
            S0 = ATT_MFMA(lds_b128((tile) + a_), q_, S0); S1 = ATT_MFMA(lds_b128((tile) + a_ + 8192), q_, S1); } \
        { const bf16x8 q_ = lds_b128(qimg + 32 * 256 + (kr0 - TILE_LAT)); S0 = ATT_MFMA(lds_b128((tile) + kr0), q_, S0); S1 = ATT_MFMA(lds_b128((tile) + kr0 + 2048), q_, S1); } \
        { const bf16x8 q_ = lds_b128(qimg + 32 * 256 + (kr1 - TILE_LAT)); S0 = ATT_MFMA(lds_b128((tile) + kr1), q_, S0); S1 = ATT_MFMA(lds_b128((tile) + kr1 + 2048), q_, S1); } } while (0)
#define PR_STEP(A0, A1, B0, B1, kt) do { \
        ldsp tcur = lds + cur; \
        if ((kt) + 2 < ntile_u) PR_DMA(KVseq + (size_t)((kt) + 2) * 64 * QD, nn); \
        if ((kt) + 1 < ntile_w) PR_QK(B0, B1, lds + nxt); \
        if ((kt) < ntile_w) { \
          if ((kt) == ntile_w - 1) { const int tok = tq0 + r32, kb = (kt) * 64; \
            _Pragma("unroll") for (int r = 0; r < 16; ++r) { const int key = kb + crow(r, hi); if (key > tok) A0[r] = -INFINITY; if (key + 32 > tok) A1[r] = -INFINITY; } } \
          softmax_step2(A0, A1, m, l, o, (kt) == 0); \
          unsigned qqo = qq; asm volatile("" : "+v"(qqo)); \
          _Pragma("unroll") for (int ks = 0; ks < 4; ++ks) { \
            const f32x16& pv = (ks < 2) ? A0 : A1; const int bb = 8 * (ks & 1); \
            u32x4 pw; pw.x = cvtpk(pv[bb + 0], pv[bb + 1]); pw.y = cvtpk(pv[bb + 2], pv[bb + 3]); pw.z = cvtpk(pv[bb + 4], pv[bb + 5]); pw.w = cvtpk(pv[bb + 6], pv[bb + 7]); \
            const bf16x8 pf = __builtin_bit_cast(bf16x8, pw); \
            _Pragma("unroll") for (int c = 2; c < 4; ++c) { const unsigned co = 64u * ((unsigned)c ^ qqo); \
                const s16x4 lo = lds_tr(tcur + vb0 + co + 4096 * ks), hv = lds_tr(tcur + vb1 + co + 4096 * ks); \
                const bf16x8 vf = {lo[0], lo[1], lo[2], lo[3], hv[0], hv[1], hv[2], hv[3]}; \
                o[c - 2] = ATT_MFMA(vf, pf, o[c - 2]); } } } \
        asm volatile("s_waitcnt vmcnt(0)" ::: "memory"); \
        __syncthreads(); \
        { const int t_ = cur; cur = nxt; nxt = nn; nn = t_; } } while (0)
    int cur = 0, nxt = TILE_BYTES, nn = 2 * TILE_BYTES;
    f32x16 sa0, sa1, sb0, sb1;
    PR_QK(sa0, sa1, lds);
    for (int kt = 0; kt < ntile_u; kt += 2) { PR_STEP(sa0, sa1, sb0, sb1, kt); PR_STEP(sb0, sb1, sa0, sa1, kt + 1); }
#undef PR_STEP
#undef PR_QK
#undef PR_DMA
#undef PR_GLDS
    l = swapsum(l);
    const float rl = 1.0f / l;
    float ss = 0.f;
#pragma unroll
    for (int c = 0; c < 2; ++c)
#pragma unroll
        for (int r = 0; r < 16; ++r) { o[c][r] *= rl; ss += o[c][r] * o[c][r]; }
    ss = swapsum(ss);
    if (hi == 0) SSQM[(row0 + r32) * NH + h] = ss;
    bf16* yp = YC + (row0 + r32) * DMIX + DLRU + h * VD + 4 * hi;
#pragma unroll
    for (int c = 0; c < 2; ++c)
#pragma unroll
        for (int g = 0; g < 4; ++g) { typedef unsigned u32x2 __attribute__((ext_vector_type(2)));
            u32x2 w; w.x = cvtpk(o[c][4 * g], o[c][4 * g + 1]); w.y = cvtpk(o[c][4 * g + 2], o[c][4 * g + 3]); *(u32x2*)(yp + 32 * c + 8 * g) = w; }
    __syncthreads();
}
}
namespace att {
constexpr int PG_LAT = 128 * 256, PG_ROPE = 128 * 64, PG_BYTES = PG_LAT + PG_ROPE;
constexpr int PART_ROWS = 66, PART_FLOATS = PART_ROWS * 64;

__device__ __forceinline__ void page_load(f32x4 (&st)[10], const float* __restrict__ ckv, const float* __restrict__ ckr, size_t slot0, int tid) {
    const f32x4* pl = (const f32x4*)(ckv + slot0 * KVL) + tid; const f32x4* pr = (const f32x4*)(ckr + slot0 * ROPE) + tid;
#pragma unroll
    for (int i = 0; i < 8; ++i) st[i] = __builtin_nontemporal_load(pl + 512 * i);
#pragma unroll
    for (int i = 0; i < 2; ++i) st[8 + i] = __builtin_nontemporal_load(pr + 512 * i);
}
__device__ __forceinline__ void page_store(const f32x4 (&st)[10], ldsp pg, unsigned dl, unsigned dr) {
    typedef unsigned u32x2 __attribute__((ext_vector_type(2)));
#pragma unroll
    for (int i = 0; i < 8; ++i) { u32x2 w; w.x = cvtpk(st[i].x, st[i].y); w.y = cvtpk(st[i].z, st[i].w); *(ATT_LAS u32x2*)(pg + dl + 4096 * i) = w; }
#pragma unroll
    for (int i = 0; i < 2; ++i) { u32x2 w; w.x = cvtpk(st[8 + i].x, st[8 + i].y); w.y = cvtpk(st[8 + i].z, st[8 + i].w); *(ATT_LAS u32x2*)(pg + PG_LAT + dr + 4096 * i) = w; }
}
constexpr int Q_OFF = 2 * PG_BYTES;
__device__ __forceinline__ void decode_item(ldsp lds, const bf16* __restrict__ Qb, const float* __restrict__ ckv, const float* __restrict__ ckr, const int* __restrict__ ptab,
                                            float* __restrict__ PART, int db, int pg0, int npg) {
    const int tid = threadIdx.x, lane = tid & 63, wid = __builtin_amdgcn_readfirstlane(tid >> 6), r32 = lane & 31, hi = lane >> 5;
    const int qb = wid & 1, rb = 64 * (wid >> 2) + 32 * ((wid >> 1) & 1), grp = wid >> 1;
    const int* pt = ptab + db * NPAGES + pg0;
    unsigned dl, dr;
    { const unsigned row = (unsigned)tid >> 5, c4 = (unsigned)tid & 31u; dl = offL(row, c4 >> 1) + 8u * (c4 & 1u);
      const unsigned rr = (unsigned)tid >> 3, c4r = (unsigned)tid & 7u; dr = offR(rr, c4r >> 1) + 8u * (c4r & 1u); }
    f32x4 sa[10], sb[10];
    page_load(sa, ckv, ckr, (size_t)pt[0] * PAGE, tid);
    if (npg > 1) page_load(sb, ckv, ckr, (size_t)pt[1] * PAGE, tid);
    {
      const bf16* qsrc = Qb + ((size_t)RP + (size_t)db * DS) * NH * QD;
      const u32x4 q0 = *(const u32x4*)(qsrc + (size_t)(tid >> 4) * QD + (tid & 15) * 8), q1 = *(const u32x4*)(qsrc + (size_t)((tid >> 4) + 32) * QD + (tid & 15) * 8);
      const unsigned dq = offL((unsigned)tid >> 4, (unsigned)tid & 15u);
      *(ATT_LAS u32x4*)(lds + Q_OFF + dq) = q0; *(ATT_LAS u32x4*)(lds + Q_OFF + dq + 8192) = q1;
      if (tid < 256) { const u32x4 q2 = *(const u32x4*)(qsrc + (size_t)(tid >> 2) * QD + KVL + (tid & 3) * 8); *(ATT_LAS u32x4*)(lds + Q_OFF + TILE_LAT + offR((unsigned)tid >> 2, (unsigned)tid & 3u)) = q2; } }
    page_store(sa, lds, dl, dr);
    __syncthreads();
    float m = 0.f, l = 0.f; f32x16 o[4];
#pragma unroll
    for (int r = 0; r < 16; ++r) { o[0][r] = 0.f; o[1][r] = 0.f; o[2][r] = 0.f; o[3][r] = 0.f; }
    const unsigned xk = (unsigned)(((r32 & 3) << 1) | ((r32 >> 3) & 1));
    const unsigned x0 = (unsigned)hi ^ ((unsigned)(r32 >> 2) & 1u);
    const unsigned ka = 256u * (unsigned)(rb + r32) + 16u * x0, qa = Q_OFF + 256u * (unsigned)(32 * qb + r32) + 16u * x0;
    const unsigned kr0 = PG_LAT + offR((unsigned)(rb + r32), (unsigned)hi), kr1 = PG_LAT + offR((unsigned)(rb + r32), 2u + (unsigned)hi);
    const unsigned qr0 = Q_OFF + TILE_LAT + offR((unsigned)(32 * qb + r32), (unsigned)hi), qr1 = Q_OFF + TILE_LAT + offR((unsigned)(32 * qb + r32), 2u + (unsigned)hi);
    const unsigned blk = (lane >> 4) & 1, qq = (lane & 15) >> 2, pp = lane & 3;
    const unsigned vb0 = 256u * (unsigned)(rb + 4 * hi + qq) + 16u * ((2u * blk + (pp >> 1)) ^ (unsigned)hi) + 8u * (pp & 1u);
    const unsigned vb1 = 256u * (unsigned)(rb + 8 + 4 * hi + qq) + 16u * ((2u * blk + (pp >> 1)) ^ (2u + (unsigned)hi)) + 8u * (pp & 1u);
#define DEC_PAGE(pg, first) do { \
        unsigned xko = xk, qqo = qq; asm volatile("" : "+v"(xko), "+v"(qqo)); \
        f32x16 s; \
        _Pragma("unroll") for (int r = 0; r < 16; ++r) s[r] = 0.f; \
        _Pragma("unroll") for (int k = 0; k < 8; ++k) { const unsigned co = 32u * ((unsigned)k ^ xko); s = ATT_MFMA(lds_b128((pg) + ka + co), lds_b128(lds + qa + co), s); } \
        s = ATT_MFMA(lds_b128((pg) + kr0), lds_b128(lds + qr0), s); \
        s = ATT_MFMA(lds_b128((pg) + kr1), lds_b128(lds + qr1), s); \
        float rm = s[0]; \
        _Pragma("unroll") for (int r = 1; r < 16; ++r) rm = fmaxf(rm, s[r]); \
        rm = swapmax(rm); \
        if (first) m = rm; \
        rm -= m; \
        if (!(first) && __any(rm > THR)) { const float dlt = fmaxf(rm, 0.f); m += dlt; const float f = __builtin_amdgcn_exp2f(-dlt); l *= f; \
            _Pragma("unroll") for (int c = 0; c < 4; ++c) _Pragma("unroll") for (int r = 0; r < 16; ++r) o[c][r] *= f; } \
        float sum = 0.f; \
        _Pragma("unroll") for (int r = 0; r < 16; ++r) { s[r] = __builtin_amdgcn_exp2f(s[r] - m); sum += s[r]; } \
        l += sum; \
        _Pragma("unroll") for (int ks = 0; ks < 2; ++ks) { \
            u32x4 pw; pw.x = cvtpk(s[8 * ks + 0], s[8 * ks + 1]); pw.y = cvtpk(s[8 * ks + 2], s[8 * ks + 3]); pw.z = cvtpk(s[8 * ks + 4], s[8 * ks + 5]); pw.w = cvtpk(s[8 * ks + 6], s[8 * ks + 7]); \
            const bf16x8 pf = __builtin_bit_cast(bf16x8, pw); \
            _Pragma("unroll") for (int c = 0; c < 4; ++c) { const unsigned co = 64u * ((unsigned)c ^ qqo); \
                const s16x4 lo = lds_tr((pg) + vb0 + co + 4096 * ks), hv = lds_tr((pg) + vb1 + co + 4096 * ks); \
                const bf16x8 vf = {lo[0], lo[1], lo[2], lo[3], hv[0], hv[1], hv[2], hv[3]}; \
                o[c] = ATT_MFMA(vf, pf, o[c]); } } \
    } while (0)
    for (int pi = 0; pi < npg; pi += 2) {
        if (pi + 2 < npg) page_load(sa, ckv, ckr, (size_t)pt[pi + 2] * PAGE, tid);
        DEC_PAGE(lds, pi == 0);
        page_store(sb, lds + PG_BYTES, dl, dr);
        __syncthreads();
        if (pi + 3 < npg) page_load(sb, ckv, ckr, (size_t)pt[pi + 3] * PAGE, tid);
        DEC_PAGE(lds + PG_BYTES, false);
        if (pi + 2 < npg) page_store(sa, lds, dl, dr);
        __syncthreads();
    }
#undef DEC_PAGE
    ATT_LAS float* reg = (ATT_LAS float*)(lds) + qb * PART_FLOATS;
    for (int g = 0; g < 4; ++g) {
        if (grp == g) {
            if (g > 0) { const float m2 = reg[64 * 64 + lane], l2 = reg[65 * 64 + lane]; const float mn = fmaxf(m, m2); const float a1 = __builtin_amdgcn_exp2f(m - mn), a2 = __builtin_amdgcn_exp2f(m2 - mn);
#pragma unroll
                for (int c = 0; c < 4; ++c)
#pragma unroll
                    for (int r = 0; r < 16; ++r) o[c][r] = o[c][r] * a1 + reg[(c * 16 + r) * 64 + lane] * a2;
                l = l * a1 + l2 * a2; m = mn; }
            if (g < 3) {
#pragma unroll
                for (int c = 0; c < 4; ++c)
#pragma unroll
                    for (int r = 0; r < 16; ++r) reg[(c * 16 + r) * 64 + lane] = o[c][r];
                reg[64 * 64 + lane] = m; reg[65 * 64 + lane] = l; }
            else { float* gp = PART + (size_t)qb * PART_FLOATS;
#pragma unroll
                for (int c = 0; c < 4; ++c)
#pragma unroll
                    for (int r = 0; r < 16; ++r) gp[(c * 16 + r) * 64 + lane] = o[c][r];
                gp[64 * 64 + lane] = m; gp[65 * 64 + lane] = l; }
        }
        __syncthreads();
    }
}
__device__ __forceinline__ void decode_combine(ldsp lds, const bf16* __restrict__ Qb, const float* __restrict__ KN, const float* __restrict__ KR, const float* __restrict__ PARTdb, int ns,
                                               const float* __restrict__ w_uv, const float* __restrict__ gm, bf16* __restrict__ YC, int db) {
    const int tid = threadIdx.x, lane = tid & 63, wid = __builtin_amdgcn_readfirstlane(tid >> 6), qb = wid >> 2, rg = wid & 3, r32 = lane & 31, hi = lane >> 5;
    ATT_LAS float* sc = (ATT_LAS float*)lds;
    ATT_LAS float* ol = (ATT_LAS float*)(lds + 2048);
    ATT_LAS float* red = (ATT_LAS float*)(lds + 2048 + 32768);
    __syncthreads();
    { const int q = tid >> 3, sp = tid & 7;
      const bf16* qp = Qb + (((size_t)RP + (size_t)db * DS) * NH + q) * QD; const float* kn = KN + ((size_t)db * DS + sp) * KVL; const float* kr = KR + ((size_t)db * DS + sp) * ROPE;
      float a = 0.f; const u32x4* qv = (const u32x4*)qp;
#pragma unroll
      for (int part = 0; part < 3; ++part) { const int nq = part < 2 ? 8 : 4; const f32x4* kv = part < 2 ? (const f32x4*)kn + 16 * part : (const f32x4*)kr;
          u32x4 qq[8]; f32x4 kk[16];
#pragma unroll
          for (int j = 0; j < 8; ++j) if (j < nq) qq[j] = qv[8 * part + j];
#pragma unroll
          for (int j = 0; j < 16; ++j) if (j < 2 * nq) kk[j] = kv[j];
#pragma unroll
          for (int j = 0; j < 8; ++j) if (j < nq) { const f32x4 k0 = kk[2 * j], k1 = kk[2 * j + 1];
              a += __uint_as_float(qq[j].x << 16) * k0[0] + __uint_as_float(qq[j].x & 0xffff0000u) * k0[1] + __uint_as_float(qq[j].y << 16) * k0[2] + __uint_as_float(qq[j].y & 0xffff0000u) * k0[3]
                 + __uint_as_float(qq[j].z << 16) * k1[0] + __uint_as_float(qq[j].z & 0xffff0000u) * k1[1] + __uint_as_float(qq[j].w << 16) * k1[2] + __uint_as_float(qq[j].w & 0xffff0000u) * k1[3]; } }
      sc[q * 8 + sp] = a; }
    __syncthreads();
    const int q = 32 * qb + r32, stok = q >> 3, hq = q & 7;
    float M = -INFINITY;
    for (int i = 0; i < ns; ++i) M = fmaxf(M, PARTdb[((size_t)i * 2 + qb) * PART_FLOATS + 64 * 64 + lane]);
    for (int sp = 0; sp <= stok; ++sp) M = fmaxf(M, sc[q * 8 + sp]);
    float acc[16], lsum = 0.f;
#pragma unroll
    for (int r = 0; r < 16; ++r) acc[r] = 0.f;
    for (int i = 0; i < ns; ++i) { const float* pp = PARTdb + ((size_t)i * 2 + qb) * PART_FLOATS; const float f = __builtin_amdgcn_exp2f(pp[64 * 64 + lane] - M);
        lsum += f * pp[65 * 64 + lane];
#pragma unroll
        for (int r = 0; r < 16; ++r) acc[r] += f * pp[(rg * 16 + r) * 64 + lane]; }
    lsum += __shfl_xor(lsum, 32);
    for (int sp = 0; sp <= stok; ++sp) { const float p = __builtin_amdgcn_exp2f(sc[q * 8 + sp] - M); lsum += p; const float* kn = KN + ((size_t)db * DS + sp) * KVL;
#pragma unroll
        for (int r = 0; r < 16; ++r) acc[r] += p * kn[32 * rg + crow(r, hi)]; }
    const float rl = 1.0f / lsum;
#pragma unroll
    for (int r = 0; r < 16; ++r) ol[q * KVL + 32 * rg + crow(r, hi)] = acc[r] * rl;
    __syncthreads();
    float y[8];
#pragma unroll
    for (int s = 0; s < 8; ++s) y[s] = 0.f;
#pragma unroll 1
    for (int c0 = 0; c0 < KVL; c0 += 16) { float w[16];
#pragma unroll
        for (int j = 0; j < 16; ++j) w[j] = w_uv[((size_t)(c0 + j) * NH + wid) * VD + lane];
#pragma unroll
        for (int s = 0; s < 8; ++s) {
#pragma unroll
            for (int j4 = 0; j4 < 4; ++j4) { const f32x4 o4 = *(const ATT_LAS f32x4*)(ol + (s * 8 + wid) * KVL + c0 + 4 * j4);
                y[s] += (o4[0] * w[4 * j4] + o4[1] * w[4 * j4 + 1]) + (o4[2] * w[4 * j4 + 2] + o4[3] * w[4 * j4 + 3]); }
            __builtin_amdgcn_sched_barrier(0); } }
    (void)hq;
#pragma unroll
    for (int s = 0; s < 8; ++s) { float v = y[s] * y[s];
#pragma unroll
        for (int o = 1; o < 64; o <<= 1) v += __shfl_xor(v, o);
        if (lane == 0) red[wid * 8 + s] = v; }
    __syncthreads();
#pragma unroll
    for (int s = 0; s < 8; ++s) { float t = 0.f;
#pragma unroll
        for (int w = 0; w < 8; ++w) t += red[w * 8 + s];
        const float rstd = 1.0f / sqrtf(t * (1.0f / DMLA) + EPS);
        YC[((size_t)RP + (size_t)db * DS + s) * DMIX + DLRU + wid * VD + lane] = (bf16)f2bf(y[s] * rstd * gm[wid * VD + lane]); }
}
}
namespace att2 {
using att::bf16x8; using att::f32x16; using att::s16x4; using att::u32x4; using att::ldsp; using att::cvtpk; using att::crow; using att::offL; using att::offR; using att::lds_b128; using att::lds_tr;
using att::swapmax; using att::swapsum; using att::TILE_LAT; using att::TILE_BYTES; using att::THR; using att::PART_FLOATS;
typedef unsigned u32x2 __attribute__((ext_vector_type(2)));
constexpr int L_PT = 0, L_DT = 3 * TILE_BYTES, L_MG = L_DT + 2 * TILE_BYTES, L_BAR = L_MG + 2 * PART_FLOATS * 4 + 1024;
static_assert(L_BAR + 128 <= 146432, "attention LDS map");

__device__ __forceinline__ void role_bar(ATT_LAS unsigned* cnt, unsigned& target) {
    target += 4u;
    asm volatile("s_waitcnt lgkmcnt(0)" ::: "memory");
    if ((threadIdx.x & 63) == 0) (void)__hip_atomic_fetch_add(cnt, 1u, __ATOMIC_RELAXED, __HIP_MEMORY_SCOPE_WORKGROUP);
    while (__hip_atomic_load(cnt, __ATOMIC_RELAXED, __HIP_MEMORY_SCOPE_WORKGROUP) < target) __builtin_amdgcn_s_sleep(1);
    asm volatile("" ::: "memory");
}

typedef float f32x2 __attribute__((ext_vector_type(2)));
__device__ __forceinline__ float max3(float a, float b, float c) { float d; asm("v_max3_f32 %0, %1, %2, %3" : "=v"(d) : "v"(a), "v"(b), "v"(c)); return d; }
__device__ __forceinline__ void sm_max(const f32x16& s0, const f32x16& s1, float& m, float& l, f32x16 (&o)[2], bool first) {
    float r0 = max3(s0[0], s1[0], s0[1]), r1 = max3(s1[1], s0[2], s1[2]);
#pragma unroll
    for (int r = 3; r < 15; r += 2) { r0 = max3(r0, s0[r], s1[r]); r1 = max3(r1, s0[r + 1], s1[r + 1]); }
    float rm = swapmax(max3(r0, r1, fmaxf(s0[15], s1[15])));
    if (first) m = rm;
    rm -= m;
    if (!first && __any(rm > THR)) { const float dl = fmaxf(rm, 0.f); m += dl; const float f = __builtin_amdgcn_exp2f(-dl); l *= f;
#pragma unroll
        for (int c = 0; c < 2; ++c)
#pragma unroll
            for (int r = 0; r < 16; ++r) o[c][r] *= f; }
}
__device__ __forceinline__ void sm_fin(float rm, float& m, float& l, f32x16 (&o)[2], bool first) {
    rm = swapmax(rm);
    if (first) m = rm;
    rm -= m;
    if (!first && __any(rm > THR)) { const float dl = fmaxf(rm, 0.f); m += dl; const float f = __builtin_amdgcn_exp2f(-dl); l *= f;
#pragma unroll
        for (int c = 0; c < 2; ++c)
#pragma unroll
            for (int r = 0; r < 16; ++r) o[c][r] *= f; }
}
__device__ __forceinline__ void sm_exp(f32x16& s0, f32x16& s1, const float m, float& l) {
    float sum0 = 0.f, sum1 = 0.f;
#pragma unroll
    for (int r = 0; r < 16; ++r) { s0[r] = __builtin_amdgcn_exp2f(s0[r] - m); s1[r] = __builtin_amdgcn_exp2f(s1[r] - m); sum0 += s0[r]; sum1 += s1[r]; }
    l += sum0 + sum1;
}
__device__ __forceinline__ void prompt_role(ldsp lds, const bf16* __restrict__ QbP, const bf16* __restrict__ KVH, float* __restrict__ SSQM, bf16* __restrict__ YC, int b, int h, int qb, unsigned& bt) {
    const int t4 = threadIdx.x & 255, lane = t4 & 63, wid = __builtin_amdgcn_readfirstlane(t4 >> 6), r32 = lane & 31, hi = lane >> 5;
    ATT_LAS unsigned* cnt = (ATT_LAS unsigned*)(lds + L_BAR);
    const int tq0 = 256 * qb + 64 * wid; const size_t row0 = (size_t)b * SEQ + tq0;
    const bf16* KVseq = KVH + ((size_t)(b * NH + h) * SEQ) * QD;
    const int ntile_u = 4 * qb + 4, ntile_w = 4 * qb + wid + 1;
    const unsigned lsrc = (unsigned)(4 * wid + (lane >> 4)) * (QD * 2) + 16u * ((unsigned)(lane & 15) ^ ((((unsigned)(lane >> 4) & 3u) << 2) | ((unsigned)wid & 3u)));
    const unsigned rsrc = (unsigned)(16 * wid + (lane >> 2)) * (QD * 2) + 2 * KVL + 16u * ((unsigned)(lane & 3) ^ ((unsigned)(lane >> 4) & 3u));
    const unsigned lds0 = (unsigned)(size_t)lds + L_PT;
#define R_GLDS(gptr, ldsaddr) do { unsigned keep_; asm volatile("s_mov_b32 %0, m0\n\ts_mov_b32 m0, %2\n\ts_nop 0\n\tglobal_load_lds_dwordx4 %1, off\n\ts_mov_b32 m0, %0" : "=&s"(keep_) : "v"(gptr), "s"(ldsaddr) : "memory"); } while (0)
#define R_DMA(gtile, slot) do { const char* g_ = (const char*)(gtile); const unsigned l_ = (unsigned)__builtin_amdgcn_readfirstlane((int)(lds0 + (unsigned)(slot) + (unsigned)wid * 1024u)); \
        R_GLDS(g_ + lsrc, l_); R_GLDS(g_ + lsrc + 16 * QD * 2, l_ + 4096u); R_GLDS(g_ + lsrc + 32 * QD * 2, l_ + 8192u); R_GLDS(g_ + lsrc + 48 * QD * 2, l_ + 12288u); \
        R_GLDS(g_ + rsrc, l_ + (unsigned)TILE_LAT); } while (0)
    R_DMA(KVseq, 0);
    bf16x8 qa[6], qbf[6];
    { const bf16* qp = QbP + ((row0 + r32) * NH + h) * 96 + 8 * hi;
#pragma unroll
      for (int s = 0; s < 6; ++s) { qa[s] = *(const bf16x8*)(qp + 16 * s); qbf[s] = *(const bf16x8*)(qp + (size_t)32 * NH * 96 + 16 * s); } }
    R_DMA(KVseq + (size_t)64 * QD, TILE_BYTES);
    asm volatile("s_waitcnt vmcnt(0)" ::: "memory");
#pragma unroll
    for (int s = 0; s < 6; ++s) asm volatile("" : "+v"(qa[s]), "+v"(qbf[s]));
    role_bar(cnt, bt);
    float mA = 0.f, lA = 0.f, mB = 0.f, lB = 0.f; f32x16 oA[2], oB[2];
#pragma unroll
    for (int r = 0; r < 16; ++r) { oA[0][r] = 0.f; oA[1][r] = 0.f; oB[0][r] = 0.f; oB[1][r] = 0.f; }
    const unsigned xk = (unsigned)(((r32 & 3) << 1) | ((r32 >> 3) & 1));
    const unsigned ka = 256u * (unsigned)r32 + 16u * ((unsigned)hi ^ ((unsigned)(r32 >> 2) & 1u));
    const unsigned kr0 = TILE_LAT + offR((unsigned)r32, (unsigned)hi), kr1 = TILE_LAT + offR((unsigned)r32, 2u + (unsigned)hi);
    const unsigned blk = (lane >> 4) & 1, qq = (lane & 15) >> 2, pp = lane & 3;
    const unsigned vb0 = 256u * (unsigned)(4 * hi + qq) + 16u * ((2u * blk + (pp >> 1)) ^ (unsigned)hi) + 8u * (pp & 1u);
    const unsigned vb1 = 256u * (unsigned)(8 + 4 * hi + qq) + 16u * ((2u * blk + (pp >> 1)) ^ (2u + (unsigned)hi)) + 8u * (pp & 1u);
    ldsp ring = lds + L_PT;
    int cur = 0, nxt = TILE_BYTES, nn = 2 * TILE_BYTES;
    for (int kt = 0; kt < ntile_u; ++kt) {
        ldsp tile = ring + cur;
        const char* gsrc = (const char*)(KVseq + (size_t)min(kt + 2, ntile_u - 1) * 64 * QD);
        const unsigned ldst = (unsigned)__builtin_amdgcn_readfirstlane((int)(lds0 + (unsigned)nn + (unsigned)wid * 1024u));
#define R_GLDS_S(sbase, voff, ldsaddr) do { unsigned keep_; asm volatile("s_mov_b32 %0, m0\n\ts_mov_b32 m0, %2\n\ts_nop 0\n\tglobal_load_lds_dwordx4 %1, %3\n\ts_mov_b32 m0, %0" : "=&s"(keep_) : "v"(voff), "s"(ldsaddr), "s"(sbase) : "memory"); } while (0)
#define R_PIECE(j) do { if ((j) < 4) R_GLDS_S(gsrc + (j) * 16 * QD * 2, lsrc, ldst + 4096u * (unsigned)(j)); else R_GLDS_S(gsrc, rsrc, ldst + (unsigned)TILE_LAT); } while (0)
        { R_PIECE(0); R_PIECE(1); R_PIECE(2); R_PIECE(3); R_PIECE(4); }
        if (kt < ntile_w) {
            unsigned xko = xk, qqo = qq; asm volatile("" : "+v"(xko), "+v"(qqo));
            const bool lastt = kt == ntile_w - 1; const int kb = kt * 64;
            f32x16 a0, a1, b0, b1;
#define R_QK(s0_, s1_, qf_) do { \
            _Pragma("unroll") for (int r = 0; r < 16; ++r) { s0_[r] = 0.f; s1_[r] = 0.f; } \
            _Pragma("unroll") for (int k = 0; k < 4; ++k) { const unsigned a_ = ka + 32u * ((unsigned)k ^ xko); const bf16x8 k0 = lds_b128(tile + a_), k1 = lds_b128(tile + a_ + 8192); \
                s0_ = ATT_MFMA(k0, qf_[k], s0_); s1_ = ATT_MFMA(k1, qf_[k], s1_); } \
            { const bf16x8 k0 = lds_b128(tile + kr0), k1 = lds_b128(tile + kr0 + 2048); s0_ = ATT_MFMA(k0, qf_[4], s0_); s1_ = ATT_MFMA(k1, qf_[4], s1_); } \
            { const bf16x8 k0 = lds_b128(tile + kr1), k1 = lds_b128(tile + kr1 + 2048); s0_ = ATT_MFMA(k0, qf_[5], s0_); s1_ = ATT_MFMA(k1, qf_[5], s1_); } } while (0)
#define R_MASK(s0_, s1_, tok_) do { int ln_ = lane; asm volatile("" : "+v"(ln_)); int d_ = (tok_) + (ln_ & 31) - kb - 4 * (ln_ >> 5); asm volatile("" : "+v"(d_));   \
            _Pragma("unroll") for (int r = 0; r < 16; ++r) { const int c_ = (r & 3) + 8 * (r >> 2); if (c_ > d_) s0_[r] = -INFINITY; if (c_ + 32 > d_) s1_[r] = -INFINITY; } } while (0)
#define R_PV(s0_, s1_, o_) do { \
            _Pragma("unroll") for (int ks = 0; ks < 4; ++ks) { const int bb = 8 * (ks & 1); const f32x16& pa = (ks < 2) ? s0_ : s1_; \
                u32x4 wa; wa.x = cvtpk(pa[bb + 0], pa[bb + 1]); wa.y = cvtpk(pa[bb + 2], pa[bb + 3]); wa.z = cvtpk(pa[bb + 4], pa[bb + 5]); wa.w = cvtpk(pa[bb + 6], pa[bb + 7]); \
                const bf16x8 pfa = __builtin_bit_cast(bf16x8, wa); \
                _Pragma("unroll") for (int c = 2; c < 4; ++c) { const unsigned co = 64u * ((unsigned)c ^ qqo); \
                    const s16x4 lo = lds_tr(tile + vb0 + co + 4096 * ks), hv = lds_tr(tile + vb1 + co + 4096 * ks); \
                    const bf16x8 vf = {lo[0], lo[1], lo[2], lo[3], hv[0], hv[1], hv[2], hv[3]}; \
                    o_[c - 2] = ATT_MFMA(vf, pfa, o_[c - 2]); } } } while (0)
#define R_K0(i) ((i) < 4 ? ka + 32u * ((unsigned)(i) ^ xko) : ((i) == 4 ? kr0 : kr1))
#define R_K1(i) (R_K0(i) + ((i) < 4 ? 8192u : 2048u))
            { bf16x8 kc0 = lds_b128(tile + R_K0(0)), kc1 = lds_b128(tile + R_K1(0));
#pragma unroll
              for (int r = 0; r < 16; ++r) { a0[r] = 0.f; a1[r] = 0.f; }
#pragma unroll
              for (int i = 0; i < 6; ++i) { bf16x8 kn0 = kc0, kn1 = kc1;
                  if (i < 5) { kn0 = lds_b128(tile + R_K0(i + 1)); kn1 = lds_b128(tile + R_K1(i + 1)); }
                  a0 = ATT_MFMA(kc0, qa[i], a0);
                  __builtin_amdgcn_sched_barrier(0);
                  a1 = ATT_MFMA(kc1, qa[i], a1);
                  __builtin_amdgcn_sched_barrier(0);
                  kc0 = kn0; kc1 = kn1; } }
            if (lastt) R_MASK(a0, a1, tq0);
            sm_max(a0, a1, mA, lA, oA, kt == 0);
#define R_EXPS(v_, s_, n_, m_, acc_) do { \
            _Pragma("unroll") for (int r = 0; r < (n_); ++r) v_[(s_) + r] -= m_; \
            _Pragma("unroll") for (int r = 0; r < (n_); ++r) v_[(s_) + r] = __builtin_amdgcn_exp2f(v_[(s_) + r]); \
            _Pragma("unroll") for (int r = 0; r < (n_); ++r) acc_ += v_[(s_) + r]; } while (0)
            { float sum = 0.f; bf16x8 kc0 = lds_b128(tile + R_K0(0)), kc1 = lds_b128(tile + R_K1(0));
#pragma unroll
              for (int r = 0; r < 16; ++r) { b0[r] = 0.f; b1[r] = 0.f; }
#pragma unroll
              for (int i = 0; i < 6; ++i) { bf16x8 kn0 = kc0, kn1 = kc1;
                  if (i < 5) { kn0 = lds_b128(tile + R_K0(i + 1)); kn1 = lds_b128(tile + R_K1(i + 1)); }
                  const int st_ = i < 4 ? 3 * i : 12 + 2 * (i - 4), n_ = i < 4 ? 3 : 2;
                  b0 = ATT_MFMA(kc0, qbf[i], b0);
                  R_EXPS(a0, st_, n_, mA, sum);
                  __builtin_amdgcn_sched_barrier(0);
                  b1 = ATT_MFMA(kc1, qbf[i], b1);
                  R_EXPS(a1, st_, n_, mA, sum);
                  __builtin_amdgcn_sched_barrier(0);
                  kc0 = kn0; kc1 = kn1; }
              asm volatile("" : "+v"(a0), "+v"(a1), "+v"(sum));
              lA += sum; }
            if (lastt) R_MASK(b0, b1, tq0 + 32);
#define R_VF(g_, dst_) do { const unsigned co_ = 64u * ((unsigned)(2 + ((g_) & 1)) ^ qqo); const s16x4 lo_ = lds_tr(tile + vb0 + co_ + 4096 * ((g_) >> 1)), hv_ = lds_tr(tile + vb1 + co_ + 4096 * ((g_) >> 1)); \
            dst_ = bf16x8{lo_[0], lo_[1], lo_[2], lo_[3], hv_[0], hv_[1], hv_[2], hv_[3]}; } while (0)
#define R_PF(s0_, s1_, ks_, dst_) do { const int bb_ = 8 * ((ks_) & 1); const f32x16& pa_ = ((ks_) < 2) ? s0_ : s1_; u32x4 w_; w_.x = cvtpk(pa_[bb_ + 0], pa_[bb_ + 1]); w_.y = cvtpk(pa_[bb_ + 2], pa_[bb_ + 3]); \
            w_.z = cvtpk(pa_[bb_ + 4], pa_[bb_ + 5]); w_.w = cvtpk(pa_[bb_ + 6], pa_[bb_ + 7]); dst_ = __builtin_bit_cast(bf16x8, w_); } while (0)
            { bf16x8 vc, pf; R_VF(0, vc); R_PF(a0, a1, 0, pf);
              { bf16x8 vn, pn; float r0, r1;
                R_VF(1, vn);
                oA[0] = ATT_MFMA(vc, pf, oA[0]);
                r0 = max3(b0[0], b1[0], b0[1]); r1 = max3(b1[1], b0[2], b1[2]);
#pragma unroll
                for (int r = 3; r < 9; r += 2) { r0 = max3(r0, b0[r], b1[r]); r1 = max3(r1, b0[r + 1], b1[r + 1]); }
                __builtin_amdgcn_sched_barrier(0);
                vc = vn; R_VF(2, vn); R_PF(a0, a1, 1, pn);
                oA[1] = ATT_MFMA(vc, pf, oA[1]);
#pragma unroll
                for (int r = 9; r < 15; r += 2) { r0 = max3(r0, b0[r], b1[r]); r1 = max3(r1, b0[r + 1], b1[r + 1]); }
                r0 = max3(r0, r1, fmaxf(b0[15], b1[15]));
                __builtin_amdgcn_sched_barrier(0);
                vc = vn; pf = pn;
                sm_fin(r0, mB, lB, oB, kt == 0); }
              float sum = 0.f;
#pragma unroll
              for (int g = 2; g < 8; ++g) { bf16x8 vn = vc, pn = pf;
                  if (g < 7) R_VF(g + 1, vn);
                  if ((g & 1) && g < 7) R_PF(a0, a1, (g + 1) >> 1, pn);
                  oA[g & 1] = ATT_MFMA(vc, pf, oA[g & 1]);
                  if (g < 5) R_EXPS(b0, g == 2 ? 0 : 6 + 5 * (g - 3), g == 2 ? 6 : 5, mB, sum); else R_EXPS(b1, g == 5 ? 0 : 6 + 5 * (g - 6), g == 5 ? 6 : 5, mB, sum);
                  __builtin_amdgcn_sched_barrier(0);
                  vc = vn; pf = pn; }
              lB += sum; }
            R_PV(b0, b1, oB);
#undef R_K0
#undef R_K1
#undef R_PIECE
#undef R_GLDS_S
#undef R_EXPS
#undef R_VF
#undef R_PF
#undef R_QK
#undef R_MASK
#undef R_PV
        }
        if (kt + 2 < ntile_u) asm volatile("s_waitcnt vmcnt(5)" ::: "memory");
        else asm volatile("s_waitcnt vmcnt(0)" ::: "memory");
        role_bar(cnt, bt);
        { const int t_ = cur; cur = nxt; nxt = nn; nn = t_; }
    }
#undef R_DMA
#undef R_GLDS
    int lne = lane; asm volatile("" : "+v"(lne));
    const int r32e = lne & 31, hie = lne >> 5;
#pragma unroll
    for (int blkq = 0; blkq < 2; ++blkq) { f32x16 (&o)[2] = blkq ? oB : oA; float l = swapsum(blkq ? lB : lA);
        const float rl = 1.0f / l; float ss = 0.f;
#pragma unroll
        for (int c = 0; c < 2; ++c)
#pragma unroll
            for (int r = 0; r < 16; ++r) { o[c][r] *= rl; ss += o[c][r] * o[c][r]; }
        ss = swapsum(ss);
        const size_t row = row0 + 32 * blkq + r32e;
        if (hie == 0) SSQM[row * NH + h] = ss;
        bf16* yp = YC + row * DMIX + DLRU + h * VD + 4 * hie;
#pragma unroll
        for (int c = 0; c < 2; ++c)
#pragma unroll
            for (int g = 0; g < 4; ++g) { u32x2 w; w.x = cvtpk(o[c][4 * g], o[c][4 * g + 1]); w.y = cvtpk(o[c][4 * g + 2], o[c][4 * g + 3]); *(u32x2*)(yp + 32 * c + 8 * g) = w; } }
    asm volatile("s_waitcnt vmcnt(0)" ::: "memory");
}

__device__ __forceinline__ void dc_load(f32x4 (&st)[10], const float* __restrict__ ckv, const float* __restrict__ ckr, size_t slot0, int t4) {
    const f32x4* pl = (const f32x4*)(ckv + slot0 * KVL) + t4; const f32x4* pr = (const f32x4*)(ckr + slot0 * ROPE) + t4;
#pragma unroll
    for (int i = 0; i < 8; ++i) st[i] = __builtin_nontemporal_load(pl + 256 * i);
#pragma unroll
    for (int i = 0; i < 2; ++i) st[8 + i] = __builtin_nontemporal_load(pr + 256 * i);
}
__device__ __forceinline__ void dc_store(const f32x4 (&st)[10], ldsp img, unsigned dE, unsigned dO, unsigned dr) {
#pragma unroll
    for (int i = 0; i < 8; ++i) { u32x2 wv; wv.x = cvtpk(st[i].x, st[i].y); wv.y = cvtpk(st[i].z, st[i].w); *(ATT_LAS u32x2*)(img + ((i & 1) ? dO : dE) + 2048 * i) = wv; }
#pragma unroll
    for (int i = 0; i < 2; ++i) { u32x2 wv; wv.x = cvtpk(st[8 + i].x, st[8 + i].y); wv.y = cvtpk(st[8 + i].z, st[8 + i].w); *(ATT_LAS u32x2*)(img + TILE_LAT + dr + 2048 * i) = wv; }
}
__device__ __forceinline__ void decode_role(ldsp lds, const bf16* __restrict__ Qb, const float* __restrict__ ckv, const float* __restrict__ ckr, const int* __restrict__ ptab,
                                            float* __restrict__ PART, int db, int pg0, int npg, unsigned& bt) {
    const int t4 = threadIdx.x & 255, lane = t4 & 63, w = __builtin_amdgcn_readfirstlane(t4 >> 6), r32 = lane & 31, hi = lane >> 5;
    const int qb = w & 1, kb = w >> 1, rb = 32 * kb;
    ATT_LAS unsigned* cnt = (ATT_LAS unsigned*)(lds + L_BAR + 64);
    const int mypg = ptab[db * NPAGES + pg0 + (lane < npg ? lane : 0)];
#define DC_PG(i) ((size_t)__builtin_amdgcn_readlane(mypg, (i)))
    unsigned dE, dO, dr;
    { const unsigned r0 = (unsigned)t4 >> 5, c4 = (unsigned)t4 & 31u;
      const unsigned xE = ((r0 & 3u) << 2) | ((r0 >> 2) & 3u), xO = ((r0 & 3u) << 2) | (((r0 >> 2) + 2u) & 3u);
      dE = 256u * r0 + 16u * ((c4 >> 1) ^ xE) + 8u * (c4 & 1u); dO = 256u * r0 + 16u * ((c4 >> 1) ^ xO) + 8u * (c4 & 1u);
      const unsigned rr = (unsigned)t4 >> 3, c4r = (unsigned)t4 & 7u; dr = offR(rr, c4r >> 1) + 8u * (c4r & 1u); }
    f32x4 sa[10], sb[10];
    dc_load(sa, ckv, ckr, DC_PG(0) * PAGE, t4);
    dc_load(sb, ckv, ckr, DC_PG(0) * PAGE + 64, t4);
    {
      const bf16* qsrc = Qb + ((size_t)RP + (size_t)db * DS) * NH * QD; const unsigned dq = offL((unsigned)t4 >> 4, (unsigned)t4 & 15u);
#pragma unroll
      for (int i = 0; i < 4; ++i) *(ATT_LAS u32x4*)(lds + L_MG + dq + 4096 * i) = *(const u32x4*)(qsrc + (size_t)((t4 >> 4) + 16 * i) * QD + (t4 & 15) * 8);
      *(ATT_LAS u32x4*)(lds + L_MG + TILE_LAT + offR((unsigned)t4 >> 2, (unsigned)t4 & 3u)) = *(const u32x4*)(qsrc + (size_t)(t4 >> 2) * QD + KVL + (t4 & 3) * 8); }
    dc_store(sa, lds + L_DT, dE, dO, dr);
    role_bar(cnt, bt);
    const unsigned qa = L_MG + 256u * (unsigned)(32 * qb + r32) + 16u * ((unsigned)hi ^ ((unsigned)(r32 >> 2) & 1u));
    const unsigned qr0 = L_MG + TILE_LAT + offR((unsigned)(32 * qb + r32), (unsigned)hi), qr1 = L_MG + TILE_LAT + offR((unsigned)(32 * qb + r32), 2u + (unsigned)hi);
    float m = 0.f, l = 0.f; f32x16 o[4];
#pragma unroll
    for (int r = 0; r < 16; ++r) { o[0][r] = 0.f; o[1][r] = 0.f; o[2][r] = 0.f; o[3][r] = 0.f; }
    const unsigned xk = (unsigned)(((r32 & 3) << 1) | ((r32 >> 3) & 1));
    const unsigned ka = 256u * (unsigned)(rb + r32) + 16u * ((unsigned)hi ^ ((unsigned)(r32 >> 2) & 1u));
    const unsigned kr0 = TILE_LAT + offR((unsigned)(rb + r32), (unsigned)hi), kr1 = TILE_LAT + offR((unsigned)(rb + r32), 2u + (unsigned)hi);
    const unsigned blk = (lane >> 4) & 1, qq = (lane & 15) >> 2, pp = lane & 3;
    const unsigned vb0 = 256u * (unsigned)(rb + 4 * hi + qq) + 16u * ((2u * blk + (pp >> 1)) ^ (unsigned)hi) + 8u * (pp & 1u);
    const unsigned vb1 = 256u * (unsigned)(rb + 8 + 4 * hi + qq) + 16u * ((2u * blk + (pp >> 1)) ^ (2u + (unsigned)hi)) + 8u * (pp & 1u);
    const int nhp = 2 * npg;
    bf16x8 qf[6];
    { unsigned xq = xk; asm volatile("" : "+v"(xq));
#pragma unroll
      for (int k = 0; k < 6; ++k) qf[k] = lds_b128(lds + qa + 32u * ((unsigned)k ^ xq));
    }
#define DC_HALF(img, first) do { \
        unsigned xko = xk, qqo = qq; asm volatile("" : "+v"(xko), "+v"(qqo)); \
        f32x16 s; \
        _Pragma("unroll") for (int r = 0; r < 16; ++r) s[r] = 0.f; \
        _Pragma("unroll") for (int k = 0; k < 8; ++k) { const unsigned co_ = 32u * ((unsigned)k ^ xko); s = ATT_MFMA(lds_b128((img) + ka + co_), k < 6 ? qf[k < 6 ? k : 0] : lds_b128(lds + qa + co_), s); } \
        s = ATT_MFMA(lds_b128((img) + kr0), lds_b128(lds + qr0), s); \
        s = ATT_MFMA(lds_b128((img) + kr1), lds_b128(lds + qr1), s); \
        float rm = max3(s[0], s[1], s[2]); \
        _Pragma("unroll") for (int r = 3; r < 15; r += 2) rm = max3(rm, s[r], s[r + 1]); \
        rm = max3(rm, s[15], s[15]); \
        rm = swapmax(rm); \
        if (first) m = rm; \
        rm -= m; \
        if (!(first) && __any(rm > THR)) { const float dlt = fmaxf(rm, 0.f); m += dlt; const float f = __builtin_amdgcn_exp2f(-dlt); l *= f; \
            _Pragma("unroll") for (int c = 0; c < 4; ++c) _Pragma("unroll") for (int r = 0; r < 16; ++r) o[c][r] *= f; } \
        { float sum0 = 0.f, sum1 = 0.f;     \
          _Pragma("unroll") for (int r = 0; r < 16; r += 2) { s[r] = __builtin_amdgcn_exp2f(s[r] - m); s[r + 1] = __builtin_amdgcn_exp2f(s[r + 1] - m); sum0 += s[r]; sum1 += s[r + 1]; } \
          l += sum0 + sum1; } \
        _Pragma("unroll") for (int ks = 0; ks < 2; ++ks) { \
            u32x4 pw; pw.x = cvtpk(s[8 * ks + 0], s[8 * ks + 1]); pw.y = cvtpk(s[8 * ks + 2], s[8 * ks + 3]); pw.z = cvtpk(s[8 * ks + 4], s[8 * ks + 5]); pw.w = cvtpk(s[8 * ks + 6], s[8 * ks + 7]); \
            const bf16x8 pf = __builtin_bit_cast(bf16x8, pw); \
            _Pragma("unroll") for (int c = 0; c < 4; ++c) { const unsigned co = 64u * ((unsigned)c ^ qqo); \
                const s16x4 lo = lds_tr((img) + vb0 + co + 4096 * ks), hv = lds_tr((img) + vb1 + co + 4096 * ks); \
                const bf16x8 vf = {lo[0], lo[1], lo[2], lo[3], hv[0], hv[1], hv[2], hv[3]}; \
                o[c] = ATT_MFMA(vf, pf, o[c]); } } \
    } while (0)
    for (int hp = 0; hp < nhp; hp += 2) {
        dc_load(sa, ckv, ckr, DC_PG(min((hp + 2) >> 1, npg - 1)) * PAGE, t4);
        DC_HALF(lds + L_DT, hp == 0);
        dc_store(sb, lds + L_DT + TILE_BYTES, dE, dO, dr);
        role_bar(cnt, bt);
        dc_load(sb, ckv, ckr, DC_PG(min((hp + 3) >> 1, npg - 1)) * PAGE + 64, t4);
        DC_HALF(lds + L_DT + TILE_BYTES, false);
        if (hp + 2 < nhp) dc_store(sa, lds + L_DT, dE, dO, dr);
        role_bar(cnt, bt);
    }
#undef DC_HALF
#undef DC_PG
    ATT_LAS float* reg = (ATT_LAS float*)(lds + L_MG) + qb * PART_FLOATS + lane;
    if (kb == 0) {
#pragma unroll
        for (int c = 0; c < 4; ++c)
#pragma unroll
            for (int r = 0; r < 16; ++r) reg[(c * 16 + r) * 64] = o[c][r];
        reg[64 * 64] = m; reg[65 * 64] = l; }
    role_bar(cnt, bt);
    if (kb == 1) { const float m2 = reg[64 * 64], l2 = reg[65 * 64]; const float mn = fmaxf(m, m2); const float a1 = __builtin_amdgcn_exp2f(m - mn), a2 = __builtin_amdgcn_exp2f(m2 - mn);
        float* gp = PART + (size_t)qb * PART_FLOATS + lane;
#pragma unroll
        for (int c = 0; c < 4; ++c)
#pragma unroll
            for (int r = 0; r < 16; ++r) gp[(c * 16 + r) * 64] = o[c][r] * a1 + reg[(c * 16 + r) * 64] * a2;
        gp[64 * 64] = mn; gp[65 * 64] = l * a1 + l2 * a2; }
    role_bar(cnt, bt);
}
}
namespace lru {
using att::bf16x8; using att::f32x16; using att::u32x4; using att::ldsp; using att::cvtpk; using att::crow;
constexpr int XCT_STRIDE = 72;
constexpr int XCT_WAVE_BYTES = 64 * XCT_STRIDE * 2;
constexpr int LDS_RED = 0;
constexpr int LDS_RS = LDS_RED + 8 * 64 * 32 * 4;
__device__ __forceinline__ float bf2f(unsigned short v) { return __uint_as_float((unsigned)v << 16); }
__device__ __forceinline__ float sigm(float x) { return __builtin_amdgcn_rcpf(1.0f + __builtin_amdgcn_exp2f(-1.4426950408889634f * x)); }

struct State { f32x16 P[2][2]; f32x16 H[2][2]; };

template <bool SAMPLE, int NRB = 2>
__device__ __forceinline__ void unit_pre(ldsp lds, State& st, const bf16* __restrict__ XL, const bf16* __restrict__ WGT, const float* __restrict__ conv_w, const float* __restrict__ conv_b,
                                         const float* __restrict__ b_a, const float* __restrict__ b_i, const float* __restrict__ lam, const float* __restrict__ state_conv, const float* __restrict__ state_h,
                                         float* __restrict__ out, size_t rowbase, int b0, int tpos0, float* __restrict__ SUMp  ) {
    const int tid = threadIdx.x, lane = tid & 63, n = __builtin_amdgcn_readfirstlane(tid >> 6), r32 = lane & 31, hi = lane >> 5;
    ATT_LAS unsigned short* xct = (ATT_LAS unsigned short*)(lds + n * XCT_WAVE_BYTES);
    bf16x8 af[2][4];
#pragma unroll
    for (int s = 0; s < 4; ++s) { const int ch0 = 64 * n + 16 * s + 8 * hi;
        float w[4][8], bb[8];
#pragma unroll
        for (int k = 0; k < 4; ++k) { const f32x4 a = *(const f32x4*)(conv_w + k * DLRU + ch0), c = *(const f32x4*)(conv_w + k * DLRU + ch0 + 4);
            w[k][0] = a[0]; w[k][1] = a[1]; w[k][2] = a[2]; w[k][3] = a[3]; w[k][4] = c[0]; w[k][5] = c[1]; w[k][6] = c[2]; w[k][7] = c[3]; }
        { const f32x4 a = *(const f32x4*)(conv_b + ch0), c = *(const f32x4*)(conv_b + ch0 + 4); bb[0] = a[0]; bb[1] = a[1]; bb[2] = a[2]; bb[3] = a[3]; bb[4] = c[0]; bb[5] = c[1]; bb[6] = c[2]; bb[7] = c[3]; }
#pragma unroll
        for (int rb = 0; rb < NRB; ++rb) { const int tk = 32 * rb + r32;
            const int tseq = SAMPLE ? (tk & 7) : tpos0 + tk;
            float xc[8];
#pragma unroll
            for (int j = 0; j < 8; ++j) xc[j] = bb[j];
#pragma unroll
            for (int k = 0; k < 4; ++k) { const int back = 3 - k;
                float xv[8];
                const bool inseq = tseq - back >= 0;
                { const bf16x8 v = *(const bf16x8*)(XL + (rowbase + tk - (inseq ? back : 0)) * DLRU + ch0);
#pragma unroll
                  for (int j = 0; j < 8; ++j) xv[j] = inseq ? bf2f((unsigned short)v[j]) : 0.f; }
                if (SAMPLE && back > 0) { const int sr = inseq ? 0 : 3 + tseq - back;
                    const float* sp = state_conv + ((size_t)(b0 + (tk >> 3)) * 3 + sr) * DLRU + ch0; const f32x4 a = *(const f32x4*)sp, c = *(const f32x4*)(sp + 4);
                    if (!inseq) { xv[0] = a[0]; xv[1] = a[1]; xv[2] = a[2]; xv[3] = a[3]; xv[4] = c[0]; xv[5] = c[1]; xv[6] = c[2]; xv[7] = c[3]; } }
#pragma unroll
                for (int j = 0; j < 8; ++j) xc[j] += w[k][j] * xv[j]; }
            u32x4 pw; pw.x = cvtpk(xc[0], xc[1]); pw.y = cvtpk(xc[2], xc[3]); pw.z = cvtpk(xc[4], xc[5]); pw.w = cvtpk(xc[6], xc[7]);
            af[rb][s] = __builtin_bit_cast(bf16x8, pw);
            *(ATT_LAS u32x4*)(xct + tk * XCT_STRIDE + 16 * s + 8 * hi) = pw;
        }
    }
    if (SAMPLE || tpos0 + 32 * NRB > SEQ - 3) {
#pragma unroll
        for (int s = 0; s < 4; ++s) { const int ch0 = 64 * n + 16 * s + 8 * hi;
#pragma unroll
            for (int rb = 0; rb < NRB; ++rb) { const int tk = 32 * rb + r32; const int tseq = SAMPLE ? (tk & 7) : tpos0 + tk;
                if (tseq >= (SAMPLE ? DS : SEQ) - 3) { const bf16x8 v = *(const bf16x8*)(XL + (rowbase + tk) * DLRU + ch0);
                    float* o = out + (SAMPLE ? O_CVS : O_CVP) + ((size_t)(SAMPLE ? b0 + (tk >> 3) : b0) * 3 + (tseq - ((SAMPLE ? DS : SEQ) - 3))) * DLRU + ch0;
#pragma unroll
                    for (int j = 0; j < 8; ++j) o[j] = bf2f((unsigned short)v[j]); } } }
    }
#pragma unroll
    for (int g = 0; g < 2; ++g)
#pragma unroll
        for (int cb = 0; cb < 2; ++cb) { f32x16 c0, c1;
#pragma unroll
            for (int r = 0; r < 16; ++r) { c0[r] = 0.f; c1[r] = 0.f; }
#pragma unroll
            for (int s = 0; s < 4; ++s) { const bf16x8 bf = *(const bf16x8*)(WGT + (((size_t)n * 2 + g) * 64 + 32 * cb + r32) * 64 + 16 * s + 8 * hi);
                c0 = ATT_MFMA(af[0][s], bf, c0); if (NRB == 2) c1 = ATT_MFMA(af[1][s], bf, c1); }
            if (g == 0) { st.P[0][cb] = c0; st.P[1][cb] = c1; } else { st.H[0][cb] = c0; st.H[1][cb] = c1; }
            __builtin_amdgcn_sched_barrier(0); }
    asm volatile("s_waitcnt lgkmcnt(0)" ::: "memory");
#pragma unroll
    for (int cb = 0; cb < 2; ++cb) { const int ch = 64 * n + 32 * cb + r32;
        const float ba = b_a[ch], bi = b_i[ch]; const float nl = -lam[ch]; const float sp8 = 8.0f * (fmaxf(nl, 0.f) + log1pf(__expf(-fabsf(nl))));
#pragma unroll
        for (int rb = 0; rb < NRB; ++rb)
#pragma unroll
            for (int r = 0; r < 16; ++r) { const int tk = 32 * rb + crow(r, hi);
                const float xc = bf2f(xct[tk * XCT_STRIDE + 32 * cb + r32]);
                const float rg = sigm(st.P[rb][cb][r] + ba), ig = sigm(st.H[rb][cb][r] + bi);
                const float la = -rg * sp8;
                const float a = __builtin_amdgcn_exp2f(1.4426950408889634f * la);
                const float y = -2.0f * la;
                const float poly = y * (1.0f + y * (-0.5f + y * (1.6666667e-1f + y * (-4.1666667e-2f + y * (8.3333333e-3f + y * -1.3888889e-3f)))));
                const float wgt = __builtin_amdgcn_fmed3f(10.0f * y - 2.0f, 0.0f, 1.0f);
                const float om = poly + wgt * ((1.0f - a * a) - poly);
                st.P[rb][cb][r] = a; st.H[rb][cb][r] = __builtin_amdgcn_sqrtf(om) * (ig * xc); }
        __builtin_amdgcn_sched_barrier(0); }
#pragma unroll
    for (int cb = 0; cb < 2; ++cb) { const int ch = 64 * n + 32 * cb + r32;
        float h = 0.f, pr = 1.f;
#pragma unroll
        for (int k = 0; k < 8 * NRB; ++k) { const int rb = k >> 3, g = (k >> 1) & 3, owner = k & 1;
            if (SAMPLE && (k & 1) == 0) { h = state_h[(size_t)(b0 + (k >> 1)) * DLRU + ch]; pr = 1.f; }
            if (hi == owner) {
#pragma unroll
                for (int i = 0; i < 4; ++i) { const float a = st.P[rb][cb][4 * g + i]; h = a * h + st.H[rb][cb][4 * g + i]; pr *= a; st.H[rb][cb][4 * g + i] = h; st.P[rb][cb][4 * g + i] = pr; } }
            const float ho = __shfl_xor(h, 32), po = __shfl_xor(pr, 32);
            if (hi != owner) { h = ho; pr = po; }
            if (SAMPLE && (k & 1) == 1 && hi == 0) out[O_HS + (size_t)(b0 + (k >> 1)) * DLRU + ch] = h; }
        if (!SAMPLE && hi == 0) { SUMp[2 * ch] = pr; SUMp[2 * ch + 1] = h; } }
}
template <int NRB = 2>
__device__ __forceinline__ void unit_post(ldsp lds, State& st, const bf16* __restrict__ GG, const float* __restrict__ gain, bf16* __restrict__ YC, size_t rowbase, float carry0, float carry1) {
    const int tid = threadIdx.x, lane = tid & 63, n = __builtin_amdgcn_readfirstlane(tid >> 6), r32 = lane & 31, hi = lane >> 5;
    ATT_LAS float* red = (ATT_LAS float*)(lds + LDS_RED); ATT_LAS float* rs = (ATT_LAS float*)(lds + LDS_RS);
    __syncthreads();
#pragma unroll
    for (int rb = 0; rb < NRB; ++rb)
#pragma unroll
        for (int r = 0; r < 16; ++r) { const int tk = 32 * rb + crow(r, hi); float ss = 0.f;
#pragma unroll
            for (int cb = 0; cb < 2; ++cb) { const int ch = 64 * n + 32 * cb + r32; const float cr = cb ? carry1 : carry0;
                const float h = st.H[rb][cb][r] + st.P[rb][cb][r] * cr;
                const float y = bf2f(GG[(rowbase + tk) * DLRU + ch]) * h;
                st.H[rb][cb][r] = y; ss += y * y; }
            red[(n * 64 + tk) * 32 + r32] = ss; }
    __syncthreads();
    { const int tk = tid >> 3, part = tid & 7; float s = 0.f;
#pragma unroll
      for (int j = 0; j < 8; ++j) { const f32x4 v = *(const ATT_LAS f32x4*)(red + (part * 64 + tk) * 32 + 4 * j); s += (v[0] + v[1]) + (v[2] + v[3]); }
      s += __shfl_xor(s, 1); s += __shfl_xor(s, 2); s += __shfl_xor(s, 4);
      if (part == 0 && tk < 32 * NRB) rs[tk] = __builtin_amdgcn_rsqf(s * (1.0f / DLRU) + EPS); }
    __syncthreads();
#pragma unroll
    for (int cb = 0; cb < 2; ++cb) { const int ch = 64 * n + 32 * cb + r32; const float gn = gain[ch];
#pragma unroll
        for (int rb = 0; rb < NRB; ++rb)
#pragma unroll
            for (int r = 0; r < 16; ++r) { const int tk = 32 * rb + crow(r, hi);
                YC[(rowbase + tk) * DMIX + ch] = (bf16)f2bf(st.H[rb][cb][r] * rs[tk] * gn); } }
    __syncthreads();
}
__device__ __forceinline__ float chunk_carry(const float* __restrict__ SUMb, int c, int ch) {
    float h = 0.f;
    int k = 0;
    for (; k + 16 <= c; k += 16) { float2 v[16];
#pragma unroll
        for (int j = 0; j < 16; ++j) v[j] = *(const float2*)(SUMb + ((size_t)(k + j) * DLRU + ch) * 2);
#pragma unroll
        for (int j = 0; j < 16; ++j) h = v[j].x * h + v[j].y; }
#pragma unroll 8
    for (; k < c; ++k) { const float2 v = *(const float2*)(SUMb + ((size_t)k * DLRU + ch) * 2); h = v.x * h + v.y; }
    return h;
}
}
namespace sg {
typedef short bf16x8 __attribute__((ext_vector_type(8)));
typedef unsigned u32x2 __attribute__((ext_vector_type(2)));
using att::u32x4; using att::offL; using att::ldsp;
constexpr int CHK = 256, HALF_B = 64 * 256, TILE_B = 2 * HALF_B  , BUF_B = 2 * TILE_B;
__device__ __forceinline__ void ld_chunk(u32x4 (&st)[8], const bf16* __restrict__ ap, const bf16* __restrict__ bp, int K) {
#pragma unroll
    for (int i = 0; i < 4; ++i) { st[i] = *(const u32x4*)(ap + (size_t)16 * i * K); st[4 + i] = *(const u32x4*)(bp + (size_t)16 * i * K); }
}
__device__ __forceinline__ void st_chunk(const u32x4 (&st)[8], ldsp buf, unsigned d) {
#pragma unroll
    for (int i = 0; i < 4; ++i) { *(ATT_LAS u32x4*)(buf + d + 4096 * i) = st[i]; *(ATT_LAS u32x4*)(buf + TILE_B + d + 4096 * i) = st[4 + i]; }
}
__device__ __forceinline__ void unit64(ldsp lds, const bf16* __restrict__ A, const bf16* __restrict__ Bt, int K, int r0, int c0, const float* __restrict__ basef,
                                       bf16* Xb, float* __restrict__ SSQX, float alpha, float* __restrict__ outf = nullptr, const float* __restrict__ gain = nullptr, unsigned* cnt = nullptr) {
    const int tid = threadIdx.x, lane = tid & 63, w = __builtin_amdgcn_readfirstlane(tid >> 6), nt = w & 1, kq = w >> 1, r32 = lane & 31, hi = lane >> 5;
    const bf16* ap = A + (size_t)(r0 + (tid >> 5)) * K + 8 * (tid & 31); const bf16* bp = Bt + (size_t)(c0 + (tid >> 5)) * K + 8 * (tid & 31);
    const unsigned d = (unsigned)((tid & 31) >> 4) * HALF_B + offL((unsigned)tid >> 5, (unsigned)tid & 15u);
    const unsigned xa = (unsigned)(((r32 & 3) << 2) | ((r32 >> 2) & 3));
    const unsigned ra = (unsigned)(kq >> 1) * HALF_B + 256u * (unsigned)r32, rb = TILE_B + (unsigned)(kq >> 1) * HALF_B + 256u * (unsigned)(32 * nt + r32);
    typedef float f32x16 __attribute__((ext_vector_type(16)));
    f32x16 acc0, acc1;
#pragma unroll
    for (int r = 0; r < 16; ++r) { acc0[r] = 0.f; acc1[r] = 0.f; }
    u32x4 s0[8], s1[8], s2[8];
    const int nch = K / CHK;
    ld_chunk(s0, ap, bp, K);
    { const int c1 = min(1, nch - 1), c2 = min(2, nch - 1); ld_chunk(s1, ap + c1 * CHK, bp + c1 * CHK, K); ld_chunk(s2, ap + c2 * CHK, bp + c2 * CHK, K); }
    __syncthreads();
    st_chunk(s0, lds, d);
    __syncthreads();
#define SG_COMPUTE(buf) do { unsigned xo = xa; asm volatile("" : "+v"(xo)); \
        _Pragma("unroll") for (int j = 0; j < 4; ++j) { const unsigned co = 16u * ((unsigned)(8 * (kq & 1) + 2 * j + hi) ^ xo); \
            const bf16x8 b = *(const ATT_LAS bf16x8*)((buf) + rb + co), a0 = *(const ATT_LAS bf16x8*)((buf) + ra + co), a1 = *(const ATT_LAS bf16x8*)((buf) + ra + 8192 + co); \
            acc0 = __builtin_amdgcn_mfma_f32_32x32x16_bf16(b, a0, acc0, 0, 0, 0); acc1 = __builtin_amdgcn_mfma_f32_32x32x16_bf16(b, a1, acc1, 0, 0, 0); } } while (0)
#define SG_STEP(j, SETL, SETS) { const int cc = c + (j); if (cc >= nch) break; \
        { const int cn = min(cc + 3, nch - 1); ld_chunk(SETL, ap + cn * CHK, bp + cn * CHK, K); } \
        SG_COMPUTE(lds + ((j) & 1) * BUF_B); \
        if (cc + 1 < nch) st_chunk(SETS, lds + (((j) + 1) & 1) * BUF_B, d); \
        __syncthreads(); }
    for (int c = 0; c < nch; c += 6) { SG_STEP(0, s0, s1) SG_STEP(1, s1, s2) SG_STEP(2, s2, s0) SG_STEP(3, s0, s1) SG_STEP(4, s1, s2) SG_STEP(5, s2, s0) }
#undef SG_STEP
#undef SG_COMPUTE
    constexpr int PS = 68;
    ATT_LAS float* P = (ATT_LAS float*)lds;
#pragma unroll
    for (int f = 0; f < 2; ++f)
#pragma unroll
        for (int g = 0; g < 4; ++g) { const f32x16& a = f ? acc1 : acc0; f32x4 q = {a[4 * g], a[4 * g + 1], a[4 * g + 2], a[4 * g + 3]};
            *(ATT_LAS f32x4*)(P + ((size_t)(kq * 64 + 32 * f + r32) * PS + 32 * nt + 8 * g + 4 * hi)) = q; }
    __syncthreads();
    { const int m = tid >> 3, n8 = 8 * (tid & 7); f32x4 v0 = {0.f, 0.f, 0.f, 0.f}, v1 = {0.f, 0.f, 0.f, 0.f};
#pragma unroll
      for (int q = 0; q < 4; ++q) { const ATT_LAS f32x4* pp = (const ATT_LAS f32x4*)(P + ((size_t)(q * 64 + m) * PS + n8)); v0 = v0 + pp[0]; v1 = v1 + pp[1]; }
      const size_t off = ((size_t)r0 + m) * 1024 + c0 + n8; f32x4 b0, b1;
      if (basef) { b0 = *(const f32x4*)(basef + off); b1 = *(const f32x4*)(basef + off + 4); }
      else { const u32x4 bw = *(const u32x4*)(Xb + off);
          b0[0] = __uint_as_float(bw.x << 16); b0[1] = __uint_as_float(bw.x & 0xffff0000u); b0[2] = __uint_as_float(bw.y << 16); b0[3] = __uint_as_float(bw.y & 0xffff0000u);
          b1[0] = __uint_as_float(bw.z << 16); b1[1] = __uint_as_float(bw.z & 0xffff0000u); b1[2] = __uint_as_float(bw.w << 16); b1[3] = __uint_as_float(bw.w & 0xffff0000u); }
      v0 = v0 * alpha + b0; v1 = v1 * alpha + b1;
      float ss = ((v0[0] * v0[0] + v0[1] * v0[1]) + (v0[2] * v0[2] + v0[3] * v0[3])) + ((v1[0] * v1[0] + v1[1] * v1[1]) + (v1[2] * v1[2] + v1[3] * v1[3]));
      ss += __shfl_xor(ss, 1); ss += __shfl_xor(ss, 2); ss += __shfl_xor(ss, 4);
      if (!outf) { u32x4 pw; pw.x = att::cvtpk(v0[0], v0[1]); pw.y = att::cvtpk(v0[2], v0[3]); pw.z = att::cvtpk(v1[0], v1[1]); pw.w = att::cvtpk(v1[2], v1[3]); *(u32x4*)(Xb + off) = pw;
          if ((tid & 7) == 0) SSQX[((size_t)r0 + m) * 16 + (c0 >> 6)] = ss; }
      else {
          if ((tid & 7) == 0) __hip_atomic_store(SSQX + ((size_t)r0 + m) * 16 + (c0 >> 6), ss, __ATOMIC_RELAXED, __HIP_MEMORY_SCOPE_AGENT);
          asm volatile("s_waitcnt vmcnt(0)" ::: "memory");
          __syncthreads();
          if (tid == 0) { __hip_atomic_fetch_add(cnt, 1u, __ATOMIC_RELAXED, __HIP_MEMORY_SCOPE_AGENT); unsigned sp = 0u;
              while (__hip_atomic_load(cnt, __ATOMIC_RELAXED, __HIP_MEMORY_SCOPE_AGENT) < 16u) { __builtin_amdgcn_s_sleep(2); if (++sp > (1u << 22)) break; }
              __builtin_amdgcn_fence(__ATOMIC_ACQUIRE, "agent"); }
          asm volatile("s_waitcnt vmcnt(0)" ::: "memory");
          __syncthreads();
          const unsigned long long* sl = (const unsigned long long*)(SSQX + ((size_t)r0 + m) * 16); float t = 0.f;
#pragma unroll
          for (int j = 0; j < 8; ++j) { const unsigned long long w = __hip_atomic_load(sl + j, __ATOMIC_RELAXED, __HIP_MEMORY_SCOPE_AGENT); t += __uint_as_float((unsigned)w) + __uint_as_float((unsigned)(w >> 32)); }
          const float rs = 1.0f / sqrtf(t * (1.0f / 1024.0f) + 1e-6f);
          const f32x4 g0 = *(const f32x4*)(gain + c0 + n8), g1 = *(const f32x4*)(gain + c0 + n8 + 4);
          *(f32x4*)(outf + off) = v0 * rs * g0; *(f32x4*)(outf + off + 4) = v1 * rs * g1; } }
}
}
constexpr size_t MiB = 1u << 20;
constexpr size_t WS_CTL = 0, CTL_ZERO_BYTES = 64 * 1024;
constexpr size_t WS_WGU1 = 2 * MiB, WS_WD1 = 14 * MiB, WS_WGU2 = 20 * MiB, WS_WD2 = 32 * MiB, WS_WIN = 38 * MiB, WS_WOUT = 42 * MiB, WS_WQ = 44 * MiB, WS_SUM = 46 * MiB, WS_WGT = 48 * MiB, WS_SSQ = 49 * MiB, WS_KCS = 50 * MiB, WS_WUVF = 51 * MiB, WS_CKV = 52 * MiB, WS_SSQX = 61 * MiB, WS_WQP = 45 * MiB, WS_WKV = 45 * MiB + 512 * 1024;
static_assert(WS_SSQX + (size_t)R * 64 <= 64 * MiB && WS_WQ + (size_t)NQ * QL * 2 <= WS_WQP && WS_WQP + (size_t)NH * 96 * QL * 2 <= WS_WKV && WS_WKV + (size_t)NH * 128 * KVL * 2 <= WS_SUM, "workspace map");
constexpr size_t WS_XN = 64 * MiB, WS_H = 100 * MiB, WS_X1 = 200 * MiB, WS_X2 = 270 * MiB, WS_Z = 340 * MiB, WS_QALL = 444 * MiB, WS_CQN = 530 * MiB;
constexpr size_t WS_A = 540 * MiB, WS_U = 576 * MiB, WS_YL = 612 * MiB, WS_OLAT = 648 * MiB, WS_YC = 720 * MiB, WS_QB = 760 * MiB, WS_KC = 820 * MiB, WS_PART = 830 * MiB, WS_XL = 900 * MiB, WS_GG = 920 * MiB, WS_CQ = 940 * MiB, WS_QBP = 950 * MiB, WS_KVH = 980 * MiB, WS_CKVB = 1024 * MiB, WS_SSQM = 1030 * MiB, WS_XCH = 1032 * MiB  , WS_END = 1034 * MiB;
constexpr int CW_QUE = 256;
constexpr int CW_BAR = 1024;
constexpr int CW_FIN = 8192, CW_FINS = 12288;
static_assert((CW_BAR + XCD_BAR_WORDS) <= CW_FIN && (CW_FINS + 64 * (RS / 64)) * 4 <= (int)CTL_ZERO_BYTES && CW_FIN + 64 * (RP / 256) <= CW_FINS, "CTL");
constexpr int RING_BYTES = 131072, LDS_BYTES = 147456, LDSCTL_OFF = LDS_BYTES - 1024, MISC_OFF = LDSCTL_OFF + 320;
static_assert(att::PR_LDS_END <= LDSCTL_OFF, "prompt attention LDS map");
constexpr int NSPLIT = 2;
constexpr int CHUNK = 64, NCHUNK = SEQ / CHUNK;

struct Params { const float* in[33]; float* out; unsigned char* ws; int ph_lo, ph_hi; };
static_assert(sizeof(Params) == 33 * 8 + 8 + 8 + 8, "Params has no padding");

__device__ __forceinline__ void transpose_tile(const float* __restrict__ src, int ldw, bf16* __restrict__ dst, int ldt, LAS float* scr, int lane, const float* __restrict__ gain) {
    {
        const float* wp = src + (size_t)(lane >> 5) * ldw + (lane & 31); float v[32];
#pragma unroll
        for (int i = 0; i < 32; ++i) v[i] = __builtin_nontemporal_load(wp + (size_t)(2 * i) * ldw);
        if (gain) { float g[32];
#pragma unroll
            for (int i = 0; i < 32; ++i) g[i] = gain[2 * i + (lane >> 5)];
#pragma unroll
            for (int i = 0; i < 32; ++i) v[i] *= g[i]; }
#pragma unroll
        for (int i = 0; i < 32; ++i) scr[(2 * i + (lane >> 5)) * 33 + (lane & 31)] = v[i]; }
    LDS_WAIT(); asm volatile("" ::: "memory");
    const int c = lane & 7;
#pragma unroll
    for (int j = 0; j < 4; ++j) { const int n = (lane >> 3) + 8 * j; const LAS float* sp = scr + (8 * c) * 33 + n;
        v4u o; o.x = pk2(sp[0 * 33], sp[1 * 33]); o.y = pk2(sp[2 * 33], sp[3 * 33]); o.z = pk2(sp[4 * 33], sp[5 * 33]); o.w = pk2(sp[6 * 33], sp[7 * 33]);
        *(v4u*)(dst + (size_t)n * ldt + 8 * c) = o; }
    LDS_WAIT(); asm volatile("" ::: "memory");
}
template <bool OUT_BF16>
__device__ __forceinline__ void rmsnorm_rows(const float* __restrict__ x0, const float* __restrict__ x1, int split, const float* __restrict__ gain, void* __restrict__ outp) {
    const int lane = threadIdx.x & 63, gw = blockIdx.x * 8 + __builtin_amdgcn_readfirstlane(threadIdx.x >> 6), NGW = gridDim.x * 8;
    for (int row = gw; row < R; row += NGW) {
        const float* xr = (row < split) ? x0 + (size_t)row * DM : x1 + (size_t)(row - split) * DM;
        f32x4 v[4]; float s = 0.f;
#pragma unroll
        for (int j = 0; j < 4; ++j) { v[j] = ((const f32x4*)xr)[lane + 64 * j]; s += (v[j].x * v[j].x + v[j].y * v[j].y) + (v[j].z * v[j].z + v[j].w * v[j].w); }
        const float rstd = 1.0f / sqrtf(wave_sum(s) * (1.0f / DM) + EPS);
#pragma unroll
        for (int j = 0; j < 4; ++j) { const f32x4 g = ((const f32x4*)gain)[lane + 64 * j]; const f32x4 o = v[j] * rstd * g;
            if (OUT_BF16) { unsigned long long w = (unsigned long long)pk2(o.x, o.y) | ((unsigned long long)pk2(o.z, o.w) << 32); ((unsigned long long*)((bf16*)outp + (size_t)row * DM))[lane + 64 * j] = w; }
            else ((f32x4*)((float*)outp + (size_t)row * DM))[lane + 64 * j] = o; }
    }
}
__device__ __forceinline__ void final_norm_rows(const bf16* __restrict__ XB, const float* __restrict__ SSQX, const float* __restrict__ gain, float* __restrict__ outp) {
    const int lane = threadIdx.x & 63, gw = blockIdx.x * 8 + __builtin_amdgcn_readfirstlane(threadIdx.x >> 6), NGW = gridDim.x * 8;
    const f32x4 g00 = ((const f32x4*)gain)[2 * lane], g01 = ((const f32x4*)gain)[2 * lane + 1], g10 = ((const f32x4*)gain)[2 * (lane + 64)], g11 = ((const f32x4*)gain)[2 * (lane + 64) + 1];
    for (int row = gw; row < R; row += 2 * NGW) {
        const int row2 = row + NGW; const bool two = row2 < R; const int rb_ = two ? row2 : row;
        const v4u wa0 = ((const v4u*)(XB + (size_t)row * DM))[lane], wa1 = ((const v4u*)(XB + (size_t)row * DM))[lane + 64];
        const v4u wb0 = ((const v4u*)(XB + (size_t)rb_ * DM))[lane], wb1 = ((const v4u*)(XB + (size_t)rb_ * DM))[lane + 64];
        const f32x4* spa = (const f32x4*)(SSQX + (size_t)row * 16); const f32x4* spb = (const f32x4*)(SSQX + (size_t)rb_ * 16);
        const f32x4 ta = (spa[0] + spa[1]) + (spa[2] + spa[3]), tb = (spb[0] + spb[1]) + (spb[2] + spb[3]);
        const float ra = 1.0f / sqrtf(((ta[0] + ta[1]) + (ta[2] + ta[3])) * (1.0f / DM) + EPS), rbs = 1.0f / sqrtf(((tb[0] + tb[1]) + (tb[2] + tb[3])) * (1.0f / DM) + EPS);
#define FN_OUT(W_, RS_, GA_, GB_, DST_) do { f32x4 o0, o1; \
            o0[0] = __uint_as_float((W_).x << 16) * (RS_) * (GA_)[0]; o0[1] = __uint_as_float((W_).x & 0xffff0000u) * (RS_) * (GA_)[1]; o0[2] = __uint_as_float((W_).y << 16) * (RS_) * (GA_)[2]; o0[3] = __uint_as_float((W_).y & 0xffff0000u) * (RS_) * (GA_)[3]; \
            o1[0] = __uint_as_float((W_).z << 16) * (RS_) * (GB_)[0]; o1[1] = __uint_as_float((W_).z & 0xffff0000u) * (RS_) * (GB_)[1]; o1[2] = __uint_as_float((W_).w << 16) * (RS_) * (GB_)[2]; o1[3] = __uint_as_float((W_).w & 0xffff0000u) * (RS_) * (GB_)[3]; \
            (DST_)[0] = o0; (DST_)[1] = o1; } while (0)
        FN_OUT(wa0, ra, g00, g01, (f32x4*)(outp + (size_t)row * DM) + 2 * lane);
        FN_OUT(wa1, ra, g10, g11, (f32x4*)(outp + (size_t)row * DM) + 2 * (lane + 64));
        if (two) { FN_OUT(wb0, rbs, g00, g01, (f32x4*)(outp + (size_t)row2 * DM) + 2 * lane); FN_OUT(wb1, rbs, g10, g11, (f32x4*)(outp + (size_t)row2 * DM) + 2 * (lane + 64)); }
#undef FN_OUT
    }
}
template <int MODE>
__device__ __forceinline__ void weight_items(const Params& p, LAS unsigned char* lds, int gw, int NGW) {
    const int tid = threadIdx.x, lane = tid & 63, wave = __builtin_amdgcn_readfirstlane(tid >> 6);
    unsigned char* ws = p.ws;
    LAS float* scr = (LAS float*)(lds + wave * 16384);
    constexpr int I_F = (DM / 64) * (DFF / 32), I_IN = (DM / 64) * (DIN / 32), I_OUT = (DMIX / 64) * (DM / 32);
    constexpr int I_WQ = NH * (QL / 64) * (KVL / 8), I_QP = (QL / 64) * (NH * 96 / 32), I_QR = (QL / 64) * NH, I_KV = (KVL / 64) * NH * 4, I_GT = NBLK * 2 * 2;
    constexpr int NITEMS = I_WQ + 6 * I_F + I_IN + I_OUT + I_QP + I_QR + I_KV + I_GT;
    static_assert((DFF / 64) * (DM / 32) == I_F, "down items");
    const float* wq = p.in[21]; const float* wuk = p.in[23]; const float* qn = p.in[20]; bf16* WqT = (bf16*)(ws + WS_WQ);
    constexpr bool LATE = MODE == 2;
    constexpr int NE = 2 * I_F + I_IN, NM = I_F, ND = I_F, NL = NITEMS - I_WQ - NE - NM - ND;
    for (int it = gw; it < (MODE == 2 ? I_WQ + NL : MODE == 1 ? NM : MODE == 3 ? ND : NE); it += NGW) {
        int r;
        if (MODE == 2) { r = it; if (it >= I_WQ) { const int l = it - I_WQ; r = I_WQ + (l < 2 * I_F ? l + 3 * I_F : l + 4 * I_F + I_IN); } }
        else if (MODE == 1) r = I_WQ + it + 2 * I_F;
        else if (MODE == 3) r = I_WQ + it + 5 * I_F;
        else r = I_WQ + (it < 2 * I_F ? it : it + 4 * I_F);
        if (r < I_WQ) {
            const int h = r / ((QL / 64) * (KVL / 8)), kt = (r / (KVL / 8)) % (QL / 64), cg = r % (KVL / 8), k = 64 * kt + lane;
            f32x4 a[16];
#pragma unroll
            for (int j = 0; j < 16; ++j) a[j] = *(const f32x4*)(wq + (size_t)k * (NH * 96) + h * 96 + 4 * j);
            const float gk = qn[k];
#pragma unroll 1
            for (int c = 8 * cg; c < 8 * cg + 8; c += 2) { const f32x4* b0 = (const f32x4*)(wuk + ((size_t)c * NH + h) * NOPE); const f32x4* b1 = (const f32x4*)(wuk + ((size_t)(c + 1) * NH + h) * NOPE);
                f32x4 u[16], w[16];
#pragma unroll
                for (int j = 0; j < 16; ++j) { u[j] = b0[j]; w[j] = b1[j]; }
                f32x4 s4 = {0.f, 0.f, 0.f, 0.f}, t4 = {0.f, 0.f, 0.f, 0.f};
#pragma unroll
                for (int j = 0; j < 16; ++j) { s4 = s4 + a[j] * u[j]; t4 = t4 + a[j] * w[j]; }
                WqT[(size_t)(h * KVL + c) * QL + k] = (bf16)f2bf(((s4[0] + s4[1]) + (s4[2] + s4[3])) * gk);
                WqT[(size_t)(h * KVL + c + 1) * QL + k] = (bf16)f2bf(((t4[0] + t4[1]) + (t4[2] + t4[3])) * gk); }
            continue; }
        r -= I_WQ;
        const float* src; bf16* dst; const float* gain = nullptr; int ldw, ldt;
        if (r < 6 * I_F) { const int which = r / I_F, q = r % I_F;
            const bool down = which == 2 || which == 5; const int K = down ? DFF : DM, N = down ? DM : DFF, nblk = N / 32, k0 = 64 * (q / nblk), n0 = 32 * (q % nblk);
            const int inp = which == 0 ? 8 : which == 1 ? 9 : which == 2 ? 10 : which == 3 ? 29 : which == 4 ? 30 : 31;
            const size_t wsoff = which < 2 ? WS_WGU1 : which == 2 ? WS_WD1 : which < 5 ? WS_WGU2 : WS_WD2;
            const int drow0 = down ? n0 : 256 * (n0 / 128) + (n0 % 128) + ((which == 1 || which == 4) ? 128 : 0);
            src = p.in[inp] + (size_t)k0 * N + n0; ldw = N; dst = (bf16*)(ws + wsoff) + (size_t)drow0 * K + k0; ldt = K; if (which == 3 || which == 4) gain = p.in[28] + k0; }
        else if ((r -= 6 * I_F) < I_IN) { const int nblk = DIN / 32, k0 = 64 * (r / nblk), n0 = 32 * (r % nblk);
            src = p.in[12] + (size_t)k0 * DIN + n0; ldw = DIN; dst = (bf16*)(ws + WS_WIN) + (size_t)n0 * DM + k0; ldt = DM; gain = p.in[11] + k0; }
        else if ((r -= I_IN) < I_OUT) { const int nblk = DM / 32, k0 = 64 * (r / nblk), n0 = 32 * (r % nblk);
            src = p.in[27] + (size_t)k0 * DM + n0; ldw = DM; dst = (bf16*)(ws + WS_WOUT) + (size_t)n0 * DMIX + k0; ldt = DMIX; }
        else if ((r -= I_OUT) < I_QP) { const int nblk = NH * 96 / 32, k0 = 64 * (r / nblk), n0 = 32 * (r % nblk);
            const int col = (n0 < NH * NOPE) ? (n0 / NOPE) * 96 + (n0 % NOPE) : ((n0 - NH * NOPE) / ROPE) * 96 + NOPE;
            src = wq + (size_t)k0 * (NH * 96) + col; ldw = NH * 96; dst = (bf16*)(ws + WS_WQP) + (size_t)n0 * QL + k0; ldt = QL; gain = qn + k0; }
        else if ((r -= I_QP) < I_QR) { const int k0 = 64 * (r / NH), h = r % NH;
            src = wq + (size_t)k0 * (NH * 96) + h * 96 + NOPE; ldw = NH * 96; dst = WqT + (size_t)(NH * KVL + ROPE * h) * QL + k0; ldt = QL; gain = qn + k0; }
        else if ((r -= I_QR) < I_KV) { const int c0 = 64 * (r / (NH * 4)), h = (r >> 2) % NH, jb = r & 3;
            src = (jb < 2 ? wuk : p.in[24]) + (size_t)c0 * (NH * NOPE) + h * NOPE + 32 * (jb & 1); ldw = NH * NOPE; dst = (bf16*)(ws + WS_WKV) + (size_t)(h * 128 + 32 * jb) * KVL + c0; ldt = KVL; gain = p.in[22] + c0; }
        else { r -= I_KV; const int n = r >> 2, g = (r >> 1) & 1, eb = r & 1;
            src = (g ? p.in[17] : p.in[15]) + (size_t)n * BLK * BLK + 32 * eb; ldw = BLK; dst = (bf16*)(ws + WS_WGT) + (size_t)((n * 2 + g) * BLK + 32 * eb) * BLK; ldt = BLK; }
        transpose_tile(src, ldw, dst, ldt, scr, lane, gain);
    }
}
__device__ __forceinline__ void p_prologue(const Params& p, LAS unsigned char* lds) {
    const int tid = threadIdx.x, lane = tid & 63, wave = __builtin_amdgcn_readfirstlane(tid >> 6), gw = blockIdx.x * 8 + wave, NGW = gridDim.x * 8;
    unsigned char* ws = p.ws;
    LAS float* scr = (LAS float*)(lds + wave * 16384);
    weight_items<0>(p, lds, gw, NGW);
    const int gt = blockIdx.x * 512 + tid, NGT = gridDim.x * 512;
    { unsigned* z = (unsigned*)((bf16*)(ws + WS_WIN) + (size_t)DIN * DM); for (int i = gt; i < (DINP - DIN) * DM / 2; i += NGT) z[i] = 0u; }
    { const int xcd = (int)(blockIdx.x & 7), jb = (int)(blockIdx.x >> 3), nb = (int)(gridDim.x >> 3); const float* gain = p.in[7]; bf16* XNp = (bf16*)(ws + WS_XN);
      if ((gridDim.x & 7) == 0) {
          const int rows_x = R / 8, r_lo = xcd * rows_x + (jb * rows_x) / nb, r_hi = xcd * rows_x + ((jb + 1) * rows_x) / nb;
          for (int row = r_lo + 2 * wave; row < r_hi; row += 16) {
              const bool two = row + 1 < r_hi;
              const float* xa = (row < RP) ? p.in[0] + (size_t)row * DM : p.in[1] + (size_t)(row - RP) * DM;
              const float* xb = (row + 1 < RP) ? p.in[0] + (size_t)(row + 1) * DM : p.in[1] + (size_t)(row + 1 - RP) * DM;
              f32x4 va[4], vb[4]; float sa = 0.f, sb = 0.f;
#pragma unroll
              for (int j = 0; j < 4; ++j) { va[j] = ((const f32x4*)xa)[lane + 64 * j]; vb[j] = two ? ((const f32x4*)xb)[lane + 64 * j] : va[j]; }
#pragma unroll
              for (int j = 0; j < 4; ++j) { sa += (va[j].x * va[j].x + va[j].y * va[j].y) + (va[j].z * va[j].z + va[j].w * va[j].w); sb += (vb[j].x * vb[j].x + vb[j].y * vb[j].y) + (vb[j].z * vb[j].z + vb[j].w * vb[j].w); }
              const float ra = 1.0f / sqrtf(wave_sum(sa) * (1.0f / DM) + EPS), rb = 1.0f / sqrtf(wave_sum(sb) * (1.0f / DM) + EPS);
#pragma unroll
              for (int j = 0; j < 4; ++j) { const f32x4 g = ((const f32x4*)gain)[lane + 64 * j]; const f32x4 oa = va[j] * ra * g, ob = vb[j] * rb * g;
                  ((unsigned long long*)(XNp + (size_t)row * DM))[lane + 64 * j] = (unsigned long long)pk2(oa.x, oa.y) | ((unsigned long long)pk2(oa.z, oa.w) << 32);
                  if (two) ((unsigned long long*)(XNp + (size_t)(row + 1) * DM))[lane + 64 * j] = (unsigned long long)pk2(ob.x, ob.y) | ((unsigned long long)pk2(ob.z, ob.w) << 32); }
          }
      } else rmsnorm_rows<true>(p.in[0], p.in[1], RP, p.in[7], ws + WS_XN);
    }
}

__device__ __forceinline__ float half_sum(float v, LAS float* red4) {
    v = wave_sum(v);
    __syncthreads();
    if ((threadIdx.x & 63) == 0) red4[(threadIdx.x >> 6) & 3] = v;
    __syncthreads();
    return (red4[0] + red4[1]) + (red4[2] + red4[3]);
}
__device__ __forceinline__ void p_ckv_norm(const Params& p) {
    const int lane = threadIdx.x & 63, gw = blockIdx.x * 8 + __builtin_amdgcn_readfirstlane(threadIdx.x >> 6), NGW = gridDim.x * 8;
    const float* CKV = (const float*)(p.ws + WS_CKV); const float* SSQ = (const float*)(p.ws + WS_SSQ); bf16* KC = (bf16*)(p.ws + WS_KC); bf16* KCS = (bf16*)(p.ws + WS_KCS);
    const float2 g2 = ((const float2*)p.in[22])[lane];
    for (int row = gw; row < R; row += NGW) {
        const float2 v = ((const float2*)(CKV + (size_t)row * KVL))[lane]; const f32x4 sq = *(const f32x4*)(SSQ + (size_t)row * 8 + 4);
        const float rstd = 1.0f / sqrtf(((sq[0] + sq[1]) + (sq[2] + sq[3])) * (1.0f / KVL) + EPS);
        float2 o; o.x = v.x * rstd * g2.x; o.y = v.y * rstd * g2.y;
        if (row < RP) { ((float2*)(p.out + O_KVP + (size_t)row * KVL))[lane] = o; }
        else { ((float2*)(p.out + O_KVS + (size_t)(row - RP) * KVL))[lane] = o; ((unsigned*)(KCS + (size_t)(row - RP) * QD))[lane] = pk2(o.x, o.y); }
    }
}

__device__ __forceinline__ void p_mla_norm(const Params& p, int first_block, int nblocks) {
    const int lane = threadIdx.x & 63, gw = ((int)blockIdx.x - first_block) * 8 + __builtin_amdgcn_readfirstlane(threadIdx.x >> 6), NGW = nblocks * 8;
    bf16* YCp = (bf16*)(p.ws + WS_YC); const float* SSQM = (const float*)(p.ws + WS_SSQM); const float* gm = p.in[26];
    const f32x4 g0 = ((const f32x4*)gm)[2 * lane], g1 = ((const f32x4*)gm)[2 * lane + 1];
    for (int row0 = gw; row0 < RP; row0 += 4 * NGW) {
        v4u w[4]; f32x4 t[4];
#pragma unroll
        for (int i = 0; i < 4; ++i) { const int row = row0 + i * NGW < RP ? row0 + i * NGW : row0;
            w[i] = *((const v4u*)(YCp + (size_t)row * DMIX + DLRU) + lane); const f32x4* sp = (const f32x4*)(SSQM + (size_t)row * NH); t[i] = sp[0] + sp[1]; }
#pragma unroll
        for (int i = 0; i < 4; ++i) { const int row = row0 + i * NGW; if (row < RP) {
            const float rstd = 1.0f / sqrtf(((t[i][0] + t[i][1]) + (t[i][2] + t[i][3])) * (1.0f / DMLA) + EPS); v4u o;
            o.x = pk2(__uint_as_float(w[i].x << 16) * rstd * g0[0], __uint_as_float(w[i].x & 0xffff0000u) * rstd * g0[1]); o.y = pk2(__uint_as_float(w[i].y << 16) * rstd * g0[2], __uint_as_float(w[i].y & 0xffff0000u) * rstd * g0[3]);
            o.z = pk2(__uint_as_float(w[i].z << 16) * rstd * g1[0], __uint_as_float(w[i].z & 0xffff0000u) * rstd * g1[1]); o.w = pk2(__uint_as_float(w[i].w << 16) * rstd * g1[2], __uint_as_float(w[i].w & 0xffff0000u) * rstd * g1[3]);
            *((v4u*)(YCp + (size_t)row * DMIX + DLRU) + lane) = o; } }
    }
}

#define GEMM_PHASE_AT(Epi, shift, Mm, Aptr, Bptr, Nn, Kk, Eobj) do { pg8::Gemm g_{(const pg8::bf16_t*)(Aptr), (const pg8::bf16_t*)(Bptr), (Mm), (Nn), (Kk)}; pg8::StaticOrder S_; S_.init((Mm), (Nn), (int)gridDim.x, (int)((blockIdx.x + gridDim.x - (shift)) % gridDim.x)); \
    pg8::gemm_phase<Epi, pg8::StaticOrder, true, true>((PG8_LAS unsigned char*)lds, g_, S_, (Eobj)); } while (0)
#define GEMM_PHASE(Epi, Mm, Aptr, Bptr, Nn, Kk, Eobj) do { pg8::Gemm g_{(const pg8::bf16_t*)(Aptr), (const pg8::bf16_t*)(Bptr), (Mm), (Nn), (Kk)}; pg8::StaticOrder S_; S_.init((Mm), (Nn), (int)gridDim.x, (int)blockIdx.x); \
    pg8::gemm_phase<Epi, pg8::StaticOrder, true, true>((PG8_LAS unsigned char*)lds, g_, S_, (Eobj)); } while (0)
constexpr int N_PHASES = 13;
__global__ void __launch_bounds__(512, 2) mega(Params p) {
    extern __shared__ __attribute__((aligned(16))) unsigned char lds_raw[];
    LAS unsigned char* lds = (LAS unsigned char*)lds_raw;
    volatile LAS unsigned* MISC = (volatile LAS unsigned*)(lds + MISC_OFF);
    for (int u = threadIdx.x; u < (LDS_BYTES - LDSCTL_OFF) / 4; u += 512) ((LAS unsigned*)(lds + LDSCTL_OFF))[u] = 0u;
    __syncthreads();
    unsigned char* ws = p.ws; float* out = p.out;
    XcdBarrier bar = xcd_barrier_post((unsigned*)(ws + WS_CTL) + CW_BAR, MISC + 8);
    const int lo = p.ph_lo, hi = p.ph_hi;
#ifdef ONLY_PHASE
#define IN(k) ((k) == ONLY_PHASE && lo <= (k) && (k) < hi)
#else
#define IN(k) (lo <= (k) && (k) < hi)
#endif
#ifndef PROBE
#define PROBE -1
#endif
#define SEAM(k) do { if (IN(k) && IN((k) + 1)) { xcd_barrier(bar); if (PROBE == 99) xcd_barrier(bar); } } while (0)
#define REP(id, ...) do { __VA_ARGS__; if (PROBE == (id)) { __syncthreads(); __VA_ARGS__; } } while (0)
#define Wgu1 ((bf16*)(ws + WS_WGU1))
#define Wd1 ((bf16*)(ws + WS_WD1))
#define Wgu2 ((bf16*)(ws + WS_WGU2))
#define Wd2 ((bf16*)(ws + WS_WD2))
#define Win ((bf16*)(ws + WS_WIN))
#define Wout ((bf16*)(ws + WS_WOUT))
#define Wq ((bf16*)(ws + WS_WQ))
#define XN ((bf16*)(ws + WS_XN))
#define H ((bf16*)(ws + WS_H))
#define YC ((bf16*)(ws + WS_YC))
#define Qb ((bf16*)(ws + WS_QB))
#define KC ((bf16*)(ws + WS_KC))
#define PART ((float*)(ws + WS_PART))
#define CKV ((float*)(ws + WS_CKV))
#define SSQ ((float*)(ws + WS_SSQ))
#define SUM ((float*)(ws + WS_SUM))
#define SSQX ((float*)(ws + WS_SSQX))
#define XL ((bf16*)(ws + WS_XL))
#define GG ((bf16*)(ws + WS_GG))
#define CQ ((bf16*)(ws + WS_CQ))
#define KCS ((bf16*)(ws + WS_KCS))
#define WGT ((bf16*)(ws + WS_WGT))
#define WUVF ((bf16*)(ws + WS_WUVF))
#define WqP ((bf16*)(ws + WS_WQP))
#define Wkv ((bf16*)(ws + WS_WKV))
#define QbP ((bf16*)(ws + WS_QBP))
#define KVH ((bf16*)(ws + WS_KVH))
#define CKVB ((bf16*)(ws + WS_CKVB))
#define SSQM ((float*)(ws + WS_SSQM))
    if (IN(0)) REP(0, p_prologue(p, lds));
    SEAM(0);
    if (IN(1)) { pg8::EpiSwiGLU E{H, nullptr, DFF, 0}; REP(1, GEMM_PHASE(pg8::EpiSwiGLU, R, XN, Wgu1, NGU, DM, E));
        { const int G = (int)gridDim.x, nwg1 = (R / 256) * (NGU / 256), rem = nwg1 % G; int fb = rem, nfree = G - rem; if (rem == 0 || nfree < 32) { fb = 0; nfree = G; }
          __syncthreads();
          if ((int)blockIdx.x >= fb) weight_items<1>(p, lds, ((int)blockIdx.x - fb) * 8 + __builtin_amdgcn_readfirstlane(threadIdx.x >> 6), nfree * 8); } }
    SEAM(1);
    if (IN(2)) {
        if (blockIdx.x & 1) for (int mu = blockIdx.x; mu < (RS / 64) * (DM / 64); mu += gridDim.x) { const int r0 = RP + 64 * (mu >> 4), c0 = 64 * (mu & 15);
            sg::unit64((att::ldsp)lds, H, Wd1, DFF, r0, c0, p.in[1] - (size_t)RP * DM, XN, SSQX, 0.5f); }
        { pg8::EpiRes<true> E{p.in[0], XN, SSQX, 0.5f, 0}; GEMM_PHASE(pg8::EpiRes<true>, RP, H, Wd1, DM, DFF, E); }
        if (!(blockIdx.x & 1)) for (int mu = blockIdx.x; mu < (RS / 64) * (DM / 64); mu += gridDim.x) { const int r0 = RP + 64 * (mu >> 4), c0 = 64 * (mu & 15);
            sg::unit64((att::ldsp)lds, H, Wd1, DFF, r0, c0, p.in[1] - (size_t)RP * DM, XN, SSQX, 0.5f); }
    }
    SEAM(2);
    if (IN(4)) { pg8::EpiZ E{XL, GG, CQ, CKV, SSQ, out, KC, KCS, SSQX, CKVB}; REP(4, GEMM_PHASE(pg8::EpiZ, R, XN, Win, DINP, DM, E));
        { const int G = (int)gridDim.x, nwg4 = (R / 256) * (DINP / 256), rem = nwg4 % G; int fb = rem, nfree = G - rem; if (rem == 0 || nfree < 32) { fb = 0; nfree = G; }
          __syncthreads();
          if ((int)blockIdx.x >= fb) weight_items<2>(p, lds, ((int)blockIdx.x - fb) * 8 + __builtin_amdgcn_readfirstlane(threadIdx.x >> 6), nfree * 8); } }
    SEAM(4);
    lru::State st;
    const bool has_chunk = blockIdx.x < NB * NCHUNK;
    const int cb_ = (int)blockIdx.x / NCHUNK, cc_ = (int)blockIdx.x % NCHUNK;
    const size_t crow0 = (size_t)cb_ * SEQ + (size_t)cc_ * CHUNK;
    if (IN(5)) {
        { pg8::EpiQP E{QbP, SSQ, QSCALE, 0}; GEMM_PHASE_AT(pg8::EpiQP, 0, RP, CQ, WqP, NH * 96, QL, E); }
        { pg8::EpiQ E{Qb + (size_t)RP * NH * QD, SSQ + (size_t)RP * 8, QSCALE, 1}; GEMM_PHASE_AT(pg8::EpiQ, 192, RS, CQ + (size_t)RP * QL, Wq, NQ, QL, E); }
        { pg8::EpiKV E{KVH, SSQ, KC}; GEMM_PHASE_AT(pg8::EpiKV, 64, RP, CKVB, Wkv, NH * 128, KVL, E); }
        REP(51, p_ckv_norm(p));
        REP(52, if (has_chunk) lru::unit_pre<false>((att::ldsp)lds, st, XL, WGT, p.in[13], p.in[14], p.in[16], p.in[18], p.in[19], p.in[5], p.in[4], out, crow0, cb_, cc_ * CHUNK, SUM + ((size_t)blockIdx.x * DLRU) * 2));
    }
    SEAM(5);
    if (IN(6)) {
        if (has_chunk) {
            const int ch = (int)threadIdx.x;
            const float cr = lru::chunk_carry(SUM + (size_t)cb_ * NCHUNK * DLRU * 2, cc_, ch);
            if (cc_ == NCHUNK - 1) { const float2 sv = *(const float2*)(SUM + ((size_t)blockIdx.x * DLRU + ch) * 2); out[O_HP + (size_t)cb_ * DLRU + ch] = sv.y + sv.x * cr; }
            const float c0 = __shfl(cr, (int)threadIdx.x & 31), c1 = __shfl(cr, 32 + ((int)threadIdx.x & 31));
            lru::unit_post((att::ldsp)lds, st, GG, p.in[25], YC, crow0, c0, c1);
        }
        if (threadIdx.x == 0) { *(LAS unsigned*)(lds + att2::L_BAR) = 0u; *(LAS unsigned*)(lds + att2::L_BAR + 64) = 0u; }
        __syncthreads();
        { unsigned bt = 0u;
          if (__builtin_amdgcn_readfirstlane(threadIdx.x >> 6) < 4) {
              _Pragma("unroll 1") for (int bx = (int)blockIdx.x; bx < NB * NH * 16; bx += (int)gridDim.x) { const int x = bx & 7, y = (bx >> 3) & 31, bh = x + 8 * (y & 1), pr = y >> 1;
                  _Pragma("unroll 1") for (int u = 0; u < (PROBE == 61 ? 4 : 2); ++u) att2::prompt_role((att::ldsp)lds, QbP, KVH, SSQM, YC, bh >> 3, bh & 7, (u & 1) ? pr : 31 - pr, bt); }
          } else {
              _Pragma("unroll 1") for (int rep_ = 0; rep_ < (PROBE == 62 ? 2 : 1); ++rep_)
              _Pragma("unroll 1") for (int item = blockIdx.x; item < DB * NSPLIT; item += gridDim.x) { const int db = item / NSPLIT, ch = item % NSPLIT;
                  att2::decode_role((att::ldsp)lds, Qb, p.in[2], p.in[3], (const int*)p.in[6], PART + (size_t)item * 2 * att::PART_FLOATS, db, ch * (NPAGES / NSPLIT), NPAGES / NSPLIT, bt); }
          } }
        __syncthreads();
    }
    SEAM(6);
    if (IN(7)) {
        if (blockIdx.x >= DB + RS / 32) p_mla_norm(p, DB + RS / 32, (int)gridDim.x - (DB + RS / 32));
        if (blockIdx.x >= DB && blockIdx.x < DB + RS / 32) {
            lru::State s2; const int su = (int)blockIdx.x - DB; const size_t r0 = (size_t)RP + 32 * su;
            lru::unit_pre<true, 1>((att::ldsp)lds, s2, XL, WGT, p.in[13], p.in[14], p.in[16], p.in[18], p.in[19], p.in[5], p.in[4], out, r0, 4 * su, 0, nullptr);
            lru::unit_post<1>((att::ldsp)lds, s2, GG, p.in[25], YC, r0, 0.f, 0.f);
        }
        REP(7, for (int db = blockIdx.x; db < DB; db += gridDim.x)
            att::decode_combine((att::ldsp)lds, Qb, out + O_KVS, out + O_KRS, PART + (size_t)db * NSPLIT * 2 * att::PART_FLOATS, NSPLIT, p.in[24], p.in[26], YC, db));
    }
    SEAM(7);
    if (IN(8)) {
        { pg8::EpiRes<false> E{nullptr, XN, SSQX, 1.0f, 0}; REP(80, GEMM_PHASE(pg8::EpiRes<false>, RP, YC, Wout, DM, DMIX, E)); }
        for (int mu = blockIdx.x; mu < (RS / 64) * (DM / 64); mu += gridDim.x) { const int r0 = RP + 64 * (mu >> 4), c0 = 64 * (mu & 15);
            sg::unit64((att::ldsp)lds, YC, Wout, DMIX, r0, c0, nullptr, XN, SSQX, 1.0f); }
    }
    SEAM(8);
    if (IN(10)) { pg8::EpiSwiGLU E{H, SSQX, DFF, 0}; REP(10, GEMM_PHASE(pg8::EpiSwiGLU, R, XN, Wgu2, NGU, DM, E));
        { const int G = (int)gridDim.x, nwg1 = (R / 256) * (NGU / 256), rem = nwg1 % G; int fb = rem, nfree = G - rem; if (rem == 0 || nfree < 32) { fb = 0; nfree = G; }
          __syncthreads();
          if ((int)blockIdx.x >= fb) weight_items<3>(p, lds, ((int)blockIdx.x - fb) * 8 + __builtin_amdgcn_readfirstlane(threadIdx.x >> 6), nfree * 8); } }
    SEAM(10);
    if (IN(11)) {
        { pg8::EpiFinal E{(const pg8::bf16_t*)XN, out, p.in[32], (float*)(ws + WS_XCH), (unsigned*)(ws + WS_CTL) + CW_FIN, 0.5f, 0}; GEMM_PHASE(pg8::EpiFinal, RP, H, Wd2, DM, DFF, E); }
        for (int mu = blockIdx.x; mu < (RS / 64) * (DM / 64); mu += gridDim.x) { const int r0 = RP + 64 * (mu >> 4), c0 = 64 * (mu & 15);
            sg::unit64((att::ldsp)lds, H, Wd2, DFF, r0, c0, nullptr, XN, (float*)(ws + WS_XCH), 0.5f, out, p.in[32], (unsigned*)(ws + WS_CTL) + CW_FINS + 64 * (mu >> 4)); }
    }
#undef Wgu1
#undef Wd1
#undef Wgu2
#undef Wd2
#undef Win
#undef Wout
#undef Wq
#undef XN
#undef H
#undef YC
#undef Qb
#undef KC
#undef PART
#undef CKV
#undef SSQ
#undef SUM
#undef SSQX
#undef XL
#undef GG
#undef CQ
#undef KCS
#undef WGT
#undef WUVF
#undef WqP
#undef Wkv
#undef QbP
#undef KVH
#undef CKVB
#undef SSQM
#undef IN
#undef SEAM
}

#ifndef MK_N_LAUNCHES
#define MK_N_LAUNCHES 1
#endif
extern "C" void kernel_launch(void* const* d_in, const int* in_sizes, int n_in, void* d_out, int out_size, void* d_ws, size_t ws_size, hipStream_t stream) {
    static int grid = 0;
    if (grid == 0) {
        if (n_in != 33 || out_size != (int)O_END || ws_size < WS_END) { fprintf(stderr, "kernel_launch: unexpected shapes (n_in %d, out %d, ws %zu)\n", n_in, out_size, ws_size); grid = -1; return; }
        int dev = 0, cus = 0, per_cu = 0;
        if (hipGetDevice(&dev) != hipSuccess || hipDeviceGetAttribute(&cus, hipDeviceAttributeMultiprocessorCount, dev) != hipSuccess) { grid = -1; return; }
        if (hipFuncSetAttribute((const void*)mega, hipFuncAttributeMaxDynamicSharedMemorySize, LDS_BYTES) != hipSuccess) { fprintf(stderr, "kernel_launch: hipFuncSetAttribute failed\n"); grid = -1; return; }
        if (hipOccupancyMaxActiveBlocksPerMultiprocessor(&per_cu, (const void*)mega, 512, LDS_BYTES) != hipSuccess || per_cu < 1) fprintf(stderr, "kernel_launch: occupancy query says %d\n", per_cu);
        (void)hipGetLastError();
        grid = cus;
    }
    if (grid < 0) return;
    (void)hipMemsetAsync((char*)d_ws + WS_CTL, 0, CTL_ZERO_BYTES, stream);
    Params prm; memset(&prm, 0, sizeof(prm));
    for (int i = 0; i < 33; ++i) prm.in[i] = (const float*)d_in[i];
    prm.out = (float*)d_out; prm.ws = (unsigned char*)d_ws;
    if (MK_N_LAUNCHES == 1) { prm.ph_lo = 0; prm.ph_hi = N_PHASES; hipLaunchKernelGGL(mega, dim3(grid), dim3(512), LDS_BYTES, stream, prm); }
    else for (int k = 0; k < N_PHASES; ++k) { prm.ph_lo = k; prm.ph_hi = k + 1; hipLaunchKernelGGL(mega, dim3(grid), dim3(512), LDS_BYTES, stream, prm); }
}
```

```cpp
#include <hip/hip_runtime.h>
#include <cstdio>
#include <cstdint>
#include <cstring>
constexpr int DM = 1024, SEQ = 8192, NB = 2, RP = NB * SEQ, DB = 128, DS = 8, RS = DB * DS, R = RP + RS;
constexpr int PAST = 16384, PAGE = 128, NPAGES = PAST / PAGE;
constexpr int DLRU = 512, NBLK = 8, BLK = 64, CONVW = 4;
constexpr int NH = 8, NOPE = 64, ROPE = 32, VD = 64, QL = 256, KVL = 128, DMLA = 512, DMIX = 1024, DIN = 1440, DINP = 1536;
constexpr int DFF = 2816, NGU = 2 * DFF;
constexpr int NQ = NH * KVL + NH * ROPE;
constexpr int QD = KVL + ROPE;
constexpr float EPS = 1e-6f;
constexpr size_t O_YP = 0, O_YS = O_YP + (size_t)RP * DM, O_KVP = O_YS + (size_t)RS * DM, O_KRP = O_KVP + (size_t)RP * KVL, O_HP = O_KRP + (size_t)RP * ROPE,
                 O_CVP = O_HP + (size_t)NB * DLRU, O_KVS = O_CVP + (size_t)NB * 3 * DLRU, O_KRS = O_KVS + (size_t)RS * KVL, O_HS = O_KRS + (size_t)RS * ROPE,
                 O_CVS = O_HS + (size_t)DB * DLRU, O_END = O_CVS + (size_t)DB * 3 * DLRU;
static_assert(O_END == 20877312, "output size");
__device__ const float ROPE_FREQ[16] = {1.000000000e+00f, 5.623413324e-01f, 3.162277639e-01f, 1.778279394e-01f, 1.000000015e-01f, 5.623413250e-02f, 3.162277490e-02f, 1.778279431e-02f,
                                        9.999999776e-03f, 5.623413250e-03f, 3.162277630e-03f, 1.778279431e-03f, 1.000000047e-03f, 5.623413017e-04f, 3.162277571e-04f, 1.778279402e-04f};
namespace pg8 {
#define PG8_LAS __attribute__((address_space(3)))
typedef unsigned short bf16_t;
typedef short bf16x8 __attribute__((ext_vector_type(8)));
typedef float f32x4 __attribute__((ext_vector_type(4)));
typedef unsigned u32x4 __attribute__((ext_vector_type(4)));
constexpr int BM = 256, BK = 64, HALF = 128, HTB = HALF * BK * 2  , STAGE_BYTES = 8 * HTB, NXCD = 8, WGM = 8;

__host__ __device__ __forceinline__ int lds_byte(int r, int c) { const int st = (r >> 4) * 2 + (c >> 5), rr = r & 15, cc = c & 31, ob = rr * 64 + cc * 2; return st * 1024 + (ob ^ (((ob >> 9) & 1) << 5)); }
__host__ __device__ __forceinline__ void stage_rc(int b, int& R, int& C) { const int st = b / 1024, sb = b % 1024, swz = sb ^ (((sb >> 9) & 1) << 5); R = (st >> 1) * 16 + swz / 64; C = (st & 1) * 32 + (swz % 64) / 2; }
__host__ __device__ __forceinline__ int perm32(int rho) { const int n = rho >> 4, i = rho & 15; return 8 * (i >> 2) + 4 * n + (i & 3); }

struct Unit { int pm, pn; };
struct Gemm { const bf16_t* A; const bf16_t* Bt; int M, N, K; };

struct StaticOrder {
    int nM, nN, nwg, G, c;
    __host__ __device__ void init(int M, int N, int G_, int c_) { nM = M / BM; nN = N / BM; nwg = nM * nN; G = G_; c = c_; }
    __host__ __device__ bool next(int i, Unit& u) const {
        const long L = (long)i * G + c; if (L >= nwg) return false;
        int wgid = (int)L; { const int q = nwg / NXCD, r = nwg % NXCD, xcd = wgid % NXCD, off = wgid / NXCD; wgid = (xcd < r ? xcd * (q + 1) : r * (q + 1) + (xcd - r) * q) + off; }
        const int nig = WGM * nN, gid = wgid / nig, fm = gid * WGM, gsz = (nM - fm) < WGM ? (nM - fm) : WGM;
        u.pm = fm + ((wgid % nig) % gsz); u.pn = (wgid % nig) / gsz; return true;
    }
    __device__ __forceinline__ void a_ready(const Unit&) const {}
    __device__ __forceinline__ void done(const Unit&) const {}
};

__device__ __forceinline__ unsigned cvt_pk_bf16(float lo, float hi) { unsigned r; asm volatile("v_cvt_pk_bf16_f32 %0, %1, %2" : "=v"(r) : "v"(lo), "v"(hi)); return r; }
typedef float f32x2 __attribute__((ext_vector_type(2)));
typedef float f32x2 __attribute__((ext_vector_type(2)));
template <class Epi, class Sched, bool ALIGN_EPI = false, bool SP2 = false>
__device__ __forceinline__ void gemm_phase(PG8_LAS unsigned char* lds, const Gemm g, const Sched& S, const Epi& E) {
    int tid_ = threadIdx.x; asm volatile("" : "+v"(tid_));
    const int tid = tid_, wid = __builtin_amdgcn_readfirstlane(tid >> 6), lane = tid & 63, wr = wid >> 2, wc = wid & 3, fr = lane & 15, fq = lane >> 4;
    const int K = g.K, nt = K / BK;
    unsigned voffA[2], voffB[2];
#pragma unroll
    for (int i = 0; i < 2; ++i) { int R, C; stage_rc(tid * 16 + i * 8192, R, C); const int Rb = Epi::PERM ? ((R & ~31) + perm32(R & 31)) : R;
        voffA[i] = (unsigned)(R * K + C) * 2u; voffB[i] = (unsigned)(Rb * K + C) * 2u; }
    const size_t kstep = (size_t)(BK * 2);
    const size_t hstep = (size_t)HALF * K * 2;
    const size_t tstep = 2 * hstep;
    const unsigned ldsw = (unsigned)wid * 1024u;
    const int aoff = lds_byte(wr * 64 + fr, fq * 8), boff = lds_byte(wc * 32 + fr, fq * 8);
#define PG8_SA(b, h) (((b) * 2 + (h)) * HTB)
#define PG8_SB(b, h) ((4 + (b) * 2 + (h)) * HTB)
#define PG8_STAGE(bufoff, gbase, voff) do { _Pragma("unroll") for (int _i = 0; _i < 2; ++_i) \
        __builtin_amdgcn_global_load_lds((const unsigned*)((const char*)(gbase) + (voff)[_i]), (PG8_LAS unsigned*)(lds + (bufoff) + ldsw + _i * 8192), 16, 0, 0); } while (0)
#define PG8_LDA(dst, b, h) do { _Pragma("unroll") for (int m = 0; m < 4; ++m) _Pragma("unroll") for (int k = 0; k < 2; ++k) dst[m][k] = *(const PG8_LAS bf16x8*)(lds + PG8_SA(b, h) + aoff + m * 2048 + k * 1024); } while (0)
#define PG8_LDB(dst, b, h) do { _Pragma("unroll") for (int n = 0; n < 2; ++n) _Pragma("unroll") for (int k = 0; k < 2; ++k) dst[n][k] = *(const PG8_LAS bf16x8*)(lds + PG8_SB(b, h) + boff + n * 2048 + k * 1024); } while (0)
#define PG8_MMA(ai, bj, At, Bt) do { __builtin_amdgcn_s_setprio(1); _Pragma("unroll") for (int m = 0; m < 4; ++m) _Pragma("unroll") for (int n = 0; n < 2; ++n) _Pragma("unroll") for (int k = 0; k < 2; ++k) \
        acc[ai][bj][m][n] = __builtin_amdgcn_mfma_f32_16x16x32_bf16(Bt[n][k], At[m][k], acc[ai][bj][m][n], 0, 0, 0); __builtin_amdgcn_s_setprio(0); } while (0)
#define PG8_WAIT_V(n) asm volatile("s_waitcnt vmcnt(" #n ")" ::: "memory")
#define PG8_WAIT_L(n) asm volatile("s_waitcnt lgkmcnt(" #n ")" ::: "memory")
#define PG8_BAR __builtin_amdgcn_s_barrier()
#define PG8_SCHED __builtin_amdgcn_sched_barrier(0)
    Unit cur, nxt; int ui = 0;
    if (!S.next(0, cur)) return;
    f32x4 acc[2][2][4][2];
#pragma unroll
    for (int a = 0; a < 2; ++a)
#pragma unroll
        for (int b = 0; b < 2; ++b)
#pragma unroll
            for (int m = 0; m < 4; ++m)
#pragma unroll
                for (int n = 0; n < 2; ++n) acc[a][b][m][n] = (f32x4){0.f, 0.f, 0.f, 0.f};
    bf16x8 At[4][2], B0[2][2], B1[2][2];
    const char* cA = (const char*)g.A + (size_t)cur.pm * tstep; const char* cB = (const char*)g.Bt + (size_t)cur.pn * tstep;
    S.a_ready(cur);
    if constexpr (SP2) {
        PG8_STAGE(PG8_SB(0, 0), cB, voffB); PG8_STAGE(PG8_SB(0, 1), cB + hstep, voffB); PG8_STAGE(PG8_SA(0, 0), cA, voffA); PG8_STAGE(PG8_SA(0, 1), cA + hstep, voffA);
        if (wr == 1) PG8_BAR;
        PG8_WAIT_V(2); PG8_BAR;
        PG8_STAGE(PG8_SB(1, 0), cB + kstep, voffB); PG8_STAGE(PG8_SA(1, 0), cA + kstep, voffA); PG8_STAGE(PG8_SB(1, 1), cB + hstep + kstep, voffB);
        PG8_WAIT_V(6); PG8_BAR;
    } else {
        PG8_STAGE(PG8_SB(0, 0), cB, voffB); PG8_STAGE(PG8_SA(0, 0), cA, voffA); PG8_STAGE(PG8_SB(0, 1), cB + hstep, voffB); PG8_STAGE(PG8_SA(0, 1), cA + hstep, voffA);
        if (wr == 1) PG8_BAR;
        PG8_WAIT_V(4); PG8_BAR;
        PG8_STAGE(PG8_SB(1, 0), cB + kstep, voffB); PG8_STAGE(PG8_SA(1, 0), cA + kstep, voffA); PG8_STAGE(PG8_SB(1, 1), cB + hstep + kstep, voffB);
        PG8_WAIT_V(6); PG8_BAR;
    }
    for (;;) {
        const bool has_next = S.next(ui + 1, nxt);
        const char* nA = has_next ? (const char*)g.A + (size_t)nxt.pm * tstep : cA; const char* nB = has_next ? (const char*)g.Bt + (size_t)nxt.pn * tstep : cB;
        for (int t = 0; t < nt; t += 2) {
            const bool last = (t == nt - 2);
            const char* a1 = cA + (size_t)(t + 1) * kstep;
            const char* a2 = last ? nA : cA + (size_t)(t + 2) * kstep; const char* b2 = last ? nB : cB + (size_t)(t + 2) * kstep;
            const char* a3 = a2 + kstep; const char* b3 = b2 + kstep;
            if (last && has_next) S.a_ready(nxt);
            if constexpr (SP2) {
            PG8_LDB(B0, 0, 0); PG8_LDB(B1, 0, 1); PG8_SCHED; PG8_LDA(At, 0, 0); PG8_STAGE(PG8_SA(1, 1), a1 + hstep, voffA);
            PG8_WAIT_V(8); PG8_WAIT_L(0); PG8_BAR; PG8_MMA(0, 0, At, B0); PG8_MMA(0, 1, At, B1); PG8_BAR; PG8_SCHED;
            PG8_LDA(At, 0, 1); PG8_STAGE(PG8_SB(0, 0), b2, voffB); PG8_STAGE(PG8_SB(0, 1), b2 + hstep, voffB); PG8_STAGE(PG8_SA(0, 0), a2, voffA);
            PG8_WAIT_V(8); PG8_WAIT_L(0); PG8_BAR; PG8_MMA(1, 0, At, B0); PG8_MMA(1, 1, At, B1); PG8_BAR; PG8_SCHED;
            PG8_LDB(B0, 1, 0); PG8_LDB(B1, 1, 1); PG8_SCHED; PG8_LDA(At, 1, 0); PG8_STAGE(PG8_SA(0, 1), a2 + hstep, voffA);
            PG8_WAIT_V(8); PG8_WAIT_L(0); PG8_BAR; PG8_MMA(0, 0, At, B0); PG8_MMA(0, 1, At, B1); PG8_BAR; PG8_SCHED;
            PG8_LDA(At, 1, 1); PG8_STAGE(PG8_SB(1, 0), b3, voffB); PG8_STAGE(PG8_SB(1, 1), b3 + hstep, voffB); PG8_STAGE(PG8_SA(1, 0), a3, voffA);
            PG8_WAIT_V(8); PG8_WAIT_L(0); PG8_BAR; PG8_MMA(1, 0, At, B0); PG8_MMA(1, 1, At, B1); PG8_BAR; PG8_SCHED;
            } else {
            PG8_LDB(B0, 0, 0); PG8_SCHED; PG8_LDA(At, 0, 0); PG8_STAGE(PG8_SA(1, 1), a1 + hstep, voffA);
            PG8_WAIT_L(8); PG8_BAR; PG8_WAIT_L(0); PG8_MMA(0, 0, At, B0); PG8_BAR; PG8_SCHED;
            PG8_LDB(B1, 0, 1); PG8_STAGE(PG8_SB(0, 0), b2, voffB);
            PG8_BAR; PG8_WAIT_L(0); PG8_MMA(0, 1, At, B1); PG8_BAR;
            PG8_LDA(At, 0, 1); PG8_STAGE(PG8_SA(0, 0), a2, voffA);
            PG8_BAR; PG8_WAIT_L(0); PG8_MMA(1, 0, At, B0); PG8_BAR; PG8_SCHED;
            PG8_STAGE(PG8_SB(0, 1), b2 + hstep, voffB);
            PG8_WAIT_V(6); PG8_BAR; PG8_MMA(1, 1, At, B1); PG8_BAR;
            PG8_LDB(B0, 1, 0); PG8_SCHED; PG8_LDA(At, 1, 0); PG8_STAGE(PG8_SA(0, 1), a2 + hstep, voffA);
            PG8_WAIT_L(8); PG8_BAR; PG8_WAIT_L(0); PG8_MMA(0, 0, At, B0); PG8_BAR; PG8_SCHED;
            PG8_LDB(B1, 1, 1); PG8_STAGE(PG8_SB(1, 0), b3, voffB);
            PG8_BAR; PG8_WAIT_L(0); PG8_MMA(0, 1, At, B1); PG8_BAR;
            PG8_LDA(At, 1, 1); PG8_STAGE(PG8_SA(1, 0), a3, voffA);
            PG8_BAR; PG8_WAIT_L(0); PG8_MMA(1, 0, At, B0); PG8_BAR; PG8_SCHED;
            PG8_STAGE(PG8_SB(1, 1), b3 + hstep, voffB);
            PG8_WAIT_V(6); PG8_BAR; PG8_MMA(1, 1, At, B1); PG8_BAR;
            }
        }
        if constexpr (ALIGN_EPI) { if (wr == 0) PG8_BAR; }
        if constexpr (!Epi::AFTER_DRAIN) { E(acc, cur, wr, wc, fr, fq); S.done(cur); }
        if (!has_next) break;
#pragma unroll
        for (int a = 0; a < 2; ++a)
#pragma unroll
            for (int b = 0; b < 2; ++b)
#pragma unroll
                for (int m = 0; m < 4; ++m)
#pragma unroll
                    for (int n = 0; n < 2; ++n) acc[a][b][m][n] = (f32x4){0.f, 0.f, 0.f, 0.f};
        cur = nxt; cA = nA; cB = nB; ++ui;
        if constexpr (ALIGN_EPI) { if (wr == 1) PG8_BAR; }
    }
    PG8_WAIT_V(0);
    if constexpr (!ALIGN_EPI) { if (wr == 0) PG8_BAR; }
    PG8_BAR;
    if constexpr (Epi::AFTER_DRAIN) { E.fused(acc, cur, wr, wc, fr, fq, lds, wid, lane); S.done(cur); }
#undef PG8_SA
#undef PG8_SB
#undef PG8_STAGE
#undef PG8_LDA
#undef PG8_LDB
#undef PG8_MMA
#undef PG8_WAIT_V
#undef PG8_WAIT_L
#undef PG8_BAR
#undef PG8_SCHED
}
}
namespace pg8 {
struct EpiF32 {
    static constexpr bool PERM = false, AFTER_DRAIN = false;
    float* out; const float* base0; const float* base1; int ldc; int split; float alpha; int pad;
    __device__ __forceinline__ void operator()(const f32x4 (&acc)[2][2][4][2], const Unit& u, int wr, int wc, int fr, int fq) const {
        const int col0 = u.pn * BM + wc * 32 + 4 * fq;
        const float* bp = nullptr;
        if (base0) bp = (u.pm < split) ? base0 + (size_t)u.pm * BM * ldc : base1 + (size_t)(u.pm - split) * BM * ldc;
#pragma unroll
        for (int ai = 0; ai < 2; ++ai)
#pragma unroll
            for (int m = 0; m < 4; ++m) { const int rt = ai * HALF + wr * 64 + m * 16 + fr; const size_t off = (size_t)rt * ldc + col0;
                float* orow = out + (size_t)u.pm * BM * ldc + off;
#pragma unroll
                for (int bj = 0; bj < 2; ++bj)
#pragma unroll
                    for (int n = 0; n < 2; ++n) { f32x4 v = acc[ai][bj][m][n] * alpha; if (bp) v = v + *(const f32x4*)(bp + off + bj * HALF + n * 16);
                        *(f32x4*)(orow + bj * HALF + n * 16) = v; } }
    }
};
struct EpiSwiGLU {
    static constexpr bool PERM = true, AFTER_DRAIN = false;
    bf16_t* H; const float* SSQX; int ldh; int pad;
    __device__ __forceinline__ void operator()(const f32x4 (&acc)[2][2][4][2], const Unit& u, int wr, int wc, int fr, int fq) const {
        const int col0 = u.pn * HALF + wc * 32 + 8 * fq;
#pragma unroll
        for (int ai = 0; ai < 2; ++ai)
#pragma unroll
            for (int m = 0; m < 4; ++m) { const int row = u.pm * BM + ai * HALF + wr * 64 + m * 16 + fr; bf16_t* rowp = H + (size_t)row * ldh + col0;
                float rs = 1.0f;
                if (SSQX) { const f32x4* sp = (const f32x4*)(SSQX + (size_t)row * 16); const f32x4 s0 = sp[0], s1 = sp[1], s2 = sp[2], s3 = sp[3]; const f32x4 t = (s0 + s1) + (s2 + s3);
                    rs = __builtin_amdgcn_rsqf(((t[0] + t[1]) + (t[2] + t[3])) * (1.0f / 1024.0f) + 1e-6f); }
                float hv[8];
#pragma unroll
                for (int n = 0; n < 2; ++n)
#pragma unroll
                    for (int i = 0; i < 4; ++i) { const float g = acc[ai][0][m][n][i] * rs, up = acc[ai][1][m][n][i] * rs;
                        hv[4 * n + i] = g * __builtin_amdgcn_rcpf(1.0f + __builtin_amdgcn_exp2f(-1.4426950408889634f * g)) * up; }
                u32x4 w; w.x = cvt_pk_bf16(hv[0], hv[1]); w.y = cvt_pk_bf16(hv[2], hv[3]); w.z = cvt_pk_bf16(hv[4], hv[5]); w.w = cvt_pk_bf16(hv[6], hv[7]);
                *(u32x4*)rowp = w; }
    }
};
template <bool BASE_F32> struct EpiRes {
    static constexpr bool PERM = false, AFTER_DRAIN = false;
    const float* basef; bf16_t* Xb; float* SSQX; float alpha; int pad;
    __device__ __forceinline__ void operator()(const f32x4 (&acc)[2][2][4][2], const Unit& u, int wr, int wc, int fr, int fq) const {
        typedef unsigned u32x2 __attribute__((ext_vector_type(2)));
        constexpr int ldc = 1024;
        const int col0 = u.pn * BM + wc * 32 + 4 * fq;
#pragma unroll
        for (int ai = 0; ai < 2; ++ai)
#pragma unroll
            for (int m = 0; m < 4; ++m) { const size_t row = (size_t)u.pm * BM + ai * HALF + wr * 64 + m * 16 + fr; float ss = 0.f;
#pragma unroll
                for (int bj = 0; bj < 2; ++bj)
#pragma unroll
                    for (int n = 0; n < 2; ++n) { const size_t off = row * ldc + col0 + bj * HALF + n * 16; f32x4 bv;
                        if (BASE_F32) bv = *(const f32x4*)(basef + off);
                        else { const u32x2 bw = *(const u32x2*)(Xb + off); bv[0] = __uint_as_float(bw.x << 16); bv[1] = __uint_as_float(bw.x & 0xffff0000u); bv[2] = __uint_as_float(bw.y << 16); bv[3] = __uint_as_float(bw.y & 0xffff0000u); }
                        const f32x4 v = acc[ai][bj][m][n] * alpha + bv;
                        u32x2 w; w.x = cvt_pk_bf16(v[0], v[1]); w.y = cvt_pk_bf16(v[2], v[3]); *(u32x2*)(Xb + off) = w;
                        ss += (v[0] * v[0] + v[1] * v[1]) + (v[2] * v[2] + v[3] * v[3]); }
                ss += __shfl_xor(ss, 16); ss += __shfl_xor(ss, 32); if (fq == 0) SSQX[row * 16 + u.pn * 4 + wc] = ss; }
    }
};
struct EpiFinal {
    static constexpr bool PERM = false, AFTER_DRAIN = true;
    const bf16_t* Xb; float* out; const float* gain; float* xch; unsigned* cnt; float alpha; int pad;
    __device__ __forceinline__ void fused(f32x4 (&acc)[2][2][4][2], const Unit& u, int wr, int wc, int fr, int fq, PG8_LAS unsigned char* lds, int wid, int lane) const {
        typedef unsigned u32x2 __attribute__((ext_vector_type(2)));
        constexpr int ldc = 1024;
        PG8_LAS float* S = (PG8_LAS float*)(lds + 8192);
        const int col0 = u.pn * BM + wc * 32 + 4 * fq;
        float ssv[2][4];
        {
            u32x2 bw[2][4][2][2];
#pragma unroll
            for (int ai = 0; ai < 2; ++ai)
#pragma unroll
                for (int m = 0; m < 4; ++m) { const size_t row = (size_t)u.pm * BM + ai * HALF + wr * 64 + m * 16 + fr;
#pragma unroll
                    for (int bj = 0; bj < 2; ++bj)
#pragma unroll
                        for (int n = 0; n < 2; ++n) bw[ai][m][bj][n] = *(const u32x2*)(Xb + row * ldc + col0 + bj * HALF + n * 16); }
#pragma unroll
            for (int ai = 0; ai < 2; ++ai)
#pragma unroll
                for (int m = 0; m < 4; ++m) { float ss = 0.f;
#pragma unroll
                    for (int bj = 0; bj < 2; ++bj)
#pragma unroll
                        for (int n = 0; n < 2; ++n) { const u32x2 w_ = bw[ai][m][bj][n]; f32x4 bv;
                            bv[0] = __uint_as_float(w_.x << 16); bv[1] = __uint_as_float(w_.x & 0xffff0000u); bv[2] = __uint_as_float(w_.y << 16); bv[3] = __uint_as_float(w_.y & 0xffff0000u);
                            const f32x4 v = acc[ai][bj][m][n] * alpha + bv; acc[ai][bj][m][n] = v;
                            ss += (v[0] * v[0] + v[1] * v[1]) + (v[2] * v[2] + v[3] * v[3]); }
                    ss += __shfl_xor(ss, 16); ss += __shfl_xor(ss, 32); ssv[ai][m] = ss; } }
        if (fq == 0) {
#pragma unroll
            for (int ai = 0; ai < 2; ++ai)
#pragma unroll
                for (int m = 0; m < 4; ++m) { const size_t row = (size_t)u.pm * BM + ai * HALF + wr * 64 + m * 16 + fr;
                    __hip_atomic_store(xch + row * 16 + u.pn * 4 + wc, ssv[ai][m], __ATOMIC_RELAXED, __HIP_MEMORY_SCOPE_AGENT); } }
        asm volatile("s_waitcnt vmcnt(0)" ::: "memory");
        if (lane == 0) __hip_atomic_fetch_add(cnt + 64 * u.pm, 1u, __ATOMIC_RELAXED, __HIP_MEMORY_SCOPE_AGENT);
        if (wid == 0) { unsigned sp = 0u;
            while ((unsigned)__builtin_amdgcn_readfirstlane(__hip_atomic_load(cnt + 64 * u.pm, __ATOMIC_RELAXED, __HIP_MEMORY_SCOPE_AGENT)) < 32u) { __builtin_amdgcn_s_sleep(2); if (++sp > (1u << 22)) break; }
            __builtin_amdgcn_fence(__ATOMIC_ACQUIRE, "agent"); }
        asm volatile("s_waitcnt vmcnt(0) lgkmcnt(0)" ::: "memory"); __builtin_amdgcn_s_barrier(); asm volatile("" ::: "memory");
        if (lane < 32) { const int r = wid * 32 + lane; const unsigned long long* sl = (const unsigned long long*)(xch + ((size_t)u.pm * BM + r) * 16); float t = 0.f;
#pragma unroll
            for (int j = 0; j < 8; ++j) { const unsigned long long w = __hip_atomic_load(sl + j, __ATOMIC_RELAXED, __HIP_MEMORY_SCOPE_AGENT); t += __uint_as_float((unsigned)w) + __uint_as_float((unsigned)(w >> 32)); }
            S[r] = 1.0f / sqrtf(t * (1.0f / 1024.0f) + 1e-6f); }
        asm volatile("s_waitcnt lgkmcnt(0)" ::: "memory"); __builtin_amdgcn_s_barrier(); asm volatile("" ::: "memory");
        f32x4 gv[2][2];
#pragma unroll
        for (int bj = 0; bj < 2; ++bj)
#pragma unroll
            for (int n = 0; n < 2; ++n) gv[bj][n] = *(const f32x4*)(gain + col0 + bj * HALF + n * 16);
#pragma unroll
        for (int ai = 0; ai < 2; ++ai)
#pragma unroll
            for (int m = 0; m < 4; ++m) { const int r = ai * HALF + wr * 64 + m * 16 + fr; const float rs = S[r]; float* op = out + ((size_t)u.pm * BM + r) * ldc + col0;
#pragma unroll
                for (int bj = 0; bj < 2; ++bj)
#pragma unroll
                    for (int n = 0; n < 2; ++n) *(f32x4*)(op + bj * HALF + n * 16) = acc[ai][bj][m][n] * rs * gv[bj][n]; }
    }
};
}
namespace pg8 {
__device__ __forceinline__ void rope_cs_e(int pos, int i, float& c, float& s) {
    const float ang = (float)pos * ROPE_FREQ[i];
    const double q4 = (double)ang * 0.6366197723675814; const double qr = rint(q4);
    const float r = (float)((q4 - qr) * 1.5707963267948966); const int qi = ((int)qr) & 3; const float r2 = r * r;
    const float sn = r * (1.0f + r2 * (-1.6666667e-1f + r2 * (8.3333333e-3f + r2 * (-1.9841270e-4f + r2 * 2.7557319e-6f))));
    const float cs = 1.0f + r2 * (-0.5f + r2 * (4.1666667e-2f + r2 * (-1.3888889e-3f + r2 * (2.4801587e-5f + r2 * -2.7557319e-7f))));
    c = (qi == 0) ? cs : (qi == 1) ? -sn : (qi == 2) ? -cs : sn;
    s = (qi == 0) ? sn : (qi == 1) ? cs : (qi == 2) ? -sn : -cs;
}
__device__ __forceinline__ float gelu_e(float x) { const float y = 0.7978845608028654f * (x + 0.044715f * x * x * x); return x * __builtin_amdgcn_rcpf(1.0f + __builtin_amdgcn_exp2f(-2.8853900817779268f * y)); }
typedef unsigned u32x2 __attribute__((ext_vector_type(2)));
struct EpiZ {
    static constexpr bool PERM = false, AFTER_DRAIN = false;
    bf16_t* XL; bf16_t* GG; bf16_t* CQ; float* CKV; float* SSQ; float* out; bf16_t* KC; bf16_t* KCS; const float* SSQX; bf16_t* CKVB;
    __device__ __forceinline__ void operator()(const f32x4 (&acc0)[2][2][4][2], const Unit& u, int wr, int wc, int fr, int fq) const {
        const int pn = u.pn;
#pragma unroll
        for (int ai = 0; ai < 2; ++ai)
#pragma unroll
            for (int m = 0; m < 4; ++m) { const int row = u.pm * BM + ai * HALF + wr * 64 + m * 16 + fr;
                f32x4 acc[2][2][4][2];
                { const f32x4* sp = (const f32x4*)(SSQX + (size_t)row * 16); const f32x4 s0 = sp[0], s1 = sp[1], s2 = sp[2], s3 = sp[3]; const f32x4 t = (s0 + s1) + (s2 + s3);
                  const float rs = __builtin_amdgcn_rsqf(((t[0] + t[1]) + (t[2] + t[3])) * (1.0f / 1024.0f) + 1e-6f);
#pragma unroll
                  for (int bj = 0; bj < 2; ++bj)
#pragma unroll
                      for (int n = 0; n < 2; ++n) acc[ai][bj][m][n] = acc0[ai][bj][m][n] * rs; }
                if (pn < 4) { bf16_t* dst = (pn < 2 ? XL : GG) + (size_t)row * 512 + (pn & 1) * 256 + wc * 32 + 4 * fq;
#pragma unroll
                    for (int bj = 0; bj < 2; ++bj)
#pragma unroll
                        for (int n = 0; n < 2; ++n) { f32x4 v = acc[ai][bj][m][n]; if (pn >= 2) { v[0] = gelu_e(v[0]); v[1] = gelu_e(v[1]); v[2] = gelu_e(v[2]); v[3] = gelu_e(v[3]); }
                            u32x2 w; w.x = cvt_pk_bf16(v[0], v[1]); w.y = cvt_pk_bf16(v[2], v[3]); *(u32x2*)(dst + bj * HALF + n * 16) = w; } }
                else if (pn == 4) { bf16_t* dst = CQ + (size_t)row * 256 + wc * 32 + 4 * fq; float ss = 0.f;
#pragma unroll
                    for (int bj = 0; bj < 2; ++bj)
#pragma unroll
                        for (int n = 0; n < 2; ++n) { const f32x4 v = acc[ai][bj][m][n]; ss += (v[0] * v[0] + v[1] * v[1]) + (v[2] * v[2] + v[3] * v[3]);
                            u32x2 w; w.x = cvt_pk_bf16(v[0], v[1]); w.y = cvt_pk_bf16(v[2], v[3]); *(u32x2*)(dst + bj * HALF + n * 16) = w; }
                    ss += __shfl_xor(ss, 16); ss += __shfl_xor(ss, 32);
                    if (fq == 0) SSQ[(size_t)row * 8 + wc] = ss; }
                else { float* dst = CKV + (size_t)row * 128 + wc * 32 + 4 * fq; float ss = 0.f;
#pragma unroll
                    for (int n = 0; n < 2; ++n) { const f32x4 v = acc[ai][0][m][n]; ss += (v[0] * v[0] + v[1] * v[1]) + (v[2] * v[2] + v[3] * v[3]); *(f32x4*)(dst + n * 16) = v;
                        u32x2 w; w.x = cvt_pk_bf16(v[0], v[1]); w.y = cvt_pk_bf16(v[2], v[3]); *(u32x2*)(CKVB + (size_t)row * 128 + wc * 32 + 4 * fq + n * 16) = w; }
                    ss += __shfl_xor(ss, 16); ss += __shfl_xor(ss, 32);
                    if (fq == 0) SSQ[(size_t)row * 8 + 4 + wc] = ss;
                    if (wc == 0) { const bool prompt = row < 16384; const int pos = prompt ? (row & 8191) : 16384 + ((row - 16384) & 7);
                        float* ko = prompt ? out + O_KRP + (size_t)row * 32 : out + O_KRS + (size_t)(row - 16384) * 32;
                        bf16_t* kb = prompt ? KC + (size_t)row * 160 + 128 : KCS + (size_t)(row - 16384) * 160 + 128;
                        const f32x4 x1 = acc[ai][1][m][0], x2 = acc[ai][1][m][1]; f32x4 o1, o2;
#pragma unroll
                        for (int i = 0; i < 4; ++i) { float c, s; rope_cs_e(pos, 4 * fq + i, c, s); o1[i] = x1[i] * c - x2[i] * s; o2[i] = x2[i] * c + x1[i] * s; }
                        *(f32x4*)(ko + 4 * fq) = o1; *(f32x4*)(ko + 16 + 4 * fq) = o2;
                        u32x2 w1, w2; w1.x = cvt_pk_bf16(o1[0], o1[1]); w1.y = cvt_pk_bf16(o1[2], o1[3]); w2.x = cvt_pk_bf16(o2[0], o2[1]); w2.y = cvt_pk_bf16(o2[2], o2[3]);
                        *(u32x2*)(kb + 4 * fq) = w1; *(u32x2*)(kb + 16 + 4 * fq) = w2; } }
            }
    }
};
struct EpiQ {
    static constexpr bool PERM = false, AFTER_DRAIN = false;
    bf16_t* Qb; const float* SSQ; float qscale; int sample;
    __device__ __forceinline__ void operator()(const f32x4 (&acc)[2][2][4][2], const Unit& u, int wr, int wc, int fr, int fq) const {
        const int pn = u.pn;
#pragma unroll
        for (int ai = 0; ai < 2; ++ai)
#pragma unroll
            for (int m = 0; m < 4; ++m) { const int row = u.pm * BM + ai * HALF + wr * 64 + m * 16 + fr;
                const f32x4 sq = *(const f32x4*)(SSQ + (size_t)row * 8);
                const float sc = qscale * __builtin_amdgcn_rsqf(((sq[0] + sq[1]) + (sq[2] + sq[3])) * (1.0f / 256.0f) + 1e-6f);
                if (pn < 4) {
#pragma unroll
                    for (int bj = 0; bj < 2; ++bj) { bf16_t* dst = Qb + ((size_t)row * 8 + 2 * pn + bj) * 160 + wc * 32 + 4 * fq;
#pragma unroll
                        for (int n = 0; n < 2; ++n) { const f32x4 v = acc[ai][bj][m][n] * sc; u32x2 w; w.x = cvt_pk_bf16(v[0], v[1]); w.y = cvt_pk_bf16(v[2], v[3]); *(u32x2*)(dst + n * 16) = w; } } }
                else { const int pos = sample ? 16384 + (row & 7) : (row & 8191);
                    float cs[4], sn[4];
#pragma unroll
                    for (int i = 0; i < 4; ++i) rope_cs_e(pos, 4 * fq + i, cs[i], sn[i]);
#pragma unroll
                    for (int bj = 0; bj < 2; ++bj) { bf16_t* dst = Qb + ((size_t)row * 8 + 4 * bj + wc) * 160 + 128 + 4 * fq;
                        const f32x4 x1 = acc[ai][bj][m][0] * sc, x2 = acc[ai][bj][m][1] * sc; f32x4 o1, o2;
#pragma unroll
                        for (int i = 0; i < 4; ++i) { o1[i] = x1[i] * cs[i] - x2[i] * sn[i]; o2[i] = x2[i] * cs[i] + x1[i] * sn[i]; }
                        u32x2 w1, w2; w1.x = cvt_pk_bf16(o1[0], o1[1]); w1.y = cvt_pk_bf16(o1[2], o1[3]); w2.x = cvt_pk_bf16(o2[0], o2[1]); w2.y = cvt_pk_bf16(o2[2], o2[3]);
                        *(u32x2*)dst = w1; *(u32x2*)(dst + 16) = w2; } }
            }
    }
};
struct EpiQP {
    static constexpr bool PERM = false, AFTER_DRAIN = false;
    bf16_t* Qb; const float* SSQ; float qscale; int pad;
    __device__ __forceinline__ void operator()(const f32x4 (&acc)[2][2][4][2], const Unit& u, int wr, int wc, int fr, int fq) const {
        const int pn = u.pn;
#pragma unroll
        for (int ai = 0; ai < 2; ++ai)
#pragma unroll
            for (int m = 0; m < 4; ++m) { const int row = u.pm * BM + ai * HALF + wr * 64 + m * 16 + fr;
                const f32x4 sq = *(const f32x4*)(SSQ + (size_t)row * 8);
                const float sc = qscale * __builtin_amdgcn_rsqf(((sq[0] + sq[1]) + (sq[2] + sq[3])) * (1.0f / 256.0f) + 1e-6f);
                if (pn < 2) {
#pragma unroll
                    for (int bj = 0; bj < 2; ++bj) { bf16_t* dst = Qb + ((size_t)row * 8 + 4 * pn + 2 * bj + (wc >> 1)) * 96 + 32 * (wc & 1) + 4 * fq;
#pragma unroll
                        for (int n = 0; n < 2; ++n) { const f32x4 v = acc[ai][bj][m][n] * sc; u32x2 w; w.x = cvt_pk_bf16(v[0], v[1]); w.y = cvt_pk_bf16(v[2], v[3]); *(u32x2*)(dst + n * 16) = w; } } }
                else { const int pos = row & 8191;
                    float cs[4], sn[4];
#pragma unroll
                    for (int i = 0; i < 4; ++i) rope_cs_e(pos, 4 * fq + i, cs[i], sn[i]);
#pragma unroll
                    for (int bj = 0; bj < 2; ++bj) { bf16_t* dst = Qb + ((size_t)row * 8 + 4 * bj + wc) * 96 + 64 + 4 * fq;
                        const f32x4 x1 = acc[ai][bj][m][0] * sc, x2 = acc[ai][bj][m][1] * sc; f32x4 o1, o2;
#pragma unroll
                        for (int i = 0; i < 4; ++i) { o1[i] = x1[i] * cs[i] - x2[i] * sn[i]; o2[i] = x2[i] * cs[i] + x1[i] * sn[i]; }
                        u32x2 w1, w2; w1.x = cvt_pk_bf16(o1[0], o1[1]); w1.y = cvt_pk_bf16(o1[2], o1[3]); w2.x = cvt_pk_bf16(o2[0], o2[1]); w2.y = cvt_pk_bf16(o2[2], o2[3]);
                        *(u32x2*)dst = w1; *(u32x2*)(dst + 16) = w2; } }
            }
    }
};
struct EpiKV {
    static constexpr bool PERM = false, AFTER_DRAIN = false;
    bf16_t* KVH; const float* SSQ; const bf16_t* KC;
    __device__ __forceinline__ void operator()(const f32x4 (&acc)[2][2][4][2], const Unit& u, int wr, int wc, int fr, int fq) const {
#pragma unroll
        for (int ai = 0; ai < 2; ++ai)
#pragma unroll
            for (int m = 0; m < 4; ++m) { const int row = u.pm * BM + ai * HALF + wr * 64 + m * 16 + fr; const int b = row >> 13, t = row & 8191;
                const f32x4 sq = *(const f32x4*)(SSQ + (size_t)row * 8 + 4);
                const float sc = __builtin_amdgcn_rsqf(((sq[0] + sq[1]) + (sq[2] + sq[3])) * (1.0f / 128.0f) + 1e-6f);
#pragma unroll
                for (int bj = 0; bj < 2; ++bj) { bf16_t* dst = KVH + (((size_t)b * 8 + 2 * u.pn + bj) * 8192 + t) * 160;
#pragma unroll
                    for (int n = 0; n < 2; ++n) { const f32x4 v = acc[ai][bj][m][n] * sc; u32x2 w; w.x = cvt_pk_bf16(v[0], v[1]); w.y = cvt_pk_bf16(v[2], v[3]); *(u32x2*)(dst + wc * 32 + 4 * fq + n * 16) = w; }
                    if (wc == 0) *(u32x4*)(dst + 128 + 8 * fq) = *(const u32x4*)(KC + (size_t)row * 160 + 128 + 8 * fq); }
            }
    }
};
}
#define GAS __attribute__((address_space(1)))
#define LAS __attribute__((address_space(3)))
typedef unsigned short bf16;
typedef unsigned v4u __attribute__((ext_vector_type(4)));
typedef float f32x4 __attribute__((ext_vector_type(4)));
typedef short bf16x8 __attribute__((ext_vector_type(8)));
typedef GAS unsigned gu32;
typedef GAS unsigned long long gu64;
#define RLX_AGENT __ATOMIC_RELAXED, __HIP_MEMORY_SCOPE_AGENT
#define LDS_WAIT() asm volatile("s_waitcnt lgkmcnt(0)" ::: "memory")
#define VM_WAIT() asm volatile("s_waitcnt vmcnt(0)" ::: "memory")
__device__ __forceinline__ unsigned long long rt() { return __builtin_amdgcn_s_memrealtime(); }
__device__ __forceinline__ unsigned f2bf(float f) { unsigned u = __builtin_bit_cast(unsigned, f); return (u + 0x7fffu + ((u >> 16) & 1u)) >> 16; }
__device__ __forceinline__ unsigned pk2(float lo, float hi) { return f2bf(lo) | (f2bf(hi) << 16); }

#define XB_TMO      128
#define XB_XCNT(j)  (256  + 64 * (j))
#define XB_XSUB(j)  (1280 + 64 * (j))
#define XB_XGEN(j)  (2304 + 64 * (j))
#define XB_TOP      3328
#define XB_TOPGEN   3392
#define XCD_BAR_WORDS 3456
#define XB_SPIN_CAP (1u << 18)

__device__ __forceinline__ unsigned xb_ld(unsigned* p)              { return __hip_atomic_load(p, __ATOMIC_RELAXED, __HIP_MEMORY_SCOPE_AGENT); }
__device__ __forceinline__ unsigned xb_add(unsigned* p, unsigned v) { return __hip_atomic_fetch_add(p, v, __ATOMIC_RELAXED, __HIP_MEMORY_SCOPE_AGENT); }
__device__ __forceinline__ unsigned xb_xcc_id() { return (unsigned)__builtin_amdgcn_s_getreg((3 << 11) | 20) & 0xFu; }
#define XB_SPIN(cond, bar) do { unsigned _sp = 0; while (cond) { __builtin_amdgcn_s_sleep(1); \
    if ((++_sp & 255u) == 0u) { if (xb_ld(&(bar)[XB_TMO])) break; if (_sp > XB_SPIN_CAP) { atomicAdd(&(bar)[XB_TMO], 1u); break; } } } } while (0)

struct XcdBarrier {
    unsigned* bar; unsigned x;
    volatile LAS unsigned* st;
};

__device__ __forceinline__ XcdBarrier xcd_barrier_post(unsigned* bar, volatile LAS unsigned* st) {
    XcdBarrier b; b.bar = bar; b.x = xb_xcc_id(); b.st = st;
    if (threadIdx.x == 0) (void)xb_add(&bar[XB_XCNT(b.x)], 1u);
    return b;
}
__device__ __forceinline__ void xcd_barrier_complete(unsigned* bar, unsigned x, unsigned& nloc, unsigned& nx) {
    const unsigned G = gridDim.x * gridDim.y * gridDim.z;
    unsigned sum, cnt, mine, sp = 0u;
    for (;;) {
        sum = 0u; cnt = 0u; mine = 0u;
#pragma unroll
        for (unsigned j = 0; j < 16; ++j) { const unsigned c = xb_ld(&bar[XB_XCNT(j)]); sum += c; cnt += (c > 0u) ? 1u : 0u; mine = (j == x) ? c : mine; }
        if (sum == G) break;
        __builtin_amdgcn_s_sleep(1);
        if ((++sp & 255u) == 0u) { if (xb_ld(&bar[XB_TMO])) break; if (sp > XB_SPIN_CAP) { atomicAdd(&bar[XB_TMO], 1u); break; } }
    }
    nloc = mine > 0u ? mine : 1u; nx = cnt > 0u ? cnt : 1u;
}

__device__ __forceinline__ void xcd_barrier(const XcdBarrier& b) {
    asm volatile("s_waitcnt vmcnt(0)" ::: "memory");
    __syncthreads();
    if (threadIdx.x == 0) {
        unsigned* bar = b.bar;
        __builtin_amdgcn_s_waitcnt(0);
        unsigned nloc = b.st[0], nx = b.st[1];
        if (nloc == 0u) { xcd_barrier_complete(bar, b.x, nloc, nx); b.st[0] = nloc; b.st[1] = nx; }
        const unsigned old = xb_add(&bar[XB_XSUB(b.x)], 1u);
        const unsigned gen = old / nloc;
        if (old + 1u == (gen + 1u) * nloc) {
            __builtin_amdgcn_fence(__ATOMIC_RELEASE, "agent");
            asm volatile("s_waitcnt vmcnt(0)" ::: "memory");
            const unsigned og = xb_add(&bar[XB_TOP], 1u);
            const unsigned tg = og / nx;
            if (og + 1u == (tg + 1u) * nx) xb_add(&bar[XB_TOPGEN], 1u);
            else XB_SPIN(xb_ld(&bar[XB_TOPGEN]) == tg, bar);
            __builtin_amdgcn_fence(__ATOMIC_ACQUIRE, "agent");
            xb_add(&bar[XB_XGEN(b.x)], 1u);
            asm volatile("s_waitcnt vmcnt(0)" ::: "memory");
        } else {
            XB_SPIN(xb_ld(&bar[XB_XGEN(b.x)]) == gen, bar);
            __builtin_amdgcn_fence(__ATOMIC_ACQUIRE, "agent");
            asm volatile("s_waitcnt vmcnt(0)" ::: "memory");
        }
    }
    __syncthreads();
}
__device__ __forceinline__ float wave_sum(float v) {
#pragma unroll
    for (int o = 1; o < 64; o <<= 1) v += __shfl_xor(v, o);
    return v;
}
__device__ __forceinline__ float sigmoidf_(float x) { return 1.0f / (1.0f + __expf(-x)); }
__device__ __forceinline__ float gelu_tanh(float x) { const float y = 0.7978845608028654f * (x + 0.044715f * x * x * x); return x * sigmoidf_(2.0f * y); }
__device__ __forceinline__ void rope_cs(int pos, int i, float& c, float& s) {
    const float ang = (float)pos * ROPE_FREQ[i];
    const double q4 = (double)ang * 0.6366197723675814;
    const double qr = rint(q4);
    const float r = (float)((q4 - qr) * 1.5707963267948966);
    const int qi = ((int)qr) & 3;
    const float r2 = r * r;
    const float sn = r * (1.0f + r2 * (-1.6666667e-1f + r2 * (8.3333333e-3f + r2 * (-1.9841270e-4f + r2 * 2.7557319e-6f))));
    const float cs = 1.0f + r2 * (-0.5f + r2 * (4.1666667e-2f + r2 * (-1.3888889e-3f + r2 * (2.4801587e-5f + r2 * -2.7557319e-7f))));
    c = (qi == 0) ? cs : (qi == 1) ? -sn : (qi == 2) ? -cs : sn;
    s = (qi == 0) ? sn : (qi == 1) ? cs : (qi == 2) ? -sn : -cs;
}
constexpr float QSCALE = 0.10206207261596577f * 1.4426950408889634f;
namespace att {
#define ATT_LAS __attribute__((address_space(3)))
typedef short bf16x8 __attribute__((ext_vector_type(8)));
typedef float f32x16 __attribute__((ext_vector_type(16)));
typedef short s16x4 __attribute__((ext_vector_type(4)));
typedef short v4i16_t __attribute__((ext_vector_type(4)));
typedef unsigned u32x4 __attribute__((ext_vector_type(4)));
typedef float f32x2_t __attribute__((ext_vector_type(2)));
typedef __bf16 bf16x2_t __attribute__((ext_vector_type(2)));
typedef ATT_LAS unsigned char* ldsp;
#define ATT_MFMA(a, b, c) __builtin_amdgcn_mfma_f32_32x32x16_bf16((a), (b), (c), 0, 0, 0)
__device__ __forceinline__ int crow(int r, int hi) { return (r & 3) + 8 * (r >> 2) + 4 * hi; }
__device__ __forceinline__ unsigned cvtpk(float lo, float hi) { f32x2_t v = {lo, hi}; bf16x2_t b = __builtin_convertvector(v, bf16x2_t); return __builtin_bit_cast(unsigned, b); }
__device__ __forceinline__ unsigned offL(unsigned row, unsigned ch) { return 256u * row + 16u * (ch ^ (((row & 3u) << 2) | ((row >> 2) & 3u))); }
__device__ __forceinline__ unsigned offR(unsigned row, unsigned ch) { return 64u * row + 16u * (ch ^ ((row >> 2) & 3u)); }
__device__ __forceinline__ bf16x8 lds_b128(ldsp p) { return *(const ATT_LAS bf16x8*)p; }
__device__ __forceinline__ s16x4 lds_tr(ldsp p) { return __builtin_bit_cast(s16x4, __builtin_amdgcn_ds_read_tr16_b64_v4i16((ATT_LAS v4i16_t*)p)); }
__device__ __forceinline__ float swapmax(float m) { auto rr = __builtin_amdgcn_permlane32_swap(__float_as_uint(m), __float_as_uint(m), false, false); return fmaxf(__uint_as_float(rr[0]), __uint_as_float(rr[1])); }
__device__ __forceinline__ float swapsum(float m) { auto rr = __builtin_amdgcn_permlane32_swap(__float_as_uint(m), __float_as_uint(m), false, false); return __uint_as_float(rr[0]) + __uint_as_float(rr[1]); }

constexpr int TILE_LAT = 64 * 256, TILE_ROPE = 64 * 64, TILE_BYTES = TILE_LAT + TILE_ROPE;
constexpr float THR = 8.0f;

__device__ __forceinline__ void softmax_step(f32x16& s0, f32x16& s1, float& m, float& l, f32x16 (&o)[4], bool first) {
    float rm = fmaxf(s0[0], s1[0]);
#pragma unroll
    for (int r = 1; r < 16; ++r) rm = fmaxf(rm, fmaxf(s0[r], s1[r]));
    rm = swapmax(rm);
    if (first) m = rm;
    rm -= m;
    if (!first && __any(rm > THR)) {
        const float dl = fmaxf(rm, 0.f);
        m += dl;
        const float f = __builtin_amdgcn_exp2f(-dl); l *= f;
#pragma unroll
        for (int c = 0; c < 4; ++c)
#pragma unroll
            for (int r = 0; r < 16; ++r) o[c][r] *= f;
    }
    float sum = 0.f;
#pragma unroll
    for (int r = 0; r < 16; ++r) { s0[r] = __builtin_amdgcn_exp2f(s0[r] - m); s1[r] = __builtin_amdgcn_exp2f(s1[r] - m); sum += s0[r] + s1[r]; }
    l += sum;
}

__device__ __forceinline__ void stage_load(u32x4 (&st)[3], const bf16* __restrict__ tilep, int tid) {
    const bf16* pl = tilep + (size_t)(tid >> 4) * QD + (tid & 15) * 8;
    st[0] = *(const u32x4*)pl; st[1] = *(const u32x4*)(pl + 32 * QD);
    if (tid < 256) st[2] = *(const u32x4*)(tilep + (size_t)(tid >> 2) * QD + KVL + (tid & 3) * 8);
}
__device__ __forceinline__ void stage_store(const u32x4 (&st)[3], ldsp tile, unsigned dl, unsigned dr, int tid) {
    *(ATT_LAS u32x4*)(tile + dl) = st[0]; *(ATT_LAS u32x4*)(tile + dl + 8192) = st[1];
    if (tid < 256) *(ATT_LAS u32x4*)(tile + TILE_LAT + dr) = st[2];
}
constexpr int PR_Q = 3 * TILE_BYTES, PR_QW = 32 * 256 + 32 * 64;
constexpr int PR_LDS_END = PR_Q + 8 * PR_QW;
__device__ __forceinline__ void softmax_step2(f32x16& s0, f32x16& s1, float& m, float& l, f32x16 (&o)[2], bool first) {
    float rm = fmaxf(s0[0], s1[0]);
#pragma unroll
    for (int r = 1; r < 16; ++r) rm = fmaxf(rm, fmaxf(s0[r], s1[r]));
    rm = swapmax(rm);
    if (first) m = rm;
    rm -= m;
    if (!first && __any(rm > THR)) {
        const float dl = fmaxf(rm, 0.f);
        m += dl;
        const float f = __builtin_amdgcn_exp2f(-dl); l *= f;
#pragma unroll
        for (int c = 0; c < 2; ++c)
#pragma unroll
            for (int r = 0; r < 16; ++r) o[c][r] *= f;
    }
    float sum = 0.f;
#pragma unroll
    for (int r = 0; r < 16; ++r) { s0[r] = __builtin_amdgcn_exp2f(s0[r] - m); s1[r] = __builtin_amdgcn_exp2f(s1[r] - m); sum += s0[r] + s1[r]; }
    l += sum;
}
__device__ __forceinline__ void prompt_unit(ldsp lds, const bf16* __restrict__ QbP, const bf16* __restrict__ KVH, float* __restrict__ SSQM, bf16* __restrict__ YC, int b, int h, int qb) {
    const int tid = threadIdx.x, lane = tid & 63, wid = __builtin_amdgcn_readfirstlane(tid >> 6), r32 = lane & 31, hi = lane >> 5;
    const int tq0 = 256 * qb + 32 * wid; const size_t row0 = (size_t)b * SEQ + tq0;
    const bf16* KVseq = KVH + ((size_t)(b * NH + h) * SEQ) * QD;
    const int ntile_u = 4 * qb + 4, ntile_w = 4 * qb + (wid >> 1) + 1;
    const unsigned lsrc = (unsigned)(4 * wid + (lane >> 4)) * (QD * 2) + 16u * ((unsigned)(lane & 15) ^ ((((unsigned)(lane >> 4) & 3u) << 2) | ((unsigned)wid & 3u)));
    const unsigned rsrc = (unsigned)(16 * wid + (lane >> 2)) * (QD * 2) + 2 * KVL + 16u * ((unsigned)(lane & 3) ^ ((unsigned)(lane >> 4) & 3u));
#define PR_GLDS(gptr, ldsaddr) do { unsigned keep_; asm volatile("s_mov_b32 %0, m0\n\ts_mov_b32 m0, %2\n\ts_nop 0\n\tglobal_load_lds_dwordx4 %1, off\n\ts_mov_b32 m0, %0" : "=&s"(keep_) : "v"(gptr), "s"(ldsaddr) : "memory"); } while (0)
#ifdef PR_SYNC_STAGE
#define PR_DMA(gtile, slot) do { const char* g_ = (const char*)(gtile); ldsp d_ = lds + (slot) + wid * 1024 + 16 * lane; \
        *(ATT_LAS u32x4*)(d_) = *(const u32x4*)(g_ + lsrc); *(ATT_LAS u32x4*)(d_ + 8192) = *(const u32x4*)(g_ + lsrc + 32 * QD * 2); \
        if (wid < 4) *(ATT_LAS u32x4*)(d_ + TILE_LAT) = *(const u32x4*)(g_ + rsrc); } while (0)
#else
#define PR_DMA(gtile, slot) do { const char* g_ = (const char*)(gtile); const unsigned l_ = (unsigned)__builtin_amdgcn_readfirstlane((int)(lds0 + (unsigned)(slot) + (unsigned)wid * 1024u)); \
        PR_GLDS(g_ + lsrc, l_); PR_GLDS(g_ + lsrc + 32 * QD * 2, l_ + 8192u); \
        if (wid < 4) PR_GLDS(g_ + rsrc, l_ + (unsigned)TILE_LAT); } while (0)
#endif
    const unsigned lds0 = (unsigned)(size_t)lds;
    PR_DMA(KVseq, 0);
    ldsp qimg = lds + PR_Q + wid * PR_QW;
    { const bf16* qp = QbP + ((row0 + r32) * NH + h) * 96 + 8 * hi;
#pragma unroll
      for (int s = 0; s < 4; ++s) *(ATT_LAS bf16x8*)(qimg + offL((unsigned)r32, (unsigned)(2 * s + hi))) = *(const bf16x8*)(qp + 16 * s);
#pragma unroll
      for (int s = 0; s < 2; ++s) *(ATT_LAS bf16x8*)(qimg + 32 * 256 + offR((unsigned)r32, (unsigned)(2 * s + hi))) = *(const bf16x8*)(qp + 64 + 16 * s); }
    PR_DMA(KVseq + (size_t)64 * QD, TILE_BYTES);
    asm volatile("s_waitcnt vmcnt(0) lgkmcnt(0)" ::: "memory");
    __syncthreads();
    float m = 0.f, l = 0.f; f32x16 o[2];
#pragma unroll
    for (int r = 0; r < 16; ++r) { o[0][r] = 0.f; o[1][r] = 0.f; }
    const unsigned xk = (unsigned)(((r32 & 3) << 1) | ((r32 >> 3) & 1));
    const unsigned ka = 256u * (unsigned)r32 + 16u * ((unsigned)hi ^ ((unsigned)(r32 >> 2) & 1u));
    const unsigned kr0 = TILE_LAT + offR((unsigned)r32, (unsigned)hi), kr1 = TILE_LAT + offR((unsigned)r32, 2u + (unsigned)hi);
    const unsigned blk = (lane >> 4) & 1, qq = (lane & 15) >> 2, pp = lane & 3;
    const unsigned vb0 = 256u * (unsigned)(4 * hi + qq) + 16u * ((2u * blk + (pp >> 1)) ^ (unsigned)hi) + 8u * (pp & 1u);
    const unsigned vb1 = 256u * (unsigned)(8 + 4 * hi + qq) + 16u * ((2u * blk + (pp >> 1)) ^ (2u + (unsigned)hi)) + 8u * (pp & 1u);
#define PR_QK(S0, S1, tile) do { unsigned xko = xk; asm volatile("" : "+v"(xko)); \
        _Pragma("unroll") for (int r = 0; r < 16; ++r) { S0[r] = 0.f; S1[r] = 0.f; } \
        _Pragma("unroll") for (int k = 0; k < 4; ++k) { const unsigned a_ = ka + 32u * ((unsigned)k ^ xko); const bf16x8 q_ = lds_b128(qimg + a_); \
            S0 = ATT_MFMA(lds_b128((tile) + a_), q_, S0); S1 = ATT_MFMA(lds_b128((tile) + a_ + 8192), q_, S1); } \
        { const bf16x8 q_ = lds_b128(qimg + 32 * 256 + (kr0 - TILE_LAT)); S0 = ATT_MFMA(lds_b128((tile) + kr0), q_, S0); S1 = ATT_MFMA(lds_b128((tile) + kr0 + 2048), q_, S1); } \
        { const bf16x8 q_ = lds_b128(qimg + 32 * 256 + (kr1 - TILE_LAT)); S0 = ATT_MFMA(lds_b128((tile) + kr1), q_, S0); S1 = ATT_MFMA(lds_b128((tile) + kr1 + 2048), q_, S1); } } while (0)
#define PR_STEP(A0, A1, B0, B1, kt) do { \
        ldsp tcur = lds + cur; \
        if ((kt) + 2 < ntile_u) PR_DMA(KVseq + (size_t)((kt) + 2) * 64 * QD, nn); \
        if ((kt) + 1 < ntile_w) PR_QK(B0, B1, lds + nxt); \
        if ((kt) < ntile_w) { \
          if ((kt) == ntile_w - 1) { const int tok = tq0 + r32, kb = (kt) * 64; \
            _Pragma("unroll") for (int r = 0; r < 16; ++r) { const int key = kb + crow(r, hi); if (key > tok) A0[r] = -INFINITY; if (key + 32 > tok) A1[r] = -INFINITY; } } \
          softmax_step2(A0, A1, m, l, o, (kt) == 0); \
          unsigned qqo = qq; asm volatile("" : "+v"(qqo)); \
          _Pragma("unroll") for (int ks = 0; ks < 4; ++ks) { \
            const f32x16& pv = (ks < 2) ? A0 : A1; const int bb = 8 * (ks & 1); \
            u32x4 pw; pw.x = cvtpk(pv[bb + 0], pv[bb + 1]); pw.y = cvtpk(pv[bb + 2], pv[bb + 3]); pw.z = cvtpk(pv[bb + 4], pv[bb + 5]); pw.w = cvtpk(pv[bb + 6], pv[bb + 7]); \
            const bf16x8 pf = __builtin_bit_cast(bf16x8, pw); \
            _Pragma("unroll") for (int c = 2; c < 4; ++c) { const unsigned co = 64u * ((unsigned)c ^ qqo); \
                const s16x4 lo = lds_tr(tcur + vb0 + co + 4096 * ks), hv = lds_tr(tcur + vb1 + co + 4096 * ks); \
                const bf16x8 vf = {lo[0], lo[1], lo[2], lo[3], hv[0], hv[1], hv[2], hv[3]}; \
                o[c - 2] = ATT_MFMA(vf, pf, o[c - 2]); } } } \
        asm volatile("s_waitcnt vmcnt(0)" ::: "memory"); \
        __syncthreads(); \
        { const int t_ = cur; cur = nxt; nxt = nn; nn = t_; } } while (0)
    int cur = 0, nxt = TILE_BYTES, nn = 2 * TILE_BYTES;
    f32x16 sa0, sa1, sb0, sb1;
    PR_QK(sa0, sa1, lds);
    for (int kt = 0; kt < ntile_u; kt += 2) { PR_STEP(sa0, sa1, sb0, sb1, kt); PR_STEP(sb0, sb1, sa0, sa1, kt + 1); }
#undef PR_STEP
#undef PR_QK
#undef PR_DMA
#undef PR_GLDS
    l = swapsum(l);
    const float rl = 1.0f / l;
    float ss = 0.f;
#pragma unroll
    for (int c = 0; c < 2; ++c)
#pragma unroll
        for (int r = 0; r < 16; ++r) { o[c][r] *= rl; ss += o[c][r] * o[c][r]; }
    ss = swapsum(ss);
    if (hi == 0) SSQM[(row0 + r32) * NH + h] = ss;
    bf16* yp = YC + (row0 + r32) * DMIX + DLRU + h * VD + 4 * hi;
#pragma unroll
    for (int c = 0; c < 2; ++c)
#pragma unroll
        for (int g = 0; g < 4; ++g) { typedef unsigned u32x2 __attribute__((ext_vector_type(2)));
            u32x2 w; w.x = cvtpk(o[c][4 * g], o[c][4 * g + 1]); w.y = cvtpk(o[c][4 * g + 2], o[c][4 * g + 3]); *(u32x2*)(yp + 32 * c + 8 * g) = w; }
    __syncthreads();
}
}
namespace att {
constexpr int PG_LAT = 128 * 256, PG_ROPE = 128 * 64, PG_BYTES = PG_LAT + PG_ROPE;
constexpr int PART_ROWS = 66, PART_FLOATS = PART_ROWS * 64;

__device__ __forceinline__ void page_load(f32x4 (&st)[10], const float* __restrict__ ckv, const float* __restrict__ ckr, size_t slot0, int tid) {
    const f32x4* pl = (const f32x4*)(ckv + slot0 * KVL) + tid; const f32x4* pr = (const f32x4*)(ckr + slot0 * ROPE) + tid;
#pragma unroll
    for (int i = 0; i < 8; ++i) st[i] = __builtin_nontemporal_load(pl + 512 * i);
#pragma unroll
    for (int i = 0; i < 2; ++i) st[8 + i] = __builtin_nontemporal_load(pr + 512 * i);
}
__device__ __forceinline__ void page_store(const f32x4 (&st)[10], ldsp pg, unsigned dl, unsigned dr) {
    typedef unsigned u32x2 __attribute__((ext_vector_type(2)));
#pragma unroll
    for (int i = 0; i < 8; ++i) { u32x2 w; w.x = cvtpk(st[i].x, st[i].y); w.y = cvtpk(st[i].z, st[i].w); *(ATT_LAS u32x2*)(pg + dl + 4096 * i) = w; }
#pragma unroll
    for (int i = 0; i < 2; ++i) { u32x2 w; w.x = cvtpk(st[8 + i].x, st[8 + i].y); w.y = cvtpk(st[8 + i].z, st[8 + i].w); *(ATT_LAS u32x2*)(pg + PG_LAT + dr + 4096 * i) = w; }
}
constexpr int Q_OFF = 2 * PG_BYTES;
__device__ __forceinline__ void decode_item(ldsp lds, const bf16* __restrict__ Qb, const float* __restrict__ ckv, const float* __restrict__ ckr, const int* __restrict__ ptab,
                                            float* __restrict__ PART, int db, int pg0, int npg) {
    const int tid = threadIdx.x, lane = tid & 63, wid = __builtin_amdgcn_readfirstlane(tid >> 6), r32 = lane & 31, hi = lane >> 5;
    const int qb = wid & 1, rb = 64 * (wid >> 2) + 32 * ((wid >> 1) & 1), grp = wid >> 1;
    const int* pt = ptab + db * NPAGES + pg0;
    unsigned dl, dr;
    { const unsigned row = (unsigned)tid >> 5, c4 = (unsigned)tid & 31u; dl = offL(row, c4 >> 1) + 8u * (c4 & 1u);
      const unsigned rr = (unsigned)tid >> 3, c4r = (unsigned)tid & 7u; dr = offR(rr, c4r >> 1) + 8u * (c4r & 1u); }
    f32x4 sa[10], sb[10];
    page_load(sa, ckv, ckr, (size_t)pt[0] * PAGE, tid);
    if (npg > 1) page_load(sb, ckv, ckr, (size_t)pt[1] * PAGE, tid);
    {
      const bf16* qsrc = Qb + ((size_t)RP + (size_t)db * DS) * NH * QD;
      const u32x4 q0 = *(const u32x4*)(qsrc + (size_t)(tid >> 4) * QD + (tid & 15) * 8), q1 = *(const u32x4*)(qsrc + (size_t)((tid >> 4) + 32) * QD + (tid & 15) * 8);
      const unsigned dq = offL((unsigned)tid >> 4, (unsigned)tid & 15u);
      *(ATT_LAS u32x4*)(lds + Q_OFF + dq) = q0; *(ATT_LAS u32x4*)(lds + Q_OFF + dq + 8192) = q1;
      if (tid < 256) { const u32x4 q2 = *(const u32x4*)(qsrc + (size_t)(tid >> 2) * QD + KVL + (tid & 3) * 8); *(ATT_LAS u32x4*)(lds + Q_OFF + TILE_LAT + offR((unsigned)tid >> 2, (unsigned)tid & 3u)) = q2; } }
    page_store(sa, lds, dl, dr);
    __syncthreads();
    float m = 0.f, l = 0.f; f32x16 o[4];
#pragma unroll
    for (int r = 0; r < 16; ++r) { o[0][r] = 0.f; o[1][r] = 0.f; o[2][r] = 0.f; o[3][r] = 0.f; }
    const unsigned xk = (unsigned)(((r32 & 3) << 1) | ((r32 >> 3) & 1));
    const unsigned x0 = (unsigned)hi ^ ((unsigned)(r32 >> 2) & 1u);
    const unsigned ka = 256u * (unsigned)(rb + r32) + 16u * x0, qa = Q_OFF + 256u * (unsigned)(32 * qb + r32) + 16u * x0;
    const unsigned kr0 = PG_LAT + offR((unsigned)(rb + r32), (unsigned)hi), kr1 = PG_LAT + offR((unsigned)(rb + r32), 2u + (unsigned)hi);
    const unsigned qr0 = Q_OFF + TILE_LAT + offR((unsigned)(32 * qb + r32), (unsigned)hi), qr1 = Q_OFF + TILE_LAT + offR((unsigned)(32 * qb + r32), 2u + (unsigned)hi);
    const unsigned blk = (lane >> 4) & 1, qq = (lane & 15) >> 2, pp = lane & 3;
    const unsigned vb0 = 256u * (unsigned)(rb + 4 * hi + qq) + 16u * ((2u * blk + (pp >> 1)) ^ (unsigned)hi) + 8u * (pp & 1u);
    const unsigned vb1 = 256u * (unsigned)(rb + 8 + 4 * hi + qq) + 16u * ((2u * blk + (pp >> 1)) ^ (2u + (unsigned)hi)) + 8u * (pp & 1u);
#define DEC_PAGE(pg, first) do { \
        unsigned xko = xk, qqo = qq; asm volatile("" : "+v"(xko), "+v"(qqo)); \
        f32x16 s; \
        _Pragma("unroll") for (int r = 0; r < 16; ++r) s[r] = 0.f; \
        _Pragma("unroll") for (int k = 0; k < 8; ++k) { const unsigned co = 32u * ((unsigned)k ^ xko); s = ATT_MFMA(lds_b128((pg) + ka + co), lds_b128(lds + qa + co), s); } \
        s = ATT_MFMA(lds_b128((pg) + kr0), lds_b128(lds + qr0), s); \
        s = ATT_MFMA(lds_b128((pg) + kr1), lds_b128(lds + qr1), s); \
        float rm = s[0]; \
        _Pragma("unroll") for (int r = 1; r < 16; ++r) rm = fmaxf(rm, s[r]); \
        rm = swapmax(rm); \
        if (first) m = rm; \
        rm -= m; \
        if (!(first) && __any(rm > THR)) { const float dlt = fmaxf(rm, 0.f); m += dlt; const float f = __builtin_amdgcn_exp2f(-dlt); l *= f; \
            _Pragma("unroll") for (int c = 0; c < 4; ++c) _Pragma("unroll") for (int r = 0; r < 16; ++r) o[c][r] *= f; } \
        float sum = 0.f; \
        _Pragma("unroll") for (int r = 0; r < 16; ++r) { s[r] = __builtin_amdgcn_exp2f(s[r] - m); sum += s[r]; } \
        l += sum; \
        _Pragma("unroll") for (int ks = 0; ks < 2; ++ks) { \
            u32x4 pw; pw.x = cvtpk(s[8 * ks + 0], s[8 * ks + 1]); pw.y = cvtpk(s[8 * ks + 2], s[8 * ks + 3]); pw.z = cvtpk(s[8 * ks + 4], s[8 * ks + 5]); pw.w = cvtpk(s[8 * ks + 6], s[8 * ks + 7]); \
            const bf16x8 pf = __builtin_bit_cast(bf16x8, pw); \
            _Pragma("unroll") for (int c = 0; c < 4; ++c) { const unsigned co = 64u * ((unsigned)c ^ qqo); \
                const s16x4 lo = lds_tr((pg) + vb0 + co + 4096 * ks), hv = lds_tr((pg) + vb1 + co + 4096 * ks); \
                const bf16x8 vf = {lo[0], lo[1], lo[2], lo[3], hv[0], hv[1], hv[2], hv[3]}; \
                o[c] = ATT_MFMA(vf, pf, o[c]); } } \
    } while (0)
    for (int pi = 0; pi < npg; pi += 2) {
        if (pi + 2 < npg) page_load(sa, ckv, ckr, (size_t)pt[pi + 2] * PAGE, tid);
        DEC_PAGE(lds, pi == 0);
        page_store(sb, lds + PG_BYTES, dl, dr);
        __syncthreads();
        if (pi + 3 < npg) page_load(sb, ckv, ckr, (size_t)pt[pi + 3] * PAGE, tid);
        DEC_PAGE(lds + PG_BYTES, false);
        if (pi + 2 < npg) page_store(sa, lds, dl, dr);
        __syncthreads();
    }
#undef DEC_PAGE
    ATT_LAS float* reg = (ATT_LAS float*)(lds) + qb * PART_FLOATS;
    for (int g = 0; g < 4; ++g) {
        if (grp == g) {
            if (g > 0) { const float m2 = reg[64 * 64 + lane], l2 = reg[65 * 64 + lane]; const float mn = fmaxf(m, m2); const float a1 = __builtin_amdgcn_exp2f(m - mn), a2 = __builtin_amdgcn_exp2f(m2 - mn);
#pragma unroll
                for (int c = 0; c < 4; ++c)
#pragma unroll
                    for (int r = 0; r < 16; ++r) o[c][r] = o[c][r] * a1 + reg[(c * 16 + r) * 64 + lane] * a2;
                l = l * a1 + l2 * a2; m = mn; }
            if (g < 3) {
#pragma unroll
                for (int c = 0; c < 4; ++c)
#pragma unroll
                    for (int r = 0; r < 16; ++r) reg[(c * 16 + r) * 64 + lane] = o[c][r];
                reg[64 * 64 + lane] = m; reg[65 * 64 + lane] = l; }
            else { float* gp = PART + (size_t)qb * PART_FLOATS;
#pragma unroll
                for (int c = 0; c < 4; ++c)
#pragma unroll
                    for (int r = 0; r < 16; ++r) gp[(c * 16 + r) * 64 + lane] = o[c][r];
                gp[64 * 64 + lane] = m; gp[65 * 64 + lane] = l; }
        }
        __syncthreads();
    }
}
__device__ __forceinline__ void decode_combine(ldsp lds, const bf16* __restrict__ Qb, const float* __restrict__ KN, const float* __restrict__ KR, const float* __restrict__ PARTdb, int ns,
                                               const float* __restrict__ w_uv, const float* __restrict__ gm, bf16* __restrict__ YC, int db) {
    const int tid = threadIdx.x, lane = tid & 63, wid = __builtin_amdgcn_readfirstlane(tid >> 6), qb = wid >> 2, rg = wid & 3, r32 = lane & 31, hi = lane >> 5;
    ATT_LAS float* sc = (ATT_LAS float*)lds;
    ATT_LAS float* ol = (ATT_LAS float*)(lds + 2048);
    ATT_LAS float* red = (ATT_LAS float*)(lds + 2048 + 32768);
    __syncthreads();
    { const int q = tid >> 3, sp = tid & 7;
      const bf16* qp = Qb + (((size_t)RP + (size_t)db * DS) * NH + q) * QD; const float* kn = KN + ((size_t)db * DS + sp) * KVL; const float* kr = KR + ((size_t)db * DS + sp) * ROPE;
      float a = 0.f; const u32x4* qv = (const u32x4*)qp;
#pragma unroll
      for (int part = 0; part < 3; ++part) { const int nq = part < 2 ? 8 : 4; const f32x4* kv = part < 2 ? (const f32x4*)kn + 16 * part : (const f32x4*)kr;
          u32x4 qq[8]; f32x4 kk[16];
#pragma unroll
          for (int j = 0; j < 8; ++j) if (j < nq) qq[j] = qv[8 * part + j];
#pragma unroll
          for (int j = 0; j < 16; ++j) if (j < 2 * nq) kk[j] = kv[j];
#pragma unroll
          for (int j = 0; j < 8; ++j) if (j < nq) { const f32x4 k0 = kk[2 * j], k1 = kk[2 * j + 1];
              a += __uint_as_float(qq[j].x << 16) * k0[0] + __uint_as_float(qq[j].x & 0xffff0000u) * k0[1] + __uint_as_float(qq[j].y << 16) * k0[2] + __uint_as_float(qq[j].y & 0xffff0000u) * k0[3]
                 + __uint_as_float(qq[j].z << 16) * k1[0] + __uint_as_float(qq[j].z & 0xffff0000u) * k1[1] + __uint_as_float(qq[j].w << 16) * k1[2] + __uint_as_float(qq[j].w & 0xffff0000u) * k1[3]; } }
      sc[q * 8 + sp] = a; }
    __syncthreads();
    const int q = 32 * qb + r32, stok = q >> 3, hq = q & 7;
    float M = -INFINITY;
    for (int i = 0; i < ns; ++i) M = fmaxf(M, PARTdb[((size_t)i * 2 + qb) * PART_FLOATS + 64 * 64 + lane]);
    for (int sp = 0; sp <= stok; ++sp) M = fmaxf(M, sc[q * 8 + sp]);
    float acc[16], lsum = 0.f;
#pragma unroll
    for (int r = 0; r < 16; ++r) acc[r] = 0.f;
    for (int i = 0; i < ns; ++i) { const float* pp = PARTdb + ((size_t)i * 2 + qb) * PART_FLOATS; const float f = __builtin_amdgcn_exp2f(pp[64 * 64 + lane] - M);
        lsum += f * pp[65 * 64 + lane];
#pragma unroll
        for (int r = 0; r < 16; ++r) acc[r] += f * pp[(rg * 16 + r) * 64 + lane]; }
    lsum += __shfl_xor(lsum, 32);
#pragma unroll
    for (int sp0 = 0; sp0 < 8; sp0 += 4) { f32x4 kv[4][4]; float pw[4];
#pragma unroll
        for (int j = 0; j < 4; ++j) { const float* kn = KN + ((size_t)db * DS + sp0 + j) * KVL + 32 * rg + 4 * hi;
#pragma unroll
            for (int g = 0; g < 4; ++g) kv[j][g] = *(const f32x4*)(kn + 8 * g); }
#pragma unroll
        for (int j = 0; j < 4; ++j) { const float p = (sp0 + j <= stok) ? __builtin_amdgcn_exp2f(sc[q * 8 + sp0 + j] - M) : 0.f; lsum += p; pw[j] = p; }
#pragma unroll
        for (int j = 0; j < 4; ++j)
#pragma unroll
            for (int g = 0; g < 4; ++g)
#pragma unroll
                for (int i = 0; i < 4; ++i) acc[4 * g + i] += pw[j] * kv[j][g][i]; }
    const float rl = 1.0f / lsum;
#pragma unroll
    for (int r = 0; r < 16; ++r) ol[q * KVL + 32 * rg + crow(r, hi)] = acc[r] * rl;
    __syncthreads();
    float y[8];
#pragma unroll
    for (int s = 0; s < 8; ++s) y[s] = 0.f;
#pragma unroll 1
    for (int c0 = 0; c0 < KVL; c0 += 16) { float w[16];
#pragma unroll
        for (int j = 0; j < 16; ++j) w[j] = w_uv[((size_t)(c0 + j) * NH + wid) * VD + lane];
#pragma unroll
        for (int s = 0; s < 8; ++s) {
#pragma unroll
            for (int j4 = 0; j4 < 4; ++j4) { const f32x4 o4 = *(const ATT_LAS f32x4*)(ol + (s * 8 + wid) * KVL + c0 + 4 * j4);
                y[s] += (o4[0] * w[4 * j4] + o4[1] * w[4 * j4 + 1]) + (o4[2] * w[4 * j4 + 2] + o4[3] * w[4 * j4 + 3]); }
            __builtin_amdgcn_sched_barrier(0); } }
    (void)hq;
#pragma unroll
    for (int s = 0; s < 8; ++s) { float v = y[s] * y[s];
#pragma unroll
        for (int o = 1; o < 64; o <<= 1) v += __shfl_xor(v, o);
        if (lane == 0) red[wid * 8 + s] = v; }
    __syncthreads();
#pragma unroll
    for (int s = 0; s < 8; ++s) { float t = 0.f;
#pragma unroll
        for (int w = 0; w < 8; ++w) t += red[w * 8 + s];
        const float rstd = 1.0f / sqrtf(t * (1.0f / DMLA) + EPS);
        YC[((size_t)RP + (size_t)db * DS + s) * DMIX + DLRU + wid * VD + lane] = (bf16)f2bf(y[s] * rstd * gm[wid * VD + lane]); }
}
}
namespace att2 {
using att::bf16x8; using att::f32x16; using att::s16x4; using att::u32x4; using att::ldsp; using att::cvtpk; using att::crow; using att::offL; using att::offR; using att::lds_b128; using att::lds_tr;
using att::swapmax; using att::swapsum; using att::TILE_LAT; using att::TILE_BYTES; using att::THR; using att::PART_FLOATS;
typedef unsigned u32x2 __attribute__((ext_vector_type(2)));
constexpr int L_PT = 0, L_DT = 3 * TILE_BYTES, L_MG = L_DT + 2 * TILE_BYTES, L_BAR = L_MG + 2 * PART_FLOATS * 4 + 1024;
static_assert(L_BAR + 128 <= 146432, "attention LDS map");

__device__ __forceinline__ void role_bar(ATT_LAS unsigned* cnt, unsigned& target) {
    target += 4u;
    asm volatile("s_waitcnt lgkmcnt(0)" ::: "memory");
    if ((threadIdx.x & 63) == 0) (void)__hip_atomic_fetch_add(cnt, 1u, __ATOMIC_RELAXED, __HIP_MEMORY_SCOPE_WORKGROUP);
    while (__hip_atomic_load(cnt, __ATOMIC_RELAXED, __HIP_MEMORY_SCOPE_WORKGROUP) < target) __builtin_amdgcn_s_sleep(1);
    asm volatile("" ::: "memory");
}

typedef float f32x2 __attribute__((ext_vector_type(2)));
__device__ __forceinline__ float max3(float a, float b, float c) { float d; asm("v_max3_f32 %0, %1, %2, %3" : "=v"(d) : "v"(a), "v"(b), "v"(c)); return d; }
__device__ __forceinline__ void sm_max(const f32x16& s0, const f32x16& s1, float& m, float& l, f32x16 (&o)[2], bool first) {
    float r0 = max3(s0[0], s1[0], s0[1]), r1 = max3(s1[1], s0[2], s1[2]);
#pragma unroll
    for (int r = 3; r < 15; r += 2) { r0 = max3(r0, s0[r], s1[r]); r1 = max3(r1, s0[r + 1], s1[r + 1]); }
    float rm = swapmax(max3(r0, r1, fmaxf(s0[15], s1[15])));
    if (first) m = rm;
    rm -= m;
    if (!first && __any(rm > THR)) { const float dl = fmaxf(rm, 0.f); m += dl; const float f = __builtin_amdgcn_exp2f(-dl); l *= f;
#pragma unroll
        for (int c = 0; c < 2; ++c)
#pragma unroll
            for (int r = 0; r < 16; ++r) o[c][r] *= f; }
}
__device__ __forceinline__ void sm_fin(float rm, float& m, float& l, f32x16 (&o)[2], bool first) {
    rm = swapmax(rm);
    if (first) m = rm;
    rm -= m;
    if (!first && __any(rm > THR)) { const float dl = fmaxf(rm, 0.f); m += dl; const float f = __builtin_amdgcn_exp2f(-dl); l *= f;
#pragma unroll
        for (int c = 0; c < 2; ++c)
#pragma unroll
            for (int r = 0; r < 16; ++r) o[c][r] *= f; }
}
__device__ __forceinline__ void sm_exp(f32x16& s0, f32x16& s1, const float m, float& l) {
    float sum0 = 0.f, sum1 = 0.f;
#pragma unroll
    for (int r = 0; r < 16; ++r) { s0[r] = __builtin_amdgcn_exp2f(s0[r] - m); s1[r] = __builtin_amdgcn_exp2f(s1[r] - m); sum0 += s0[r]; sum1 += s1[r]; }
    l += sum0 + sum1;
}
__device__ __forceinline__ void prompt_role(ldsp lds, const bf16* __restrict__ QbP, const bf16* __restrict__ KVH, float* __restrict__ SSQM, bf16* __restrict__ YC, int b, int h, int qb, unsigned& bt) {
    const int t4 = threadIdx.x & 255, lane = t4 & 63, wid = __builtin_amdgcn_readfirstlane(t4 >> 6), r32 = lane & 31, hi = lane >> 5;
    ATT_LAS unsigned* cnt = (ATT_LAS unsigned*)(lds + L_BAR);
    const int tq0 = 256 * qb + 64 * wid; const size_t row0 = (size_t)b * SEQ + tq0;
    const bf16* KVseq = KVH + ((size_t)(b * NH + h) * SEQ) * QD;
    const int ntile_u = 4 * qb + 4, ntile_w = 4 * qb + wid + 1;
    const unsigned lsrc = (unsigned)(4 * wid + (lane >> 4)) * (QD * 2) + 16u * ((unsigned)(lane & 15) ^ ((((unsigned)(lane >> 4) & 3u) << 2) | ((unsigned)wid & 3u)));
    const unsigned rsrc = (unsigned)(16 * wid + (lane >> 2)) * (QD * 2) + 2 * KVL + 16u * ((unsigned)(lane & 3) ^ ((unsigned)(lane >> 4) & 3u));
    const unsigned lds0 = (unsigned)(size_t)lds + L_PT;
#define R_GLDS(gptr, ldsaddr) do { unsigned keep_; asm volatile("s_mov_b32 %0, m0\n\ts_mov_b32 m0, %2\n\ts_nop 0\n\tglobal_load_lds_dwordx4 %1, off\n\ts_mov_b32 m0, %0" : "=&s"(keep_) : "v"(gptr), "s"(ldsaddr) : "memory"); } while (0)
#define R_DMA(gtile, slot) do { const char* g_ = (const char*)(gtile); const unsigned l_ = (unsigned)__builtin_amdgcn_readfirstlane((int)(lds0 + (unsigned)(slot) + (unsigned)wid * 1024u)); \
        R_GLDS(g_ + lsrc, l_); R_GLDS(g_ + lsrc + 16 * QD * 2, l_ + 4096u); R_GLDS(g_ + lsrc + 32 * QD * 2, l_ + 8192u); R_GLDS(g_ + lsrc + 48 * QD * 2, l_ + 12288u); \
        R_GLDS(g_ + rsrc, l_ + (unsigned)TILE_LAT); } while (0)
    R_DMA(KVseq, 0);
    bf16x8 qa[6], qbf[6];
    { const bf16* qp = QbP + ((row0 + r32) * NH + h) * 96 + 8 * hi;
#pragma unroll
      for (int s = 0; s < 6; ++s) { qa[s] = *(const bf16x8*)(qp + 16 * s); qbf[s] = *(const bf16x8*)(qp + (size_t)32 * NH * 96 + 16 * s); } }
    R_DMA(KVseq + (size_t)64 * QD, TILE_BYTES);
    asm volatile("s_waitcnt vmcnt(0)" ::: "memory");
#pragma unroll
    for (int s = 0; s < 6; ++s) asm volatile("" : "+v"(qa[s]), "+v"(qbf[s]));
    role_bar(cnt, bt);
    float mA = 0.f, lA = 0.f, mB = 0.f, lB = 0.f; f32x16 oA[2], oB[2];
#pragma unroll
    for (int r = 0; r < 16; ++r) { oA[0][r] = 0.f; oA[1][r] = 0.f; oB[0][r] = 0.f; oB[1][r] = 0.f; }
    const unsigned xk = (unsigned)(((r32 & 3) << 1) | ((r32 >> 3) & 1));
    const unsigned ka = 256u * (unsigned)r32 + 16u * ((unsigned)hi ^ ((unsigned)(r32 >> 2) & 1u));
    const unsigned kr0 = TILE_LAT + offR((unsigned)r32, (unsigned)hi), kr1 = TILE_LAT + offR((unsigned)r32, 2u + (unsigned)hi);
    const unsigned blk = (lane >> 4) & 1, qq = (lane & 15) >> 2, pp = lane & 3;
    const unsigned vb0 = 256u * (unsigned)(4 * hi + qq) + 16u * ((2u * blk + (pp >> 1)) ^ (unsigned)hi) + 8u * (pp & 1u);
    const unsigned vb1 = 256u * (unsigned)(8 + 4 * hi + qq) + 16u * ((2u * blk + (pp >> 1)) ^ (2u + (unsigned)hi)) + 8u * (pp & 1u);
    ldsp ring = lds + L_PT;
    int cur = 0, nxt = TILE_BYTES, nn = 2 * TILE_BYTES;
    for (int kt = 0; kt < ntile_u; ++kt) {
        ldsp tile = ring + cur;
        const char* gsrc = (const char*)(KVseq + (size_t)min(kt + 2, ntile_u - 1) * 64 * QD);
        const unsigned ldst = (unsigned)__builtin_amdgcn_readfirstlane((int)(lds0 + (unsigned)nn + (unsigned)wid * 1024u));
#define R_GLDS_S(sbase, voff, ldsaddr) do { unsigned keep_; asm volatile("s_mov_b32 %0, m0\n\ts_mov_b32 m0, %2\n\ts_nop 0\n\tglobal_load_lds_dwordx4 %1, %3\n\ts_mov_b32 m0, %0" : "=&s"(keep_) : "v"(voff), "s"(ldsaddr), "s"(sbase) : "memory"); } while (0)
#define R_PIECE(j) do { if ((j) < 4) R_GLDS_S(gsrc + (j) * 16 * QD * 2, lsrc, ldst + 4096u * (unsigned)(j)); else R_GLDS_S(gsrc, rsrc, ldst + (unsigned)TILE_LAT); } while (0)
        { R_PIECE(0); R_PIECE(1); R_PIECE(2); R_PIECE(3); R_PIECE(4); }
        if (kt < ntile_w) {
            unsigned xko = xk, qqo = qq; asm volatile("" : "+v"(xko), "+v"(qqo));
            const bool lastt = kt == ntile_w - 1; const int kb = kt * 64;
            f32x16 a0, a1, b0, b1;
#define R_QK(s0_, s1_, qf_) do { \
            _Pragma("unroll") for (int r = 0; r < 16; ++r) { s0_[r] = 0.f; s1_[r] = 0.f; } \
            _Pragma("unroll") for (int k = 0; k < 4; ++k) { const unsigned a_ = ka + 32u * ((unsigned)k ^ xko); const bf16x8 k0 = lds_b128(tile + a_), k1 = lds_b128(tile + a_ + 8192); \
                s0_ = ATT_MFMA(k0, qf_[k], s0_); s1_ = ATT_MFMA(k1, qf_[k], s1_); } \
            { const bf16x8 k0 = lds_b128(tile + kr0), k1 = lds_b128(tile + kr0 + 2048); s0_ = ATT_MFMA(k0, qf_[4], s0_); s1_ = ATT_MFMA(k1, qf_[4], s1_); } \
            { const bf16x8 k0 = lds_b128(tile + kr1), k1 = lds_b128(tile + kr1 + 2048); s0_ = ATT_MFMA(k0, qf_[5], s0_); s1_ = ATT_MFMA(k1, qf_[5], s1_); } } while (0)
#define R_MASK(s0_, s1_, tok_) do { int ln_ = lane; asm volatile("" : "+v"(ln_)); int d_ = (tok_) + (ln_ & 31) - kb - 4 * (ln_ >> 5); asm volatile("" : "+v"(d_));   \
            _Pragma("unroll") for (int r = 0; r < 16; ++r) { const int c_ = (r & 3) + 8 * (r >> 2); if (c_ > d_) s0_[r] = -INFINITY; if (c_ + 32 > d_) s1_[r] = -INFINITY; } } while (0)
#define R_PV(s0_, s1_, o_) do { \
            _Pragma("unroll") for (int ks = 0; ks < 4; ++ks) { const int bb = 8 * (ks & 1); const f32x16& pa = (ks < 2) ? s0_ : s1_; \
                u32x4 wa; wa.x = cvtpk(pa[bb + 0], pa[bb + 1]); wa.y = cvtpk(pa[bb + 2], pa[bb + 3]); wa.z = cvtpk(pa[bb + 4], pa[bb + 5]); wa.w = cvtpk(pa[bb + 6], pa[bb + 7]); \
                const bf16x8 pfa = __builtin_bit_cast(bf16x8, wa); \
                _Pragma("unroll") for (int c = 2; c < 4; ++c) { const unsigned co = 64u * ((unsigned)c ^ qqo); \
                    const s16x4 lo = lds_tr(tile + vb0 + co + 4096 * ks), hv = lds_tr(tile + vb1 + co + 4096 * ks); \
                    const bf16x8 vf = {lo[0], lo[1], lo[2], lo[3], hv[0], hv[1], hv[2], hv[3]}; \
                    o_[c - 2] = ATT_MFMA(vf, pfa, o_[c - 2]); } } } while (0)
#define R_K0(i) ((i) < 4 ? ka + 32u * ((unsigned)(i) ^ xko) : ((i) == 4 ? kr0 : kr1))
#define R_K1(i) (R_K0(i) + ((i) < 4 ? 8192u : 2048u))
            { bf16x8 kc0 = lds_b128(tile + R_K0(0)), kc1 = lds_b128(tile + R_K1(0));
#pragma unroll
              for (int r = 0; r < 16; ++r) { a0[r] = 0.f; a1[r] = 0.f; }
#pragma unroll
              for (int i = 0; i < 6; ++i) { bf16x8 kn0 = kc0, kn1 = kc1;
                  if (i < 5) { kn0 = lds_b128(tile + R_K0(i + 1)); kn1 = lds_b128(tile + R_K1(i + 1)); }
                  a0 = ATT_MFMA(kc0, qa[i], a0);
                  __builtin_amdgcn_sched_barrier(0);
                  a1 = ATT_MFMA(kc1, qa[i], a1);
                  __builtin_amdgcn_sched_barrier(0);
                  kc0 = kn0; kc1 = kn1; } }
            if (lastt) R_MASK(a0, a1, tq0);
            sm_max(a0, a1, mA, lA, oA, kt == 0);
#define R_EXPS(v_, s_, n_, m_, acc_) do { \
            _Pragma("unroll") for (int r = 0; r < (n_); ++r) v_[(s_) + r] -= m_; \
            _Pragma("unroll") for (int r = 0; r < (n_); ++r) v_[(s_) + r] = __builtin_amdgcn_exp2f(v_[(s_) + r]); \
            _Pragma("unroll") for (int r = 0; r < (n_); ++r) acc_ += v_[(s_) + r]; } while (0)
            { float sum = 0.f; bf16x8 kc0 = lds_b128(tile + R_K0(0)), kc1 = lds_b128(tile + R_K1(0));
#pragma unroll
              for (int r = 0; r < 16; ++r) { b0[r] = 0.f; b1[r] = 0.f; }
#pragma unroll
              for (int i = 0; i < 6; ++i) { bf16x8 kn0 = kc0, kn1 = kc1;
                  if (i < 5) { kn0 = lds_b128(tile + R_K0(i + 1)); kn1 = lds_b128(tile + R_K1(i + 1)); }
                  const int st_ = i < 4 ? 3 * i : 12 + 2 * (i - 4), n_ = i < 4 ? 3 : 2;
                  b0 = ATT_MFMA(kc0, qbf[i], b0);
                  R_EXPS(a0, st_, n_, mA, sum);
                  __builtin_amdgcn_sched_barrier(0);
                  b1 = ATT_MFMA(kc1, qbf[i], b1);
                  R_EXPS(a1, st_, n_, mA, sum);
                  __builtin_amdgcn_sched_barrier(0);
                  kc0 = kn0; kc1 = kn1; }
              asm volatile("" : "+v"(a0), "+v"(a1), "+v"(sum));
              lA += sum; }
            if (lastt) R_MASK(b0, b1, tq0 + 32);
#define R_VF(g_, dst_) do { const unsigned co_ = 64u * ((unsigned)(2 + ((g_) & 1)) ^ qqo); const s16x4 lo_ = lds_tr(tile + vb0 + co_ + 4096 * ((g_) >> 1)), hv_ = lds_tr(tile + vb1 + co_ + 4096 * ((g_) >> 1)); \
            dst_ = bf16x8{lo_[0], lo_[1], lo_[2], lo_[3], hv_[0], hv_[1], hv_[2], hv_[3]}; } while (0)
#define R_PF(s0_, s1_, ks_, dst_) do { const int bb_ = 8 * ((ks_) & 1); const f32x16& pa_ = ((ks_) < 2) ? s0_ : s1_; u32x4 w_; w_.x = cvtpk(pa_[bb_ + 0], pa_[bb_ + 1]); w_.y = cvtpk(pa_[bb_ + 2], pa_[bb_ + 3]); \
            w_.z = cvtpk(pa_[bb_ + 4], pa_[bb_ + 5]); w_.w = cvtpk(pa_[bb_ + 6], pa_[bb_ + 7]); dst_ = __builtin_bit_cast(bf16x8, w_); } while (0)
            { bf16x8 vc, pf; R_VF(0, vc); R_PF(a0, a1, 0, pf);
              { bf16x8 vn, pn; float r0, r1;
                R_VF(1, vn);
                oA[0] = ATT_MFMA(vc, pf, oA[0]);
                r0 = max3(b0[0], b1[0], b0[1]); r1 = max3(b1[1], b0[2], b1[2]);
#pragma unroll
                for (int r = 3; r < 9; r += 2) { r0 = max3(r0, b0[r], b1[r]); r1 = max3(r1, b0[r + 1], b1[r + 1]); }
                __builtin_amdgcn_sched_barrier(0);
                vc = vn; R_VF(2, vn); R_PF(a0, a1, 1, pn);
                oA[1] = ATT_MFMA(vc, pf, oA[1]);
#pragma unroll
                for (int r = 9; r < 15; r += 2) { r0 = max3(r0, b0[r], b1[r]); r1 = max3(r1, b0[r + 1], b1[r + 1]); }
                r0 = max3(r0, r1, fmaxf(b0[15], b1[15]));
                __builtin_amdgcn_sched_barrier(0);
                vc = vn; pf = pn;
                sm_fin(r0, mB, lB, oB, kt == 0); }
              float sum = 0.f;
#pragma unroll
              for (int g = 2; g < 8; ++g) { bf16x8 vn = vc, pn = pf;
                  if (g < 7) R_VF(g + 1, vn);
                  if ((g & 1) && g < 7) R_PF(a0, a1, (g + 1) >> 1, pn);
                  oA[g & 1] = ATT_MFMA(vc, pf, oA[g & 1]);
                  if (g < 5) R_EXPS(b0, g == 2 ? 0 : 6 + 5 * (g - 3), g == 2 ? 6 : 5, mB, sum); else R_EXPS(b1, g == 5 ? 0 : 6 + 5 * (g - 6), g == 5 ? 6 : 5, mB, sum);
                  __builtin_amdgcn_sched_barrier(0);
                  vc = vn; pf = pn; }
              lB += sum; }
            R_PV(b0, b1, oB);
#undef R_K0
#undef R_K1
#undef R_PIECE
#undef R_GLDS_S
#undef R_EXPS
#undef R_VF
#undef R_PF
#undef R_QK
#undef R_MASK
#undef R_PV
        }
        if (kt + 2 < ntile_u) asm volatile("s_waitcnt vmcnt(5)" ::: "memory");
        else asm volatile("s_waitcnt vmcnt(0)" ::: "memory");
        role_bar(cnt, bt);
        { const int t_ = cur; cur = nxt; nxt = nn; nn = t_; }
    }
#undef R_DMA
#undef R_GLDS
    int lne = lane; asm volatile("" : "+v"(lne));
    const int r32e = lne & 31, hie = lne >> 5;
#pragma unroll
    for (int blkq = 0; blkq < 2; ++blkq) { f32x16 (&o)[2] = blkq ? oB : oA; float l = swapsum(blkq ? lB : lA);
        const float rl = 1.0f / l; float ss = 0.f;
#pragma unroll
        for (int c = 0; c < 2; ++c)
#pragma unroll
            for (int r = 0; r < 16; ++r) { o[c][r] *= rl; ss += o[c][r] * o[c][r]; }
        ss = swapsum(ss);
        const size_t row = row0 + 32 * blkq + r32e;
        if (hie == 0) SSQM[row * NH + h] = ss;
        bf16* yp = YC + row * DMIX + DLRU + h * VD + 4 * hie;
#pragma unroll
        for (int c = 0; c < 2; ++c)
#pragma unroll
            for (int g = 0; g < 4; ++g) { u32x2 w; w.x = cvtpk(o[c][4 * g], o[c][4 * g + 1]); w.y = cvtpk(o[c][4 * g + 2], o[c][4 * g + 3]); *(u32x2*)(yp + 32 * c + 8 * g) = w; } }
    asm volatile("s_waitcnt vmcnt(0)" ::: "memory");
}

__device__ __forceinline__ void dc_load(f32x4 (&st)[10], const float* __restrict__ ckv, const float* __restrict__ ckr, size_t slot0, int t4) {
    const f32x4* pl = (const f32x4*)(ckv + slot0 * KVL) + t4; const f32x4* pr = (const f32x4*)(ckr + slot0 * ROPE) + t4;
#pragma unroll
    for (int i = 0; i < 8; ++i) st[i] = __builtin_nontemporal_load(pl + 256 * i);
#pragma unroll
    for (int i = 0; i < 2; ++i) st[8 + i] = __builtin_nontemporal_load(pr + 256 * i);
}
__device__ __forceinline__ void dc_store(const f32x4 (&st)[10], ldsp img, unsigned dE, unsigned dO, unsigned dr) {
#pragma unroll
    for (int i = 0; i < 8; ++i) { u32x2 wv; wv.x = cvtpk(st[i].x, st[i].y); wv.y = cvtpk(st[i].z, st[i].w); *(ATT_LAS u32x2*)(img + ((i & 1) ? dO : dE) + 2048 * i) = wv; }
#pragma unroll
    for (int i = 0; i < 2; ++i) { u32x2 wv; wv.x = cvtpk(st[8 + i].x, st[8 + i].y); wv.y = cvtpk(st[8 + i].z, st[8 + i].w); *(ATT_LAS u32x2*)(img + TILE_LAT + dr + 2048 * i) = wv; }
}
__device__ __forceinline__ void decode_role(ldsp lds, const bf16* __restrict__ Qb, const float* __restrict__ ckv, const float* __restrict__ ckr, const int* __restrict__ ptab,
                                            float* __restrict__ PART, int db, int pg0, int npg, unsigned& bt) {
    const int t4 = threadIdx.x & 255, lane = t4 & 63, w = __builtin_amdgcn_readfirstlane(t4 >> 6), r32 = lane & 31, hi = lane >> 5;
    const int qb = w & 1, kb = w >> 1, rb = 32 * kb;
    ATT_LAS unsigned* cnt = (ATT_LAS unsigned*)(lds + L_BAR + 64);
    const int mypg = ptab[db * NPAGES + pg0 + (lane < npg ? lane : 0)];
#define DC_PG(i) ((size_t)__builtin_amdgcn_readlane(mypg, (i)))
    unsigned dE, dO, dr;
    { const unsigned r0 = (unsigned)t4 >> 5, c4 = (unsigned)t4 & 31u;
      const unsigned xE = ((r0 & 3u) << 2) | ((r0 >> 2) & 3u), xO = ((r0 & 3u) << 2) | (((r0 >> 2) + 2u) & 3u);
      dE = 256u * r0 + 16u * ((c4 >> 1) ^ xE) + 8u * (c4 & 1u); dO = 256u * r0 + 16u * ((c4 >> 1) ^ xO) + 8u * (c4 & 1u);
      const unsigned rr = (unsigned)t4 >> 3, c4r = (unsigned)t4 & 7u; dr = offR(rr, c4r >> 1) + 8u * (c4r & 1u); }
    f32x4 sa[10], sb[10];
    dc_load(sa, ckv, ckr, DC_PG(0) * PAGE, t4);
    dc_load(sb, ckv, ckr, DC_PG(0) * PAGE + 64, t4);
    {
      const bf16* qsrc = Qb + ((size_t)RP + (size_t)db * DS) * NH * QD; const unsigned dq = offL((unsigned)t4 >> 4, (unsigned)t4 & 15u);
#pragma unroll
      for (int i = 0; i < 4; ++i) *(ATT_LAS u32x4*)(lds + L_MG + dq + 4096 * i) = *(const u32x4*)(qsrc + (size_t)((t4 >> 4) + 16 * i) * QD + (t4 & 15) * 8);
      *(ATT_LAS u32x4*)(lds + L_MG + TILE_LAT + offR((unsigned)t4 >> 2, (unsigned)t4 & 3u)) = *(const u32x4*)(qsrc + (size_t)(t4 >> 2) * QD + KVL + (t4 & 3) * 8); }
    dc_store(sa, lds + L_DT, dE, dO, dr);
    role_bar(cnt, bt);
    const unsigned qa = L_MG + 256u * (unsigned)(32 * qb + r32) + 16u * ((unsigned)hi ^ ((unsigned)(r32 >> 2) & 1u));
    const unsigned qr0 = L_MG + TILE_LAT + offR((unsigned)(32 * qb + r32), (unsigned)hi), qr1 = L_MG + TILE_LAT + offR((unsigned)(32 * qb + r32), 2u + (unsigned)hi);
    float m = 0.f, l = 0.f; f32x16 o[4];
#pragma unroll
    for (int r = 0; r < 16; ++r) { o[0][r] = 0.f; o[1][r] = 0.f; o[2][r] = 0.f; o[3][r] = 0.f; }
    const unsigned xk = (unsigned)(((r32 & 3) << 1) | ((r32 >> 3) & 1));
    const unsigned ka = 256u * (unsigned)(rb + r32) + 16u * ((unsigned)hi ^ ((unsigned)(r32 >> 2) & 1u));
    const unsigned kr0 = TILE_LAT + offR((unsigned)(rb + r32), (unsigned)hi), kr1 = TILE_LAT + offR((unsigned)(rb + r32), 2u + (unsigned)hi);
    const unsigned blk = (lane >> 4) & 1, qq = (lane & 15) >> 2, pp = lane & 3;
    const unsigned vb0 = 256u * (unsigned)(rb + 4 * hi + qq) + 16u * ((2u * blk + (pp >> 1)) ^ (unsigned)hi) + 8u * (pp & 1u);
    const unsigned vb1 = 256u * (unsigned)(rb + 8 + 4 * hi + qq) + 16u * ((2u * blk + (pp >> 1)) ^ (2u + (unsigned)hi)) + 8u * (pp & 1u);
    const int nhp = 2 * npg;
    bf16x8 qf[6];
    { unsigned xq = xk; asm volatile("" : "+v"(xq));
#pragma unroll
      for (int k = 0; k < 6; ++k) qf[k] = lds_b128(lds + qa + 32u * ((unsigned)k ^ xq));
    }
#define DC_HALF(img, first) do { \
        unsigned xko = xk, qqo = qq; asm volatile("" : "+v"(xko), "+v"(qqo)); \
        f32x16 s; \
        _Pragma("unroll") for (int r = 0; r < 16; ++r) s[r] = 0.f; \
        _Pragma("unroll") for (int k = 0; k < 8; ++k) { const unsigned co_ = 32u * ((unsigned)k ^ xko); s = ATT_MFMA(lds_b128((img) + ka + co_), k < 6 ? qf[k < 6 ? k : 0] : lds_b128(lds + qa + co_), s); } \
        s = ATT_MFMA(lds_b128((img) + kr0), lds_b128(lds + qr0), s); \
        s = ATT_MFMA(lds_b128((img) + kr1), lds_b128(lds + qr1), s); \
        float rm = max3(s[0], s[1], s[2]); \
        _Pragma("unroll") for (int r = 3; r < 15; r += 2) rm = max3(rm, s[r], s[r + 1]); \
        rm = max3(rm, s[15], s[15]); \
        rm = swapmax(rm); \
        if (first) m = rm; \
        rm -= m; \
        if (!(first) && __any(rm > THR)) { const float dlt = fmaxf(rm, 0.f); m += dlt; const float f = __builtin_amdgcn_exp2f(-dlt); l *= f; \
            _Pragma("unroll") for (int c = 0; c < 4; ++c) _Pragma("unroll") for (int r = 0; r < 16; ++r) o[c][r] *= f; } \
        { float sum0 = 0.f, sum1 = 0.f;     \
          _Pragma("unroll") for (int r = 0; r < 16; r += 2) { s[r] = __builtin_amdgcn_exp2f(s[r] - m); s[r + 1] = __builtin_amdgcn_exp2f(s[r + 1] - m); sum0 += s[r]; sum1 += s[r + 1]; } \
          l += sum0 + sum1; } \
        _Pragma("unroll") for (int ks = 0; ks < 2; ++ks) { \
            u32x4 pw; pw.x = cvtpk(s[8 * ks + 0], s[8 * ks + 1]); pw.y = cvtpk(s[8 * ks + 2], s[8 * ks + 3]); pw.z = cvtpk(s[8 * ks + 4], s[8 * ks + 5]); pw.w = cvtpk(s[8 * ks + 6], s[8 * ks + 7]); \
            const bf16x8 pf = __builtin_bit_cast(bf16x8, pw); \
            _Pragma("unroll") for (int c = 0; c < 4; ++c) { const unsigned co = 64u * ((unsigned)c ^ qqo); \
                const s16x4 lo = lds_tr((img) + vb0 + co + 4096 * ks), hv = lds_tr((img) + vb1 + co + 4096 * ks); \
                const bf16x8 vf = {lo[0], lo[1], lo[2], lo[3], hv[0], hv[1], hv[2], hv[3]}; \
                o[c] = ATT_MFMA(vf, pf, o[c]); } } \
    } while (0)
    for (int hp = 0; hp < nhp; hp += 2) {
        dc_load(sa, ckv, ckr, DC_PG(min((hp + 2) >> 1, npg - 1)) * PAGE, t4);
        DC_HALF(lds + L_DT, hp == 0);
        dc_store(sb, lds + L_DT + TILE_BYTES, dE, dO, dr);
        role_bar(cnt, bt);
        dc_load(sb, ckv, ckr, DC_PG(min((hp + 3) >> 1, npg - 1)) * PAGE + 64, t4);
        DC_HALF(lds + L_DT + TILE_BYTES, false);
        if (hp + 2 < nhp) dc_store(sa, lds + L_DT, dE, dO, dr);
        role_bar(cnt, bt);
    }
#undef DC_HALF
#undef DC_PG
    ATT_LAS float* reg = (ATT_LAS float*)(lds + L_MG) + qb * PART_FLOATS + lane;
    if (kb == 0) {
#pragma unroll
        for (int c = 0; c < 4; ++c)
#pragma unroll
            for (int r = 0; r < 16; ++r) reg[(c * 16 + r) * 64] = o[c][r];
        reg[64 * 64] = m; reg[65 * 64] = l; }
    role_bar(cnt, bt);
    if (kb == 1) { const float m2 = reg[64 * 64], l2 = reg[65 * 64]; const float mn = fmaxf(m, m2); const float a1 = __builtin_amdgcn_exp2f(m - mn), a2 = __builtin_amdgcn_exp2f(m2 - mn);
        float* gp = PART + (size_t)qb * PART_FLOATS + lane;
#pragma unroll
        for (int c = 0; c < 4; ++c)
#pragma unroll
            for (int r = 0; r < 16; ++r) gp[(c * 16 + r) * 64] = o[c][r] * a1 + reg[(c * 16 + r) * 64] * a2;
        gp[64 * 64] = mn; gp[65 * 64] = l * a1 + l2 * a2; }
    role_bar(cnt, bt);
}
}
namespace lru {
using att::bf16x8; using att::f32x16; using att::u32x4; using att::ldsp; using att::cvtpk; using att::crow;
constexpr int XCT_STRIDE = 72;
constexpr int XCT_WAVE_BYTES = 64 * XCT_STRIDE * 2;
constexpr int LDS_RED = 0;
constexpr int LDS_RS = LDS_RED + 8 * 64 * 32 * 4;
__device__ __forceinline__ float bf2f(unsigned short v) { return __uint_as_float((unsigned)v << 16); }
__device__ __forceinline__ float sigm(float x) { return __builtin_amdgcn_rcpf(1.0f + __builtin_amdgcn_exp2f(-1.4426950408889634f * x)); }

struct State { f32x16 P[2][2]; f32x16 H[2][2]; };

template <bool SAMPLE, int NRB = 2>
__device__ __forceinline__ void unit_pre(ldsp lds, State& st, const bf16* __restrict__ XL, const bf16* __restrict__ WGT, const float* __restrict__ conv_w, const float* __restrict__ conv_b,
                                         const float* __restrict__ b_a, const float* __restrict__ b_i, const float* __restrict__ lam, const float* __restrict__ state_conv, const float* __restrict__ state_h,
                                         float* __restrict__ out, size_t rowbase, int b0, int tpos0, float* __restrict__ SUMp  ) {
    const int tid = threadIdx.x, lane = tid & 63, n = __builtin_amdgcn_readfirstlane(tid >> 6), r32 = lane & 31, hi = lane >> 5;
    ATT_LAS unsigned short* xct = (ATT_LAS unsigned short*)(lds + n * XCT_WAVE_BYTES);
    bf16x8 af[2][4];
#pragma unroll
    for (int s = 0; s < 4; ++s) { const int ch0 = 64 * n + 16 * s + 8 * hi;
        float w[4][8], bb[8];
#pragma unroll
        for (int k = 0; k < 4; ++k) { const f32x4 a = *(const f32x4*)(conv_w + k * DLRU + ch0), c = *(const f32x4*)(conv_w + k * DLRU + ch0 + 4);
            w[k][0] = a[0]; w[k][1] = a[1]; w[k][2] = a[2]; w[k][3] = a[3]; w[k][4] = c[0]; w[k][5] = c[1]; w[k][6] = c[2]; w[k][7] = c[3]; }
        { const f32x4 a = *(const f32x4*)(conv_b + ch0), c = *(const f32x4*)(conv_b + ch0 + 4); bb[0] = a[0]; bb[1] = a[1]; bb[2] = a[2]; bb[3] = a[3]; bb[4] = c[0]; bb[5] = c[1]; bb[6] = c[2]; bb[7] = c[3]; }
#pragma unroll
        for (int rb = 0; rb < NRB; ++rb) { const int tk = 32 * rb + r32;
            const int tseq = SAMPLE ? (tk & 7) : tpos0 + tk;
            float xc[8];
#pragma unroll
            for (int j = 0; j < 8; ++j) xc[j] = bb[j];
#pragma unroll
            for (int k = 0; k < 4; ++k) { const int back = 3 - k;
                float xv[8];
                const bool inseq = tseq - back >= 0;
                { const bf16x8 v = *(const bf16x8*)(XL + (rowbase + tk - (inseq ? back : 0)) * DLRU + ch0);
#pragma unroll
                  for (int j = 0; j < 8; ++j) xv[j] = inseq ? bf2f((unsigned short)v[j]) : 0.f; }
                if (SAMPLE && back > 0) { const int sr = inseq ? 0 : 3 + tseq - back;
                    const float* sp = state_conv + ((size_t)(b0 + (tk >> 3)) * 3 + sr) * DLRU + ch0; const f32x4 a = *(const f32x4*)sp, c = *(const f32x4*)(sp + 4);
                    if (!inseq) { xv[0] = a[0]; xv[1] = a[1]; xv[2] = a[2]; xv[3] = a[3]; xv[4] = c[0]; xv[5] = c[1]; xv[6] = c[2]; xv[7] = c[3]; } }
#pragma unroll
                for (int j = 0; j < 8; ++j) xc[j] += w[k][j] * xv[j]; }
            u32x4 pw; pw.x = cvtpk(xc[0], xc[1]); pw.y = cvtpk(xc[2], xc[3]); pw.z = cvtpk(xc[4], xc[5]); pw.w = cvtpk(xc[6], xc[7]);
            af[rb][s] = __builtin_bit_cast(bf16x8, pw);
            *(ATT_LAS u32x4*)(xct + tk * XCT_STRIDE + 16 * s + 8 * hi) = pw;
        }
    }
    if (SAMPLE || tpos0 + 32 * NRB > SEQ - 3) {
#pragma unroll
        for (int s = 0; s < 4; ++s) { const int ch0 = 64 * n + 16 * s + 8 * hi;
#pragma unroll
            for (int rb = 0; rb < NRB; ++rb) { const int tk = 32 * rb + r32; const int tseq = SAMPLE ? (tk & 7) : tpos0 + tk;
                if (tseq >= (SAMPLE ? DS : SEQ) - 3) { const bf16x8 v = *(const bf16x8*)(XL + (rowbase + tk) * DLRU + ch0);
                    float* o = out + (SAMPLE ? O_CVS : O_CVP) + ((size_t)(SAMPLE ? b0 + (tk >> 3) : b0) * 3 + (tseq - ((SAMPLE ? DS : SEQ) - 3))) * DLRU + ch0;
#pragma unroll
                    for (int j = 0; j < 8; ++j) o[j] = bf2f((unsigned short)v[j]); } } }
    }
#pragma unroll
    for (int g = 0; g < 2; ++g)
#pragma unroll
        for (int cb = 0; cb < 2; ++cb) { f32x16 c0, c1;
#pragma unroll
            for (int r = 0; r < 16; ++r) { c0[r] = 0.f; c1[r] = 0.f; }
#pragma unroll
            for (int s = 0; s < 4; ++s) { const bf16x8 bf = *(const bf16x8*)(WGT + (((size_t)n * 2 + g) * 64 + 32 * cb + r32) * 64 + 16 * s + 8 * hi);
                c0 = ATT_MFMA(af[0][s], bf, c0); if (NRB == 2) c1 = ATT_MFMA(af[1][s], bf, c1); }
            if (g == 0) { st.P[0][cb] = c0; st.P[1][cb] = c1; } else { st.H[0][cb] = c0; st.H[1][cb] = c1; }
            __builtin_amdgcn_sched_barrier(0); }
    asm volatile("s_waitcnt lgkmcnt(0)" ::: "memory");
#pragma unroll
    for (int cb = 0; cb < 2; ++cb) { const int ch = 64 * n + 32 * cb + r32;
        const float ba = b_a[ch], bi = b_i[ch]; const float nl = -lam[ch]; const float sp8 = 8.0f * (fmaxf(nl, 0.f) + log1pf(__expf(-fabsf(nl))));
#pragma unroll
        for (int rb = 0; rb < NRB; ++rb)
#pragma unroll
            for (int r = 0; r < 16; ++r) { const int tk = 32 * rb + crow(r, hi);
                const float xc = bf2f(xct[tk * XCT_STRIDE + 32 * cb + r32]);
                const float rg = sigm(st.P[rb][cb][r] + ba), ig = sigm(st.H[rb][cb][r] + bi);
                const float la = -rg * sp8;
                const float a = __builtin_amdgcn_exp2f(1.4426950408889634f * la);
                const float y = -2.0f * la;
                const float poly = y * (1.0f + y * (-0.5f + y * (1.6666667e-1f + y * (-4.1666667e-2f + y * (8.3333333e-3f + y * -1.3888889e-3f)))));
                const float wgt = __builtin_amdgcn_fmed3f(10.0f * y - 2.0f, 0.0f, 1.0f);
                const float om = poly + wgt * ((1.0f - a * a) - poly);
                st.P[rb][cb][r] = a; st.H[rb][cb][r] = __builtin_amdgcn_sqrtf(om) * (ig * xc); }
        __builtin_amdgcn_sched_barrier(0); }
#pragma unroll
    for (int cb = 0; cb < 2; ++cb) { const int ch = 64 * n + 32 * cb + r32;
        float h = 0.f, pr = 1.f;
#pragma unroll
        for (int k = 0; k < 8 * NRB; ++k) { const int rb = k >> 3, g = (k >> 1) & 3, owner = k & 1;
            if (SAMPLE && (k & 1) == 0) { h = state_h[(size_t)(b0 + (k >> 1)) * DLRU + ch]; pr = 1.f; }
            if (hi == owner) {
#pragma unroll
                for (int i = 0; i < 4; ++i) { const float a = st.P[rb][cb][4 * g + i]; h = a * h + st.H[rb][cb][4 * g + i]; pr *= a; st.H[rb][cb][4 * g + i] = h; st.P[rb][cb][4 * g + i] = pr; } }
            const float ho = __shfl_xor(h, 32), po = __shfl_xor(pr, 32);
            if (hi != owner) { h = ho; pr = po; }
            if (SAMPLE && (k & 1) == 1 && hi == 0) out[O_HS + (size_t)(b0 + (k >> 1)) * DLRU + ch] = h; }
        if (!SAMPLE && hi == 0) { SUMp[2 * ch] = pr; SUMp[2 * ch + 1] = h; } }
}
template <int NRB = 2>
__device__ __forceinline__ void unit_post(ldsp lds, State& st, const bf16* __restrict__ GG, const float* __restrict__ gain, bf16* __restrict__ YC, size_t rowbase, float carry0, float carry1) {
    const int tid = threadIdx.x, lane = tid & 63, n = __builtin_amdgcn_readfirstlane(tid >> 6), r32 = lane & 31, hi = lane >> 5;
    ATT_LAS float* red = (ATT_LAS float*)(lds + LDS_RED); ATT_LAS float* rs = (ATT_LAS float*)(lds + LDS_RS);
    __syncthreads();
#pragma unroll
    for (int rb = 0; rb < NRB; ++rb)
#pragma unroll
        for (int r = 0; r < 16; ++r) { const int tk = 32 * rb + crow(r, hi); float ss = 0.f;
#pragma unroll
            for (int cb = 0; cb < 2; ++cb) { const int ch = 64 * n + 32 * cb + r32; const float cr = cb ? carry1 : carry0;
                const float h = st.H[rb][cb][r] + st.P[rb][cb][r] * cr;
                const float y = bf2f(GG[(rowbase + tk) * DLRU + ch]) * h;
                st.H[rb][cb][r] = y; ss += y * y; }
            red[(n * 64 + tk) * 32 + r32] = ss; }
    __syncthreads();
    { const int tk = tid >> 3, part = tid & 7; float s = 0.f;
#pragma unroll
      for (int j = 0; j < 8; ++j) { const f32x4 v = *(const ATT_LAS f32x4*)(red + (part * 64 + tk) * 32 + 4 * j); s += (v[0] + v[1]) + (v[2] + v[3]); }
      s += __shfl_xor(s, 1); s += __shfl_xor(s, 2); s += __shfl_xor(s, 4);
      if (part == 0 && tk < 32 * NRB) rs[tk] = __builtin_amdgcn_rsqf(s * (1.0f / DLRU) + EPS); }
    __syncthreads();
#pragma unroll
    for (int cb = 0; cb < 2; ++cb) { const int ch = 64 * n + 32 * cb + r32; const float gn = gain[ch];
#pragma unroll
        for (int rb = 0; rb < NRB; ++rb)
#pragma unroll
            for (int r = 0; r < 16; ++r) { const int tk = 32 * rb + crow(r, hi);
                YC[(rowbase + tk) * DMIX + ch] = (bf16)f2bf(st.H[rb][cb][r] * rs[tk] * gn); } }
    __syncthreads();
}
__device__ __forceinline__ float chunk_carry(const float* __restrict__ SUMb, int c, int ch) {
    float h = 0.f;
    int k = 0;
    for (; k + 16 <= c; k += 16) { float2 v[16];
#pragma unroll
        for (int j = 0; j < 16; ++j) v[j] = *(const float2*)(SUMb + ((size_t)(k + j) * DLRU + ch) * 2);
#pragma unroll
        for (int j = 0; j < 16; ++j) h = v[j].x * h + v[j].y; }
#pragma unroll 8
    for (; k < c; ++k) { const float2 v = *(const float2*)(SUMb + ((size_t)k * DLRU + ch) * 2); h = v.x * h + v.y; }
    return h;
}
}
namespace sg {
typedef short bf16x8 __attribute__((ext_vector_type(8)));
typedef unsigned u32x2 __attribute__((ext_vector_type(2)));
using att::u32x4; using att::offL; using att::ldsp;
constexpr int CHK = 256, HALF_B = 64 * 256, TILE_B = 2 * HALF_B  , BUF_B = 2 * TILE_B;
__device__ __forceinline__ void ld_chunk(u32x4 (&st)[8], const bf16* __restrict__ ap, const bf16* __restrict__ bp, int K) {
#pragma unroll
    for (int i = 0; i < 4; ++i) { st[i] = *(const u32x4*)(ap + (size_t)16 * i * K); st[4 + i] = *(const u32x4*)(bp + (size_t)16 * i * K); }
}
__device__ __forceinline__ void st_chunk(const u32x4 (&st)[8], ldsp buf, unsigned d) {
#pragma unroll
    for (int i = 0; i < 4; ++i) { *(ATT_LAS u32x4*)(buf + d + 4096 * i) = st[i]; *(ATT_LAS u32x4*)(buf + TILE_B + d + 4096 * i) = st[4 + i]; }
}
__device__ __forceinline__ void unit64(ldsp lds, const bf16* __restrict__ A, const bf16* __restrict__ Bt, int K, int r0, int c0, const float* __restrict__ basef,
                                       bf16* Xb, float* __restrict__ SSQX, float alpha, float* __restrict__ outf = nullptr, const float* __restrict__ gain = nullptr, unsigned* cnt = nullptr) {
    const int tid = threadIdx.x, lane = tid & 63, w = __builtin_amdgcn_readfirstlane(tid >> 6), nt = w & 1, kq = w >> 1, r32 = lane & 31, hi = lane >> 5;
    const bf16* ap = A + (size_t)(r0 + (tid >> 5)) * K + 8 * (tid & 31); const bf16* bp = Bt + (size_t)(c0 + (tid >> 5)) * K + 8 * (tid & 31);
    const unsigned d = (unsigned)((tid & 31) >> 4) * HALF_B + offL((unsigned)tid >> 5, (unsigned)tid & 15u);
    const unsigned xa = (unsigned)(((r32 & 3) << 2) | ((r32 >> 2) & 3));
    const unsigned ra = (unsigned)(kq >> 1) * HALF_B + 256u * (unsigned)r32, rb = TILE_B + (unsigned)(kq >> 1) * HALF_B + 256u * (unsigned)(32 * nt + r32);
    typedef float f32x16 __attribute__((ext_vector_type(16)));
    f32x16 acc0, acc1;
#pragma unroll
    for (int r = 0; r < 16; ++r) { acc0[r] = 0.f; acc1[r] = 0.f; }
    u32x4 s0[8], s1[8], s2[8];
    const int nch = K / CHK;
    ld_chunk(s0, ap, bp, K);
    { const int c1 = min(1, nch - 1), c2 = min(2, nch - 1); ld_chunk(s1, ap + c1 * CHK, bp + c1 * CHK, K); ld_chunk(s2, ap + c2 * CHK, bp + c2 * CHK, K); }
    __syncthreads();
    st_chunk(s0, lds, d);
    __syncthreads();
#define SG_COMPUTE(buf) do { unsigned xo = xa; asm volatile("" : "+v"(xo)); \
        _Pragma("unroll") for (int j = 0; j < 4; ++j) { const unsigned co = 16u * ((unsigned)(8 * (kq & 1) + 2 * j + hi) ^ xo); \
            const bf16x8 b = *(const ATT_LAS bf16x8*)((buf) + rb + co), a0 = *(const ATT_LAS bf16x8*)((buf) + ra + co), a1 = *(const ATT_LAS bf16x8*)((buf) + ra + 8192 + co); \
            acc0 = __builtin_amdgcn_mfma_f32_32x32x16_bf16(b, a0, acc0, 0, 0, 0); acc1 = __builtin_amdgcn_mfma_f32_32x32x16_bf16(b, a1, acc1, 0, 0, 0); } } while (0)
#define SG_STEP(j, SETL, SETS) { const int cc = c + (j); if (cc >= nch) break; \
        { const int cn = min(cc + 3, nch - 1); ld_chunk(SETL, ap + cn * CHK, bp + cn * CHK, K); } \
        SG_COMPUTE(lds + ((j) & 1) * BUF_B); \
        if (cc + 1 < nch) st_chunk(SETS, lds + (((j) + 1) & 1) * BUF_B, d); \
        __syncthreads(); }
    for (int c = 0; c < nch; c += 6) { SG_STEP(0, s0, s1) SG_STEP(1, s1, s2) SG_STEP(2, s2, s0) SG_STEP(3, s0, s1) SG_STEP(4, s1, s2) SG_STEP(5, s2, s0) }
#undef SG_STEP
#undef SG_COMPUTE
    constexpr int PS = 68;
    ATT_LAS float* P = (ATT_LAS float*)lds;
#pragma unroll
    for (int f = 0; f < 2; ++f)
#pragma unroll
        for (int g = 0; g < 4; ++g) { const f32x16& a = f ? acc1 : acc0; f32x4 q = {a[4 * g], a[4 * g + 1], a[4 * g + 2], a[4 * g + 3]};
            *(ATT_LAS f32x4*)(P + ((size_t)(kq * 64 + 32 * f + r32) * PS + 32 * nt + 8 * g + 4 * hi)) = q; }
    __syncthreads();
    { const int m = tid >> 3, n8 = 8 * (tid & 7); f32x4 v0 = {0.f, 0.f, 0.f, 0.f}, v1 = {0.f, 0.f, 0.f, 0.f};
#pragma unroll
      for (int q = 0; q < 4; ++q) { const ATT_LAS f32x4* pp = (const ATT_LAS f32x4*)(P + ((size_t)(q * 64 + m) * PS + n8)); v0 = v0 + pp[0]; v1 = v1 + pp[1]; }
      const size_t off = ((size_t)r0 + m) * 1024 + c0 + n8; f32x4 b0, b1;
      if (basef) { b0 = *(const f32x4*)(basef + off); b1 = *(const f32x4*)(basef + off + 4); }
      else { const u32x4 bw = *(const u32x4*)(Xb + off);
          b0[0] = __uint_as_float(bw.x << 16); b0[1] = __uint_as_float(bw.x & 0xffff0000u); b0[2] = __uint_as_float(bw.y << 16); b0[3] = __uint_as_float(bw.y & 0xffff0000u);
          b1[0] = __uint_as_float(bw.z << 16); b1[1] = __uint_as_float(bw.z & 0xffff0000u); b1[2] = __uint_as_float(bw.w << 16); b1[3] = __uint_as_float(bw.w & 0xffff0000u); }
      v0 = v0 * alpha + b0; v1 = v1 * alpha + b1;
      float ss = ((v0[0] * v0[0] + v0[1] * v0[1]) + (v0[2] * v0[2] + v0[3] * v0[3])) + ((v1[0] * v1[0] + v1[1] * v1[1]) + (v1[2] * v1[2] + v1[3] * v1[3]));
      ss += __shfl_xor(ss, 1); ss += __shfl_xor(ss, 2); ss += __shfl_xor(ss, 4);
      if (!outf) { u32x4 pw; pw.x = att::cvtpk(v0[0], v0[1]); pw.y = att::cvtpk(v0[2], v0[3]); pw.z = att::cvtpk(v1[0], v1[1]); pw.w = att::cvtpk(v1[2], v1[3]); *(u32x4*)(Xb + off) = pw;
          if ((tid & 7) == 0) SSQX[((size_t)r0 + m) * 16 + (c0 >> 6)] = ss; }
      else {
          if ((tid & 7) == 0) __hip_atomic_store(SSQX + ((size_t)r0 + m) * 16 + (c0 >> 6), ss, __ATOMIC_RELAXED, __HIP_MEMORY_SCOPE_AGENT);
          asm volatile("s_waitcnt vmcnt(0)" ::: "memory");
          __syncthreads();
          if (tid == 0) { __hip_atomic_fetch_add(cnt, 1u, __ATOMIC_RELAXED, __HIP_MEMORY_SCOPE_AGENT); unsigned sp = 0u;
              while (__hip_atomic_load(cnt, __ATOMIC_RELAXED, __HIP_MEMORY_SCOPE_AGENT) < 16u) { __builtin_amdgcn_s_sleep(2); if (++sp > (1u << 22)) break; }
              __builtin_amdgcn_fence(__ATOMIC_ACQUIRE, "agent"); }
          asm volatile("s_waitcnt vmcnt(0)" ::: "memory");
          __syncthreads();
          const unsigned long long* sl = (const unsigned long long*)(SSQX + ((size_t)r0 + m) * 16); float t = 0.f;
#pragma unroll
          for (int j = 0; j < 8; ++j) { const unsigned long long w = __hip_atomic_load(sl + j, __ATOMIC_RELAXED, __HIP_MEMORY_SCOPE_AGENT); t += __uint_as_float((unsigned)w) + __uint_as_float((unsigned)(w >> 32)); }
          const float rs = 1.0f / sqrtf(t * (1.0f / 1024.0f) + 1e-6f);
          const f32x4 g0 = *(const f32x4*)(gain + c0 + n8), g1 = *(const f32x4*)(gain + c0 + n8 + 4);
          *(f32x4*)(outf + off) = v0 * rs * g0; *(f32x4*)(outf + off + 4) = v1 * rs * g1; } }
}
}
constexpr size_t MiB = 1u << 20;
constexpr size_t WS_CTL = 0, CTL_ZERO_BYTES = 64 * 1024;
constexpr size_t WS_WGU1 = 2 * MiB, WS_WD1 = 14 * MiB, WS_WGU2 = 20 * MiB, WS_WD2 = 32 * MiB, WS_WIN = 38 * MiB, WS_WOUT = 42 * MiB, WS_WQ = 44 * MiB, WS_SUM = 46 * MiB, WS_WGT = 48 * MiB, WS_SSQ = 49 * MiB, WS_KCS = 50 * MiB, WS_WUVF = 51 * MiB, WS_CKV = 52 * MiB, WS_SSQX = 61 * MiB, WS_WQP = 45 * MiB, WS_WKV = 45 * MiB + 512 * 1024;
static_assert(WS_SSQX + (size_t)R * 64 <= 64 * MiB && WS_WQ + (size_t)NQ * QL * 2 <= WS_WQP && WS_WQP + (size_t)NH * 96 * QL * 2 <= WS_WKV && WS_WKV + (size_t)NH * 128 * KVL * 2 <= WS_SUM, "workspace map");
constexpr size_t WS_XN = 64 * MiB, WS_H = 100 * MiB, WS_X1 = 200 * MiB, WS_X2 = 270 * MiB, WS_Z = 340 * MiB, WS_QALL = 444 * MiB, WS_CQN = 530 * MiB;
constexpr size_t WS_A = 540 * MiB, WS_U = 576 * MiB, WS_YL = 612 * MiB, WS_OLAT = 648 * MiB, WS_YC = 720 * MiB, WS_QB = 760 * MiB, WS_KC = 820 * MiB, WS_PART = 830 * MiB, WS_XL = 900 * MiB, WS_GG = 920 * MiB, WS_CQ = 940 * MiB, WS_QBP = 950 * MiB, WS_KVH = 980 * MiB, WS_CKVB = 1024 * MiB, WS_SSQM = 1030 * MiB, WS_XCH = 1032 * MiB  , WS_END = 1034 * MiB;
constexpr int CW_QUE = 256;
constexpr int CW_BAR = 1024;
constexpr int CW_FIN = 8192, CW_FINS = 12288;
static_assert((CW_BAR + XCD_BAR_WORDS) <= CW_FIN && (CW_FINS + 64 * (RS / 64)) * 4 <= (int)CTL_ZERO_BYTES && CW_FIN + 64 * (RP / 256) <= CW_FINS, "CTL");
constexpr int RING_BYTES = 131072, LDS_BYTES = 147456, LDSCTL_OFF = LDS_BYTES - 1024, MISC_OFF = LDSCTL_OFF + 320;
static_assert(att::PR_LDS_END <= LDSCTL_OFF, "prompt attention LDS map");
constexpr int NSPLIT = 2;
constexpr int CHUNK = 64, NCHUNK = SEQ / CHUNK;

struct Params { const float* in[33]; float* out; unsigned char* ws; int ph_lo, ph_hi; };
static_assert(sizeof(Params) == 33 * 8 + 8 + 8 + 8, "Params has no padding");

__device__ __forceinline__ void transpose_tile(const float* __restrict__ src, int ldw, bf16* __restrict__ dst, int ldt, LAS float* scr, int lane, const float* __restrict__ gain) {
    {
        const float* wp = src + (size_t)(lane >> 5) * ldw + (lane & 31); float v[32];
#pragma unroll
        for (int i = 0; i < 32; ++i) v[i] = __builtin_nontemporal_load(wp + (size_t)(2 * i) * ldw);
        if (gain) { float g[32];
#pragma unroll
            for (int i = 0; i < 32; ++i) g[i] = gain[2 * i + (lane >> 5)];
#pragma unroll
            for (int i = 0; i < 32; ++i) v[i] *= g[i]; }
#pragma unroll
        for (int i = 0; i < 32; ++i) scr[(2 * i + (lane >> 5)) * 33 + (lane & 31)] = v[i]; }
    LDS_WAIT(); asm volatile("" ::: "memory");
    const int c = lane & 7;
#pragma unroll
    for (int j = 0; j < 4; ++j) { const int n = (lane >> 3) + 8 * j; const LAS float* sp = scr + (8 * c) * 33 + n;
        v4u o; o.x = pk2(sp[0 * 33], sp[1 * 33]); o.y = pk2(sp[2 * 33], sp[3 * 33]); o.z = pk2(sp[4 * 33], sp[5 * 33]); o.w = pk2(sp[6 * 33], sp[7 * 33]);
        *(v4u*)(dst + (size_t)n * ldt + 8 * c) = o; }
    LDS_WAIT(); asm volatile("" ::: "memory");
}
template <bool OUT_BF16>
__device__ __forceinline__ void rmsnorm_rows(const float* __restrict__ x0, const float* __restrict__ x1, int split, const float* __restrict__ gain, void* __restrict__ outp) {
    const int lane = threadIdx.x & 63, gw = blockIdx.x * 8 + __builtin_amdgcn_readfirstlane(threadIdx.x >> 6), NGW = gridDim.x * 8;
    for (int row = gw; row < R; row += NGW) {
        const float* xr = (row < split) ? x0 + (size_t)row * DM : x1 + (size_t)(row - split) * DM;
        f32x4 v[4]; float s = 0.f;
#pragma unroll
        for (int j = 0; j < 4; ++j) { v[j] = ((const f32x4*)xr)[lane + 64 * j]; s += (v[j].x * v[j].x + v[j].y * v[j].y) + (v[j].z * v[j].z + v[j].w * v[j].w); }
        const float rstd = 1.0f / sqrtf(wave_sum(s) * (1.0f / DM) + EPS);
#pragma unroll
        for (int j = 0; j < 4; ++j) { const f32x4 g = ((const f32x4*)gain)[lane + 64 * j]; const f32x4 o = v[j] * rstd * g;
            if (OUT_BF16) { unsigned long long w = (unsigned long long)pk2(o.x, o.y) | ((unsigned long long)pk2(o.z, o.w) << 32); ((unsigned long long*)((bf16*)outp + (size_t)row * DM))[lane + 64 * j] = w; }
            else ((f32x4*)((float*)outp + (size_t)row * DM))[lane + 64 * j] = o; }
    }
}
__device__ __forceinline__ void final_norm_rows(const bf16* __restrict__ XB, const float* __restrict__ SSQX, const float* __restrict__ gain, float* __restrict__ outp) {
    const int lane = threadIdx.x & 63, gw = blockIdx.x * 8 + __builtin_amdgcn_readfirstlane(threadIdx.x >> 6), NGW = gridDim.x * 8;
    const f32x4 g00 = ((const f32x4*)gain)[2 * lane], g01 = ((const f32x4*)gain)[2 * lane + 1], g10 = ((const f32x4*)gain)[2 * (lane + 64)], g11 = ((const f32x4*)gain)[2 * (lane + 64) + 1];
    for (int row = gw; row < R; row += 2 * NGW) {
        const int row2 = row + NGW; const bool two = row2 < R; const int rb_ = two ? row2 : row;
        const v4u wa0 = ((const v4u*)(XB + (size_t)row * DM))[lane], wa1 = ((const v4u*)(XB + (size_t)row * DM))[lane + 64];
        const v4u wb0 = ((const v4u*)(XB + (size_t)rb_ * DM))[lane], wb1 = ((const v4u*)(XB + (size_t)rb_ * DM))[lane + 64];
        const f32x4* spa = (const f32x4*)(SSQX + (size_t)row * 16); const f32x4* spb = (const f32x4*)(SSQX + (size_t)rb_ * 16);
        const f32x4 ta = (spa[0] + spa[1]) + (spa[2] + spa[3]), tb = (spb[0] + spb[1]) + (spb[2] + spb[3]);
        const float ra = 1.0f / sqrtf(((ta[0] + ta[1]) + (ta[2] + ta[3])) * (1.0f / DM) + EPS), rbs = 1.0f / sqrtf(((tb[0] + tb[1]) + (tb[2] + tb[3])) * (1.0f / DM) + EPS);
#define FN_OUT(W_, RS_, GA_, GB_, DST_) do { f32x4 o0, o1; \
            o0[0] = __uint_as_float((W_).x << 16) * (RS_) * (GA_)[0]; o0[1] = __uint_as_float((W_).x & 0xffff0000u) * (RS_) * (GA_)[1]; o0[2] = __uint_as_float((W_).y << 16) * (RS_) * (GA_)[2]; o0[3] = __uint_as_float((W_).y & 0xffff0000u) * (RS_) * (GA_)[3]; \
            o1[0] = __uint_as_float((W_).z << 16) * (RS_) * (GB_)[0]; o1[1] = __uint_as_float((W_).z & 0xffff0000u) * (RS_) * (GB_)[1]; o1[2] = __uint_as_float((W_).w << 16) * (RS_) * (GB_)[2]; o1[3] = __uint_as_float((W_).w & 0xffff0000u) * (RS_) * (GB_)[3]; \
            (DST_)[0] = o0; (DST_)[1] = o1; } while (0)
        FN_OUT(wa0, ra, g00, g01, (f32x4*)(outp + (size_t)row * DM) + 2 * lane);
        FN_OUT(wa1, ra, g10, g11, (f32x4*)(outp + (size_t)row * DM) + 2 * (lane + 64));
        if (two) { FN_OUT(wb0, rbs, g00, g01, (f32x4*)(outp + (size_t)row2 * DM) + 2 * lane); FN_OUT(wb1, rbs, g10, g11, (f32x4*)(outp + (size_t)row2 * DM) + 2 * (lane + 64)); }
#undef FN_OUT
    }
}
template <int MODE>
__device__ __forceinline__ void weight_items(const Params& p, LAS unsigned char* lds, int gw, int NGW) {
    const int tid = threadIdx.x, lane = tid & 63, wave = __builtin_amdgcn_readfirstlane(tid >> 6);
    unsigned char* ws = p.ws;
    LAS float* scr = (LAS float*)(lds + wave * 16384);
    constexpr int I_F = (DM / 64) * (DFF / 32), I_IN = (DM / 64) * (DIN / 32), I_OUT = (DMIX / 64) * (DM / 32);
    constexpr int I_WQ = NH * (QL / 64) * (KVL / 8), I_QP = (QL / 64) * (NH * 96 / 32), I_QR = (QL / 64) * NH, I_KV = (KVL / 64) * NH * 4, I_GT = NBLK * 2 * 2;
    constexpr int NITEMS = I_WQ + 6 * I_F + I_IN + I_OUT + I_QP + I_QR + I_KV + I_GT;
    static_assert((DFF / 64) * (DM / 32) == I_F, "down items");
    const float* wq = p.in[21]; const float* wuk = p.in[23]; const float* qn = p.in[20]; bf16* WqT = (bf16*)(ws + WS_WQ);
    constexpr bool LATE = MODE == 2;
    constexpr int NE = 2 * I_F + I_IN, NM = I_F, ND = I_F, NL = NITEMS - I_WQ - NE - NM - ND;
    for (int it = gw; it < (MODE == 2 ? I_WQ + NL : MODE == 1 ? NM : MODE == 3 ? ND : NE); it += NGW) {
        int r;
        if (MODE == 2) { r = it; if (it >= I_WQ) { const int l = it - I_WQ; r = I_WQ + (l < 2 * I_F ? l + 3 * I_F : l + 4 * I_F + I_IN); } }
        else if (MODE == 1) r = I_WQ + it + 2 * I_F;
        else if (MODE == 3) r = I_WQ + it + 5 * I_F;
        else r = I_WQ + (it < 2 * I_F ? it : it + 4 * I_F);
        if (r < I_WQ) {
            const int h = r / ((QL / 64) * (KVL / 8)), kt = (r / (KVL / 8)) % (QL / 64), cg = r % (KVL / 8), k = 64 * kt + lane;
            f32x4 a[16];
#pragma unroll
            for (int j = 0; j < 16; ++j) a[j] = *(const f32x4*)(wq + (size_t)k * (NH * 96) + h * 96 + 4 * j);
            const float gk = qn[k];
#pragma unroll 1
            for (int c = 8 * cg; c < 8 * cg + 8; c += 2) { const f32x4* b0 = (const f32x4*)(wuk + ((size_t)c * NH + h) * NOPE); const f32x4* b1 = (const f32x4*)(wuk + ((size_t)(c + 1) * NH + h) * NOPE);
                f32x4 u[16], w[16];
#pragma unroll
                for (int j = 0; j < 16; ++j) { u[j] = b0[j]; w[j] = b1[j]; }
                f32x4 s4 = {0.f, 0.f, 0.f, 0.f}, t4 = {0.f, 0.f, 0.f, 0.f};
#pragma unroll
                for (int j = 0; j < 16; ++j) { s4 = s4 + a[j] * u[j]; t4 = t4 + a[j] * w[j]; }
                WqT[(size_t)(h * KVL + c) * QL + k] = (bf16)f2bf(((s4[0] + s4[1]) + (s4[2] + s4[3])) * gk);
                WqT[(size_t)(h * KVL + c + 1) * QL + k] = (bf16)f2bf(((t4[0] + t4[1]) + (t4[2] + t4[3])) * gk); }
            continue; }
        r -= I_WQ;
        const float* src; bf16* dst; const float* gain = nullptr; int ldw, ldt;
        if (r < 6 * I_F) { const int which = r / I_F, q = r % I_F;
            const bool down = which == 2 || which == 5; const int K = down ? DFF : DM, N = down ? DM : DFF, nblk = N / 32, k0 = 64 * (q / nblk), n0 = 32 * (q % nblk);
            const int inp = which == 0 ? 8 : which == 1 ? 9 : which == 2 ? 10 : which == 3 ? 29 : which == 4 ? 30 : 31;
            const size_t wsoff = which < 2 ? WS_WGU1 : which == 2 ? WS_WD1 : which < 5 ? WS_WGU2 : WS_WD2;
            const int drow0 = down ? n0 : 256 * (n0 / 128) + (n0 % 128) + ((which == 1 || which == 4) ? 128 : 0);
            src = p.in[inp] + (size_t)k0 * N + n0; ldw = N; dst = (bf16*)(ws + wsoff) + (size_t)drow0 * K + k0; ldt = K; if (which == 3 || which == 4) gain = p.in[28] + k0; }
        else if ((r -= 6 * I_F) < I_IN) { const int nblk = DIN / 32, k0 = 64 * (r / nblk), n0 = 32 * (r % nblk);
            src = p.in[12] + (size_t)k0 * DIN + n0; ldw = DIN; dst = (bf16*)(ws + WS_WIN) + (size_t)n0 * DM + k0; ldt = DM; gain = p.in[11] + k0; }
        else if ((r -= I_IN) < I_OUT) { const int nblk = DM / 32, k0 = 64 * (r / nblk), n0 = 32 * (r % nblk);
            src = p.in[27] + (size_t)k0 * DM + n0; ldw = DM; dst = (bf16*)(ws + WS_WOUT) + (size_t)n0 * DMIX + k0; ldt = DMIX; }
        else if ((r -= I_OUT) < I_QP) { const int nblk = NH * 96 / 32, k0 = 64 * (r / nblk), n0 = 32 * (r % nblk);
            const int col = (n0 < NH * NOPE) ? (n0 / NOPE) * 96 + (n0 % NOPE) : ((n0 - NH * NOPE) / ROPE) * 96 + NOPE;
            src = wq + (size_t)k0 * (NH * 96) + col; ldw = NH * 96; dst = (bf16*)(ws + WS_WQP) + (size_t)n0 * QL + k0; ldt = QL; gain = qn + k0; }
        else if ((r -= I_QP) < I_QR) { const int k0 = 64 * (r / NH), h = r % NH;
            src = wq + (size_t)k0 * (NH * 96) + h * 96 + NOPE; ldw = NH * 96; dst = WqT + (size_t)(NH * KVL + ROPE * h) * QL + k0; ldt = QL; gain = qn + k0; }
        else if ((r -= I_QR) < I_KV) { const int c0 = 64 * (r / (NH * 4)), h = (r >> 2) % NH, jb = r & 3;
            src = (jb < 2 ? wuk : p.in[24]) + (size_t)c0 * (NH * NOPE) + h * NOPE + 32 * (jb & 1); ldw = NH * NOPE; dst = (bf16*)(ws + WS_WKV) + (size_t)(h * 128 + 32 * jb) * KVL + c0; ldt = KVL; gain = p.in[22] + c0; }
        else { r -= I_KV; const int n = r >> 2, g = (r >> 1) & 1, eb = r & 1;
            src = (g ? p.in[17] : p.in[15]) + (size_t)n * BLK * BLK + 32 * eb; ldw = BLK; dst = (bf16*)(ws + WS_WGT) + (size_t)((n * 2 + g) * BLK + 32 * eb) * BLK; ldt = BLK; }
        transpose_tile(src, ldw, dst, ldt, scr, lane, gain);
    }
}
__device__ __forceinline__ void p_prologue(const Params& p, LAS unsigned char* lds) {
    const int tid = threadIdx.x, lane = tid & 63, wave = __builtin_amdgcn_readfirstlane(tid >> 6), gw = blockIdx.x * 8 + wave, NGW = gridDim.x * 8;
    unsigned char* ws = p.ws;
    LAS float* scr = (LAS float*)(lds + wave * 16384);
    weight_items<0>(p, lds, gw, NGW);
    const int gt = blockIdx.x * 512 + tid, NGT = gridDim.x * 512;
    { unsigned* z = (unsigned*)((bf16*)(ws + WS_WIN) + (size_t)DIN * DM); for (int i = gt; i < (DINP - DIN) * DM / 2; i += NGT) z[i] = 0u; }
    { const int xcd = (int)(blockIdx.x & 7), jb = (int)(blockIdx.x >> 3), nb = (int)(gridDim.x >> 3); const float* gain = p.in[7]; bf16* XNp = (bf16*)(ws + WS_XN);
      if ((gridDim.x & 7) == 0) {
          const int rows_x = R / 8, r_lo = xcd * rows_x + (jb * rows_x) / nb, r_hi = xcd * rows_x + ((jb + 1) * rows_x) / nb;
          for (int row = r_lo + 2 * wave; row < r_hi; row += 16) {
              const bool two = row + 1 < r_hi;
              const float* xa = (row < RP) ? p.in[0] + (size_t)row * DM : p.in[1] + (size_t)(row - RP) * DM;
              const float* xb = (row + 1 < RP) ? p.in[0] + (size_t)(row + 1) * DM : p.in[1] + (size_t)(row + 1 - RP) * DM;
              f32x4 va[4], vb[4]; float sa = 0.f, sb = 0.f;
#pragma unroll
              for (int j = 0; j < 4; ++j) { va[j] = ((const f32x4*)xa)[lane + 64 * j]; vb[j] = two ? ((const f32x4*)xb)[lane + 64 * j] : va[j]; }
#pragma unroll
              for (int j = 0; j < 4; ++j) { sa += (va[j].x * va[j].x + va[j].y * va[j].y) + (va[j].z * va[j].z + va[j].w * va[j].w); sb += (vb[j].x * vb[j].x + vb[j].y * vb[j].y) + (vb[j].z * vb[j].z + vb[j].w * vb[j].w); }
              const float ra = 1.0f / sqrtf(wave_sum(sa) * (1.0f / DM) + EPS), rb = 1.0f / sqrtf(wave_sum(sb) * (1.0f / DM) + EPS);
#pragma unroll
              for (int j = 0; j < 4; ++j) { const f32x4 g = ((const f32x4*)gain)[lane + 64 * j]; const f32x4 oa = va[j] * ra * g, ob = vb[j] * rb * g;
                  ((unsigned long long*)(XNp + (size_t)row * DM))[lane + 64 * j] = (unsigned long long)pk2(oa.x, oa.y) | ((unsigned long long)pk2(oa.z, oa.w) << 32);
                  if (two) ((unsigned long long*)(XNp + (size_t)(row + 1) * DM))[lane + 64 * j] = (unsigned long long)pk2(ob.x, ob.y) | ((unsigned long long)pk2(ob.z, ob.w) << 32); }
          }
      } else rmsnorm_rows<true>(p.in[0], p.in[1], RP, p.in[7], ws + WS_XN);
    }
}

__device__ __forceinline__ float half_sum(float v, LAS float* red4) {
    v = wave_sum(v);
    __syncthreads();
    if ((threadIdx.x & 63) == 0) red4[(threadIdx.x >> 6) & 3] = v;
    __syncthreads();
    return (red4[0] + red4[1]) + (red4[2] + red4[3]);
}
__device__ __forceinline__ void p_ckv_norm(const Params& p) {
    const int lane = threadIdx.x & 63, gw = blockIdx.x * 8 + __builtin_amdgcn_readfirstlane(threadIdx.x >> 6), NGW = gridDim.x * 8;
    const float* CKV = (const float*)(p.ws + WS_CKV); const float* SSQ = (const float*)(p.ws + WS_SSQ); bf16* KC = (bf16*)(p.ws + WS_KC); bf16* KCS = (bf16*)(p.ws + WS_KCS);
    const float2 g2 = ((const float2*)p.in[22])[lane];
    for (int row = gw; row < R; row += NGW) {
        const float2 v = ((const float2*)(CKV + (size_t)row * KVL))[lane]; const f32x4 sq = *(const f32x4*)(SSQ + (size_t)row * 8 + 4);
        const float rstd = 1.0f / sqrtf(((sq[0] + sq[1]) + (sq[2] + sq[3])) * (1.0f / KVL) + EPS);
        float2 o; o.x = v.x * rstd * g2.x; o.y = v.y * rstd * g2.y;
        if (row < RP) { ((float2*)(p.out + O_KVP + (size_t)row * KVL))[lane] = o; }
        else { ((float2*)(p.out + O_KVS + (size_t)(row - RP) * KVL))[lane] = o; ((unsigned*)(KCS + (size_t)(row - RP) * QD))[lane] = pk2(o.x, o.y); }
    }
}

__device__ __forceinline__ void p_mla_norm(const Params& p, int first_block, int nblocks) {
    const int lane = threadIdx.x & 63, gw = ((int)blockIdx.x - first_block) * 8 + __builtin_amdgcn_readfirstlane(threadIdx.x >> 6), NGW = nblocks * 8;
    bf16* YCp = (bf16*)(p.ws + WS_YC); const float* SSQM = (const float*)(p.ws + WS_SSQM); const float* gm = p.in[26];
    const f32x4 g0 = ((const f32x4*)gm)[2 * lane], g1 = ((const f32x4*)gm)[2 * lane + 1];
    for (int row0 = gw; row0 < RP; row0 += 4 * NGW) {
        v4u w[4]; f32x4 t[4];
#pragma unroll
        for (int i = 0; i < 4; ++i) { const int row = row0 + i * NGW < RP ? row0 + i * NGW : row0;
            w[i] = *((const v4u*)(YCp + (size_t)row * DMIX + DLRU) + lane); const f32x4* sp = (const f32x4*)(SSQM + (size_t)row * NH); t[i] = sp[0] + sp[1]; }
#pragma unroll
        for (int i = 0; i < 4; ++i) { const int row = row0 + i * NGW; if (row < RP) {
            const float rstd = 1.0f / sqrtf(((t[i][0] + t[i][1]) + (t[i][2] + t[i][3])) * (1.0f / DMLA) + EPS); v4u o;
            o.x = pk2(__uint_as_float(w[i].x << 16) * rstd * g0[0], __uint_as_float(w[i].x & 0xffff0000u) * rstd * g0[1]); o.y = pk2(__uint_as_float(w[i].y << 16) * rstd * g0[2], __uint_as_float(w[i].y & 0xffff0000u) * rstd * g0[3]);
            o.z = pk2(__uint_as_float(w[i].z << 16) * rstd * g1[0], __uint_as_float(w[i].z & 0xffff0000u) * rstd * g1[1]); o.w = pk2(__uint_as_float(w[i].w << 16) * rstd * g1[2], __uint_as_float(w[i].w & 0xffff0000u) * rstd * g1[3]);
            *((v4u*)(YCp + (size_t)row * DMIX + DLRU) + lane) = o; } }
    }
}

#define GEMM_PHASE_AT(Epi, shift, Mm, Aptr, Bptr, Nn, Kk, Eobj) do { pg8::Gemm g_{(const pg8::bf16_t*)(Aptr), (const pg8::bf16_t*)(Bptr), (Mm), (Nn), (Kk)}; pg8::StaticOrder S_; S_.init((Mm), (Nn), (int)gridDim.x, (int)((blockIdx.x + gridDim.x - (shift)) % gridDim.x)); \
    pg8::gemm_phase<Epi, pg8::StaticOrder, true, true>((PG8_LAS unsigned char*)lds, g_, S_, (Eobj)); } while (0)
#define GEMM_PHASE(Epi, Mm, Aptr, Bptr, Nn, Kk, Eobj) do { pg8::Gemm g_{(const pg8::bf16_t*)(Aptr), (const pg8::bf16_t*)(Bptr), (Mm), (Nn), (Kk)}; pg8::StaticOrder S_; S_.init((Mm), (Nn), (int)gridDim.x, (int)blockIdx.x); \
    pg8::gemm_phase<Epi, pg8::StaticOrder, true, true>((PG8_LAS unsigned char*)lds, g_, S_, (Eobj)); } while (0)
constexpr int N_PHASES = 13;
__global__ void __launch_bounds__(512, 2) mega(Params p) {
    extern __shared__ __attribute__((aligned(16))) unsigned char lds_raw[];
    LAS unsigned char* lds = (LAS unsigned char*)lds_raw;
    volatile LAS unsigned* MISC = (volatile LAS unsigned*)(lds + MISC_OFF);
    for (int u = threadIdx.x; u < (LDS_BYTES - LDSCTL_OFF) / 4; u += 512) ((LAS unsigned*)(lds + LDSCTL_OFF))[u] = 0u;
    __syncthreads();
    unsigned char* ws = p.ws; float* out = p.out;
    XcdBarrier bar = xcd_barrier_post((unsigned*)(ws + WS_CTL) + CW_BAR, MISC + 8);
    const int lo = p.ph_lo, hi = p.ph_hi;
#ifdef ONLY_PHASE
#define IN(k) ((k) == ONLY_PHASE && lo <= (k) && (k) < hi)
#else
#define IN(k) (lo <= (k) && (k) < hi)
#endif
#ifndef PROBE
#define PROBE -1
#endif
#define SEAM(k) do { if (IN(k) && IN((k) + 1)) { xcd_barrier(bar); if (PROBE == 99) xcd_barrier(bar); } } while (0)
#define REP(id, ...) do { __VA_ARGS__; if (PROBE == (id)) { __syncthreads(); __VA_ARGS__; } } while (0)
#define Wgu1 ((bf16*)(ws + WS_WGU1))
#define Wd1 ((bf16*)(ws + WS_WD1))
#define Wgu2 ((bf16*)(ws + WS_WGU2))
#define Wd2 ((bf16*)(ws + WS_WD2))
#define Win ((bf16*)(ws + WS_WIN))
#define Wout ((bf16*)(ws + WS_WOUT))
#define Wq ((bf16*)(ws + WS_WQ))
#define XN ((bf16*)(ws + WS_XN))
#define H ((bf16*)(ws + WS_H))
#define YC ((bf16*)(ws + WS_YC))
#define Qb ((bf16*)(ws + WS_QB))
#define KC ((bf16*)(ws + WS_KC))
#define PART ((float*)(ws + WS_PART))
#define CKV ((float*)(ws + WS_CKV))
#define SSQ ((float*)(ws + WS_SSQ))
#define SUM ((float*)(ws + WS_SUM))
#define SSQX ((float*)(ws + WS_SSQX))
#define XL ((bf16*)(ws + WS_XL))
#define GG ((bf16*)(ws + WS_GG))
#define CQ ((bf16*)(ws + WS_CQ))
#define KCS ((bf16*)(ws + WS_KCS))
#define WGT ((bf16*)(ws + WS_WGT))
#define WUVF ((bf16*)(ws + WS_WUVF))
#define WqP ((bf16*)(ws + WS_WQP))
#define Wkv ((bf16*)(ws + WS_WKV))
#define QbP ((bf16*)(ws + WS_QBP))
#define KVH ((bf16*)(ws + WS_KVH))
#define CKVB ((bf16*)(ws + WS_CKVB))
#define SSQM ((float*)(ws + WS_SSQM))
    if (IN(0)) REP(0, p_prologue(p, lds));
    SEAM(0);
    if (IN(1)) { pg8::EpiSwiGLU E{H, nullptr, DFF, 0}; REP(1, GEMM_PHASE(pg8::EpiSwiGLU, R, XN, Wgu1, NGU, DM, E));
        { const int G = (int)gridDim.x, nwg1 = (R / 256) * (NGU / 256), rem = nwg1 % G; int fb = rem, nfree = G - rem; if (rem == 0 || nfree < 32) { fb = 0; nfree = G; }
          __syncthreads();
          if ((int)blockIdx.x >= fb) weight_items<1>(p, lds, ((int)blockIdx.x - fb) * 8 + __builtin_amdgcn_readfirstlane(threadIdx.x >> 6), nfree * 8); } }
    SEAM(1);
    if (IN(2)) {
        if (blockIdx.x & 1) for (int mu = blockIdx.x; mu < (RS / 64) * (DM / 64); mu += gridDim.x) { const int r0 = RP + 64 * (mu >> 4), c0 = 64 * (mu & 15);
            sg::unit64((att::ldsp)lds, H, Wd1, DFF, r0, c0, p.in[1] - (size_t)RP * DM, XN, SSQX, 0.5f); }
        { pg8::EpiRes<true> E{p.in[0], XN, SSQX, 0.5f, 0}; GEMM_PHASE(pg8::EpiRes<true>, RP, H, Wd1, DM, DFF, E); }
        if (!(blockIdx.x & 1)) for (int mu = blockIdx.x; mu < (RS / 64) * (DM / 64); mu += gridDim.x) { const int r0 = RP + 64 * (mu >> 4), c0 = 64 * (mu & 15);
            sg::unit64((att::ldsp)lds, H, Wd1, DFF, r0, c0, p.in[1] - (size_t)RP * DM, XN, SSQX, 0.5f); }
    }
    SEAM(2);
    if (IN(4)) { pg8::EpiZ E{XL, GG, CQ, CKV, SSQ, out, KC, KCS, SSQX, CKVB}; REP(4, GEMM_PHASE(pg8::EpiZ, R, XN, Win, DINP, DM, E));
        { const int G = (int)gridDim.x, nwg4 = (R / 256) * (DINP / 256), rem = nwg4 % G; int fb = rem, nfree = G - rem; if (rem == 0 || nfree < 32) { fb = 0; nfree = G; }
          __syncthreads();
          if ((int)blockIdx.x >= fb) weight_items<2>(p, lds, ((int)blockIdx.x - fb) * 8 + __builtin_amdgcn_readfirstlane(threadIdx.x >> 6), nfree * 8); } }
    SEAM(4);
    lru::State st;
    const bool has_chunk = blockIdx.x < NB * NCHUNK;
    const int cb_ = (int)blockIdx.x / NCHUNK, cc_ = (int)blockIdx.x % NCHUNK;
    const size_t crow0 = (size_t)cb_ * SEQ + (size_t)cc_ * CHUNK;
    if (IN(5)) {
        { pg8::EpiQP E{QbP, SSQ, QSCALE, 0}; GEMM_PHASE_AT(pg8::EpiQP, 0, RP, CQ, WqP, NH * 96, QL, E); }
        { pg8::EpiQ E{Qb + (size_t)RP * NH * QD, SSQ + (size_t)RP * 8, QSCALE, 1}; GEMM_PHASE_AT(pg8::EpiQ, 192, RS, CQ + (size_t)RP * QL, Wq, NQ, QL, E); }
        { pg8::EpiKV E{KVH, SSQ, KC}; GEMM_PHASE_AT(pg8::EpiKV, 64, RP, CKVB, Wkv, NH * 128, KVL, E); }
        REP(51, p_ckv_norm(p));
        REP(52, if (has_chunk) lru::unit_pre<false>((att::ldsp)lds, st, XL, WGT, p.in[13], p.in[14], p.in[16], p.in[18], p.in[19], p.in[5], p.in[4], out, crow0, cb_, cc_ * CHUNK, SUM + ((size_t)blockIdx.x * DLRU) * 2));
    }
    SEAM(5);
    if (IN(6)) {
        if (has_chunk) {
            const int ch = (int)threadIdx.x;
            const float cr = lru::chunk_carry(SUM + (size_t)cb_ * NCHUNK * DLRU * 2, cc_, ch);
            if (cc_ == NCHUNK - 1) { const float2 sv = *(const float2*)(SUM + ((size_t)blockIdx.x * DLRU + ch) * 2); out[O_HP + (size_t)cb_ * DLRU + ch] = sv.y + sv.x * cr; }
            const float c0 = __shfl(cr, (int)threadIdx.x & 31), c1 = __shfl(cr, 32 + ((int)threadIdx.x & 31));
            lru::unit_post((att::ldsp)lds, st, GG, p.in[25], YC, crow0, c0, c1);
        }
        if (threadIdx.x == 0) { *(LAS unsigned*)(lds + att2::L_BAR) = 0u; *(LAS unsigned*)(lds + att2::L_BAR + 64) = 0u; }
        __syncthreads();
        { unsigned bt = 0u;
          if (__builtin_amdgcn_readfirstlane(threadIdx.x >> 6) < 4) {
              _Pragma("unroll 1") for (int bx = (int)blockIdx.x; bx < NB * NH * 16; bx += (int)gridDim.x) { const int x = bx & 7, y = (bx >> 3) & 31, bh = x + 8 * (y & 1), pr = y >> 1;
                  _Pragma("unroll 1") for (int u = 0; u < (PROBE == 61 ? 4 : 2); ++u) att2::prompt_role((att::ldsp)lds, QbP, KVH, SSQM, YC, bh >> 3, bh & 7, (u & 1) ? pr : 31 - pr, bt); }
          } else {
              _Pragma("unroll 1") for (int rep_ = 0; rep_ < (PROBE == 62 ? 2 : 1); ++rep_)
              _Pragma("unroll 1") for (int item = blockIdx.x; item < DB * NSPLIT; item += gridDim.x) { const int db = item / NSPLIT, ch = item % NSPLIT;
                  att2::decode_role((att::ldsp)lds, Qb, p.in[2], p.in[3], (const int*)p.in[6], PART + (size_t)item * 2 * att::PART_FLOATS, db, ch * (NPAGES / NSPLIT), NPAGES / NSPLIT, bt); }
          } }
        __syncthreads();
    }
    SEAM(6);
    if (IN(7)) {
        if (blockIdx.x >= DB + RS / 32) p_mla_norm(p, DB + RS / 32, (int)gridDim.x - (DB + RS / 32));
        if (blockIdx.x >= DB && blockIdx.x < DB + RS / 32) {
            lru::State s2; const int su = (int)blockIdx.x - DB; const size_t r0 = (size_t)RP + 32 * su;
            lru::unit_pre<true, 1>((att::ldsp)lds, s2, XL, WGT, p.in[13], p.in[14], p.in[16], p.in[18], p.in[19], p.in[5], p.in[4], out, r0, 4 * su, 0, nullptr);
            lru::unit_post<1>((att::ldsp)lds, s2, GG, p.in[25], YC, r0, 0.f, 0.f);
        }
        REP(7, for (int db = blockIdx.x; db < DB; db += gridDim.x)
            att::decode_combine((att::ldsp)lds, Qb, out + O_KVS, out + O_KRS, PART + (size_t)db * NSPLIT * 2 * att::PART_FLOATS, NSPLIT, p.in[24], p.in[26], YC, db));
    }
    SEAM(7);
    if (IN(8)) {
        { pg8::EpiRes<false> E{nullptr, XN, SSQX, 1.0f, 0}; REP(80, GEMM_PHASE(pg8::EpiRes<false>, RP, YC, Wout, DM, DMIX, E)); }
        for (int mu = blockIdx.x; mu < (RS / 64) * (DM / 64); mu += gridDim.x) { const int r0 = RP + 64 * (mu >> 4), c0 = 64 * (mu & 15);
            sg::unit64((att::ldsp)lds, YC, Wout, DMIX, r0, c0, nullptr, XN, SSQX, 1.0f); }
    }
    SEAM(8);
    if (IN(10)) { pg8::EpiSwiGLU E{H, SSQX, DFF, 0}; REP(10, GEMM_PHASE(pg8::EpiSwiGLU, R, XN, Wgu2, NGU, DM, E));
        { const int G = (int)gridDim.x, nwg1 = (R / 256) * (NGU / 256), rem = nwg1 % G; int fb = rem, nfree = G - rem; if (rem == 0 || nfree < 32) { fb = 0; nfree = G; }
          __syncthreads();
          if ((int)blockIdx.x >= fb) weight_items<3>(p, lds, ((int)blockIdx.x - fb) * 8 + __builtin_amdgcn_readfirstlane(threadIdx.x >> 6), nfree * 8); } }
    SEAM(10);
    if (IN(11)) {
        { pg8::EpiFinal E{(const pg8::bf16_t*)XN, out, p.in[32], (float*)(ws + WS_XCH), (unsigned*)(ws + WS_CTL) + CW_FIN, 0.5f, 0}; GEMM_PHASE(pg8::EpiFinal, RP, H, Wd2, DM, DFF, E); }
        for (int mu = blockIdx.x; mu < (RS / 64) * (DM / 64); mu += gridDim.x) { const int r0 = RP + 64 * (mu >> 4), c0 = 64 * (mu & 15);
            sg::unit64((att::ldsp)lds, H, Wd2, DFF, r0, c0, nullptr, XN, (float*)(ws + WS_XCH), 0.5f, out, p.in[32], (unsigned*)(ws + WS_CTL) + CW_FINS + 64 * (mu >> 4)); }
    }
#undef Wgu1
#undef Wd1
#undef Wgu2
#undef Wd2
#undef Win
#undef Wout
#undef Wq
#undef XN
#undef H
#undef YC
#undef Qb
#undef KC
#undef PART
#undef CKV
#undef SSQ
#undef SUM
#undef SSQX
#undef XL
#undef GG
#undef CQ
#undef KCS
#undef WGT
#undef WUVF
#undef WqP
#undef Wkv
#undef QbP
#undef KVH
#undef CKVB
#undef SSQM
#undef IN
#undef SEAM
}

#ifndef MK_N_LAUNCHES
#define MK_N_LAUNCHES 1
#endif
extern "C" void kernel_launch(void* const* d_in, const int* in_sizes, int n_in, void* d_out, int out_size, void* d_ws, size_t ws_size, hipStream_t stream) {
    static int grid = 0;
    if (grid == 0) {
        if (n_in != 33 || out_size != (int)O_END || ws_size < WS_END) { fprintf(stderr, "kernel_launch: unexpected shapes (n_in %d, out %d, ws %zu)\n", n_in, out_size, ws_size); grid = -1; return; }
        int dev = 0, cus = 0, per_cu = 0;
        if (hipGetDevice(&dev) != hipSuccess || hipDeviceGetAttribute(&cus, hipDeviceAttributeMultiprocessorCount, dev) != hipSuccess) { grid = -1; return; }
        if (hipFuncSetAttribute((const void*)mega, hipFuncAttributeMaxDynamicSharedMemorySize, LDS_BYTES) != hipSuccess) { fprintf(stderr, "kernel_launch: hipFuncSetAttribute failed\n"); grid = -1; return; }
        if (hipOccupancyMaxActiveBlocksPerMultiprocessor(&per_cu, (const void*)mega, 512, LDS_BYTES) != hipSuccess || per_cu < 1) fprintf(stderr, "kernel_launch: occupancy query says %d\n", per_cu);
        (void)hipGetLastError();
        grid = cus;
    }
    if (grid < 0) return;
    (void)hipMemsetAsync((char*)d_ws + WS_CTL, 0, CTL_ZERO_BYTES, stream);
    Params prm; memset(&prm, 0, sizeof(prm));
    for (int i = 0; i < 33; ++i) prm.in[i] = (const float*)d_in[i];
    prm.out = (float*)d_out; prm.ws = (unsigned char*)d_ws;
    if (MK_N_LAUNCHES == 1) { prm.ph_lo = 0; prm.ph_hi = N_PHASES; hipLaunchKernelGGL(mega, dim3(grid), dim3(512), LDS_BYTES, stream, prm); }
    else for (int k = 0; k < N_PHASES; ++k) { prm.ph_lo = k; prm.ph_hi = k + 1; hipLaunchKernelGGL(mega, dim3(grid), dim3(512), LDS_BYTES, stream, prm); }
}
```
